# Optimizing an MI355X kernel written in HIP

```python
import math
import jax
import jax.numpy as jnp
from jax import lax
import numpy as np

D_MODEL = 1024
BATCH = 16
SEQ = 256
DEPTH = 4
DEC_BATCH = 8
DEC_SEQ = 2048
PAST_LEN = 512

GRID_W = 64
N_BRANCH = 4
BRANCH_W = D_MODEL // 4
HEAD_DIM = 64
Q_BLOCK = 128
NA_HEADS = BRANCH_W // HEAD_DIM
NA_WIN_R = 8
NA_WIN_C = 16
SWA_HEADS = BRANCH_W // HEAD_DIM
SWA_KV_HEADS = SWA_HEADS // 2
SWA_WINDOW = 128
SWA_BLOCK = 128
HY_WIDTH = BRANCH_W
HY_ORDER = 2
HY_FREQS = 16
HY_EMB = 1 + 2 * HY_FREQS
HY_HIDDEN = 64
HY_MIN_DECAY = 3.07
HY_MAX_DECAY = 15.35
DIFF_HD = 32
DIFF_HEADS = BRANCH_W // (2 * DIFF_HD)
D_FF = 128 * ((8 * D_MODEL // 3 + 127) // 128)
ROPE_BASE = 10000.0
EPS = 1e-6
NEG = -1e30
N_MOD = 9
NA_W = 3 * NA_HEADS * HEAD_DIM
SWA_QW = SWA_HEADS * HEAD_DIM
SWA_KVW = SWA_KV_HEADS * HEAD_DIM
SWA_W = SWA_QW + 2 * SWA_KVW
HY_IN_W = 3 * HY_WIDTH
DIFF_W = 3 * DIFF_HEADS * 2 * DIFF_HD
GATE_W = N_BRANCH * D_MODEL
SPLIT_IDX = (NA_W, NA_W + SWA_W, NA_W + SWA_W + HY_IN_W, NA_W + SWA_W + HY_IN_W + DIFF_W)
IN_W = SPLIT_IDX[-1] + GATE_W

kernel_name = 'hybrid_diffusion_trunk_step'

F32 = jnp.float32


def rmsnorm(x, g):
    xf = x.astype(F32)
    y = xf * lax.rsqrt(jnp.mean(xf * xf, axis=-1, keepdims=True) + EPS)
    return (y * g.astype(F32)).astype(x.dtype)


def swiglu(h, w1, w3, w2):
    return (jax.nn.silu(h @ w1) * (h @ w3)) @ w2


def to_heads(t, n):
    B, L, _ = t.shape
    return t.reshape(B, L, n, -1).transpose(0, 2, 1, 3)


def from_heads(t):
    B, H, L, d = t.shape
    return t.transpose(0, 2, 1, 3).reshape(B, L, H * d)


def expand_kv(t):
    return jnp.repeat(t, SWA_HEADS // SWA_KV_HEADS, axis=1)


def rope_tables(L, dh):
    nf = dh // 4
    t = jnp.arange(L)
    freqs = ROPE_BASE ** (-jnp.arange(nf, dtype=F32) / nf)
    ang_r = (t // GRID_W).astype(F32)[:, None] * freqs
    ang_c = (t % GRID_W).astype(F32)[:, None] * freqs
    return (jnp.cos(ang_r), jnp.sin(ang_r), jnp.cos(ang_c), jnp.sin(ang_c))


def apply_rope(x, tabs):
    cr, sr, cc, sc = tabs
    nf = x.shape[-1] // 4
    xf = x.astype(F32)

    def rot(xa, cos, sin):
        a, b = xa[..., :nf], xa[..., nf:]
        return jnp.concatenate([a * cos - b * sin, b * cos + a * sin], axis=-1)

    half = 2 * nf
    out = jnp.concatenate([rot(xf[..., :half], cr, sr), rot(xf[..., half:], cc, sc)], axis=-1)
    return out.astype(x.dtype)


def rope_pair(x, tabs):
    return jnp.concatenate([apply_rope(x[..., :DIFF_HD], tabs), apply_rope(x[..., DIFF_HD:], tabs)], axis=-1)


def dense_attention(q, k, v, sink):
    B, H, Lq, d = q.shape
    nb = Lq // Q_BLOCK
    scale = d ** -0.5
    qb = jnp.moveaxis(q.reshape(B, H, nb, Q_BLOCK, d), 2, 0)

    def block(qi):
        s = jnp.einsum('bhqd,bhkd->bhqk', qi, k).astype(F32) * scale
        if sink is None:
            p = jax.nn.softmax(s, axis=-1)
        else:
            s_sink = jnp.broadcast_to(sink.astype(F32)[None, :, None, None], s.shape[:-1] + (1,))
            p = jax.nn.softmax(jnp.concatenate([s, s_sink], axis=-1), axis=-1)[..., :-1]
        return jnp.einsum('bhqk,bhkd->bhqd', p.astype(v.dtype), v)

    o = lax.map(block, qb)
    return jnp.moveaxis(o, 0, 2).reshape(B, H, Lq, v.shape[-1])


def diff_attention(q, k, v, lam):
    B, H, Lq, _ = q.shape
    Lk = k.shape[2]
    nb = Lq // Q_BLOCK
    scale = DIFF_HD ** -0.5
    qb = jnp.moveaxis(q.reshape(B, H, nb, Q_BLOCK, 2, DIFF_HD), 2, 0)
    kk = k.reshape(B, H, Lk, 2, DIFF_HD)

    def block(qi):
        s = jnp.einsum('bhqmd,bhkmd->bhmqk', qi, kk).astype(F32) * scale
        p = jax.nn.softmax(s, axis=-1)
        a = p[:, :, 0] - lam * p[:, :, 1]
        return jnp.einsum('bhqk,bhkd->bhqd', a.astype(v.dtype), v)

    o = lax.map(block, qb)
    return jnp.moveaxis(o, 0, 2).reshape(B, H, Lq, v.shape[-1])


def neighbourhood_attention(q, k, v, kc, vc, rpb):
    B, H, L, d = q.shape
    R = L // GRID_W
    kh = min(NA_WIN_R, R)
    scale = d ** -0.5
    qg = q.reshape(B, H, R, GRID_W, d)
    r = jnp.arange(R)
    rows = jnp.clip(r - kh // 2, 0, R - kh)[:, None] + jnp.arange(kh)[None, :]
    k_win = k.reshape(B, H, R, GRID_W, d)[:, :, rows]
    v_win = v.reshape(B, H, R, GRID_W, d)[:, :, rows]
    col = jnp.arange(GRID_W)
    c0 = jnp.clip(col - NA_WIN_C // 2, 0, GRID_W - NA_WIN_C)
    col_ok = (col[None, :] >= c0[:, None]) & (col[None, :] < c0[:, None] + NA_WIN_C)
    d_row = rows - r[:, None] + (NA_WIN_R - 1)
    d_col = jnp.clip(col[None, :] - col[:, None] + (NA_WIN_C - 1), 0, 2 * NA_WIN_C - 2)
    bias = rpb.astype(F32)[:, d_row[:, None, :, None], d_col[None, :, None, :]]
    s = jnp.einsum('bhrqd,bhrjkd->bhrqjk', qg, k_win).astype(F32) * scale + bias[None]
    s = jnp.where(col_ok[:, None, :], s, NEG).reshape(B, H, R, GRID_W, kh * GRID_W)
    s_ctx = jnp.einsum('bhrqd,bhcd->bhrqc', qg, kc).astype(F32) * scale
    p = jax.nn.softmax(jnp.concatenate([s, s_ctx], axis=-1), axis=-1).astype(v.dtype)
    nw = kh * GRID_W
    p_win = p[..., :nw].reshape(B, H, R, GRID_W, kh, GRID_W)
    o = jnp.einsum('bhrqjk,bhrjkd->bhrqd', p_win, v_win) + jnp.einsum('bhrqc,bhcd->bhrqd', p[..., nw:], vc)
    return o.reshape(B, H, L, d)


def window_attention(q, k, v, kc, vc, sink):
    B, H, L, d = q.shape
    nb = L // SWA_BLOCK
    scale = d ** -0.5
    pad = ((0, 0), (0, 0), (SWA_BLOCK, SWA_BLOCK), (0, 0))

    def band(t):
        tb = jnp.pad(t, pad).reshape(B, H, nb + 2, SWA_BLOCK, d)
        return jnp.concatenate([tb[:, :, :-2], tb[:, :, 1:-1], tb[:, :, 2:]], axis=3)

    k_b, v_b = band(k), band(v)
    qb = q.reshape(B, H, nb, SWA_BLOCK, d)
    q_pos = jnp.arange(nb)[:, None] * SWA_BLOCK + jnp.arange(SWA_BLOCK)[None, :]
    k_pos = jnp.arange(nb)[:, None] * SWA_BLOCK - SWA_BLOCK + jnp.arange(3 * SWA_BLOCK)[None, :]
    kp = k_pos[:, None, :]
    ok = (kp >= 0) & (kp < L) & (jnp.abs(kp - q_pos[:, :, None]) <= SWA_WINDOW)
    s = jnp.einsum('bhnqd,bhnkd->bhnqk', qb, k_b).astype(F32) * scale
    s = jnp.where(ok, s, NEG)
    s_ctx = jnp.einsum('bhnqd,bhcd->bhnqc', qb, kc).astype(F32) * scale
    s_sink = jnp.broadcast_to(sink.astype(F32)[None, :, None, None, None], (B, H, nb, SWA_BLOCK, 1))
    p = jax.nn.softmax(jnp.concatenate([s, s_ctx, s_sink], axis=-1), axis=-1).astype(v.dtype)
    nk = 3 * SWA_BLOCK
    Lc = kc.shape[2]
    o = jnp.einsum('bhnqk,bhnkd->bhnqd', p[..., :nk], v_b) + jnp.einsum('bhnqc,bhcd->bhnqd', p[..., nk:nk + Lc], vc)
    return o.reshape(B, H, L, d)


def hyena_filters(L, lp):
    tn = jnp.arange(L, dtype=F32) / L
    ang = 2.0 * math.pi * tn[:, None] * jnp.arange(1, HY_FREQS + 1, dtype=F32)[None, :]
    z = jnp.concatenate([tn[:, None], jnp.cos(ang), jnp.sin(ang)], axis=-1)
    w = lp['hy_sin_freq'].astype(F32)
    g = jnp.sin(w * (z @ lp['hy_w1'].astype(F32) + lp['hy_b1'].astype(F32)))
    g = jnp.sin(w * (g @ lp['hy_w2'].astype(F32) + lp['hy_b2'].astype(F32)))
    hfil = (g @ lp['hy_w3'].astype(F32)).reshape(L, HY_ORDER, 2, HY_WIDTH)
    rate = jnp.exp(lp['hy_log_decay'].astype(F32)).reshape(HY_ORDER, 2, HY_WIDTH)
    hfil = hfil * jnp.exp(-rate[None] * tn[:, None, None, None])
    full = jnp.concatenate([hfil[:, :, 0], jnp.zeros((1, HY_ORDER, HY_WIDTH), F32), hfil[1:, :, 1][::-1]], axis=0)
    return full / (jnp.sum(jnp.abs(full), axis=0, keepdims=True) + EPS)


def hyena(u, lp):
    B, L, _ = u.shape
    w = lp['hy_short_w']
    up = jnp.pad(u, ((0, 0), (1, 1), (0, 0)))
    z = up[:, :L] * w[0] + up[:, 1:L + 1] * w[1] + up[:, 2:] * w[2] + lp['hy_short_b']
    v, x1, x2 = jnp.split(z, 3, axis=-1)
    filt_f = jnp.fft.rfft(hyena_filters(L, lp), axis=0)
    y = v.astype(F32)
    for o, gate in enumerate((x1, x2)):
        yf = jnp.fft.rfft(y, n=2 * L, axis=1)
        conv = jnp.fft.irfft(yf * filt_f[None, :, o], n=2 * L, axis=1)[:, :L]
        y = gate.astype(F32) * (conv + lp['hy_skip'][o].astype(F32) * y)
    return y.astype(u.dtype)


def token_mixing(h, lp, l, ctx_cache):
    B, L, _ = h.shape
    proj = h @ lp['w_in']
    na_in, swa_in, hy_in, diff_in, gate_in = jnp.split(proj, list(SPLIT_IDX), axis=-1)
    na_q, na_k, na_v = [to_heads(t, NA_HEADS) for t in jnp.split(na_in, 3, axis=-1)]
    swa_q = to_heads(swa_in[..., :SWA_QW], SWA_HEADS)
    swa_k = to_heads(swa_in[..., SWA_QW:SWA_QW + SWA_KVW], SWA_KV_HEADS)
    swa_v = to_heads(swa_in[..., SWA_QW + SWA_KVW:], SWA_KV_HEADS)
    d_q, d_k, d_v = [to_heads(t, DIFF_HEADS) for t in jnp.split(diff_in, 3, axis=-1)]
    lam_init = 0.8 - 0.6 * math.exp(-0.3 * l)
    lvec = lp['diff_lambda'].astype(F32)
    lam = jnp.exp(jnp.sum(lvec[0] * lvec[1])) - jnp.exp(jnp.sum(lvec[2] * lvec[3])) + lam_init
    sink = lp['swa_sink']
    if ctx_cache is None:
        a_o = dense_attention(na_q, na_k, na_v, None)
        b_o = dense_attention(swa_q, expand_kv(swa_k), expand_kv(swa_v), sink)
        d_o = diff_attention(d_q, d_k, d_v, lam)
        ctx_out = (na_k, na_v, swa_k, swa_v, d_k, d_v)
    else:
        ck_na, cv_na, ck_swa, cv_swa, ck_d, cv_d = ctx_cache
        a_o = neighbourhood_attention(na_q, na_k, na_v, ck_na, cv_na, lp['na_rpb'])
        tabs = rope_tables(L, HEAD_DIM)
        b_o = window_attention(apply_rope(swa_q, tabs), expand_kv(apply_rope(swa_k, tabs)), expand_kv(swa_v),
                               expand_kv(ck_swa), expand_kv(cv_swa), sink)
        tabs_d = rope_tables(L, DIFF_HD)
        d_o = diff_attention(rope_pair(d_q, tabs_d), jnp.concatenate([rope_pair(d_k, tabs_d), ck_d], axis=2),
                             jnp.concatenate([d_v, cv_d], axis=2), lam)
        ctx_out = None
    d_o = rmsnorm(d_o, lp['diff_subln']) * (1.0 - lam_init)
    c_o = hyena(hy_in, lp)
    branches = (from_heads(a_o), from_heads(b_o), c_o, from_heads(d_o))
    gates = jax.nn.sigmoid(gate_in.reshape(B, L, N_BRANCH, D_MODEL))
    merged = gates[:, :, 0] * (branches[0] @ lp['w_branch'][0])
    for i in range(1, N_BRANCH):
        merged = merged + gates[:, :, i] * (branches[i] @ lp['w_branch'][i])
    return merged @ lp['w_out'], ctx_out


def trunk_layer(x, cond, lp, l, ctx_cache):
    mod = jax.nn.silu(cond) @ lp['w_ada'] + lp['b_ada']
    mod = mod.reshape(mod.shape[0], 1, N_MOD, D_MODEL)
    sh1, sc1, g1, sh2, sc2, g2, sh3, sc3, g3 = [mod[:, :, i] for i in range(N_MOD)]
    h = rmsnorm(x, lp['norm_ffn1']) * (1 + sc1) + sh1
    x = x + 0.5 * g1 * swiglu(h, lp['ffn1_w1'], lp['ffn1_w3'], lp['ffn1_w2'])
    h = rmsnorm(x, lp['norm_mix']) * (1 + sc2) + sh2
    mix, ctx_out = token_mixing(h, lp, l, ctx_cache)
    x = x + g2 * mix
    h = rmsnorm(x, lp['norm_ffn2']) * (1 + sc3) + sh3
    x = x + 0.5 * g3 * swiglu(h, lp['ffn2_w1'], lp['ffn2_w3'], lp['ffn2_w2'])
    return x, ctx_out


def setup_inputs(seed: int = 0) -> dict:
    key = jax.random.key(seed)
    keys = iter(jax.random.split(key, 64))

    def nrm(shape, scale):
        return jax.random.normal(next(keys), shape, jnp.float32) * scale

    D = D_MODEL
    C = HY_WIDTH
    hy_rates = jnp.log(jnp.linspace(HY_MIN_DECAY, HY_MAX_DECAY, HY_ORDER * 2 * C, dtype=jnp.float32))
    return {
        'x_prompt': nrm((BATCH, SEQ, D), 1.0),
        'x_sample': nrm((DEC_BATCH, DEC_SEQ, D), 1.0),
        'cache_na_k': nrm((DEC_BATCH, DEPTH, NA_HEADS, PAST_LEN, HEAD_DIM), 1.0),
        'cache_na_v': nrm((DEC_BATCH, DEPTH, NA_HEADS, PAST_LEN, HEAD_DIM), 1.0),
        'cache_swa_k': nrm((DEC_BATCH, DEPTH, SWA_KV_HEADS, PAST_LEN, HEAD_DIM), 1.0),
        'cache_swa_v': nrm((DEC_BATCH, DEPTH, SWA_KV_HEADS, PAST_LEN, HEAD_DIM), 1.0),
        'cache_diff_k': nrm((DEC_BATCH, DEPTH, DIFF_HEADS, PAST_LEN, 2 * DIFF_HD), 1.0),
        'cache_diff_v': nrm((DEC_BATCH, DEPTH, DIFF_HEADS, PAST_LEN, 2 * DIFF_HD), 1.0),
        'c': nrm((DEC_BATCH, D), 1.0),
        'c_ctx': nrm((D,), 1.0),
        'w_ada': nrm((DEPTH, D, N_MOD * D), D ** -0.5),
        'b_ada': nrm((DEPTH, N_MOD * D), 0.02),
        'norm_ffn1': 1.0 + nrm((DEPTH, D), 0.02),
        'norm_mix': 1.0 + nrm((DEPTH, D), 0.02),
        'norm_ffn2': 1.0 + nrm((DEPTH, D), 0.02),
        'final_norm': 1.0 + nrm((D,), 0.02),
        'ffn1_w1': nrm((DEPTH, D, D_FF), D ** -0.5),
        'ffn1_w3': nrm((DEPTH, D, D_FF), D ** -0.5),
        'ffn1_w2': nrm((DEPTH, D_FF, D), D_FF ** -0.5),
        'ffn2_w1': nrm((DEPTH, D, D_FF), D ** -0.5),
        'ffn2_w3': nrm((DEPTH, D, D_FF), D ** -0.5),
        'ffn2_w2': nrm((DEPTH, D_FF, D), D_FF ** -0.5),
        'w_in': nrm((DEPTH, D, IN_W), D ** -0.5),
        'w_branch': nrm((DEPTH, N_BRANCH, BRANCH_W, D), BRANCH_W ** -0.5),
        'w_out': nrm((DEPTH, D, D), D ** -0.5),
        'na_rpb': nrm((DEPTH, NA_HEADS, 2 * NA_WIN_R - 1, 2 * NA_WIN_C - 1), 0.1),
        'swa_sink': nrm((DEPTH, SWA_HEADS), 0.5),
        'hy_short_w': nrm((DEPTH, 3, HY_IN_W), 3 ** -0.5),
        'hy_short_b': nrm((DEPTH, HY_IN_W), 0.02),
        'hy_w1': nrm((DEPTH, HY_EMB, HY_HIDDEN), HY_EMB ** -0.5),
        'hy_b1': nrm((DEPTH, HY_HIDDEN), 0.1),
        'hy_w2': nrm((DEPTH, HY_HIDDEN, HY_HIDDEN), HY_HIDDEN ** -0.5),
        'hy_b2': nrm((DEPTH, HY_HIDDEN), 0.1),
        'hy_w3': nrm((DEPTH, HY_HIDDEN, HY_ORDER * 2 * C), HY_HIDDEN ** -0.5),
        'hy_sin_freq': 1.0 + nrm((DEPTH, HY_HIDDEN), 0.05),
        'hy_log_decay': hy_rates[None, :] + nrm((DEPTH, HY_ORDER * 2 * C), 0.05),
        'hy_skip': nrm((DEPTH, HY_ORDER, C), 0.5),
        'diff_lambda': nrm((DEPTH, 4, DIFF_HD), 0.1),
        'diff_subln': 1.0 + nrm((DEPTH, 2 * DIFF_HD), 0.02),
    }


def reference(x_prompt, x_sample, cache_na_k, cache_na_v, cache_swa_k, cache_swa_v, cache_diff_k, cache_diff_v,
              c, c_ctx, w_ada, b_ada, norm_ffn1, norm_mix, norm_ffn2, final_norm,
              ffn1_w1, ffn1_w3, ffn1_w2, ffn2_w1, ffn2_w3, ffn2_w2, w_in, w_branch, w_out,
              na_rpb, swa_sink, hy_short_w, hy_short_b, hy_w1, hy_b1, hy_w2, hy_b2, hy_w3,
              hy_sin_freq, hy_log_decay, hy_skip, diff_lambda, diff_subln):
    layer_params = {
        'w_ada': w_ada, 'b_ada': b_ada, 'norm_ffn1': norm_ffn1, 'norm_mix': norm_mix, 'norm_ffn2': norm_ffn2,
        'ffn1_w1': ffn1_w1, 'ffn1_w3': ffn1_w3, 'ffn1_w2': ffn1_w2,
        'ffn2_w1': ffn2_w1, 'ffn2_w3': ffn2_w3, 'ffn2_w2': ffn2_w2,
        'w_in': w_in, 'w_branch': w_branch, 'w_out': w_out, 'na_rpb': na_rpb, 'swa_sink': swa_sink,
        'hy_short_w': hy_short_w, 'hy_short_b': hy_short_b, 'hy_w1': hy_w1, 'hy_b1': hy_b1,
        'hy_w2': hy_w2, 'hy_b2': hy_b2, 'hy_w3': hy_w3, 'hy_sin_freq': hy_sin_freq,
        'hy_log_decay': hy_log_decay, 'hy_skip': hy_skip, 'diff_lambda': diff_lambda, 'diff_subln': diff_subln,
    }
    x = x_prompt
    ctx_cond = c_ctx[None, :]
    collected = ([], [], [], [], [], [])
    for l in range(DEPTH):
        lp = {name: arr[l] for name, arr in layer_params.items()}
        x, ctx_out = trunk_layer(x, ctx_cond, lp, l, None)
        for store, t in zip(collected, ctx_out):
            store.append(t)
    y_prompt = rmsnorm(x, final_norm)
    new_na_k, new_na_v, new_swa_k, new_swa_v, new_diff_k, new_diff_v = [jnp.stack(s, axis=1) for s in collected]

    caches = (cache_na_k, cache_na_v, cache_swa_k, cache_swa_v, cache_diff_k, cache_diff_v)
    x = x_sample
    for l in range(DEPTH):
        lp = {name: arr[l] for name, arr in layer_params.items()}
        x, _ = trunk_layer(x, c, lp, l, tuple(t[:, l] for t in caches))
    y_sample = rmsnorm(x, final_norm)
    return (y_prompt, y_sample, new_na_k, new_na_v, new_swa_k, new_swa_v, new_diff_k, new_diff_v)
```

```cpp
#include <hip/hip_runtime.h>
#include <hip/hip_cooperative_groups.h>
#include <cstdio>
#include <cstdint>
namespace cg = cooperative_groups;

#define LAS __attribute__((address_space(3)))
typedef unsigned short bf16_t;
typedef short bf16x8 __attribute__((ext_vector_type(8)));
typedef float f32x4 __attribute__((ext_vector_type(4)));
typedef float f32x2 __attribute__((ext_vector_type(2)));
typedef unsigned u32x4 __attribute__((ext_vector_type(4)));
typedef unsigned u32x2 __attribute__((ext_vector_type(2)));

constexpr int DM = 1024, DFF = 2816, INW = 6912, PROJW = 2816, GATEW = 4096;
constexpr int M_CTX = 4096, M_DEC = 16384, M_TOT = 20480;
constexpr int NLAYER = 4;
constexpr float EPSF = 1e-6f;
constexpr float LOG2E = 1.4426950408889634f;
constexpr size_t O_Y = 0, O_NAK = 20971520, O_NAV = 25165824, O_SWK = 29360128, O_SWV = 31457280, O_DFK = 33554432, O_DFV = 37748736;
enum { I_XP = 0, I_XS, I_CNAK, I_CNAV, I_CSWK, I_CSWV, I_CDFK, I_CDFV, I_C, I_CCTX, I_WADA, I_BADA, I_NF1, I_NMIX, I_NF2, I_FNORM,
       I_F1W1, I_F1W3, I_F1W2, I_F2W1, I_F2W3, I_F2W2, I_WIN, I_WBR, I_WOUT, I_RPB, I_SINK, I_HSW, I_HSB, I_HW1, I_HB1, I_HW2, I_HB2, I_HW3,
       I_HSF, I_HLD, I_HSKIP, I_DLAM, I_DSUB, N_IN };

constexpr size_t MiB = 1u << 20;
constexpr size_t WS_CTL = 0;
constexpr size_t WS_MOD = 1 * MiB;
constexpr size_t WS_ZERO_BYTES = 3 * MiB;
constexpr size_t WS_LAM = 3 * MiB;
constexpr size_t WS_W = 4 * MiB;
constexpr size_t W_F1UP = 0, W_F1DN = W_F1UP + (size_t)5632 * 1024 * 2, W_F2UP = W_F1DN + (size_t)1024 * 2816 * 2, W_F2DN = W_F2UP + (size_t)5632 * 1024 * 2,
                 W_IN = W_F2DN + (size_t)1024 * 2816 * 2, W_BR = W_IN + (size_t)6912 * 1024 * 2, W_OUT = W_BR + (size_t)4 * 1024 * 256 * 2, W_END = W_OUT + (size_t)1024 * 1024 * 2;
static_assert(W_END <= 52 * MiB, "weights");
constexpr size_t WS_X = 56 * MiB;
constexpr size_t WS_ACT = 136 * MiB;
constexpr size_t WS_BR = 176 * MiB;
constexpr size_t WS_BIG = 216 * MiB;
constexpr size_t WS_PROJ = 376 * MiB;
constexpr size_t WS_TR = 486 * MiB;
constexpr size_t WS_CK = 541 * MiB;
constexpr size_t WS_HFIL = 551 * MiB;
constexpr size_t WS_END = 560 * MiB;
constexpr int TRW = 1408;
constexpr size_t CK_NA = 0, CK_SW = 1048576, CK_DF = 1572864, CK_HALF = 2621440;
constexpr int LDS_BYTES = 147456;

struct Params { const float* in[N_IN]; float* out; unsigned char* ws; int ph_lo, ph_hi; };
struct Ctx { float* out; unsigned char* ws; };
constexpr size_t WS_TAB = 3 * MiB + 65536;
__device__ __forceinline__ const float* inp(const unsigned char* ws, int i) {
    const unsigned long long v = __hip_atomic_load((const unsigned long long*)(ws + WS_TAB) + i, __ATOMIC_RELAXED, __HIP_MEMORY_SCOPE_AGENT);
    const unsigned lo = __builtin_amdgcn_readfirstlane((unsigned)v), hi = __builtin_amdgcn_readfirstlane((unsigned)(v >> 32));
    return (const float*)(((unsigned long long)hi << 32) | lo);
}


__device__ __forceinline__ unsigned cvt_pk_bf16(float lo, float hi) { unsigned r; asm volatile("v_cvt_pk_bf16_f32 %0, %1, %2" : "=v"(r) : "v"(lo), "v"(hi)); return r; }
__device__ __forceinline__ float bf2f(unsigned short v) { return __uint_as_float(((unsigned)v) << 16); }
__device__ __forceinline__ float bflo(unsigned v) { return __uint_as_float(v << 16); }
__device__ __forceinline__ float bfhi(unsigned v) { return __uint_as_float(v & 0xffff0000u); }
__device__ __forceinline__ bf16_t f2bf1(float f) { return (bf16_t)(cvt_pk_bf16(f, 0.f) & 0xffffu); }
__device__ __forceinline__ float fast_exp2(float x) { return __builtin_amdgcn_exp2f(x); }
__device__ __forceinline__ float fast_rcp(float x) { return __builtin_amdgcn_rcpf(x); }
__device__ __forceinline__ float sigmoidf_(float x) { return fast_rcp(1.f + fast_exp2(-x * LOG2E)); }
__device__ __forceinline__ float wave_sum(float v) {
#pragma unroll
    for (int o = 1; o < 64; o <<= 1) v += __shfl_xor(v, o);
    return v;
}
__device__ __forceinline__ int cond_of_row(int row) { return row < M_CTX ? 0 : 1 + ((row - M_CTX) >> 11); }
__device__ __forceinline__ const float* mod_ptr(const unsigned char* ws, int cond, int l, int chunk) { return (const float*)(ws + WS_MOD) + ((size_t)(cond * 4 + l) * 9 + chunk) * 1024; }

namespace pg8 {
constexpr int BM = 256, BK = 64, HALF = 128, HTB = HALF * BK * 2, STAGE_BYTES = 8 * HTB, NXCD = 8, WGM = 8;
__device__ __forceinline__ int lds_byte(int r, int c) { const int st = (r >> 4) * 2 + (c >> 5), rr = r & 15, cc = c & 31, ob = rr * 64 + cc * 2; return st * 1024 + (ob ^ (((ob >> 9) & 1) << 5)); }
__device__ __forceinline__ void stage_rc(int b, int& R, int& C) { const int st = b / 1024, sb = b % 1024, swz = sb ^ (((sb >> 9) & 1) << 5); R = (st >> 1) * 16 + swz / 64; C = (st & 1) * 32 + (swz % 64) / 2; }
__device__ __forceinline__ int perm32(int rho) { const int n = rho >> 4, i = rho & 15; return 8 * (i >> 2) + 4 * n + (i & 3); }
struct Unit { int pm, pn; };
struct Sched { int mode, nM, nN, nwg, G, c; };
__device__ __forceinline__ bool sched_next(const Sched& S, int i, Unit& u) {
    const int j = (S.mode == 1) ? (i >> 2) : i;
    const long L = (long)j * S.G + S.c; if (L >= S.nwg) return false;
    int wgid = (int)L; { const int q = S.nwg / NXCD, r = S.nwg % NXCD, xcd = wgid % NXCD, off = wgid / NXCD; wgid = (xcd < r ? xcd * (q + 1) : r * (q + 1) + (xcd - r) * q) + off; }
    const int nig = WGM * S.nN, gid = wgid / nig, fm = gid * WGM, gsz = (S.nM - fm) < WGM ? (S.nM - fm) : WGM;
    const int pm = fm + ((wgid % nig) % gsz), pn = (wgid % nig) / gsz;
    if (S.mode == 1) { const int b = i & 3; u.pm = b * S.nM + pm; u.pn = b * S.nN + pn; } else { u.pm = pm; u.pn = pn; }
    return true;
}
enum { EK_SWIGLU = 0, EK_RESID = 1, EK_PROJ = 2, EK_BRANCH = 3 };
struct Epi { int kind; bf16_t* o16; bf16_t* o16b; float* of; const float* g; const bf16_t* gates; float scale; };
struct Gemm { const bf16_t* A; const bf16_t* Bt; int K; };

__device__ __forceinline__ void epilogue(const Epi& E, const f32x4 (&acc)[2][2][4][2], const Unit& u, int wr, int wc, int fr, int fq) {
    if (E.kind == EK_SWIGLU) {
        const int row0 = u.pm * BM + wr * 64 + fr, col0 = u.pn * 128 + wc * 32 + 8 * fq;
#pragma unroll
        for (int ai = 0; ai < 2; ++ai)
#pragma unroll
            for (int m = 0; m < 4; ++m) {
                const f32x4 a0 = acc[ai][0][m][0], a1 = acc[ai][0][m][1], b0 = acc[ai][1][m][0], b1 = acc[ai][1][m][1];
                float r[8];
#pragma unroll
                for (int e = 0; e < 4; ++e) { r[e] = a0[e] * sigmoidf_(a0[e]) * b0[e]; r[4 + e] = a1[e] * sigmoidf_(a1[e]) * b1[e]; }
                u32x4 w; w.x = cvt_pk_bf16(r[0], r[1]); w.y = cvt_pk_bf16(r[2], r[3]); w.z = cvt_pk_bf16(r[4], r[5]); w.w = cvt_pk_bf16(r[6], r[7]);
                *(u32x4*)(E.o16 + (size_t)(row0 + ai * HALF + m * 16) * DFF + col0) = w;
            }
    } else if (E.kind == EK_PROJ) {
        const int row0 = u.pm * BM + wr * 64 + fr;
        const bool isgate = u.pn >= 11;
        bf16_t* base = isgate ? E.o16b : E.o16; const int ld = isgate ? GATEW : PROJW;
        const int col0 = (isgate ? (u.pn - 11) * BM : u.pn * BM) + wc * 32 + 8 * fq;
#pragma unroll
        for (int ai = 0; ai < 2; ++ai)
#pragma unroll
            for (int m = 0; m < 4; ++m)
#pragma unroll
                for (int bj = 0; bj < 2; ++bj) {
                    f32x4 v0 = acc[ai][bj][m][0], v1 = acc[ai][bj][m][1];
                    if (isgate) {
#pragma unroll
                        for (int e = 0; e < 4; ++e) { v0[e] = sigmoidf_(v0[e]); v1[e] = sigmoidf_(v1[e]); }
                    }
                    u32x4 w; w.x = cvt_pk_bf16(v0[0], v0[1]); w.y = cvt_pk_bf16(v0[2], v0[3]); w.z = cvt_pk_bf16(v1[0], v1[1]); w.w = cvt_pk_bf16(v1[2], v1[3]);
                    *(u32x4*)(base + (size_t)(row0 + ai * HALF + m * 16) * ld + col0 + bj * HALF) = w;
                }
    } else if (E.kind == EK_RESID) {
        const int cond = (u.pm < 16) ? 0 : 1 + ((u.pm - 16) >> 3);
        const float* gv = E.g + (size_t)cond * (4 * 9 * 1024);
        const int row0 = u.pm * BM + wr * 64 + fr, col0 = u.pn * BM + wc * 32 + 4 * fq;
#pragma unroll
        for (int bj = 0; bj < 2; ++bj)
#pragma unroll
            for (int n = 0; n < 2; ++n) {
                const int col = col0 + bj * HALF + n * 16;
                const f32x4 g4 = *(const f32x4*)(gv + col) * E.scale;
#pragma unroll
                for (int ai = 0; ai < 2; ++ai)
#pragma unroll
                    for (int m = 0; m < 4; ++m) {
                        f32x4* px = (f32x4*)(E.of + (size_t)(row0 + ai * HALF + m * 16) * DM + col);
                        *px = *px + g4 * acc[ai][bj][m][n];
                    }
            }
    } else {
        const int bi = u.pm / 80, pm = u.pm - bi * 80, pn = u.pn & 3;
        const int row0 = pm * BM + wr * 64 + fr, col0 = pn * BM + wc * 32 + 4 * fq;
#pragma unroll
        for (int bj = 0; bj < 2; ++bj)
#pragma unroll
            for (int n = 0; n < 2; ++n) {
                const int col = col0 + bj * HALF + n * 16;
#pragma unroll
                for (int ai = 0; ai < 2; ++ai)
#pragma unroll
                    for (int m = 0; m < 4; ++m) {
                        const size_t row = (size_t)(row0 + ai * HALF + m * 16);
                        const u32x2 gw = *(const u32x2*)(E.gates + row * GATEW + bi * 1024 + col);
                        f32x4 gt; gt[0] = bflo(gw.x); gt[1] = bfhi(gw.x); gt[2] = bflo(gw.y); gt[3] = bfhi(gw.y);
                        f32x4* pmf = (f32x4*)(E.of + row * DM + col);
                        f32x4 v = gt * acc[ai][bj][m][n];
                        if (bi > 0) v = v + *pmf;
                        if (bi < 3) *pmf = v;
                        else { u32x2 w; w.x = cvt_pk_bf16(v[0], v[1]); w.y = cvt_pk_bf16(v[2], v[3]); *(u32x2*)(E.o16 + row * DM + col) = w; }
                    }
            }
    }
}

__device__ __forceinline__ void gemm_phase(LAS unsigned char* lds, const Gemm g, const Sched& S, const Epi& E, const bool perm) {
    const int tid = threadIdx.x, wid = __builtin_amdgcn_readfirstlane(tid >> 6), lane = tid & 63, wr = wid >> 2, wc = wid & 3, fr = lane & 15, fq = lane >> 4;
    const int K = g.K, nt = K / BK;
    unsigned voffA[2], voffB[2];
#pragma unroll
    for (int i = 0; i < 2; ++i) { int R, C; stage_rc(tid * 16 + i * 8192, R, C); const int Rb = perm ? ((R & ~31) + perm32(R & 31)) : R;
        voffA[i] = (unsigned)(R * K + C) * 2u; voffB[i] = (unsigned)(Rb * K + C) * 2u; }
    const size_t kstep = (size_t)(BK * 2);
    const size_t hstep = (size_t)HALF * K * 2;
    const size_t tstep = 2 * hstep;
    const unsigned ldsw = (unsigned)wid * 1024u;
    const int aoff = lds_byte(wr * 64 + fr, fq * 8), boff = lds_byte(wc * 32 + fr, fq * 8);
#define PG8_SA(b, h) (((b) * 2 + (h)) * HTB)
#define PG8_SB(b, h) ((4 + (b) * 2 + (h)) * HTB)
#define PG8_STAGE(bufoff, gbase, voff) do { _Pragma("unroll") for (int _i = 0; _i < 2; ++_i) \
        __builtin_amdgcn_global_load_lds((const unsigned*)((const char*)(gbase) + (voff)[_i]), (LAS unsigned*)(lds + (bufoff) + ldsw + _i * 8192), 16, 0, 0); } while (0)
#define PG8_LDA(dst, b, h) do { _Pragma("unroll") for (int m = 0; m < 4; ++m) _Pragma("unroll") for (int k = 0; k < 2; ++k) dst[m][k] = *(const LAS bf16x8*)(lds + PG8_SA(b, h) + aoff + m * 2048 + k * 1024); } while (0)
#define PG8_LDB(dst, b, h) do { _Pragma("unroll") for (int n = 0; n < 2; ++n) _Pragma("unroll") for (int k = 0; k < 2; ++k) dst[n][k] = *(const LAS bf16x8*)(lds + PG8_SB(b, h) + boff + n * 2048 + k * 1024); } while (0)
#define PG8_MMA(ai, bj, At, Bt) do { __builtin_amdgcn_s_setprio(1); _Pragma("unroll") for (int m = 0; m < 4; ++m) _Pragma("unroll") for (int n = 0; n < 2; ++n) _Pragma("unroll") for (int k = 0; k < 2; ++k) \
        acc[ai][bj][m][n] = __builtin_amdgcn_mfma_f32_16x16x32_bf16(Bt[n][k], At[m][k], acc[ai][bj][m][n], 0, 0, 0); __builtin_amdgcn_s_setprio(0); } while (0)
#define PG8_WAIT_V(n) asm volatile("s_waitcnt vmcnt(" #n ")" ::: "memory")
#define PG8_WAIT_L(n) asm volatile("s_waitcnt lgkmcnt(" #n ")" ::: "memory")
#define PG8_BAR __builtin_amdgcn_s_barrier()
#define PG8_SCHED __builtin_amdgcn_sched_barrier(0)
    Unit cur, nxt; int ui = 0;
    if (!sched_next(S, 0, cur)) return;
    f32x4 acc[2][2][4][2];
#pragma unroll
    for (int a = 0; a < 2; ++a)
#pragma unroll
        for (int b = 0; b < 2; ++b)
#pragma unroll
            for (int m = 0; m < 4; ++m)
#pragma unroll
                for (int n = 0; n < 2; ++n) acc[a][b][m][n] = (f32x4){0.f, 0.f, 0.f, 0.f};
    bf16x8 At[4][2], B0[2][2], B1[2][2];
    const char* cA = (const char*)g.A + (size_t)cur.pm * tstep; const char* cB = (const char*)g.Bt + (size_t)cur.pn * tstep;
    PG8_STAGE(PG8_SB(0, 0), cB, voffB); PG8_STAGE(PG8_SB(0, 1), cB + hstep, voffB); PG8_STAGE(PG8_SA(0, 0), cA, voffA); PG8_STAGE(PG8_SA(0, 1), cA + hstep, voffA);
    if (wr == 1) PG8_BAR;
    PG8_WAIT_V(2); PG8_BAR;
    PG8_STAGE(PG8_SB(1, 0), cB + kstep, voffB); PG8_STAGE(PG8_SA(1, 0), cA + kstep, voffA); PG8_STAGE(PG8_SB(1, 1), cB + hstep + kstep, voffB);
    PG8_WAIT_V(6); PG8_BAR;
    for (;;) {
        const bool has_next = sched_next(S, ui + 1, nxt);
        const char* nA = has_next ? (const char*)g.A + (size_t)nxt.pm * tstep : cA; const char* nB = has_next ? (const char*)g.Bt + (size_t)nxt.pn * tstep : cB;
        for (int t = 0; t < nt; t += 2) {
            const bool last = (t == nt - 2);
            const char* a1 = cA + (size_t)(t + 1) * kstep;
            const char* a2 = last ? nA : cA + (size_t)(t + 2) * kstep; const char* b2 = last ? nB : cB + (size_t)(t + 2) * kstep;
            const char* a3 = a2 + kstep; const char* b3 = b2 + kstep;
            PG8_LDB(B0, 0, 0); PG8_LDB(B1, 0, 1); PG8_SCHED; PG8_LDA(At, 0, 0); PG8_STAGE(PG8_SA(1, 1), a1 + hstep, voffA);
            PG8_WAIT_V(8); PG8_WAIT_L(0); PG8_BAR; PG8_MMA(0, 0, At, B0); PG8_MMA(0, 1, At, B1); PG8_BAR; PG8_SCHED;
            PG8_LDA(At, 0, 1); PG8_STAGE(PG8_SB(0, 0), b2, voffB); PG8_STAGE(PG8_SB(0, 1), b2 + hstep, voffB); PG8_STAGE(PG8_SA(0, 0), a2, voffA);
            PG8_WAIT_V(8); PG8_WAIT_L(0); PG8_BAR; PG8_MMA(1, 0, At, B0); PG8_MMA(1, 1, At, B1); PG8_BAR; PG8_SCHED;
            PG8_LDB(B0, 1, 0); PG8_LDB(B1, 1, 1); PG8_SCHED; PG8_LDA(At, 1, 0); PG8_STAGE(PG8_SA(0, 1), a2 + hstep, voffA);
            PG8_WAIT_V(8); PG8_WAIT_L(0); PG8_BAR; PG8_MMA(0, 0, At, B0); PG8_MMA(0, 1, At, B1); PG8_BAR; PG8_SCHED;
            PG8_LDA(At, 1, 1); PG8_STAGE(PG8_SB(1, 0), b3, voffB); PG8_STAGE(PG8_SB(1, 1), b3 + hstep, voffB); PG8_STAGE(PG8_SA(1, 0), a3, voffA);
            PG8_WAIT_V(8); PG8_WAIT_L(0); PG8_BAR; PG8_MMA(1, 0, At, B0); PG8_MMA(1, 1, At, B1); PG8_BAR; PG8_SCHED;
        }
        if (wr == 0) PG8_BAR;
        epilogue(E, acc, cur, wr, wc, fr, fq);
        if (!has_next) break;
#pragma unroll
        for (int a = 0; a < 2; ++a)
#pragma unroll
            for (int b = 0; b < 2; ++b)
#pragma unroll
                for (int m = 0; m < 4; ++m)
#pragma unroll
                    for (int n = 0; n < 2; ++n) acc[a][b][m][n] = (f32x4){0.f, 0.f, 0.f, 0.f};
        cur = nxt; cA = nA; cB = nB; ++ui;
        if (wr == 1) PG8_BAR;
    }
    PG8_WAIT_V(0);
    PG8_BAR;
#undef PG8_SA
#undef PG8_SB
#undef PG8_STAGE
#undef PG8_LDA
#undef PG8_LDB
#undef PG8_MMA
#undef PG8_WAIT_V
#undef PG8_WAIT_L
#undef PG8_BAR
#undef PG8_SCHED
}
}

__device__ __forceinline__ int opaque_tid() { int t; asm volatile("v_mov_b32 %0, %1" : "=v"(t) : "v"((int)threadIdx.x)); return t; }

__device__ __forceinline__ void transpose_item(const float* W, int K, int N, bf16_t* WT, int dst_row0, LAS float* scr, int k0, int n0, int lane) {
#pragma unroll 8
    for (int i = 0; i < 32; ++i) { const int kk = 2 * i + (lane >> 5); scr[kk * 33 + (lane & 31)] = W[(size_t)(k0 + kk) * N + n0 + (lane & 31)]; }
    asm volatile("s_waitcnt lgkmcnt(0)" ::: "memory");
    const int c = lane & 7;
#pragma unroll
    for (int j = 0; j < 4; ++j) { const int n = (lane >> 3) + 8 * j; const LAS float* s = scr + (8 * c) * 33 + n;
        u32x4 o; o.x = cvt_pk_bf16(s[0 * 33], s[1 * 33]); o.y = cvt_pk_bf16(s[2 * 33], s[3 * 33]); o.z = cvt_pk_bf16(s[4 * 33], s[5 * 33]); o.w = cvt_pk_bf16(s[6 * 33], s[7 * 33]);
        *(u32x4*)(WT + (size_t)(dst_row0 + n) * K + k0 + 8 * c) = o; }
    asm volatile("s_waitcnt lgkmcnt(0)" ::: "memory");
}

__device__ __forceinline__ void prep_layer(const Ctx& p, LAS unsigned char* lds, int l) {
    const int tid = opaque_tid(), lane = tid & 63, wave = tid >> 6;
    const int G = gridDim.x, gw = blockIdx.x * 8 + wave, NGW = G * 8;
    unsigned char* ws = p.ws;
    LAS float* scr = (LAS float*)(lds + wave * 16896);
    {
        constexpr int I_UP = 16 * 88, I_DN = 44 * 32, I_IN = 16 * 216, I_BR = 4 * 32, I_OUT = 16 * 32;
        constexpr int NIT = 4 * I_UP + 2 * I_DN + I_IN + 4 * I_BR + I_OUT;
        for (int it = gw; it < NIT; it += NGW) {
            int r = it;
            if (r < 4 * I_UP) {
                const int which = r / I_UP; r -= which * I_UP; const int kb = r / 88, nb = r % 88, n0 = nb * 32;
                const float* W = inp(p.ws, (which >> 1) ? ((which & 1) ? I_F2W3 : I_F2W1) : ((which & 1) ? I_F1W3 : I_F1W1)) + (size_t)l * DM * DFF;
                bf16_t* WT = (bf16_t*)(ws + WS_W + ((which >> 1) ? W_F2UP : W_F1UP));
                const int drow = 256 * (n0 >> 7) + (which & 1) * 128 + (n0 & 127);
                transpose_item(W, DM, DFF, WT, drow, scr, kb * 64, n0, lane); continue;
            }
            r -= 4 * I_UP;
            if (r < 2 * I_DN) {
                const int which = r / I_DN; r -= which * I_DN; const int kb = r / 32, nb = r % 32;
                const float* W = inp(p.ws, which ? I_F2W2 : I_F1W2) + (size_t)l * DFF * DM;
                bf16_t* WT = (bf16_t*)(ws + WS_W + (which ? W_F2DN : W_F1DN));
                transpose_item(W, DFF, DM, WT, nb * 32, scr, kb * 64, nb * 32, lane); continue;
            }
            r -= 2 * I_DN;
            if (r < I_IN) { const int kb = r / 216, nb = r % 216;
                transpose_item(inp(p.ws, I_WIN) + (size_t)l * DM * INW, DM, INW, (bf16_t*)(ws + WS_W + W_IN), nb * 32, scr, kb * 64, nb * 32, lane); continue; }
            r -= I_IN;
            if (r < 4 * I_BR) { const int bi = r / I_BR; r -= bi * I_BR; const int kb = r / 32, nb = r % 32;
                transpose_item(inp(p.ws, I_WBR) + ((size_t)l * 4 + bi) * 256 * DM, 256, DM, (bf16_t*)(ws + WS_W + W_BR) + (size_t)bi * 1024 * 256, nb * 32, scr, kb * 64, nb * 32, lane); continue; }
            r -= 4 * I_BR;
            { const int kb = r / 32, nb = r % 32;
              transpose_item(inp(p.ws, I_WOUT) + (size_t)l * DM * DM, DM, DM, (bf16_t*)(ws + WS_W + W_OUT), nb * 32, scr, kb * 64, nb * 32, lane); }
        }
    }
    {
        bf16_t* CK = (bf16_t*)(ws + WS_CK);
        const int gt = blockIdx.x * 512 + tid, NT = G * 512;
        for (int it = gt; it < 327680; it += NT) {
            int e = it * 8; const float* src; bf16_t* dst; int per_b;
            if (e < 1048576) { src = inp(p.ws, I_CNAK); dst = CK + CK_NA; per_b = 131072; }
            else if (e < 1572864) { e -= 1048576; src = inp(p.ws, I_CSWK); dst = CK + CK_SW; per_b = 65536; }
            else { e -= 1572864; src = inp(p.ws, I_CDFK); dst = CK + CK_DF; per_b = 131072; }
            const int b = e / per_b, r = e - b * per_b;
            const float* s = src + ((size_t)(b * 4 + l)) * per_b + r;
            const f32x4 v0 = *(const f32x4*)s, v1 = *(const f32x4*)(s + 4);
            u32x4 o; o.x = cvt_pk_bf16(v0[0], v0[1]); o.y = cvt_pk_bf16(v0[2], v0[3]); o.z = cvt_pk_bf16(v1[0], v1[1]); o.w = cvt_pk_bf16(v1[2], v1[3]);
            *(u32x4*)(dst + e) = o;
        }
    }
    {
        bf16_t* CV = (bf16_t*)(ws + WS_CK) + CK_HALF;
        for (int it = gw; it < 640; it += NGW) {
            int r = it; const float* src; bf16_t* dst; int H;
            if (r < 256) { src = inp(p.ws, I_CNAV); dst = CV + CK_NA; H = 4; }
            else if (r < 384) { r -= 256; src = inp(p.ws, I_CSWV); dst = CV + CK_SW; H = 2; }
            else { r -= 384; src = inp(p.ws, I_CDFV); dst = CV + CK_DF; H = 4; }
            const int kb = r & 7, bh = r >> 3, b = bh / H, h = bh - b * H;
            const float* s = src + (((size_t)(b * 4 + l) * H + h) * 512 + kb * 64) * 64;
#pragma unroll 8
            for (int i = 0; i < 64; ++i) scr[i * 65 + lane] = s[i * 64 + lane];
            asm volatile("s_waitcnt lgkmcnt(0)" ::: "memory");
            bf16_t* d = dst + ((size_t)bh * 64 + lane) * 512 + kb * 64;
#pragma unroll
            for (int j = 0; j < 8; ++j) {
                const LAS float* q = scr + (j * 8) * 65 + lane;
                u32x4 o; o.x = cvt_pk_bf16(q[0], q[65]); o.y = cvt_pk_bf16(q[2 * 65], q[3 * 65]); o.z = cvt_pk_bf16(q[4 * 65], q[5 * 65]); o.w = cvt_pk_bf16(q[6 * 65], q[7 * 65]);
                *(u32x4*)(d + j * 8) = o;
            }
            asm volatile("s_waitcnt lgkmcnt(0)" ::: "memory");
        }
    }
    __syncthreads();
    {
        LAS float* Z = (LAS float*)lds;
        LAS float* G1 = Z + 8 * 33;
        LAS float* G2 = G1 + 8 * 64;
        float* HF = (float*)(ws + WS_HFIL);
        const float* w1 = inp(p.ws, I_HW1) + (size_t)l * 33 * 64; const float* b1 = inp(p.ws, I_HB1) + l * 64;
        const float* w2 = inp(p.ws, I_HW2) + (size_t)l * 64 * 64; const float* b2 = inp(p.ws, I_HB2) + l * 64;
        const float* w3 = inp(p.ws, I_HW3) + (size_t)l * 64 * 1024; const float* sf = inp(p.ws, I_HSF) + l * 64; const float* ld = inp(p.ws, I_HLD) + l * 1024;
        for (int it = blockIdx.x; it < 288; it += G) {
            const int Lsel = it >= 32, L = Lsel ? 2048 : 256, n0 = (Lsel ? it - 32 : it) * 8;
            const float invL = 1.f / (float)L;
            if (tid < 8 * 33) { const int nn = tid / 33, i = tid - nn * 33; const float tn = (float)(n0 + nn) * invL; float v;
                if (i == 0) v = tn; else if (i <= 16) v = __cosf(6.283185307179586f * tn * (float)i); else v = __sinf(6.283185307179586f * tn * (float)(i - 16));
                Z[nn * 33 + i] = v; }
            __syncthreads();
            { const int nn = tid >> 6, j = tid & 63; float a = b1[j];
#pragma unroll 3
              for (int i = 0; i < 33; ++i) a += Z[nn * 33 + i] * w1[i * 64 + j];
              G1[nn * 64 + j] = __sinf(sf[j] * a); }
            __syncthreads();
            { const int nn = tid >> 6, j = tid & 63; float a = b2[j];
#pragma unroll 4
              for (int i = 0; i < 64; ++i) a += G1[nn * 64 + i] * w2[i * 64 + j];
              G2[nn * 64 + j] = __sinf(sf[j] * a); }
            __syncthreads();
#pragma unroll 1
            for (int cc = 0; cc < 2; ++cc) {
                const int col = cc * 512 + tid;
                float a[8];
#pragma unroll
                for (int nn = 0; nn < 8; ++nn) a[nn] = 0.f;
#pragma unroll 4
                for (int i = 0; i < 64; ++i) { const float w = w3[i * 1024 + col];
#pragma unroll
                    for (int nn = 0; nn < 8; ++nn) a[nn] += G2[nn * 64 + i] * w; }
                const float rate = __expf(ld[col]);
#pragma unroll
                for (int nn = 0; nn < 8; ++nn) a[nn] *= __expf(-rate * (float)(n0 + nn) * invL);
                float* o = HF + (Lsel ? 262144 : 0) + (size_t)col * L + n0;
                *(f32x4*)o = (f32x4){a[0], a[1], a[2], a[3]}; *(f32x4*)(o + 4) = (f32x4){a[4], a[5], a[6], a[7]};
            }
            __syncthreads();
        }
    }
    if (blockIdx.x == 0 && tid == 0) {
        const float* lv = inp(p.ws, I_DLAM) + l * 128; float s01 = 0.f, s23 = 0.f;
        for (int i = 0; i < 32; ++i) { s01 += lv[i] * lv[32 + i]; s23 += lv[64 + i] * lv[96 + i]; }
        const float lam_init = 0.8f - 0.6f * __expf(-0.3f * (float)l);
        ((float*)(ws + WS_LAM))[l] = __expf(s01) - __expf(s23) + lam_init;
    }
}

__device__ __forceinline__ void prep_mod(const Ctx& p, LAS unsigned char* lds) {
    const int tid = opaque_tid(), lane = tid & 63, wave = tid >> 6;
    const int G = gridDim.x;
    LAS float* SC = (LAS float*)lds;
    LAS float* PART = (LAS float*)(lds + 40960);
    for (int i = tid; i < 9 * 1024; i += 512) { const float v = (i < 1024) ? inp(p.ws, I_CCTX)[i] : inp(p.ws, I_C)[i - 1024]; SC[i] = v * sigmoidf_(v); }
    __syncthreads();
    float* mod = (float*)(p.ws + WS_MOD);
    for (int it = blockIdx.x; it < 4 * 36; it += G) {
        const int cb = it % 36, l = it / 36;
        const int col = cb * 256 + lane * 4, k0 = wave * 128;
        const float* W = inp(p.ws, I_WADA) + ((size_t)l * DM + k0) * 9216 + col;
        f32x4 a[9];
#pragma unroll
        for (int c = 0; c < 9; ++c) a[c] = (f32x4){0.f, 0.f, 0.f, 0.f};
#pragma unroll 8
        for (int k = 0; k < 128; ++k) { const f32x4 w = *(const f32x4*)(W + (size_t)k * 9216);
#pragma unroll
            for (int c = 0; c < 9; ++c) a[c] += w * SC[c * 1024 + k0 + k]; }
#pragma unroll
        for (int c = 0; c < 9; ++c) *(LAS f32x4*)(PART + (wave * 9 + c) * 256 + lane * 4) = a[c];
        __syncthreads();
        for (int o = tid; o < 9 * 256; o += 512) { const int c = o >> 8, cc = o & 255;
            float v = inp(p.ws, I_BADA)[(size_t)l * 9216 + cb * 256 + cc];
#pragma unroll
            for (int w = 0; w < 8; ++w) v += PART[(w * 9 + c) * 256 + cc];
            mod[((size_t)(c * 4 + l)) * 9216 + cb * 256 + cc] = v; }
        __syncthreads();
    }
}

__device__ __forceinline__ void norm_phase(const Ctx& p, int l, int which  ) {
    const int tid_ = opaque_tid(), lane = tid_ & 63, wave = tid_ >> 6, gw = blockIdx.x * 8 + wave, NGW = gridDim.x * 8;
    float* X = (float*)(p.ws + WS_X); bf16_t* ACT = (bf16_t*)(p.ws + WS_ACT);
    const float* gsrc = inp(p.ws, which == 0 ? I_NF1 : (which == 1 ? I_NMIX : I_NF2)) + l * DM;
    const bool from_in = (l == 0 && which == 0);
    f32x4 gv[4];
#pragma unroll
    for (int j = 0; j < 4; ++j) gv[j] = *(const f32x4*)(gsrc + j * 256 + lane * 4);
    for (int row = gw; row < M_TOT; row += NGW) {
        const float* xr = from_in ? (row < M_CTX ? inp(p.ws, I_XP) + (size_t)row * DM : inp(p.ws, I_XS) + (size_t)(row - M_CTX) * DM) : X + (size_t)row * DM;
        f32x4 v[4]; float s = 0.f;
#pragma unroll
        for (int j = 0; j < 4; ++j) { v[j] = *(const f32x4*)(xr + j * 256 + lane * 4); s += (v[j][0] * v[j][0] + v[j][1] * v[j][1]) + (v[j][2] * v[j][2] + v[j][3] * v[j][3]); }
        if (from_in) {
#pragma unroll
            for (int j = 0; j < 4; ++j) *(f32x4*)(X + (size_t)row * DM + j * 256 + lane * 4) = v[j];
        }
        const float rstd = rsqrtf(wave_sum(s) * (1.f / DM) + EPSF);
        const int cond = cond_of_row(row);
        const float* sh = mod_ptr(p.ws, cond, l, which * 3 + 0); const float* sc = mod_ptr(p.ws, cond, l, which * 3 + 1);
#pragma unroll
        for (int j = 0; j < 4; ++j) {
            const f32x4 s4 = *(const f32x4*)(sc + j * 256 + lane * 4), h4 = *(const f32x4*)(sh + j * 256 + lane * 4);
            const f32x4 o = (v[j] * rstd) * gv[j] * (s4 + 1.f) + h4;
            u32x2 w; w.x = cvt_pk_bf16(o[0], o[1]); w.y = cvt_pk_bf16(o[2], o[3]);
            *(u32x2*)(ACT + (size_t)row * DM + j * 256 + lane * 4) = w;
        }
    }
}
__device__ __forceinline__ void final_norm_phase(const Ctx& p) {
    const int tid_ = opaque_tid(), lane = tid_ & 63, wave = tid_ >> 6, gw = blockIdx.x * 8 + wave, NGW = gridDim.x * 8;
    const float* X = (const float*)(p.ws + WS_X); const float* gsrc = inp(p.ws, I_FNORM);
    f32x4 gv[4];
#pragma unroll
    for (int j = 0; j < 4; ++j) gv[j] = *(const f32x4*)(gsrc + j * 256 + lane * 4);
    for (int row = gw; row < M_TOT; row += NGW) {
        const float* xr = X + (size_t)row * DM; f32x4 v[4]; float s = 0.f;
#pragma unroll
        for (int j = 0; j < 4; ++j) { v[j] = *(const f32x4*)(xr + j * 256 + lane * 4); s += (v[j][0] * v[j][0] + v[j][1] * v[j][1]) + (v[j][2] * v[j][2] + v[j][3] * v[j][3]); }
        const float rstd = rsqrtf(wave_sum(s) * (1.f / DM) + EPSF);
#pragma unroll
        for (int j = 0; j < 4; ++j) *(f32x4*)(p.out + O_Y + (size_t)row * DM + j * 256 + lane * 4) = (v[j] * rstd) * gv[j];
    }
}

__device__ __forceinline__ void mixprep_phase(const Ctx& p, LAS unsigned char* lds, int l) {
    const int tid = opaque_tid(), G = gridDim.x;
    bf16_t* PROJ = (bf16_t*)(p.ws + WS_PROJ); bf16_t* TR = (bf16_t*)(p.ws + WS_TR);
    {
        LAS float* T = (LAS float*)lds;
        const float* sw = inp(p.ws, I_HSW) + (size_t)l * 3 * 768; const float* sb = inp(p.ws, I_HSB) + (size_t)l * 768;
        for (int it = blockIdx.x; it < 320 * 22; it += G) {
            const int cb = it % 22, rb = it / 22, row0 = rb * 64, tcol0 = cb * 64;
            int src; bool hy = false;
            if (tcol0 < 256) src = 512 + tcol0; else if (tcol0 < 384) src = 1152 + (tcol0 - 256); else if (tcol0 < 640) src = 2560 + (tcol0 - 384); else { src = 1280 + (tcol0 - 640); hy = true; }
            const bool seq_start = row0 < M_CTX ? ((row0 & 255) == 0) : (((row0 - M_CTX) & 2047) == 0);
            const int rend = row0 + 64; const bool seq_end = rend <= M_CTX ? ((rend & 255) == 0) : (((rend - M_CTX) & 2047) == 0);
            for (int idx = tid; idx < 66 * 8; idx += 512) {
                const int rr = idx >> 3, cg8 = idx & 7, grow = row0 - 1 + rr;
                const bool ok = !((rr == 0 && seq_start) || (rr == 65 && seq_end)) && (hy || (rr >= 1 && rr <= 64));
                u32x4 w = (u32x4){0u, 0u, 0u, 0u};
                if (ok) w = *(const u32x4*)(PROJ + (size_t)grow * PROJW + src + cg8 * 8);
                LAS float* d = T + rr * 65 + cg8 * 8;
                d[0] = bflo(w.x); d[1] = bfhi(w.x); d[2] = bflo(w.y); d[3] = bfhi(w.y); d[4] = bflo(w.z); d[5] = bfhi(w.z); d[6] = bflo(w.w); d[7] = bfhi(w.w);
            }
            __syncthreads();
            {
                const int col = tid >> 3, rg = tid & 7; float o[8];
                if (hy) { const int ch = tcol0 - 640 + col; const float w0 = sw[ch], w1 = sw[768 + ch], w2 = sw[1536 + ch], bb = sb[ch];
#pragma unroll
                    for (int j = 0; j < 8; ++j) { const int rr = rg * 8 + j + 1; o[j] = T[(rr - 1) * 65 + col] * w0 + T[rr * 65 + col] * w1 + T[(rr + 1) * 65 + col] * w2 + bb; }
                } else {
#pragma unroll
                    for (int j = 0; j < 8; ++j) o[j] = T[(rg * 8 + j + 1) * 65 + col];
                }
                u32x4 w; w.x = cvt_pk_bf16(o[0], o[1]); w.y = cvt_pk_bf16(o[2], o[3]); w.z = cvt_pk_bf16(o[4], o[5]); w.w = cvt_pk_bf16(o[6], o[7]);
                *(u32x4*)(TR + (size_t)(tcol0 + col) * M_TOT + row0 + rg * 8) = w;
            }
            __syncthreads();
        }
    }
    const int gt = blockIdx.x * 512 + tid, NT = G * 512;
    for (int it = gt; it < M_CTX * 160; it += NT) {
        const int row = it / 160, ch = it - row * 160; int pc, H; size_t ob; int c8;
        if (ch < 32) { pc = 256; H = 4; ob = O_NAK; c8 = ch * 8; }
        else if (ch < 64) { pc = 512; H = 4; ob = O_NAV; c8 = (ch - 32) * 8; }
        else if (ch < 80) { pc = 1024; H = 2; ob = O_SWK; c8 = (ch - 64) * 8; }
        else if (ch < 96) { pc = 1152; H = 2; ob = O_SWV; c8 = (ch - 80) * 8; }
        else if (ch < 128) { pc = 2304; H = 4; ob = O_DFK; c8 = (ch - 96) * 8; }
        else { pc = 2560; H = 4; ob = O_DFV; c8 = (ch - 128) * 8; }
        const u32x4 w = *(const u32x4*)(PROJ + (size_t)row * PROJW + pc + c8);
        const int b = row >> 8, t = row & 255, h = c8 >> 6, d = c8 & 63;
        float* o = p.out + ob + ((((size_t)(b * 4 + l) * H + h) * 256 + t) * 64 + d);
        *(f32x4*)o = (f32x4){bflo(w.x), bfhi(w.x), bflo(w.y), bfhi(w.y)}; *(f32x4*)(o + 4) = (f32x4){bflo(w.z), bfhi(w.z), bflo(w.w), bfhi(w.w)};
    }
    for (int it = gt; it < M_DEC * 448; it += NT) {
        const int rowd = it / 448, pi = it - rowd * 448, t = rowd & 2047, gr = t >> 6, gc = t & 63;
        int a; int bofs; float ang;
        if (pi < 192) {
            const int base = pi < 128 ? 768 : 1024, pj = pi < 128 ? pi : pi - 128, h = pj >> 5, w = pj & 31, i = w & 15;
            const float f = fast_exp2(-(float)i * (13.287712379549449f / 16.f));
            a = base + h * 64 + (w < 16 ? i : 32 + i); bofs = 16; ang = (w < 16 ? (float)gr : (float)gc) * f;
        } else {
            const int base = pi < 320 ? 2048 : 2304, pj = pi < 320 ? pi - 192 : pi - 320, hh = pj >> 4, w = pj & 15, i = w & 7;
            const float f = fast_exp2(-(float)i * (13.287712379549449f / 8.f));
            a = base + hh * 32 + (w < 8 ? i : 16 + i); bofs = 8; ang = (w < 8 ? (float)gr : (float)gc) * f;
        }
        bf16_t* pa = PROJ + (size_t)(M_CTX + rowd) * PROJW + a;
        const float xa = bf2f(pa[0]), xb = bf2f(pa[bofs]);
        const float cs = __cosf(ang), sn = __sinf(ang);
        pa[0] = f2bf1(xa * cs - xb * sn); pa[bofs] = f2bf1(xb * cs + xa * sn);
    }
}

struct AttnState { float m, l; f32x4 o[4]; };
__device__ __forceinline__ f32x4 mfma16(bf16x8 a, bf16x8 b, f32x4 c) { return __builtin_amdgcn_mfma_f32_16x16x32_bf16(a, b, c, 0, 0, 0); }

template <int KS>
__device__ __forceinline__ void qk32(const bf16_t* kb, int ldk, const bf16x8 (&qf)[KS], int l15, int quad, float (&s)[8]) {
    f32x4 a0 = (f32x4){0.f, 0.f, 0.f, 0.f}, a1 = a0;
    const int kr0 = (l15 >> 2) * 8 + (l15 & 3);
#pragma unroll
    for (int ks = 0; ks < KS; ++ks) {
        const bf16x8 k0 = *(const bf16x8*)(kb + (size_t)kr0 * ldk + ks * 32 + quad * 8);
        const bf16x8 k1 = *(const bf16x8*)(kb + (size_t)(kr0 + 4) * ldk + ks * 32 + quad * 8);
        a0 = mfma16(k0, qf[ks], a0); a1 = mfma16(k1, qf[ks], a1);
    }
#pragma unroll
    for (int e = 0; e < 4; ++e) { s[e] = a0[e]; s[4 + e] = a1[e]; }
}
__device__ __forceinline__ void softmax_pv(AttnState& st, const float (&s2)[8], unsigned vmask, const bf16_t* vt, int ldv, int l15, int quad) {
    float mx = -1e30f;
#pragma unroll
    for (int j = 0; j < 8; ++j) mx = fmaxf(mx, ((vmask >> j) & 1u) ? s2[j] : -1e30f);
    mx = fmaxf(mx, __shfl_xor(mx, 16)); mx = fmaxf(mx, __shfl_xor(mx, 32));
    const float mn = fmaxf(st.m, mx), alpha = fast_exp2(st.m - mn);
    float pr[8]; float sum = 0.f;
#pragma unroll
    for (int j = 0; j < 8; ++j) { pr[j] = ((vmask >> j) & 1u) ? fast_exp2(s2[j] - mn) : 0.f; sum += pr[j]; }
    sum += __shfl_xor(sum, 16); sum += __shfl_xor(sum, 32);
    st.l = st.l * alpha + sum; st.m = mn;
    u32x4 pw; pw.x = cvt_pk_bf16(pr[0], pr[1]); pw.y = cvt_pk_bf16(pr[2], pr[3]); pw.z = cvt_pk_bf16(pr[4], pr[5]); pw.w = cvt_pk_bf16(pr[6], pr[7]);
    const bf16x8 pf = __builtin_bit_cast(bf16x8, pw);
#pragma unroll
    for (int nt = 0; nt < 4; ++nt) {
        const bf16x8 vf = *(const bf16x8*)(vt + (size_t)(nt * 16 + l15) * ldv + quad * 8);
        st.o[nt] = mfma16(vf, pf, st.o[nt] * alpha);
    }
}
template <int KS>
__device__ __forceinline__ void attn_dense(AttnState& st, const bf16x8 (&qf)[KS], const bf16_t* kb, int ldk, const bf16_t* vt, int ldv, int nkeys, float sc2, int l15, int quad) {
    for (int k0 = 0; k0 < nkeys; k0 += 32) {
        float s[8]; qk32<KS>(kb + (size_t)k0 * ldk, ldk, qf, l15, quad, s);
#pragma unroll
        for (int j = 0; j < 8; ++j) s[j] *= sc2;
        softmax_pv(st, s, 0xffu, vt + k0, ldv, l15, quad);
    }
}
__device__ __forceinline__ void st_init(AttnState& st, float m0, float l0) { st.m = m0; st.l = l0;
#pragma unroll
    for (int i = 0; i < 4; ++i) st.o[i] = (f32x4){0.f, 0.f, 0.f, 0.f}; }

__device__ __forceinline__ void attn_item(const Ctx& p, int l, int type, bool dec, int b, int h, int tile, int lane_) {
    const int lane = lane_, l15 = lane & 15, quad = lane >> 4;
    const bf16_t* PROJ = (const bf16_t*)(p.ws + WS_PROJ); const bf16_t* TR = (const bf16_t*)(p.ws + WS_TR);
    const bf16_t* CK = (const bf16_t*)(p.ws + WS_CK); const bf16_t* CV = CK + CK_HALF;
    bf16_t* BR = (bf16_t*)(p.ws + WS_BR);
    const int L = dec ? 2048 : 256, rowbase = dec ? M_CTX + b * 2048 : b * 256, q0 = tile * 16;
    const bf16_t* Pb = PROJ + (size_t)rowbase * PROJW;
    const size_t qrow = (size_t)(q0 + l15) * PROJW;
    if (type == 0) {
        bf16x8 qf[2];
        qf[0] = *(const bf16x8*)(Pb + qrow + h * 64 + quad * 8); qf[1] = *(const bf16x8*)(Pb + qrow + h * 64 + 32 + quad * 8);
        const bf16_t* Kb = Pb + 256 + h * 64; const bf16_t* Vt = TR + (size_t)(h * 64) * M_TOT + rowbase;
        AttnState st; st_init(st, -1e30f, 0.f);
        const float sc2 = 0.125f * LOG2E;
        if (!dec) attn_dense<2>(st, qf, Kb, PROJW, Vt, M_TOT, 256, sc2, l15, quad);
        else {
            const int r = tile >> 2, cg4 = tile & 3, qc = cg4 * 16 + l15;
            const int c0 = min(max(qc - 8, 0), 48), rs = min(max(r - 4, 0), 24), kcol0 = cg4 == 0 ? 0 : (cg4 == 1 ? 8 : (cg4 == 2 ? 24 : 32));
            const float* rpb = inp(p.ws, I_RPB) + ((size_t)(l * 4 + h)) * 15 * 31;
            for (int kr = 0; kr < 8; ++kr) {
                const int krow = rs + kr, key0 = krow * 64 + kcol0;
                float s[8]; qk32<2>(Kb + (size_t)key0 * PROJW, PROJW, qf, l15, quad, s);
                const float* rp = rpb + (krow - r + 7) * 31; unsigned vm = 0u;
#pragma unroll
                for (int j = 0; j < 8; ++j) { const int kcol = kcol0 + quad * 8 + j; const bool ok = (kcol >= c0) && (kcol < c0 + 16);
                    const int dc = min(max(kcol - qc + 15, 0), 30); s[j] = (s[j] * 0.125f + rp[dc]) * LOG2E; vm |= ok ? (1u << j) : 0u; }
                softmax_pv(st, s, vm, Vt + key0, M_TOT, l15, quad);
            }
            attn_dense<2>(st, qf, CK + CK_NA + (size_t)(b * 4 + h) * 512 * 64, 64, CV + CK_NA + (size_t)(b * 4 + h) * 64 * 512, 512, 512, sc2, l15, quad);
        }
        const float il = fast_rcp(st.l);
        bf16_t* o = BR + (size_t)(rowbase + q0 + l15) * 256 + h * 64 + quad * 4;
#pragma unroll
        for (int nt = 0; nt < 4; ++nt) { u32x2 w; w.x = cvt_pk_bf16(st.o[nt][0] * il, st.o[nt][1] * il); w.y = cvt_pk_bf16(st.o[nt][2] * il, st.o[nt][3] * il); *(u32x2*)(o + nt * 16) = w; }
    } else if (type == 1) {
        const int kvh = h >> 1;
        bf16x8 qf[2];
        qf[0] = *(const bf16x8*)(Pb + qrow + 768 + h * 64 + quad * 8); qf[1] = *(const bf16x8*)(Pb + qrow + 768 + h * 64 + 32 + quad * 8);
        const bf16_t* Kb = Pb + 1024 + kvh * 64; const bf16_t* Vt = TR + (size_t)(256 + kvh * 64) * M_TOT + rowbase;
        const float sink = inp(p.ws, I_SINK)[l * 4 + h];
        AttnState st; st_init(st, sink * LOG2E, 1.f);
        const float sc2 = 0.125f * LOG2E;
        if (!dec) attn_dense<2>(st, qf, Kb, PROJW, Vt, M_TOT, 256, sc2, l15, quad);
        else {
            const int qt = q0 + l15, s0 = (q0 - 128) & ~31;
            for (int i = 0; i < 9; ++i) {
                const int ks = s0 + 32 * i; if (ks < 0 || ks >= L) continue;
                float s[8]; qk32<2>(Kb + (size_t)ks * PROJW, PROJW, qf, l15, quad, s); unsigned vm = 0u;
#pragma unroll
                for (int j = 0; j < 8; ++j) { const int kt = ks + quad * 8 + j, dd = kt - qt; const bool ok = (dd <= 128) && (dd >= -128); s[j] *= sc2; vm |= ok ? (1u << j) : 0u; }
                softmax_pv(st, s, vm, Vt + ks, M_TOT, l15, quad);
            }
            attn_dense<2>(st, qf, CK + CK_SW + (size_t)(b * 2 + kvh) * 512 * 64, 64, CV + CK_SW + (size_t)(b * 2 + kvh) * 64 * 512, 512, 512, sc2, l15, quad);
        }
        const float il = fast_rcp(st.l);
        bf16_t* o = BR + (size_t)M_TOT * 256 + (size_t)(rowbase + q0 + l15) * 256 + h * 64 + quad * 4;
#pragma unroll
        for (int nt = 0; nt < 4; ++nt) { u32x2 w; w.x = cvt_pk_bf16(st.o[nt][0] * il, st.o[nt][1] * il); w.y = cvt_pk_bf16(st.o[nt][2] * il, st.o[nt][3] * il); *(u32x2*)(o + nt * 16) = w; }
    } else {
        const bf16_t* Vt = TR + (size_t)(384 + h * 64) * M_TOT + rowbase;
        const float sc2 = 0.17677669529663687f * LOG2E;
        f32x4 o0[4]; float l0 = 1.f;
#pragma unroll 1
        for (int mp = 0; mp < 2; ++mp) {
            bf16x8 qf[1]; qf[0] = *(const bf16x8*)(Pb + qrow + 2048 + h * 64 + mp * 32 + quad * 8);
            AttnState st; st_init(st, -1e30f, 0.f);
            attn_dense<1>(st, qf, Pb + 2304 + h * 64 + mp * 32, PROJW, Vt, M_TOT, L, sc2, l15, quad);
            if (dec) attn_dense<1>(st, qf, CK + CK_DF + (size_t)(b * 4 + h) * 512 * 64 + mp * 32, 64, CV + CK_DF + (size_t)(b * 4 + h) * 64 * 512, 512, 512, sc2, l15, quad);
            if (mp == 0) { l0 = st.l;
#pragma unroll
                for (int i = 0; i < 4; ++i) o0[i] = st.o[i]; }
            else {
                const float lam = ((const float*)(p.ws + WS_LAM))[l], lam_init = 0.8f - 0.6f * __expf(-0.3f * (float)l);
                const float i0 = fast_rcp(l0), i1 = lam * fast_rcp(st.l);
                f32x4 d[4]; float ss = 0.f;
#pragma unroll
                for (int i = 0; i < 4; ++i) { d[i] = o0[i] * i0 - st.o[i] * i1; ss += (d[i][0] * d[i][0] + d[i][1] * d[i][1]) + (d[i][2] * d[i][2] + d[i][3] * d[i][3]); }
                ss += __shfl_xor(ss, 16); ss += __shfl_xor(ss, 32);
                const float rs = rsqrtf(ss * (1.f / 64.f) + EPSF) * (1.f - lam_init);
                const float* sg = inp(p.ws, I_DSUB) + l * 64 + quad * 4;
                bf16_t* o = BR + (size_t)3 * M_TOT * 256 + (size_t)(rowbase + q0 + l15) * 256 + h * 64 + quad * 4;
#pragma unroll
                for (int nt = 0; nt < 4; ++nt) { const f32x4 g4 = *(const f32x4*)(sg + nt * 16); const f32x4 v = d[nt] * rs * g4;
                    u32x2 w; w.x = cvt_pk_bf16(v[0], v[1]); w.y = cvt_pk_bf16(v[2], v[3]); *(u32x2*)(o + nt * 16) = w; }
            }
        }
    }
}

__device__ __forceinline__ void hyena_unit(const Ctx& p, LAS unsigned char* lds, int l, int c, bool dec) {
    const int tid = opaque_tid(), lane = tid & 63, wave = __builtin_amdgcn_readfirstlane(tid >> 6), l15 = lane & 15, quad = lane >> 4;
    const int L = dec ? 2048 : 256, B = dec ? 8 : 16, LP = L + 8, rowbase = dec ? M_CTX : 0, L2 = 2 * L;
    LAS bf16_t* COP = (LAS bf16_t*)lds;
    LAS bf16_t* YA = (LAS bf16_t*)(lds + 65536);
    LAS bf16_t* YB = (LAS bf16_t*)(lds + 65536 + 33024);
    LAS float* RED = (LAS float*)(lds + 65536 + 2 * 33024);
    const bf16_t* TR = (const bf16_t*)(p.ws + WS_TR);
    bf16_t* BR2 = (bf16_t*)(p.ws + WS_BR) + (size_t)2 * M_TOT * 256;
    const float* HF = (const float*)(p.ws + WS_HFIL) + (dec ? 262144 : 0);
    { const bf16_t* src = TR + (size_t)(640 + c) * M_TOT + rowbase;
      for (int i = tid; i < B * L / 8; i += 512) { const int e = i * 8, b = e / L, t = e - b * L; *(LAS u32x4*)(YA + b * LP + t) = *(const u32x4*)(src + e); } }
#pragma unroll 1
    for (int o = 0; o < 2; ++o) {
        LAS float* RF = (LAS float*)(o == 0 ? YB : YA);
        __syncthreads();
        const float* raw0 = HF + ((size_t)((o * 2 + 0) * 256 + c)) * L; const float* raw1 = HF + ((size_t)((o * 2 + 1) * 256 + c)) * L;
        float part = 0.f;
        for (int u = tid; u < L2; u += 512) { const int lag = L - 1 - u; float v = 0.f; if (lag >= 0) v = raw0[lag]; else if (lag > -L) v = raw1[-lag]; RF[u] = v; part += fabsf(v); }
        part = wave_sum(part);
        if (lane == 0) RED[wave] = part;
        __syncthreads();
        float tot = 0.f;
#pragma unroll
        for (int w = 0; w < 8; ++w) tot += RED[w];
        const float inv = 1.f / (tot + EPSF);
        const int ng = L2 / 8;
        for (int idx = tid; idx < 8 * ng; idx += 512) { const int m = idx / ng, x = (idx - m * ng) * 8; float v[8];
#pragma unroll
            for (int j = 0; j < 8; ++j) { const int u = x + m + j; v[j] = (u < L2) ? RF[u] * inv : 0.f; }
            u32x4 w; w.x = cvt_pk_bf16(v[0], v[1]); w.y = cvt_pk_bf16(v[2], v[3]); w.z = cvt_pk_bf16(v[4], v[5]); w.w = cvt_pk_bf16(v[6], v[7]);
            *(LAS u32x4*)(COP + m * L2 + x) = w; }
        __syncthreads();
        const LAS bf16_t* Y = (o == 0) ? YA : YB;
        const LAS bf16_t* cpb = COP + (7 - (l15 & 7)) * L2 + (L - 8 - 8 * (l15 >> 3) + quad * 8);
        const float skip = inp(p.ws, I_HSKIP)[(l * 2 + o) * 256 + c];
        const bf16_t* gate = TR + (size_t)((o == 0 ? 896 : 1152) + c) * M_TOT + rowbase;
        const int ngroups = L / 64;
        const bf16x8 zero8 = (bf16x8){0, 0, 0, 0, 0, 0, 0, 0};
        for (int g = wave; g < ngroups; g += 8) {
            const int t0 = (g >> 1) * 128 + (g & 1) * 16;
            f32x4 a0 = (f32x4){0.f, 0.f, 0.f, 0.f}, a1 = a0, a2 = a0, a3 = a0;
#define HY_D(s) (*(const LAS bf16x8*)(cpb + (32 * (s) - t0)))
#define HY_Y(s) ((l15 < B) ? *(const LAS bf16x8*)(Y + l15 * LP + 32 * (s) + quad * 8) : zero8)
            bf16x8 d0, d1 = HY_D(-1), d2 = HY_D(-2), d3 = HY_D(-3), y;
            for (int s = 0; s < L / 32; s += 4) {
                d0 = HY_D(s);     y = HY_Y(s);     a0 = mfma16(d0, y, a0); a1 = mfma16(d1, y, a1); a2 = mfma16(d2, y, a2); a3 = mfma16(d3, y, a3);
                d3 = HY_D(s + 1); y = HY_Y(s + 1); a0 = mfma16(d3, y, a0); a1 = mfma16(d0, y, a1); a2 = mfma16(d1, y, a2); a3 = mfma16(d2, y, a3);
                d2 = HY_D(s + 2); y = HY_Y(s + 2); a0 = mfma16(d2, y, a0); a1 = mfma16(d3, y, a1); a2 = mfma16(d0, y, a2); a3 = mfma16(d1, y, a3);
                d1 = HY_D(s + 3); y = HY_Y(s + 3); a0 = mfma16(d1, y, a0); a1 = mfma16(d2, y, a1); a2 = mfma16(d3, y, a2); a3 = mfma16(d0, y, a3);
            }
#undef HY_D
#undef HY_Y
            if (l15 < B) {
#pragma unroll
                for (int a = 0; a < 4; ++a) {
                    const f32x4 cv = a == 0 ? a0 : (a == 1 ? a1 : (a == 2 ? a2 : a3));
                    const int t = t0 + 32 * a + quad * 4;
                    const u32x2 gw = *(const u32x2*)(gate + (size_t)l15 * L + t);
                    const u32x2 yw = *(const LAS u32x2*)(Y + l15 * LP + t);
                    f32x4 r;
                    r[0] = bflo(gw.x) * (cv[0] + skip * bflo(yw.x)); r[1] = bfhi(gw.x) * (cv[1] + skip * bfhi(yw.x));
                    r[2] = bflo(gw.y) * (cv[2] + skip * bflo(yw.y)); r[3] = bfhi(gw.y) * (cv[3] + skip * bfhi(yw.y));
                    if (o == 0) { u32x2 w; w.x = cvt_pk_bf16(r[0], r[1]); w.y = cvt_pk_bf16(r[2], r[3]); *(LAS u32x2*)(YB + l15 * LP + t) = w; }
                    else { bf16_t* op = BR2 + (size_t)(rowbase + l15 * L + t) * 256 + c;
                        op[0] = f2bf1(r[0]); op[256] = f2bf1(r[1]); op[512] = f2bf1(r[2]); op[768] = f2bf1(r[3]); }
                }
            }
        }
    }
    __syncthreads();
}

__device__ __forceinline__ void mix_phase(const Ctx& p, LAS unsigned char* lds, int l) {
    const int G = gridDim.x;
    for (int u = blockIdx.x; u < 512; u += G) hyena_unit(p, lds, l, u & 255, u < 256);
    const int tid_ = opaque_tid(), wave = tid_ >> 6, gw = blockIdx.x * 8 + wave, NGW = G * 8;
    for (int it = gw; it < 15360; it += NGW) {
        int type, r; bool dec;
        if (it < 12288) { dec = true; const int k = it >> 12; type = 2 - k; r = it & 4095; const int tile = r & 127, bh = r >> 7; attn_item(p, l, type, dec, bh >> 2, bh & 3, tile, tid_ & 63); }
        else { dec = false; const int q = it - 12288, k = q >> 10; type = 2 - k; r = q & 1023; const int tile = r & 15, bh = r >> 4; attn_item(p, l, type, dec, bh >> 2, bh & 3, tile, tid_ & 63); }
    }
}

__global__ void __launch_bounds__(512, 2) mega(Params P) {
    extern __shared__ __attribute__((aligned(16))) unsigned char lds_raw[];
    LAS unsigned char* lds = (LAS unsigned char*)lds_raw;
    cg::grid_group grid = cg::this_grid();
#pragma unroll 1
    for (int ph = P.ph_lo; ph < P.ph_hi; ++ph) {
        Ctx p; p.ws = P.ws; p.out = P.out; asm volatile("" : "+s"(p.ws), "+s"(p.out));
        unsigned char* ws = p.ws;
        if (ph == 0) {
            if (threadIdx.x < N_IN) { ((unsigned long long*)(ws + WS_TAB))[threadIdx.x] = (unsigned long long)P.in[threadIdx.x]; }
            asm volatile("s_waitcnt vmcnt(0)" ::: "memory"); __syncthreads();
#ifndef NO_PREP
            prep_mod(p, lds); __syncthreads(); prep_layer(p, lds, 0);
#endif
        }
        else if (ph == 49) final_norm_phase(p);
        else {
            const int l = (ph - 1) / 12, s = (ph - 1) % 12;
            const bool is_gemm = (s == 1 || s == 2 || s == 4 || s == 7 || s == 8 || s == 10 || s == 11);
            if (is_gemm) {
                pg8::Gemm g; pg8::Sched S; pg8::Epi E; bool perm;
                S.G = gridDim.x; S.c = blockIdx.x; S.mode = 0; S.nM = M_TOT / 256;
                E.o16 = nullptr; E.o16b = nullptr; E.of = nullptr; E.g = nullptr; E.gates = nullptr; E.scale = 1.f;
                bf16_t* ACT = (bf16_t*)(ws + WS_ACT); bf16_t* BIG = (bf16_t*)(ws + WS_BIG); float* X = (float*)(ws + WS_X);
                if (s == 1 || s == 10) { g.A = ACT; g.Bt = (const bf16_t*)(ws + WS_W + (s == 1 ? W_F1UP : W_F2UP)); g.K = DM; S.nN = 22; E.kind = pg8::EK_SWIGLU; E.o16 = BIG; perm = true; }
                else if (s == 2 || s == 11) { g.A = BIG; g.Bt = (const bf16_t*)(ws + WS_W + (s == 2 ? W_F1DN : W_F2DN)); g.K = DFF; S.nN = 4; E.kind = pg8::EK_RESID; E.of = X;
                    E.g = mod_ptr(ws, 0, l, s == 2 ? 2 : 8); E.scale = 0.5f; perm = false; }
                else if (s == 4) { g.A = ACT; g.Bt = (const bf16_t*)(ws + WS_W + W_IN); g.K = DM; S.nN = 27; E.kind = pg8::EK_PROJ; E.o16 = (bf16_t*)(ws + WS_PROJ); E.o16b = BIG; perm = true; }
                else if (s == 7) { g.A = (const bf16_t*)(ws + WS_BR); g.Bt = (const bf16_t*)(ws + WS_W + W_BR); g.K = 256; S.mode = 1; S.nN = 4; E.kind = pg8::EK_BRANCH; E.of = (float*)(ws + WS_PROJ);
                    E.o16 = ACT; E.gates = BIG; perm = false; }
                else { g.A = ACT; g.Bt = (const bf16_t*)(ws + WS_W + W_OUT); g.K = DM; S.nN = 4; E.kind = pg8::EK_RESID; E.of = X; E.g = mod_ptr(ws, 0, l, 5); E.scale = 1.f; perm = false; }
                S.nwg = S.nM * S.nN;
                #ifndef NO_GEMM
                pg8::gemm_phase(lds, g, S, E, perm);
#endif
            } else if (s == 0 || s == 3 || s == 9) {
                norm_phase(p, l, s == 0 ? 0 : (s == 3 ? 1 : 2));
                #ifndef NO_PREP
                if (s == 0 && l > 0) prep_layer(p, lds, l);
#endif
            } else if (s == 5) {
#ifndef NO_MIXPREP
                mixprep_phase(p, lds, l);
#endif
            } else {
#ifndef NO_MIX
                mix_phase(p, lds, l);
#endif
            }
        }
        if (ph + 1 < P.ph_hi) grid.sync();
    }
}

extern "C" void kernel_launch(void* const* d_in, const int* in_sizes, int n_in, void* d_out, int out_size, void* d_ws, size_t ws_size, hipStream_t stream) {
    static int grid = 0;
    if (grid == 0) {
        if (n_in != N_IN || ws_size < WS_END) { fprintf(stderr, "kernel_launch: unexpected n_in %d / ws_size %zu (need %zu)\n", n_in, ws_size, (size_t)WS_END); grid = -1; return; }
        int dev = 0, cus = 0, per_cu = 0;
        hipGetDevice(&dev); hipDeviceGetAttribute(&cus, hipDeviceAttributeMultiprocessorCount, dev);
        if (hipFuncSetAttribute((const void*)mega, hipFuncAttributeMaxDynamicSharedMemorySize, LDS_BYTES) != hipSuccess) { fprintf(stderr, "kernel_launch: hipFuncSetAttribute failed\n"); grid = -1; return; }
        if (hipOccupancyMaxActiveBlocksPerMultiprocessor(&per_cu, (const void*)mega, 512, LDS_BYTES) != hipSuccess || per_cu < 1) per_cu = 1;
        (void)hipGetLastError();
        grid = cus * 1;
        fprintf(stderr, "kernel_launch: grid %d (per_cu %d), ws %zu\n", grid, per_cu, ws_size);
    }
    if (grid < 0) return;
    hipMemsetAsync(d_ws, 0, WS_ZERO_BYTES, stream);
    Params p{};
    for (int i = 0; i < N_IN; ++i) p.in[i] = (const float*)d_in[i];
    p.out = (float*)d_out; p.ws = (unsigned char*)d_ws; p.ph_lo = 0; p.ph_hi = 50;
    void* args[] = {&p};
    hipError_t e = hipLaunchCooperativeKernel((const void*)mega, dim3(grid), dim3(512), args, LDS_BYTES, stream);
    if (e != hipSuccess) fprintf(stderr, "cooperative launch failed: %s (grid %d)\n", hipGetErrorString(e), grid);
}
```

```cpp
#include <hip/hip_runtime.h>
#include <hip/hip_cooperative_groups.h>
#include <cstdio>
#include <cstdint>
namespace cg = cooperative_groups;

#define LAS __attribute__((address_space(3)))
typedef unsigned short bf16_t;
typedef short bf16x8 __attribute__((ext_vector_type(8)));
typedef float f32x4 __attribute__((ext_vector_type(4)));
typedef float f32x2 __attribute__((ext_vector_type(2)));
typedef unsigned u32x4 __attribute__((ext_vector_type(4)));
typedef unsigned u32x2 __attribute__((ext_vector_type(2)));

constexpr int DM = 1024, DFF = 2816, INW = 6912, PROJW = 2816, GATEW = 4096;
constexpr int M_CTX = 4096, M_DEC = 16384, M_TOT = 20480;
constexpr int NLAYER = 4;
constexpr float EPSF = 1e-6f;
constexpr float LOG2E = 1.4426950408889634f;
constexpr size_t O_Y = 0, O_NAK = 20971520, O_NAV = 25165824, O_SWK = 29360128, O_SWV = 31457280, O_DFK = 33554432, O_DFV = 37748736;
enum { I_XP = 0, I_XS, I_CNAK, I_CNAV, I_CSWK, I_CSWV, I_CDFK, I_CDFV, I_C, I_CCTX, I_WADA, I_BADA, I_NF1, I_NMIX, I_NF2, I_FNORM,
       I_F1W1, I_F1W3, I_F1W2, I_F2W1, I_F2W3, I_F2W2, I_WIN, I_WBR, I_WOUT, I_RPB, I_SINK, I_HSW, I_HSB, I_HW1, I_HB1, I_HW2, I_HB2, I_HW3,
       I_HSF, I_HLD, I_HSKIP, I_DLAM, I_DSUB, N_IN };

constexpr size_t MiB = 1u << 20;
constexpr size_t WS_CTL = 0;
constexpr size_t WS_MOD = 1 * MiB;
constexpr size_t WS_ZERO_BYTES = 65536;
constexpr size_t WS_LAM = 3 * MiB;
constexpr size_t WS_W = 4 * MiB;
constexpr size_t W_F1UP = 0, W_F1DN = W_F1UP + (size_t)5632 * 1024 * 2, W_F2UP = W_F1DN + (size_t)1024 * 2816 * 2, W_F2DN = W_F2UP + (size_t)5632 * 1024 * 2,
                 W_IN = W_F2DN + (size_t)1024 * 2816 * 2, W_BR = W_IN + (size_t)6912 * 1024 * 2, W_OUT = W_BR + (size_t)4 * 1024 * 256 * 2, W_END = W_OUT + (size_t)1024 * 1024 * 2;
static_assert(W_END <= 52 * MiB, "weights");
constexpr size_t WS_X = 56 * MiB;
constexpr size_t WS_ACT = 136 * MiB;
constexpr size_t WS_BR = 176 * MiB;
constexpr size_t WS_BIG = 216 * MiB;
constexpr size_t WS_PROJ = 376 * MiB;
constexpr size_t WS_TR = 486 * MiB;
constexpr size_t WS_CK = 541 * MiB;
constexpr size_t WS_HFIL = 551 * MiB;
constexpr size_t WS_END = 560 * MiB;
constexpr int TRW = 1408;
constexpr size_t CK_NA = 0, CK_SW = 1048576, CK_DF = 1572864, CK_HALF = 2621440;
constexpr int LDS_BYTES = 147456;

struct Params { const float* in[N_IN]; float* out; unsigned char* ws; int ph_lo, ph_hi; };
struct Ctx { float* out; unsigned char* ws; };
constexpr size_t WS_TAB = 3 * MiB + 65536;
__device__ __forceinline__ const float* inp(const unsigned char* ws, int i) {
    const unsigned long long v = __hip_atomic_load((const unsigned long long*)(ws + WS_TAB) + i, __ATOMIC_RELAXED, __HIP_MEMORY_SCOPE_AGENT);
    const unsigned lo = __builtin_amdgcn_readfirstlane((unsigned)v), hi = __builtin_amdgcn_readfirstlane((unsigned)(v >> 32));
    return (const float*)(((unsigned long long)hi << 32) | lo);
}


__device__ __forceinline__ unsigned cvt_pk_bf16(float lo, float hi) { unsigned r; asm volatile("v_cvt_pk_bf16_f32 %0, %1, %2" : "=v"(r) : "v"(lo), "v"(hi)); return r; }
__device__ __forceinline__ float bf2f(unsigned short v) { return __uint_as_float(((unsigned)v) << 16); }
__device__ __forceinline__ float bflo(unsigned v) { return __uint_as_float(v << 16); }
__device__ __forceinline__ float bfhi(unsigned v) { return __uint_as_float(v & 0xffff0000u); }
__device__ __forceinline__ bf16_t f2bf1(float f) { return (bf16_t)(cvt_pk_bf16(f, 0.f) & 0xffffu); }
__device__ __forceinline__ float fast_exp2(float x) { return __builtin_amdgcn_exp2f(x); }
__device__ __forceinline__ float fast_rcp(float x) { return __builtin_amdgcn_rcpf(x); }
__device__ __forceinline__ float sigmoidf_(float x) { return fast_rcp(1.f + fast_exp2(-x * LOG2E)); }
__device__ __forceinline__ float wave_sum(float v) {
#pragma unroll
    for (int o = 1; o < 64; o <<= 1) v += __shfl_xor(v, o);
    return v;
}
__device__ __forceinline__ int cond_of_row(int row) { return row < M_CTX ? 0 : 1 + ((row - M_CTX) >> 11); }
__device__ __forceinline__ const float* mod_ptr(const unsigned char* ws, int cond, int l, int chunk) { return (const float*)(ws + WS_MOD) + ((size_t)(cond * 4 + l) * 9 + chunk) * 1024; }

__device__ __forceinline__ int opaque_tid() { int t; asm volatile("v_mov_b32 %0, %1" : "=v"(t) : "v"((int)threadIdx.x)); return t; }
namespace pg8 {
constexpr int BM = 256, BK = 64, HALF = 128, HTB = HALF * BK * 2, STAGE_BYTES = 8 * HTB, NXCD = 8, WGM = 8;
__device__ __forceinline__ int lds_byte(int r, int c) { const int st = (r >> 4) * 2 + (c >> 5), rr = r & 15, cc = c & 31, ob = rr * 64 + cc * 2; return st * 1024 + (ob ^ (((ob >> 9) & 1) << 5)); }
__device__ __forceinline__ void stage_rc(int b, int& R, int& C) { const int st = b / 1024, sb = b % 1024, swz = sb ^ (((sb >> 9) & 1) << 5); R = (st >> 1) * 16 + swz / 64; C = (st & 1) * 32 + (swz % 64) / 2; }
__device__ __forceinline__ int perm32(int rho) { const int n = rho >> 4, i = rho & 15; return 8 * (i >> 2) + 4 * n + (i & 3); }
struct Unit { int pm, pn; };
struct Sched { int mode, nM, nN, nwg, G, c; };
__device__ __forceinline__ bool sched_next(const Sched& S, int i, Unit& u) {
    const int j = (S.mode == 1) ? (i >> 2) : i;
    const long L = (long)j * S.G + S.c; if (L >= S.nwg) return false;
    int wgid = (int)L; { const int q = S.nwg / NXCD, r = S.nwg % NXCD, xcd = wgid % NXCD, off = wgid / NXCD; wgid = (xcd < r ? xcd * (q + 1) : r * (q + 1) + (xcd - r) * q) + off; }
    const int nig = WGM * S.nN, gid = wgid / nig, fm = gid * WGM, gsz = (S.nM - fm) < WGM ? (S.nM - fm) : WGM;
    const int pm = fm + ((wgid % nig) % gsz), pn = (wgid % nig) / gsz;
    if (S.mode == 1) { const int b = i & 3; u.pm = b * S.nM + pm; u.pn = b * S.nN + pn; } else { u.pm = pm; u.pn = pn; }
    return true;
}
enum { EK_SWIGLU = 0, EK_RESID = 1, EK_PROJ = 2, EK_BRANCH = 3 };
struct Epi { int kind; bf16_t* o16; bf16_t* o16b; float* of; const float* g; const bf16_t* gates; float scale; };
struct Gemm { const bf16_t* A; const bf16_t* Bt; int K; };

__device__ __forceinline__ void epilogue(const Epi& E, const f32x4 (&acc)[2][2][4][2], const Unit& u, int wr, int wc, int fr, int fq) {
    if (E.kind == EK_SWIGLU) {
        const int row0 = u.pm * BM + wr * 64 + fr, col0 = u.pn * 128 + wc * 32 + 8 * fq;
#pragma unroll
        for (int ai = 0; ai < 2; ++ai)
#pragma unroll
            for (int m = 0; m < 4; ++m) {
                const f32x4 a0 = acc[ai][0][m][0], a1 = acc[ai][0][m][1], b0 = acc[ai][1][m][0], b1 = acc[ai][1][m][1];
                float r[8];
#pragma unroll
                for (int e = 0; e < 4; ++e) { r[e] = a0[e] * sigmoidf_(a0[e]) * b0[e]; r[4 + e] = a1[e] * sigmoidf_(a1[e]) * b1[e]; }
                u32x4 w; w.x = cvt_pk_bf16(r[0], r[1]); w.y = cvt_pk_bf16(r[2], r[3]); w.z = cvt_pk_bf16(r[4], r[5]); w.w = cvt_pk_bf16(r[6], r[7]);
                *(u32x4*)(E.o16 + (size_t)(row0 + ai * HALF + m * 16) * DFF + col0) = w;
            }
    } else if (E.kind == EK_PROJ) {
        const int row0 = u.pm * BM + wr * 64 + fr;
        const bool isgate = u.pn >= 11;
        bf16_t* base = isgate ? E.o16b : E.o16; const int ld = isgate ? GATEW : PROJW;
        const int col0 = (isgate ? (u.pn - 11) * BM : u.pn * BM) + wc * 32 + 8 * fq;
#pragma unroll
        for (int ai = 0; ai < 2; ++ai)
#pragma unroll
            for (int m = 0; m < 4; ++m)
#pragma unroll
                for (int bj = 0; bj < 2; ++bj) {
                    f32x4 v0 = acc[ai][bj][m][0], v1 = acc[ai][bj][m][1];
                    if (isgate) {
#pragma unroll
                        for (int e = 0; e < 4; ++e) { v0[e] = sigmoidf_(v0[e]); v1[e] = sigmoidf_(v1[e]); }
                    }
                    u32x4 w; w.x = cvt_pk_bf16(v0[0], v0[1]); w.y = cvt_pk_bf16(v0[2], v0[3]); w.z = cvt_pk_bf16(v1[0], v1[1]); w.w = cvt_pk_bf16(v1[2], v1[3]);
                    *(u32x4*)(base + (size_t)(row0 + ai * HALF + m * 16) * ld + col0 + bj * HALF) = w;
                }
    } else if (E.kind == EK_RESID) {
        const int cond = (u.pm < 16) ? 0 : 1 + ((u.pm - 16) >> 3);
        const float* gv = E.g + (size_t)cond * (4 * 9 * 1024);
        const int row0 = u.pm * BM + wr * 64 + fr, col0 = u.pn * BM + wc * 32 + 4 * fq;
#pragma unroll
        for (int bj = 0; bj < 2; ++bj)
#pragma unroll
            for (int n = 0; n < 2; ++n) {
                const int col = col0 + bj * HALF + n * 16;
                const f32x4 g4 = *(const f32x4*)(gv + col) * E.scale;
#pragma unroll
                for (int ai = 0; ai < 2; ++ai)
#pragma unroll
                    for (int m = 0; m < 4; ++m) {
                        f32x4* px = (f32x4*)(E.of + (size_t)(row0 + ai * HALF + m * 16) * DM + col);
                        *px = *px + g4 * acc[ai][bj][m][n];
                    }
            }
    } else {
        const int bi = u.pm / 80, pm = u.pm - bi * 80, pn = u.pn & 3;
        const int row0 = pm * BM + wr * 64 + fr, col0 = pn * BM + wc * 32 + 4 * fq;
#pragma unroll
        for (int bj = 0; bj < 2; ++bj)
#pragma unroll
            for (int n = 0; n < 2; ++n) {
                const int col = col0 + bj * HALF + n * 16;
#pragma unroll
                for (int ai = 0; ai < 2; ++ai)
#pragma unroll
                    for (int m = 0; m < 4; ++m) {
                        const size_t row = (size_t)(row0 + ai * HALF + m * 16);
                        const u32x2 gw = *(const u32x2*)(E.gates + row * GATEW + bi * 1024 + col);
                        f32x4 gt; gt[0] = bflo(gw.x); gt[1] = bfhi(gw.x); gt[2] = bflo(gw.y); gt[3] = bfhi(gw.y);
                        f32x4* pmf = (f32x4*)(E.of + row * DM + col);
                        f32x4 v = gt * acc[ai][bj][m][n];
                        if (bi > 0) v = v + *pmf;
                        if (bi < 3) *pmf = v;
                        else { u32x2 w; w.x = cvt_pk_bf16(v[0], v[1]); w.y = cvt_pk_bf16(v[2], v[3]); *(u32x2*)(E.o16 + row * DM + col) = w; }
                    }
            }
    }
}

__device__ __forceinline__ void gemm_phase(LAS unsigned char* lds, const Gemm g, const Sched& S, const Epi& E, const bool perm) {
    const int tid = opaque_tid(), wid = __builtin_amdgcn_readfirstlane(tid >> 6), lane = tid & 63, wr = wid >> 2, wc = wid & 3, fr = lane & 15, fq = lane >> 4;
    const int K = g.K, nt = K / BK;
    unsigned voffA[2], voffB[2];
#pragma unroll
    for (int i = 0; i < 2; ++i) { int R, C; stage_rc(tid * 16 + i * 8192, R, C); const int Rb = perm ? ((R & ~31) + perm32(R & 31)) : R;
        voffA[i] = (unsigned)(R * K + C) * 2u; voffB[i] = (unsigned)(Rb * K + C) * 2u; }
    const size_t kstep = (size_t)(BK * 2);
    const size_t hstep = (size_t)HALF * K * 2;
    const size_t tstep = 2 * hstep;
    const unsigned ldsw = (unsigned)wid * 1024u;
    const int aoff = lds_byte(wr * 64 + fr, fq * 8), boff = lds_byte(wc * 32 + fr, fq * 8);
#define PG8_SA(b, h) (((b) * 2 + (h)) * HTB)
#define PG8_SB(b, h) ((4 + (b) * 2 + (h)) * HTB)
#define PG8_STAGE(bufoff, gbase, voff) do { _Pragma("unroll") for (int _i = 0; _i < 2; ++_i) \
        __builtin_amdgcn_global_load_lds((const unsigned*)((const char*)(gbase) + (voff)[_i]), (LAS unsigned*)(lds + (bufoff) + ldsw + _i * 8192), 16, 0, 0); } while (0)
#define PG8_LDA(dst, b, h) do { _Pragma("unroll") for (int m = 0; m < 4; ++m) _Pragma("unroll") for (int k = 0; k < 2; ++k) dst[m][k] = *(const LAS bf16x8*)(lds + PG8_SA(b, h) + aoff + m * 2048 + k * 1024); } while (0)
#define PG8_LDB(dst, b, h) do { _Pragma("unroll") for (int n = 0; n < 2; ++n) _Pragma("unroll") for (int k = 0; k < 2; ++k) dst[n][k] = *(const LAS bf16x8*)(lds + PG8_SB(b, h) + boff + n * 2048 + k * 1024); } while (0)
#define PG8_MMA(ai, bj, At, Bt) do { __builtin_amdgcn_s_setprio(1); _Pragma("unroll") for (int m = 0; m < 4; ++m) _Pragma("unroll") for (int n = 0; n < 2; ++n) _Pragma("unroll") for (int k = 0; k < 2; ++k) \
        acc[ai][bj][m][n] = __builtin_amdgcn_mfma_f32_16x16x32_bf16(Bt[n][k], At[m][k], acc[ai][bj][m][n], 0, 0, 0); __builtin_amdgcn_s_setprio(0); } while (0)
#define PG8_WAIT_V(n) asm volatile("s_waitcnt vmcnt(" #n ")" ::: "memory")
#define PG8_WAIT_L(n) asm volatile("s_waitcnt lgkmcnt(" #n ")" ::: "memory")
#define PG8_BAR __builtin_amdgcn_s_barrier()
#define PG8_SCHED __builtin_amdgcn_sched_barrier(0)
    Unit cur, nxt; int ui = 0;
    if (!sched_next(S, 0, cur)) return;
    f32x4 acc[2][2][4][2];
#pragma unroll
    for (int a = 0; a < 2; ++a)
#pragma unroll
        for (int b = 0; b < 2; ++b)
#pragma unroll
            for (int m = 0; m < 4; ++m)
#pragma unroll
                for (int n = 0; n < 2; ++n) acc[a][b][m][n] = (f32x4){0.f, 0.f, 0.f, 0.f};
    bf16x8 At[4][2], B0[2][2], B1[2][2];
    const char* cA = (const char*)g.A + (size_t)cur.pm * tstep; const char* cB = (const char*)g.Bt + (size_t)cur.pn * tstep;
    PG8_STAGE(PG8_SB(0, 0), cB, voffB); PG8_STAGE(PG8_SB(0, 1), cB + hstep, voffB); PG8_STAGE(PG8_SA(0, 0), cA, voffA); PG8_STAGE(PG8_SA(0, 1), cA + hstep, voffA);
    if (wr == 1) PG8_BAR;
    PG8_WAIT_V(2); PG8_BAR;
    PG8_STAGE(PG8_SB(1, 0), cB + kstep, voffB); PG8_STAGE(PG8_SA(1, 0), cA + kstep, voffA); PG8_STAGE(PG8_SB(1, 1), cB + hstep + kstep, voffB);
    PG8_WAIT_V(6); PG8_BAR;
    for (;;) {
        const bool has_next = sched_next(S, ui + 1, nxt);
        const char* nA = has_next ? (const char*)g.A + (size_t)nxt.pm * tstep : cA; const char* nB = has_next ? (const char*)g.Bt + (size_t)nxt.pn * tstep : cB;
        for (int t = 0; t < nt; t += 2) {
            const bool last = (t == nt - 2);
            const char* a1 = cA + (size_t)(t + 1) * kstep;
            const char* a2 = last ? nA : cA + (size_t)(t + 2) * kstep; const char* b2 = last ? nB : cB + (size_t)(t + 2) * kstep;
            const char* a3 = a2 + kstep; const char* b3 = b2 + kstep;
            PG8_LDB(B0, 0, 0); PG8_LDB(B1, 0, 1); PG8_SCHED; PG8_LDA(At, 0, 0); PG8_STAGE(PG8_SA(1, 1), a1 + hstep, voffA);
            PG8_WAIT_V(8); PG8_WAIT_L(0); PG8_BAR; PG8_MMA(0, 0, At, B0); PG8_MMA(0, 1, At, B1); PG8_BAR; PG8_SCHED;
            PG8_LDA(At, 0, 1); PG8_STAGE(PG8_SB(0, 0), b2, voffB); PG8_STAGE(PG8_SB(0, 1), b2 + hstep, voffB); PG8_STAGE(PG8_SA(0, 0), a2, voffA);
            PG8_WAIT_V(8); PG8_WAIT_L(0); PG8_BAR; PG8_MMA(1, 0, At, B0); PG8_MMA(1, 1, At, B1); PG8_BAR; PG8_SCHED;
            PG8_LDB(B0, 1, 0); PG8_LDB(B1, 1, 1); PG8_SCHED; PG8_LDA(At, 1, 0); PG8_STAGE(PG8_SA(0, 1), a2 + hstep, voffA);
            PG8_WAIT_V(8); PG8_WAIT_L(0); PG8_BAR; PG8_MMA(0, 0, At, B0); PG8_MMA(0, 1, At, B1); PG8_BAR; PG8_SCHED;
            PG8_LDA(At, 1, 1); PG8_STAGE(PG8_SB(1, 0), b3, voffB); PG8_STAGE(PG8_SB(1, 1), b3 + hstep, voffB); PG8_STAGE(PG8_SA(1, 0), a3, voffA);
            PG8_WAIT_V(8); PG8_WAIT_L(0); PG8_BAR; PG8_MMA(1, 0, At, B0); PG8_MMA(1, 1, At, B1); PG8_BAR; PG8_SCHED;
        }
        if (wr == 0) PG8_BAR;
        epilogue(E, acc, cur, wr, wc, fr, fq);
        if (!has_next) break;
#pragma unroll
        for (int a = 0; a < 2; ++a)
#pragma unroll
            for (int b = 0; b < 2; ++b)
#pragma unroll
                for (int m = 0; m < 4; ++m)
#pragma unroll
                    for (int n = 0; n < 2; ++n) acc[a][b][m][n] = (f32x4){0.f, 0.f, 0.f, 0.f};
        cur = nxt; cA = nA; cB = nB; ++ui;
        if (wr == 1) PG8_BAR;
    }
    PG8_WAIT_V(0);
    PG8_BAR;
#undef PG8_SA
#undef PG8_SB
#undef PG8_STAGE
#undef PG8_LDA
#undef PG8_LDB
#undef PG8_MMA
#undef PG8_WAIT_V
#undef PG8_WAIT_L
#undef PG8_BAR
#undef PG8_SCHED
}
}


__device__ __forceinline__ void transpose_item(const float* W, int K, int N, bf16_t* WT, int dst_row0, LAS float* scr, int k0, int n0, int lane) {
#pragma unroll 8
    for (int i = 0; i < 32; ++i) { const int kk = 2 * i + (lane >> 5); scr[kk * 33 + (lane & 31)] = W[(size_t)(k0 + kk) * N + n0 + (lane & 31)]; }
    asm volatile("s_waitcnt lgkmcnt(0)" ::: "memory");
    const int c = lane & 7;
#pragma unroll
    for (int j = 0; j < 4; ++j) { const int n = (lane >> 3) + 8 * j; const LAS float* s = scr + (8 * c) * 33 + n;
        u32x4 o; o.x = cvt_pk_bf16(s[0 * 33], s[1 * 33]); o.y = cvt_pk_bf16(s[2 * 33], s[3 * 33]); o.z = cvt_pk_bf16(s[4 * 33], s[5 * 33]); o.w = cvt_pk_bf16(s[6 * 33], s[7 * 33]);
        *(u32x4*)(WT + (size_t)(dst_row0 + n) * K + k0 + 8 * c) = o; }
    asm volatile("s_waitcnt lgkmcnt(0)" ::: "memory");
}

__device__ __forceinline__ void prep_layer(const Ctx& p, LAS unsigned char* lds, int l) {
    const int tid = opaque_tid(), lane = tid & 63, wave = tid >> 6;
    const int G = gridDim.x, gw = blockIdx.x * 8 + wave, NGW = G * 8;
    unsigned char* ws = p.ws;
    LAS float* scr = (LAS float*)(lds + wave * 16896);
    {
        constexpr int I_UP = 16 * 88, I_DN = 44 * 32, I_IN = 16 * 216, I_BR = 4 * 32, I_OUT = 16 * 32;
        constexpr int NIT = 4 * I_UP + 2 * I_DN + I_IN + 4 * I_BR + I_OUT;
        for (int it = gw; it < NIT; it += NGW) {
            int r = it;
            if (r < 4 * I_UP) {
                const int which = r / I_UP; r -= which * I_UP; const int kb = r / 88, nb = r % 88, n0 = nb * 32;
                const float* W = inp(p.ws, (which >> 1) ? ((which & 1) ? I_F2W3 : I_F2W1) : ((which & 1) ? I_F1W3 : I_F1W1)) + (size_t)l * DM * DFF;
                bf16_t* WT = (bf16_t*)(ws + WS_W + ((which >> 1) ? W_F2UP : W_F1UP));
                const int drow = 256 * (n0 >> 7) + (which & 1) * 128 + (n0 & 127);
                transpose_item(W, DM, DFF, WT, drow, scr, kb * 64, n0, lane); continue;
            }
            r -= 4 * I_UP;
            if (r < 2 * I_DN) {
                const int which = r / I_DN; r -= which * I_DN; const int kb = r / 32, nb = r % 32;
                const float* W = inp(p.ws, which ? I_F2W2 : I_F1W2) + (size_t)l * DFF * DM;
                bf16_t* WT = (bf16_t*)(ws + WS_W + (which ? W_F2DN : W_F1DN));
                transpose_item(W, DFF, DM, WT, nb * 32, scr, kb * 64, nb * 32, lane); continue;
            }
            r -= 2 * I_DN;
            if (r < I_IN) { const int kb = r / 216, nb = r % 216;
                transpose_item(inp(p.ws, I_WIN) + (size_t)l * DM * INW, DM, INW, (bf16_t*)(ws + WS_W + W_IN), nb * 32, scr, kb * 64, nb * 32, lane); continue; }
            r -= I_IN;
            if (r < 4 * I_BR) { const int bi = r / I_BR; r -= bi * I_BR; const int kb = r / 32, nb = r % 32;
                transpose_item(inp(p.ws, I_WBR) + ((size_t)l * 4 + bi) * 256 * DM, 256, DM, (bf16_t*)(ws + WS_W + W_BR) + (size_t)bi * 1024 * 256, nb * 32, scr, kb * 64, nb * 32, lane); continue; }
            r -= 4 * I_BR;
            { const int kb = r / 32, nb = r % 32;
              transpose_item(inp(p.ws, I_WOUT) + (size_t)l * DM * DM, DM, DM, (bf16_t*)(ws + WS_W + W_OUT), nb * 32, scr, kb * 64, nb * 32, lane); }
        }
    }
    {
        bf16_t* CK = (bf16_t*)(ws + WS_CK);
        const int gt = blockIdx.x * 512 + tid, NT = G * 512;
        for (int it = gt; it < 327680; it += NT) {
            int e = it * 8; const float* src; bf16_t* dst; int per_b;
            if (e < 1048576) { src = inp(p.ws, I_CNAK); dst = CK + CK_NA; per_b = 131072; }
            else if (e < 1572864) { e -= 1048576; src = inp(p.ws, I_CSWK); dst = CK + CK_SW; per_b = 65536; }
            else { e -= 1572864; src = inp(p.ws, I_CDFK); dst = CK + CK_DF; per_b = 131072; }
            const int b = e / per_b, r = e - b * per_b;
            const float* s = src + ((size_t)(b * 4 + l)) * per_b + r;
            const f32x4 v0 = *(const f32x4*)s, v1 = *(const f32x4*)(s + 4);
            u32x4 o; o.x = cvt_pk_bf16(v0[0], v0[1]); o.y = cvt_pk_bf16(v0[2], v0[3]); o.z = cvt_pk_bf16(v1[0], v1[1]); o.w = cvt_pk_bf16(v1[2], v1[3]);
            *(u32x4*)(dst + e) = o;
        }
    }
    {
        bf16_t* CV = (bf16_t*)(ws + WS_CK) + CK_HALF;
        for (int it = gw; it < 640; it += NGW) {
            int r = it; const float* src; bf16_t* dst; int H;
            if (r < 256) { src = inp(p.ws, I_CNAV); dst = CV + CK_NA; H = 4; }
            else if (r < 384) { r -= 256; src = inp(p.ws, I_CSWV); dst = CV + CK_SW; H = 2; }
            else { r -= 384; src = inp(p.ws, I_CDFV); dst = CV + CK_DF; H = 4; }
            const int kb = r & 7, bh = r >> 3, b = bh / H, h = bh - b * H;
            const float* s = src + (((size_t)(b * 4 + l) * H + h) * 512 + kb * 64) * 64;
#pragma unroll 8
            for (int i = 0; i < 64; ++i) scr[i * 65 + lane] = s[i * 64 + lane];
            asm volatile("s_waitcnt lgkmcnt(0)" ::: "memory");
            bf16_t* d = dst + ((size_t)bh * 64 + lane) * 512 + kb * 64;
#pragma unroll
            for (int j = 0; j < 8; ++j) {
                const LAS float* q = scr + (j * 8) * 65 + lane;
                u32x4 o; o.x = cvt_pk_bf16(q[0], q[65]); o.y = cvt_pk_bf16(q[2 * 65], q[3 * 65]); o.z = cvt_pk_bf16(q[4 * 65], q[5 * 65]); o.w = cvt_pk_bf16(q[6 * 65], q[7 * 65]);
                *(u32x4*)(d + j * 8) = o;
            }
            asm volatile("s_waitcnt lgkmcnt(0)" ::: "memory");
        }
    }
    __syncthreads();
    {
        LAS float* Z = (LAS float*)lds;
        LAS float* G1 = Z + 8 * 33;
        LAS float* G2 = G1 + 8 * 64;
        float* HF = (float*)(ws + WS_HFIL);
        const float* w1 = inp(p.ws, I_HW1) + (size_t)l * 33 * 64; const float* b1 = inp(p.ws, I_HB1) + l * 64;
        const float* w2 = inp(p.ws, I_HW2) + (size_t)l * 64 * 64; const float* b2 = inp(p.ws, I_HB2) + l * 64;
        const float* w3 = inp(p.ws, I_HW3) + (size_t)l * 64 * 1024; const float* sf = inp(p.ws, I_HSF) + l * 64; const float* ld = inp(p.ws, I_HLD) + l * 1024;
        for (int it = blockIdx.x; it < 288; it += G) {
            const int Lsel = it >= 32, L = Lsel ? 2048 : 256, n0 = (Lsel ? it - 32 : it) * 8;
            const float invL = 1.f / (float)L;
            if (tid < 8 * 33) { const int nn = tid / 33, i = tid - nn * 33; const float tn = (float)(n0 + nn) * invL; float v;
                if (i == 0) v = tn; else if (i <= 16) v = __cosf(6.283185307179586f * tn * (float)i); else v = __sinf(6.283185307179586f * tn * (float)(i - 16));
                Z[nn * 33 + i] = v; }
            __syncthreads();
            { const int nn = tid >> 6, j = tid & 63; float a = b1[j];
#pragma unroll 3
              for (int i = 0; i < 33; ++i) a += Z[nn * 33 + i] * w1[i * 64 + j];
              G1[nn * 64 + j] = __sinf(sf[j] * a); }
            __syncthreads();
            { const int nn = tid >> 6, j = tid & 63; float a = b2[j];
#pragma unroll 4
              for (int i = 0; i < 64; ++i) a += G1[nn * 64 + i] * w2[i * 64 + j];
              G2[nn * 64 + j] = __sinf(sf[j] * a); }
            __syncthreads();
#pragma unroll 1
            for (int cc = 0; cc < 2; ++cc) {
                const int col = cc * 512 + tid;
                float a[8];
#pragma unroll
                for (int nn = 0; nn < 8; ++nn) a[nn] = 0.f;
#pragma unroll 4
                for (int i = 0; i < 64; ++i) { const float w = w3[i * 1024 + col];
#pragma unroll
                    for (int nn = 0; nn < 8; ++nn) a[nn] += G2[nn * 64 + i] * w; }
                const float rate = __expf(ld[col]);
#pragma unroll
                for (int nn = 0; nn < 8; ++nn) a[nn] *= __expf(-rate * (float)(n0 + nn) * invL);
                float* o = HF + (Lsel ? 262144 : 0) + (size_t)col * L + n0;
                *(f32x4*)o = (f32x4){a[0], a[1], a[2], a[3]}; *(f32x4*)(o + 4) = (f32x4){a[4], a[5], a[6], a[7]};
            }
            __syncthreads();
        }
    }
    if (blockIdx.x == 0 && tid == 0) {
        const float* lv = inp(p.ws, I_DLAM) + l * 128; float s01 = 0.f, s23 = 0.f;
        for (int i = 0; i < 32; ++i) { s01 += lv[i] * lv[32 + i]; s23 += lv[64 + i] * lv[96 + i]; }
        const float lam_init = 0.8f - 0.6f * __expf(-0.3f * (float)l);
        ((float*)(ws + WS_LAM))[l] = __expf(s01) - __expf(s23) + lam_init;
    }
}

__device__ __forceinline__ void prep_mod(const Ctx& p, LAS unsigned char* lds) {
    const int tid = opaque_tid(), lane = tid & 63, wave = tid >> 6;
    const int G = gridDim.x;
    LAS float* SC = (LAS float*)lds;
    LAS float* PART = (LAS float*)(lds + 40960);
    for (int i = tid; i < 9 * 1024; i += 512) { const float v = (i < 1024) ? inp(p.ws, I_CCTX)[i] : inp(p.ws, I_C)[i - 1024]; SC[i] = v * sigmoidf_(v); }
    __syncthreads();
    float* mod = (float*)(p.ws + WS_MOD);
    for (int it = blockIdx.x; it < 4 * 36; it += G) {
        const int cb = it % 36, l = it / 36;
        const int col = cb * 256 + lane * 4, k0 = wave * 128;
        const float* W = inp(p.ws, I_WADA) + ((size_t)l * DM + k0) * 9216 + col;
        f32x4 a[9];
#pragma unroll
        for (int c = 0; c < 9; ++c) a[c] = (f32x4){0.f, 0.f, 0.f, 0.f};
#pragma unroll 8
        for (int k = 0; k < 128; ++k) { const f32x4 w = *(const f32x4*)(W + (size_t)k * 9216);
#pragma unroll
            for (int c = 0; c < 9; ++c) a[c] += w * SC[c * 1024 + k0 + k]; }
#pragma unroll
        for (int c = 0; c < 9; ++c) *(LAS f32x4*)(PART + (wave * 9 + c) * 256 + lane * 4) = a[c];
        __syncthreads();
        for (int o = tid; o < 9 * 256; o += 512) { const int c = o >> 8, cc = o & 255;
            float v = inp(p.ws, I_BADA)[(size_t)l * 9216 + cb * 256 + cc];
#pragma unroll
            for (int w = 0; w < 8; ++w) v += PART[(w * 9 + c) * 256 + cc];
            mod[((size_t)(c * 4 + l)) * 9216 + cb * 256 + cc] = v; }
        __syncthreads();
    }
}

__device__ __forceinline__ void norm_phase(const Ctx& p, int l, int which  ) {
    const int tid_ = opaque_tid(), lane = tid_ & 63, wave = tid_ >> 6, gw = blockIdx.x * 8 + wave, NGW = gridDim.x * 8;
    float* X = (float*)(p.ws + WS_X); bf16_t* ACT = (bf16_t*)(p.ws + WS_ACT);
    const float* gsrc = inp(p.ws, which == 0 ? I_NF1 : (which == 1 ? I_NMIX : I_NF2)) + l * DM;
    const bool from_in = (l == 0 && which == 0);
    f32x4 gv[4];
#pragma unroll
    for (int j = 0; j < 4; ++j) gv[j] = *(const f32x4*)(gsrc + j * 256 + lane * 4);
    for (int row = gw; row < M_TOT; row += NGW) {
        const float* xr = from_in ? (row < M_CTX ? inp(p.ws, I_XP) + (size_t)row * DM : inp(p.ws, I_XS) + (size_t)(row - M_CTX) * DM) : X + (size_t)row * DM;
        f32x4 v[4]; float s = 0.f;
#pragma unroll
        for (int j = 0; j < 4; ++j) { v[j] = *(const f32x4*)(xr + j * 256 + lane * 4); s += (v[j][0] * v[j][0] + v[j][1] * v[j][1]) + (v[j][2] * v[j][2] + v[j][3] * v[j][3]); }
        if (from_in) {
#pragma unroll
            for (int j = 0; j < 4; ++j) *(f32x4*)(X + (size_t)row * DM + j * 256 + lane * 4) = v[j];
        }
        const float rstd = rsqrtf(wave_sum(s) * (1.f / DM) + EPSF);
        const int cond = cond_of_row(row);
        const float* sh = mod_ptr(p.ws, cond, l, which * 3 + 0); const float* sc = mod_ptr(p.ws, cond, l, which * 3 + 1);
#pragma unroll
        for (int j = 0; j < 4; ++j) {
            const f32x4 s4 = *(const f32x4*)(sc + j * 256 + lane * 4), h4 = *(const f32x4*)(sh + j * 256 + lane * 4);
            const f32x4 o = (v[j] * rstd) * gv[j] * (s4 + 1.f) + h4;
            u32x2 w; w.x = cvt_pk_bf16(o[0], o[1]); w.y = cvt_pk_bf16(o[2], o[3]);
            *(u32x2*)(ACT + (size_t)row * DM + j * 256 + lane * 4) = w;
        }
    }
}
__device__ __forceinline__ void final_norm_phase(const Ctx& p) {
    const int tid_ = opaque_tid(), lane = tid_ & 63, wave = tid_ >> 6, gw = blockIdx.x * 8 + wave, NGW = gridDim.x * 8;
    const float* X = (const float*)(p.ws + WS_X); const float* gsrc = inp(p.ws, I_FNORM);
    f32x4 gv[4];
#pragma unroll
    for (int j = 0; j < 4; ++j) gv[j] = *(const f32x4*)(gsrc + j * 256 + lane * 4);
    for (int row = gw; row < M_TOT; row += NGW) {
        const float* xr = X + (size_t)row * DM; f32x4 v[4]; float s = 0.f;
#pragma unroll
        for (int j = 0; j < 4; ++j) { v[j] = *(const f32x4*)(xr + j * 256 + lane * 4); s += (v[j][0] * v[j][0] + v[j][1] * v[j][1]) + (v[j][2] * v[j][2] + v[j][3] * v[j][3]); }
        const float rstd = rsqrtf(wave_sum(s) * (1.f / DM) + EPSF);
#pragma unroll
        for (int j = 0; j < 4; ++j) *(f32x4*)(p.out + O_Y + (size_t)row * DM + j * 256 + lane * 4) = (v[j] * rstd) * gv[j];
    }
}

__device__ __forceinline__ void mixprep_phase(const Ctx& p, LAS unsigned char* lds, int l) {
    const int tid = opaque_tid(), G = gridDim.x;
    bf16_t* PROJ = (bf16_t*)(p.ws + WS_PROJ); bf16_t* TR = (bf16_t*)(p.ws + WS_TR);
    {
        LAS float* T = (LAS float*)lds;
        const float* sw = inp(p.ws, I_HSW) + (size_t)l * 3 * 768; const float* sb = inp(p.ws, I_HSB) + (size_t)l * 768;
        for (int it = blockIdx.x; it < 320 * 22; it += G) {
            const int cb = it % 22, rb = it / 22, row0 = rb * 64, tcol0 = cb * 64;
            int src; bool hy = false;
            if (tcol0 < 256) src = 512 + tcol0; else if (tcol0 < 384) src = 1152 + (tcol0 - 256); else if (tcol0 < 640) src = 2560 + (tcol0 - 384); else { src = 1280 + (tcol0 - 640); hy = true; }
            const bool seq_start = row0 < M_CTX ? ((row0 & 255) == 0) : (((row0 - M_CTX) & 2047) == 0);
            const int rend = row0 + 64; const bool seq_end = rend <= M_CTX ? ((rend & 255) == 0) : (((rend - M_CTX) & 2047) == 0);
            for (int idx = tid; idx < 66 * 8; idx += 512) {
                const int rr = idx >> 3, cg8 = idx & 7, grow = row0 - 1 + rr;
                const bool ok = !((rr == 0 && seq_start) || (rr == 65 && seq_end)) && (hy || (rr >= 1 && rr <= 64));
                u32x4 w = (u32x4){0u, 0u, 0u, 0u};
                if (ok) w = *(const u32x4*)(PROJ + (size_t)grow * PROJW + src + cg8 * 8);
                LAS float* d = T + rr * 65 + cg8 * 8;
                d[0] = bflo(w.x); d[1] = bfhi(w.x); d[2] = bflo(w.y); d[3] = bfhi(w.y); d[4] = bflo(w.z); d[5] = bfhi(w.z); d[6] = bflo(w.w); d[7] = bfhi(w.w);
            }
            __syncthreads();
            {
                const int col = tid >> 3, rg = tid & 7; float o[8];
                if (hy) { const int ch = tcol0 - 640 + col; const float w0 = sw[ch], w1 = sw[768 + ch], w2 = sw[1536 + ch], bb = sb[ch];
#pragma unroll
                    for (int j = 0; j < 8; ++j) { const int rr = rg * 8 + j + 1; o[j] = T[(rr - 1) * 65 + col] * w0 + T[rr * 65 + col] * w1 + T[(rr + 1) * 65 + col] * w2 + bb; }
                } else {
#pragma unroll
                    for (int j = 0; j < 8; ++j) o[j] = T[(rg * 8 + j + 1) * 65 + col];
                }
                u32x4 w; w.x = cvt_pk_bf16(o[0], o[1]); w.y = cvt_pk_bf16(o[2], o[3]); w.z = cvt_pk_bf16(o[4], o[5]); w.w = cvt_pk_bf16(o[6], o[7]);
                *(u32x4*)(TR + (size_t)(tcol0 + col) * M_TOT + row0 + rg * 8) = w;
            }
            __syncthreads();
        }
    }
    const int gt = blockIdx.x * 512 + tid, NT = G * 512;
    for (int it = gt; it < M_CTX * 160; it += NT) {
        const int row = it / 160, ch = it - row * 160; int pc, H; size_t ob; int c8;
        if (ch < 32) { pc = 256; H = 4; ob = O_NAK; c8 = ch * 8; }
        else if (ch < 64) { pc = 512; H = 4; ob = O_NAV; c8 = (ch - 32) * 8; }
        else if (ch < 80) { pc = 1024; H = 2; ob = O_SWK; c8 = (ch - 64) * 8; }
        else if (ch < 96) { pc = 1152; H = 2; ob = O_SWV; c8 = (ch - 80) * 8; }
        else if (ch < 128) { pc = 2304; H = 4; ob = O_DFK; c8 = (ch - 96) * 8; }
        else { pc = 2560; H = 4; ob = O_DFV; c8 = (ch - 128) * 8; }
        const u32x4 w = *(const u32x4*)(PROJ + (size_t)row * PROJW + pc + c8);
        const int b = row >> 8, t = row & 255, h = c8 >> 6, d = c8 & 63;
        float* o = p.out + ob + ((((size_t)(b * 4 + l) * H + h) * 256 + t) * 64 + d);
        *(f32x4*)o = (f32x4){bflo(w.x), bfhi(w.x), bflo(w.y), bfhi(w.y)}; *(f32x4*)(o + 4) = (f32x4){bflo(w.z), bfhi(w.z), bflo(w.w), bfhi(w.w)};
    }
    for (int it = gt; it < M_DEC * 448; it += NT) {
        const int rowd = it / 448, pi = it - rowd * 448, t = rowd & 2047, gr = t >> 6, gc = t & 63;
        int a; int bofs; float ang;
        if (pi < 192) {
            const int base = pi < 128 ? 768 : 1024, pj = pi < 128 ? pi : pi - 128, h = pj >> 5, w = pj & 31, i = w & 15;
            const float f = fast_exp2(-(float)i * (13.287712379549449f / 16.f));
            a = base + h * 64 + (w < 16 ? i : 32 + i); bofs = 16; ang = (w < 16 ? (float)gr : (float)gc) * f;
        } else {
            const int base = pi < 320 ? 2048 : 2304, pj = pi < 320 ? pi - 192 : pi - 320, hh = pj >> 4, w = pj & 15, i = w & 7;
            const float f = fast_exp2(-(float)i * (13.287712379549449f / 8.f));
            a = base + hh * 32 + (w < 8 ? i : 16 + i); bofs = 8; ang = (w < 8 ? (float)gr : (float)gc) * f;
        }
        bf16_t* pa = PROJ + (size_t)(M_CTX + rowd) * PROJW + a;
        const float xa = bf2f(pa[0]), xb = bf2f(pa[bofs]);
        const float cs = __cosf(ang), sn = __sinf(ang);
        pa[0] = f2bf1(xa * cs - xb * sn); pa[bofs] = f2bf1(xb * cs + xa * sn);
    }
}

struct AttnState { float m, l; f32x4 o[4]; };
__device__ __forceinline__ f32x4 mfma16(bf16x8 a, bf16x8 b, f32x4 c) { return __builtin_amdgcn_mfma_f32_16x16x32_bf16(a, b, c, 0, 0, 0); }

struct Seg { const bf16_t* kb; const bf16_t* vt; int kstride, vstride, n; };
struct MaskP { const float* rp0; int qc, c0, kcol0, qt, ks0; };

template <int KS>
__device__ __forceinline__ void load_frags(const Seg& s0, const Seg& s1, int step, bf16x8 (&kf)[2 * KS], bf16x8 (&vf)[4]) {
    if (step < s0.n) {
        const bf16_t* kp = s0.kb + (size_t)step * s0.kstride; const bf16_t* vp = s0.vt + (size_t)step * s0.vstride;
#pragma unroll
        for (int ks = 0; ks < KS; ++ks) { kf[2 * ks] = *(const bf16x8*)(kp + ks * 32); kf[2 * ks + 1] = *(const bf16x8*)(kp + 4 * PROJW + ks * 32); }
#pragma unroll
        for (int nt = 0; nt < 4; ++nt) vf[nt] = *(const bf16x8*)(vp + (size_t)nt * 16 * M_TOT);
    } else {
        const int j = step - s0.n;
        const bf16_t* kp = s1.kb + (size_t)j * 2048; const bf16_t* vp = s1.vt + (size_t)j * 32;
#pragma unroll
        for (int ks = 0; ks < KS; ++ks) { kf[2 * ks] = *(const bf16x8*)(kp + ks * 32); kf[2 * ks + 1] = *(const bf16x8*)(kp + 4 * 64 + ks * 32); }
#pragma unroll
        for (int nt = 0; nt < 4; ++nt) vf[nt] = *(const bf16x8*)(vp + nt * 16 * 512);
    }
}

template <int KS, int MASK>
__device__ __forceinline__ void attn_step(AttnState& st, const bf16x8 (&qf)[KS], const bf16x8 (&kf)[2 * KS], const bf16x8 (&vf)[4], int step, int n0, float sc2, const MaskP& mp, int quad) {
    f32x4 a0 = (f32x4){0.f, 0.f, 0.f, 0.f}, a1 = a0;
#pragma unroll
    for (int ks = 0; ks < KS; ++ks) { a0 = mfma16(kf[2 * ks], qf[ks], a0); a1 = mfma16(kf[2 * ks + 1], qf[ks], a1); }
    float s2[8]; unsigned vm = 0xffu;
#pragma unroll
    for (int e = 0; e < 4; ++e) { s2[e] = a0[e]; s2[4 + e] = a1[e]; }
    if (MASK == 1 && step < n0) {
        const float* rp = mp.rp0 + step * 31; vm = 0u;
#pragma unroll
        for (int j = 0; j < 8; ++j) { const int kcol = mp.kcol0 + quad * 8 + j; const bool ok = (kcol >= mp.c0) && (kcol < mp.c0 + 16);
            const int dc = min(max(kcol - mp.qc + 15, 0), 30); s2[j] = (s2[j] * 0.125f + rp[dc]) * LOG2E; vm |= ok ? (1u << j) : 0u; }
    } else if (MASK == 2 && step < n0) {
        vm = 0u;
#pragma unroll
        for (int j = 0; j < 8; ++j) { const int dd = mp.ks0 + step * 32 + quad * 8 + j - mp.qt; const bool ok = (dd <= 128) && (dd >= -128); s2[j] *= sc2; vm |= ok ? (1u << j) : 0u; }
    } else {
#pragma unroll
        for (int j = 0; j < 8; ++j) s2[j] *= sc2;
    }
    float mx = -1e30f;
#pragma unroll
    for (int j = 0; j < 8; ++j) mx = fmaxf(mx, ((vm >> j) & 1u) ? s2[j] : -1e30f);
    mx = fmaxf(mx, __shfl_xor(mx, 16)); mx = fmaxf(mx, __shfl_xor(mx, 32));
    const float mn = fmaxf(st.m, mx), alpha = fast_exp2(st.m - mn);
    float pr[8]; float sum = 0.f;
#pragma unroll
    for (int j = 0; j < 8; ++j) { pr[j] = ((vm >> j) & 1u) ? fast_exp2(s2[j] - mn) : 0.f; sum += pr[j]; }
    sum += __shfl_xor(sum, 16); sum += __shfl_xor(sum, 32);
    st.l = st.l * alpha + sum; st.m = mn;
    u32x4 pw; pw.x = cvt_pk_bf16(pr[0], pr[1]); pw.y = cvt_pk_bf16(pr[2], pr[3]); pw.z = cvt_pk_bf16(pr[4], pr[5]); pw.w = cvt_pk_bf16(pr[6], pr[7]);
    const bf16x8 pf = __builtin_bit_cast(bf16x8, pw);
#pragma unroll
    for (int nt = 0; nt < 4; ++nt) st.o[nt] = mfma16(vf[nt], pf, st.o[nt] * alpha);
}

template <int KS, int MASK>
__device__ __forceinline__ void attn_run(AttnState& st, const bf16x8 (&qf)[KS], const Seg& s0, const Seg& s1, float sc2, const MaskP& mp, int l15, int quad) {
    const int ntot = s0.n + s1.n;
    bf16x8 ka[2 * KS], va[4], kb[2 * KS], vb[4];
    if (ntot > 0) load_frags<KS>(s0, s1, 0, ka, va);
    for (int s = 0; s < ntot; s += 2) {
        if (s + 1 < ntot) load_frags<KS>(s0, s1, s + 1, kb, vb);
        attn_step<KS, MASK>(st, qf, ka, va, s, s0.n, sc2, mp, quad);
        if (s + 1 < ntot) {
            if (s + 2 < ntot) load_frags<KS>(s0, s1, s + 2, ka, va);
            attn_step<KS, MASK>(st, qf, kb, vb, s + 1, s0.n, sc2, mp, quad);
        }
    }
}
__device__ __forceinline__ void st_init(AttnState& st, float m0, float l0) { st.m = m0; st.l = l0;
#pragma unroll
    for (int i = 0; i < 4; ++i) st.o[i] = (f32x4){0.f, 0.f, 0.f, 0.f}; }

__device__ __forceinline__ void attn_item(const Ctx& p, int l, int type, bool dec, int b, int h, int tile, int lane_) {
    const int lane = lane_, l15 = lane & 15, quad = lane >> 4;
    const bf16_t* PROJ = (const bf16_t*)(p.ws + WS_PROJ); const bf16_t* TR = (const bf16_t*)(p.ws + WS_TR);
    const bf16_t* CK = (const bf16_t*)(p.ws + WS_CK); const bf16_t* CV = CK + CK_HALF;
    bf16_t* BR = (bf16_t*)(p.ws + WS_BR);
    const int L = dec ? 2048 : 256, rowbase = dec ? M_CTX + b * 2048 : b * 256, q0 = tile * 16;
    const bf16_t* Pb = PROJ + (size_t)rowbase * PROJW;
    const size_t qrow = (size_t)(q0 + l15) * PROJW;
    MaskP mp; mp.rp0 = nullptr; mp.qc = 0; mp.c0 = 0; mp.kcol0 = 0; mp.qt = 0; mp.ks0 = 0;
    const int kr0 = (l15 >> 2) * 8 + (l15 & 3);
    const size_t klo0 = (size_t)kr0 * PROJW + quad * 8, vlo0 = (size_t)l15 * M_TOT + quad * 8; const int klo1 = kr0 * 64 + quad * 8, vlo1 = l15 * 512 + quad * 8;
    Seg s0, s1; s1.kb = nullptr; s1.vt = nullptr; s1.kstride = 2048; s1.vstride = 32; s1.n = dec ? 16 : 0;
    s0.kstride = 32 * PROJW; s0.vstride = 32;
    if (type == 0) {
        bf16x8 qf[2];
        qf[0] = *(const bf16x8*)(Pb + qrow + h * 64 + quad * 8); qf[1] = *(const bf16x8*)(Pb + qrow + h * 64 + 32 + quad * 8);
        const bf16_t* Kb = Pb + 256 + h * 64; const bf16_t* Vt = TR + (size_t)(h * 64) * M_TOT + rowbase;
        AttnState st; st_init(st, -1e30f, 0.f);
        const float sc2 = 0.125f * LOG2E;
        if (!dec) { s0.kb = Kb + klo0; s0.vt = Vt + vlo0; s0.n = 8; attn_run<2, 0>(st, qf, s0, s1, sc2, mp, l15, quad); }
        else {
            const int r = tile >> 2, cg4 = tile & 3, qc = cg4 * 16 + l15;
            const int c0 = min(max(qc - 8, 0), 48), rs = min(max(r - 4, 0), 24), kcol0 = cg4 == 0 ? 0 : (cg4 == 1 ? 8 : (cg4 == 2 ? 24 : 32));
            mp.rp0 = inp(p.ws, I_RPB) + ((size_t)(l * 4 + h)) * 15 * 31 + (rs - r + 7) * 31; mp.qc = qc; mp.c0 = c0; mp.kcol0 = kcol0;
            const int key0 = rs * 64 + kcol0;
            s0.kb = Kb + (size_t)key0 * PROJW + klo0; s0.vt = Vt + key0 + vlo0; s0.kstride = 64 * PROJW; s0.vstride = 64; s0.n = 8;
            s1.kb = CK + CK_NA + (size_t)(b * 4 + h) * 512 * 64 + klo1; s1.vt = CV + CK_NA + (size_t)(b * 4 + h) * 64 * 512 + vlo1;
            attn_run<2, 1>(st, qf, s0, s1, sc2, mp, l15, quad);
        }
        const float il = fast_rcp(st.l);
        bf16_t* o = BR + (size_t)(rowbase + q0 + l15) * 256 + h * 64 + quad * 4;
#pragma unroll
        for (int nt = 0; nt < 4; ++nt) { u32x2 w; w.x = cvt_pk_bf16(st.o[nt][0] * il, st.o[nt][1] * il); w.y = cvt_pk_bf16(st.o[nt][2] * il, st.o[nt][3] * il); *(u32x2*)(o + nt * 16) = w; }
    } else if (type == 1) {
        const int kvh = h >> 1;
        bf16x8 qf[2];
        qf[0] = *(const bf16x8*)(Pb + qrow + 768 + h * 64 + quad * 8); qf[1] = *(const bf16x8*)(Pb + qrow + 768 + h * 64 + 32 + quad * 8);
        const bf16_t* Kb = Pb + 1024 + kvh * 64; const bf16_t* Vt = TR + (size_t)(256 + kvh * 64) * M_TOT + rowbase;
        const float sink = inp(p.ws, I_SINK)[l * 4 + h];
        AttnState st; st_init(st, sink * LOG2E, 1.f);
        const float sc2 = 0.125f * LOG2E;
        if (!dec) { s0.kb = Kb + klo0; s0.vt = Vt + vlo0; s0.n = 8; attn_run<2, 0>(st, qf, s0, s1, sc2, mp, l15, quad); }
        else {
            const int sfirst = (q0 - 128) & ~31, kbeg = max(sfirst, 0), kend = min(sfirst + 288, L);
            mp.qt = q0 + l15; mp.ks0 = kbeg;
            s0.kb = Kb + (size_t)kbeg * PROJW + klo0; s0.vt = Vt + kbeg + vlo0; s0.n = (kend - kbeg) >> 5;
            s1.kb = CK + CK_SW + (size_t)(b * 2 + kvh) * 512 * 64 + klo1; s1.vt = CV + CK_SW + (size_t)(b * 2 + kvh) * 64 * 512 + vlo1;
            attn_run<2, 2>(st, qf, s0, s1, sc2, mp, l15, quad);
        }
        const float il = fast_rcp(st.l);
        bf16_t* o = BR + (size_t)M_TOT * 256 + (size_t)(rowbase + q0 + l15) * 256 + h * 64 + quad * 4;
#pragma unroll
        for (int nt = 0; nt < 4; ++nt) { u32x2 w; w.x = cvt_pk_bf16(st.o[nt][0] * il, st.o[nt][1] * il); w.y = cvt_pk_bf16(st.o[nt][2] * il, st.o[nt][3] * il); *(u32x2*)(o + nt * 16) = w; }
    } else {
        const bf16_t* Vt = TR + (size_t)(384 + h * 64) * M_TOT + rowbase;
        const float sc2 = 0.17677669529663687f * LOG2E;
        f32x4 o0[4]; float l0 = 1.f;
        s0.vt = Vt + vlo0; s0.n = L >> 5;
        s1.vt = CV + CK_DF + (size_t)(b * 4 + h) * 64 * 512 + vlo1;
#pragma unroll 1
        for (int mpi = 0; mpi < 2; ++mpi) {
            bf16x8 qf[1]; qf[0] = *(const bf16x8*)(Pb + qrow + 2048 + h * 64 + mpi * 32 + quad * 8);
            AttnState st; st_init(st, -1e30f, 0.f);
            s0.kb = Pb + 2304 + h * 64 + mpi * 32 + klo0; s1.kb = CK + CK_DF + (size_t)(b * 4 + h) * 512 * 64 + mpi * 32 + klo1;
            attn_run<1, 0>(st, qf, s0, s1, sc2, mp, l15, quad);
            if (mpi == 0) { l0 = st.l;
#pragma unroll
                for (int i = 0; i < 4; ++i) o0[i] = st.o[i]; }
            else {
                const float lam = ((const float*)(p.ws + WS_LAM))[l], lam_init = 0.8f - 0.6f * __expf(-0.3f * (float)l);
                const float i0 = fast_rcp(l0), i1 = lam * fast_rcp(st.l);
                f32x4 d[4]; float ss = 0.f;
#pragma unroll
                for (int i = 0; i < 4; ++i) { d[i] = o0[i] * i0 - st.o[i] * i1; ss += (d[i][0] * d[i][0] + d[i][1] * d[i][1]) + (d[i][2] * d[i][2] + d[i][3] * d[i][3]); }
                ss += __shfl_xor(ss, 16); ss += __shfl_xor(ss, 32);
                const float rs = rsqrtf(ss * (1.f / 64.f) + EPSF) * (1.f - lam_init);
                const float* sg = inp(p.ws, I_DSUB) + l * 64 + quad * 4;
                bf16_t* o = BR + (size_t)3 * M_TOT * 256 + (size_t)(rowbase + q0 + l15) * 256 + h * 64 + quad * 4;
#pragma unroll
                for (int nt = 0; nt < 4; ++nt) { const f32x4 g4 = *(const f32x4*)(sg + nt * 16); const f32x4 v = d[nt] * rs * g4;
                    u32x2 w; w.x = cvt_pk_bf16(v[0], v[1]); w.y = cvt_pk_bf16(v[2], v[3]); *(u32x2*)(o + nt * 16) = w; }
            }
        }
    }
}

__device__ __forceinline__ void hyena_unit(const Ctx& p, LAS unsigned char* lds, int l, int c, bool dec) {
    const int tid = opaque_tid(), lane = tid & 63, wave = __builtin_amdgcn_readfirstlane(tid >> 6), l15 = lane & 15, quad = lane >> 4;
    const int L = dec ? 2048 : 256, B = dec ? 8 : 16, LP = L + 8, rowbase = dec ? M_CTX : 0, L2 = 2 * L;
    LAS bf16_t* COP = (LAS bf16_t*)lds;
    LAS bf16_t* YA = (LAS bf16_t*)(lds + 65536);
    LAS bf16_t* YB = (LAS bf16_t*)(lds + 65536 + 33024);
    LAS float* RED = (LAS float*)(lds + 65536 + 2 * 33024);
    const bf16_t* TR = (const bf16_t*)(p.ws + WS_TR);
    bf16_t* BR2 = (bf16_t*)(p.ws + WS_BR) + (size_t)2 * M_TOT * 256;
    const float* HF = (const float*)(p.ws + WS_HFIL) + (dec ? 262144 : 0);
    { const bf16_t* src = TR + (size_t)(640 + c) * M_TOT + rowbase;
      for (int i = tid; i < B * L / 8; i += 512) { const int e = i * 8, b = e / L, t = e - b * L; *(LAS u32x4*)(YA + b * LP + t) = *(const u32x4*)(src + e); } }
#pragma unroll 1
    for (int o = 0; o < 2; ++o) {
        LAS float* RF = (LAS float*)(o == 0 ? YB : YA);
        __syncthreads();
        const float* raw0 = HF + ((size_t)((o * 2 + 0) * 256 + c)) * L; const float* raw1 = HF + ((size_t)((o * 2 + 1) * 256 + c)) * L;
        float part = 0.f;
        for (int u = tid; u < L2; u += 512) { const int lag = L - 1 - u; float v = 0.f; if (lag >= 0) v = raw0[lag]; else if (lag > -L) v = raw1[-lag]; RF[u] = v; part += fabsf(v); }
        part = wave_sum(part);
        if (lane == 0) RED[wave] = part;
        __syncthreads();
        float tot = 0.f;
#pragma unroll
        for (int w = 0; w < 8; ++w) tot += RED[w];
        const float inv = 1.f / (tot + EPSF);
        const int ng = L2 / 8;
        for (int idx = tid; idx < 8 * ng; idx += 512) { const int m = idx / ng, x = (idx - m * ng) * 8; float v[8];
#pragma unroll
            for (int j = 0; j < 8; ++j) { const int u = x + m + j; v[j] = (u < L2) ? RF[u] * inv : 0.f; }
            u32x4 w; w.x = cvt_pk_bf16(v[0], v[1]); w.y = cvt_pk_bf16(v[2], v[3]); w.z = cvt_pk_bf16(v[4], v[5]); w.w = cvt_pk_bf16(v[6], v[7]);
            *(LAS u32x4*)(COP + m * L2 + x) = w; }
        __syncthreads();
        const LAS bf16_t* Y = (o == 0) ? YA : YB;
        const LAS bf16_t* cpb = COP + (7 - (l15 & 7)) * L2 + (L - 8 - 8 * (l15 >> 3) + quad * 8);
        const float skip = inp(p.ws, I_HSKIP)[(l * 2 + o) * 256 + c];
        const bf16_t* gate = TR + (size_t)((o == 0 ? 896 : 1152) + c) * M_TOT + rowbase;
        const int ngroups = L / 64;
        const bf16x8 zero8 = (bf16x8){0, 0, 0, 0, 0, 0, 0, 0};
        for (int g = wave; g < ngroups; g += 8) {
            const int t0 = (g >> 1) * 128 + (g & 1) * 16;
            f32x4 a0 = (f32x4){0.f, 0.f, 0.f, 0.f}, a1 = a0, a2 = a0, a3 = a0;
#define HY_D(s) (*(const LAS bf16x8*)(cpb + (32 * (s) - t0)))
#define HY_Y(s) ((l15 < B) ? *(const LAS bf16x8*)(Y + l15 * LP + 32 * (s) + quad * 8) : zero8)
            bf16x8 d0, d1 = HY_D(-1), d2 = HY_D(-2), d3 = HY_D(-3), y;
            for (int s = 0; s < L / 32; s += 4) {
                d0 = HY_D(s);     y = HY_Y(s);     a0 = mfma16(d0, y, a0); a1 = mfma16(d1, y, a1); a2 = mfma16(d2, y, a2); a3 = mfma16(d3, y, a3);
                d3 = HY_D(s + 1); y = HY_Y(s + 1); a0 = mfma16(d3, y, a0); a1 = mfma16(d0, y, a1); a2 = mfma16(d1, y, a2); a3 = mfma16(d2, y, a3);
                d2 = HY_D(s + 2); y = HY_Y(s + 2); a0 = mfma16(d2, y, a0); a1 = mfma16(d3, y, a1); a2 = mfma16(d0, y, a2); a3 = mfma16(d1, y, a3);
                d1 = HY_D(s + 3); y = HY_Y(s + 3); a0 = mfma16(d1, y, a0); a1 = mfma16(d2, y, a1); a2 = mfma16(d3, y, a2); a3 = mfma16(d0, y, a3);
            }
#undef HY_D
#undef HY_Y
            if (l15 < B) {
#pragma unroll
                for (int a = 0; a < 4; ++a) {
                    const f32x4 cv = a == 0 ? a0 : (a == 1 ? a1 : (a == 2 ? a2 : a3));
                    const int t = t0 + 32 * a + quad * 4;
                    const u32x2 gw = *(const u32x2*)(gate + (size_t)l15 * L + t);
                    const u32x2 yw = *(const LAS u32x2*)(Y + l15 * LP + t);
                    f32x4 r;
                    r[0] = bflo(gw.x) * (cv[0] + skip * bflo(yw.x)); r[1] = bfhi(gw.x) * (cv[1] + skip * bfhi(yw.x));
                    r[2] = bflo(gw.y) * (cv[2] + skip * bflo(yw.y)); r[3] = bfhi(gw.y) * (cv[3] + skip * bfhi(yw.y));
                    if (o == 0) { u32x2 w; w.x = cvt_pk_bf16(r[0], r[1]); w.y = cvt_pk_bf16(r[2], r[3]); *(LAS u32x2*)(YB + l15 * LP + t) = w; }
                    else { bf16_t* op = BR2 + (size_t)(rowbase + l15 * L + t) * 256 + c;
                        op[0] = f2bf1(r[0]); op[256] = f2bf1(r[1]); op[512] = f2bf1(r[2]); op[768] = f2bf1(r[3]); }
                }
            }
        }
    }
    __syncthreads();
}

__device__ __forceinline__ void mix_phase(const Ctx& p, LAS unsigned char* lds, int l) {
    const int G = gridDim.x;
    for (int u = blockIdx.x; u < 512; u += G) hyena_unit(p, lds, l, u & 255, u < 256);
    const int tid_ = opaque_tid(), wave = tid_ >> 6, gw = blockIdx.x * 8 + wave, NGW = G * 8;
    for (int it = gw; it < 15360; it += NGW) {
        int type, r; bool dec;
        if (it < 12288) { dec = true; const int k = it >> 12; type = 2 - k; r = it & 4095; const int tile = r & 127, bh = r >> 7; attn_item(p, l, type, dec, bh >> 2, bh & 3, tile, tid_ & 63); }
        else { dec = false; const int q = it - 12288, k = q >> 10; type = 2 - k; r = q & 1023; const int tile = r & 15, bh = r >> 4; attn_item(p, l, type, dec, bh >> 2, bh & 3, tile, tid_ & 63); }
    }
}


#define XB_TMO      128
#define XB_XCNT(j)  (256  + 64 * (j))
#define XB_XSUB(j)  (1280 + 64 * (j))
#define XB_XGEN(j)  (2304 + 64 * (j))
#define XB_TOP      3328
#define XB_TOPGEN   3392
#define XB_SPIN_CAP (1u << 22)
__device__ __forceinline__ unsigned xb_ld(unsigned* p)              { return __hip_atomic_load(p, __ATOMIC_RELAXED, __HIP_MEMORY_SCOPE_AGENT); }
__device__ __forceinline__ unsigned xb_add(unsigned* p, unsigned v) { return __hip_atomic_fetch_add(p, v, __ATOMIC_RELAXED, __HIP_MEMORY_SCOPE_AGENT); }
__device__ __forceinline__ unsigned xb_xcc_id() { return (unsigned)__builtin_amdgcn_s_getreg((3 << 11) | 20) & 0xFu; }
#define XB_SPIN(cond, bar) do { unsigned _sp = 0; while (cond) { __builtin_amdgcn_s_sleep(1); \
    if ((++_sp & 255u) == 0u) { if (xb_ld(&(bar)[XB_TMO])) break; if (_sp > XB_SPIN_CAP) { atomicAdd(&(bar)[XB_TMO], 1u); break; } } } } while (0)
struct XcdBarrier { unsigned* bar; unsigned x; volatile LAS unsigned* st; };
__device__ __forceinline__ XcdBarrier xcd_barrier_post(unsigned* bar, volatile LAS unsigned* st) {
    XcdBarrier b; b.bar = bar; b.x = xb_xcc_id(); b.st = st;
    if (threadIdx.x == 0) (void)xb_add(&bar[XB_XCNT(b.x)], 1u);
    return b;
}
__device__ __forceinline__ void xcd_barrier_complete(unsigned* bar, unsigned x, unsigned& nloc, unsigned& nx) {
    const unsigned G = gridDim.x * gridDim.y * gridDim.z;
    unsigned sum, cnt, mine, sp = 0u;
    for (;;) {
        sum = 0u; cnt = 0u; mine = 0u;
#pragma unroll
        for (unsigned j = 0; j < 16; ++j) { const unsigned c = xb_ld(&bar[XB_XCNT(j)]); sum += c; cnt += (c > 0u) ? 1u : 0u; mine = (j == x) ? c : mine; }
        if (sum == G) break;
        __builtin_amdgcn_s_sleep(1);
        if ((++sp & 255u) == 0u) { if (xb_ld(&bar[XB_TMO])) break; if (sp > XB_SPIN_CAP) { atomicAdd(&bar[XB_TMO], 1u); break; } }
    }
    nloc = mine > 0u ? mine : 1u; nx = cnt > 0u ? cnt : 1u;
}
__device__ __forceinline__ void xcd_barrier(const XcdBarrier& b) {
    asm volatile("s_waitcnt vmcnt(0)" ::: "memory");
    __syncthreads();
    if (threadIdx.x == 0) {
        unsigned* bar = b.bar;
        __builtin_amdgcn_s_waitcnt(0);
        unsigned nloc = b.st[0], nx = b.st[1];
        if (nloc == 0u) { xcd_barrier_complete(bar, b.x, nloc, nx); b.st[0] = nloc; b.st[1] = nx; }
        const unsigned old = xb_add(&bar[XB_XSUB(b.x)], 1u);
        const unsigned gen = old / nloc;
        if (old + 1u == (gen + 1u) * nloc) {
            __builtin_amdgcn_fence(__ATOMIC_RELEASE, "agent");
            asm volatile("s_waitcnt vmcnt(0)" ::: "memory");
            const unsigned og = xb_add(&bar[XB_TOP], 1u);
            const unsigned tg = og / nx;
            if (og + 1u == (tg + 1u) * nx) xb_add(&bar[XB_TOPGEN], 1u);
            else XB_SPIN(xb_ld(&bar[XB_TOPGEN]) == tg, bar);
            __builtin_amdgcn_fence(__ATOMIC_ACQUIRE, "agent");
            xb_add(&bar[XB_XGEN(b.x)], 1u);
            asm volatile("s_waitcnt vmcnt(0)" ::: "memory");
        } else {
            XB_SPIN(xb_ld(&bar[XB_XGEN(b.x)]) == gen, bar);
            __builtin_amdgcn_fence(__ATOMIC_ACQUIRE, "agent");
            asm volatile("s_waitcnt vmcnt(0)" ::: "memory");
        }
    }
    __syncthreads();
}

__global__ void __launch_bounds__(512, 2) mega(Params P) {
    extern __shared__ __attribute__((aligned(16))) unsigned char lds_raw[];
    LAS unsigned char* lds = (LAS unsigned char*)lds_raw;
    cg::grid_group grid = cg::this_grid();
    volatile LAS unsigned* MISC = (volatile LAS unsigned*)(lds + LDS_BYTES - 64);
    if (threadIdx.x < 16) MISC[threadIdx.x] = 0u;
    __syncthreads();
    (void)xcd_barrier_post((unsigned*)(P.ws + WS_CTL) + 1024, MISC);
#pragma unroll 1
    for (int ph = P.ph_lo; ph < P.ph_hi; ++ph) {
        Ctx p; p.ws = P.ws; p.out = P.out; asm volatile("" : "+s"(p.ws), "+s"(p.out));
        unsigned char* ws = p.ws;
        if (ph == 0) {
            if (threadIdx.x < N_IN) { ((unsigned long long*)(ws + WS_TAB))[threadIdx.x] = (unsigned long long)P.in[threadIdx.x]; }
            asm volatile("s_waitcnt vmcnt(0)" ::: "memory"); __syncthreads();
#ifndef NO_PREP
            prep_mod(p, lds); __syncthreads(); prep_layer(p, lds, 0);
#endif
        }
        else if (ph == 49) final_norm_phase(p);
        else {
            const int l = (ph - 1) / 12, s = (ph - 1) % 12;
            const bool is_gemm = (s == 1 || s == 2 || s == 4 || s == 7 || s == 8 || s == 10 || s == 11);
            if (is_gemm) {
                pg8::Gemm g; pg8::Sched S; pg8::Epi E; bool perm;
                S.G = gridDim.x; S.c = blockIdx.x; S.mode = 0; S.nM = M_TOT / 256;
                E.o16 = nullptr; E.o16b = nullptr; E.of = nullptr; E.g = nullptr; E.gates = nullptr; E.scale = 1.f;
                bf16_t* ACT = (bf16_t*)(ws + WS_ACT); bf16_t* BIG = (bf16_t*)(ws + WS_BIG); float* X = (float*)(ws + WS_X);
                if (s == 1 || s == 10) { g.A = ACT; g.Bt = (const bf16_t*)(ws + WS_W + (s == 1 ? W_F1UP : W_F2UP)); g.K = DM; S.nN = 22; E.kind = pg8::EK_SWIGLU; E.o16 = BIG; perm = true; }
                else if (s == 2 || s == 11) { g.A = BIG; g.Bt = (const bf16_t*)(ws + WS_W + (s == 2 ? W_F1DN : W_F2DN)); g.K = DFF; S.nN = 4; E.kind = pg8::EK_RESID; E.of = X;
                    E.g = mod_ptr(ws, 0, l, s == 2 ? 2 : 8); E.scale = 0.5f; perm = false; }
                else if (s == 4) { g.A = ACT; g.Bt = (const bf16_t*)(ws + WS_W + W_IN); g.K = DM; S.nN = 27; E.kind = pg8::EK_PROJ; E.o16 = (bf16_t*)(ws + WS_PROJ); E.o16b = BIG; perm = true; }
                else if (s == 7) { g.A = (const bf16_t*)(ws + WS_BR); g.Bt = (const bf16_t*)(ws + WS_W + W_BR); g.K = 256; S.mode = 1; S.nN = 4; E.kind = pg8::EK_BRANCH; E.of = (float*)(ws + WS_PROJ);
                    E.o16 = ACT; E.gates = BIG; perm = false; }
                else { g.A = ACT; g.Bt = (const bf16_t*)(ws + WS_W + W_OUT); g.K = DM; S.nN = 4; E.kind = pg8::EK_RESID; E.of = X; E.g = mod_ptr(ws, 0, l, 5); E.scale = 1.f; perm = false; }
                S.nwg = S.nM * S.nN;
                #ifndef NO_GEMM
                pg8::gemm_phase(lds, g, S, E, perm);
#endif
            } else if (s == 0 || s == 3 || s == 9) {
                norm_phase(p, l, s == 0 ? 0 : (s == 3 ? 1 : 2));
                #ifndef NO_PREP
                if (s == 0 && l > 0) prep_layer(p, lds, l);
#endif
            } else if (s == 5) {
#ifndef NO_MIXPREP
                mixprep_phase(p, lds, l);
#endif
            } else {
#ifndef NO_MIX
                mix_phase(p, lds, l);
#ifdef PROBE_MIX2
                __syncthreads(); mix_phase(p, lds, l);
#endif
#endif
            }
        }
        if (ph + 1 < P.ph_hi) { if (ph == P.ph_lo) grid.sync(); else { XcdBarrier bar; bar.bar = (unsigned*)(p.ws + WS_CTL) + 1024; bar.x = xb_xcc_id(); bar.st = (volatile LAS unsigned*)(lds + LDS_BYTES - 64); xcd_barrier(bar); } }
    }
}

extern "C" void kernel_launch(void* const* d_in, const int* in_sizes, int n_in, void* d_out, int out_size, void* d_ws, size_t ws_size, hipStream_t stream) {
    static int grid = 0;
    if (grid == 0) {
        if (n_in != N_IN || ws_size < WS_END) { fprintf(stderr, "kernel_launch: unexpected n_in %d / ws_size %zu (need %zu)\n", n_in, ws_size, (size_t)WS_END); grid = -1; return; }
        int dev = 0, cus = 0, per_cu = 0;
        hipGetDevice(&dev); hipDeviceGetAttribute(&cus, hipDeviceAttributeMultiprocessorCount, dev);
        if (hipFuncSetAttribute((const void*)mega, hipFuncAttributeMaxDynamicSharedMemorySize, LDS_BYTES) != hipSuccess) { fprintf(stderr, "kernel_launch: hipFuncSetAttribute failed\n"); grid = -1; return; }
        if (hipOccupancyMaxActiveBlocksPerMultiprocessor(&per_cu, (const void*)mega, 512, LDS_BYTES) != hipSuccess || per_cu < 1) per_cu = 1;
        (void)hipGetLastError();
        grid = cus * 1;
        fprintf(stderr, "kernel_launch: grid %d (per_cu %d), ws %zu\n", grid, per_cu, ws_size);
    }
    if (grid < 0) return;
    hipMemsetAsync(d_ws, 0, WS_ZERO_BYTES, stream);
    Params p{};
    for (int i = 0; i < N_IN; ++i) p.in[i] = (const float*)d_in[i];
    p.out = (float*)d_out; p.ws = (unsigned char*)d_ws; p.ph_lo = 0; p.ph_hi = 50;
    void* args[] = {&p};
    hipError_t e = hipLaunchCooperativeKernel((const void*)mega, dim3(grid), dim3(512), args, LDS_BYTES, stream);
    if (e != hipSuccess) fprintf(stderr, "cooperative launch failed: %s (grid %d)\n", hipGetErrorString(e), grid);
}
```

```cpp
#include <hip/hip_runtime.h>
#include <hip/hip_cooperative_groups.h>
#include <cstdio>
#include <cstdint>
namespace cg = cooperative_groups;

#define LAS __attribute__((address_space(3)))
#define GAS __attribute__((address_space(1)))
typedef unsigned short bf16_t;
typedef short bf16x8 __attribute__((ext_vector_type(8)));
typedef float f32x4 __attribute__((ext_vector_type(4)));
typedef float f32x2 __attribute__((ext_vector_type(2)));
typedef unsigned u32x4 __attribute__((ext_vector_type(4)));
typedef unsigned u32x2 __attribute__((ext_vector_type(2)));

constexpr int DM = 1024, DFF = 2816, INW = 6912, PROJW = 2816, GATEW = 4096;
constexpr int M_CTX = 4096, M_DEC = 16384, M_TOT = 20480;
constexpr int NLAYER = 4;
constexpr float EPSF = 1e-6f;
constexpr float LOG2E = 1.4426950408889634f;
constexpr size_t O_Y = 0, O_NAK = 20971520, O_NAV = 25165824, O_SWK = 29360128, O_SWV = 31457280, O_DFK = 33554432, O_DFV = 37748736;
enum { I_XP = 0, I_XS, I_CNAK, I_CNAV, I_CSWK, I_CSWV, I_CDFK, I_CDFV, I_C, I_CCTX, I_WADA, I_BADA, I_NF1, I_NMIX, I_NF2, I_FNORM,
       I_F1W1, I_F1W3, I_F1W2, I_F2W1, I_F2W3, I_F2W2, I_WIN, I_WBR, I_WOUT, I_RPB, I_SINK, I_HSW, I_HSB, I_HW1, I_HB1, I_HW2, I_HB2, I_HW3,
       I_HSF, I_HLD, I_HSKIP, I_DLAM, I_DSUB, N_IN };

constexpr size_t MiB = 1u << 20;
constexpr size_t WS_CTL = 0;
constexpr size_t WS_MOD = 1 * MiB;
constexpr size_t WS_ZERO_BYTES = 65536;
constexpr size_t WS_LAM = 3 * MiB;
constexpr size_t WS_W = 4 * MiB;
constexpr size_t W_F1UP = 0, W_F1DN = W_F1UP + (size_t)5632 * 1024 * 2, W_F2UP = W_F1DN + (size_t)1024 * 2816 * 2, W_F2DN = W_F2UP + (size_t)5632 * 1024 * 2,
                 W_IN = W_F2DN + (size_t)1024 * 2816 * 2, W_BR = W_IN + (size_t)6912 * 1024 * 2, W_OUT = W_BR + (size_t)4 * 1024 * 256 * 2, W_END = W_OUT + (size_t)1024 * 1024 * 2;
static_assert(W_END <= 52 * MiB, "weights");
constexpr size_t WS_X = 56 * MiB;
constexpr size_t WS_ACT = 136 * MiB;
constexpr size_t WS_BR = 176 * MiB;
constexpr size_t WS_BIG = 216 * MiB;
constexpr size_t WS_PROJ = 376 * MiB;
constexpr size_t WS_TR = 486 * MiB;
constexpr size_t WS_CK = 541 * MiB;
constexpr size_t WS_HFIL = 551 * MiB;
constexpr size_t WS_END = 560 * MiB;
constexpr int TRW = 1408;
constexpr size_t CK_NA = 0, CK_SW = 1048576, CK_DF = 1572864, CK_HALF = 2621440;
constexpr int LDS_BYTES = 147456;

struct Params { const float* in[N_IN]; float* out; unsigned char* ws; int ph_lo, ph_hi; };
struct Ctx { float* out; unsigned char* ws; };
constexpr size_t WS_TAB = 3 * MiB + 65536;
__device__ __forceinline__ const float* inp(const unsigned char* ws, int i) {
    const unsigned long long v = __hip_atomic_load((const unsigned long long*)(ws + WS_TAB) + i, __ATOMIC_RELAXED, __HIP_MEMORY_SCOPE_AGENT);
    const unsigned lo = __builtin_amdgcn_readfirstlane((unsigned)v), hi = __builtin_amdgcn_readfirstlane((unsigned)(v >> 32));
    return (const float*)(const GAS float*)(((unsigned long long)hi << 32) | lo);
}


__device__ __forceinline__ unsigned cvt_pk_bf16(float lo, float hi) { unsigned r; asm volatile("v_cvt_pk_bf16_f32 %0, %1, %2" : "=v"(r) : "v"(lo), "v"(hi)); return r; }
__device__ __forceinline__ float bf2f(unsigned short v) { return __uint_as_float(((unsigned)v) << 16); }
__device__ __forceinline__ float bflo(unsigned v) { return __uint_as_float(v << 16); }
__device__ __forceinline__ float bfhi(unsigned v) { return __uint_as_float(v & 0xffff0000u); }
__device__ __forceinline__ bf16_t f2bf1(float f) { return (bf16_t)(cvt_pk_bf16(f, 0.f) & 0xffffu); }
__device__ __forceinline__ float fast_exp2(float x) { return __builtin_amdgcn_exp2f(x); }
__device__ __forceinline__ float fast_rcp(float x) { return __builtin_amdgcn_rcpf(x); }
__device__ __forceinline__ float sigmoidf_(float x) { return fast_rcp(1.f + fast_exp2(-x * LOG2E)); }
__device__ __forceinline__ float wave_sum(float v) {
#pragma unroll
    for (int o = 1; o < 64; o <<= 1) v += __shfl_xor(v, o);
    return v;
}
__device__ __forceinline__ int cond_of_row(int row) { return row < M_CTX ? 0 : 1 + ((row - M_CTX) >> 11); }
__device__ __forceinline__ const float* mod_ptr(const unsigned char* ws, int cond, int l, int chunk) { return (const float*)(ws + WS_MOD) + ((size_t)(cond * 4 + l) * 9 + chunk) * 1024; }

__device__ __forceinline__ int opaque_tid() { int t; asm volatile("v_mov_b32 %0, %1" : "=v"(t) : "v"((int)threadIdx.x)); return t; }
namespace pg8 {
constexpr int BM = 256, BK = 64, HALF = 128, HTB = HALF * BK * 2, STAGE_BYTES = 8 * HTB, NXCD = 8, WGM = 8;
__device__ __forceinline__ int lds_byte(int r, int c) { const int st = (r >> 4) * 2 + (c >> 5), rr = r & 15, cc = c & 31, ob = rr * 64 + cc * 2; return st * 1024 + (ob ^ (((ob >> 9) & 1) << 5)); }
__device__ __forceinline__ void stage_rc(int b, int& R, int& C) { const int st = b / 1024, sb = b % 1024, swz = sb ^ (((sb >> 9) & 1) << 5); R = (st >> 1) * 16 + swz / 64; C = (st & 1) * 32 + (swz % 64) / 2; }
__device__ __forceinline__ int perm32(int rho) { const int n = rho >> 4, i = rho & 15; return 8 * (i >> 2) + 4 * n + (i & 3); }
struct Unit { int pm, pn; };
struct Sched { int mode, nM, nN, nwg, G, c; };
__device__ __forceinline__ bool sched_next(const Sched& S, int i, Unit& u) {
    const int j = (S.mode == 1) ? (i >> 2) : i;
    const long L = (long)j * S.G + S.c; if (L >= S.nwg) return false;
    int wgid = (int)L; { const int q = S.nwg / NXCD, r = S.nwg % NXCD, xcd = wgid % NXCD, off = wgid / NXCD; wgid = (xcd < r ? xcd * (q + 1) : r * (q + 1) + (xcd - r) * q) + off; }
    const int nig = WGM * S.nN, gid = wgid / nig, fm = gid * WGM, gsz = (S.nM - fm) < WGM ? (S.nM - fm) : WGM;
    const int pm = fm + ((wgid % nig) % gsz), pn = (wgid % nig) / gsz;
    if (S.mode == 1) { const int b = i & 3; u.pm = b * S.nM + pm; u.pn = b * S.nN + pn; } else { u.pm = pm; u.pn = pn; }
    return true;
}
enum { EK_SWIGLU = 0, EK_RESID = 1, EK_PROJ = 2, EK_BRANCH = 3 };
struct Epi { int kind; bf16_t* o16; bf16_t* o16b; float* of; const float* g; const bf16_t* gates; float scale; };
struct Gemm { const bf16_t* A; const bf16_t* Bt; int K; };

__device__ __forceinline__ void epilogue(const Epi& E, const f32x4 (&acc)[2][2][4][2], const Unit& u, int wr, int wc, int fr, int fq) {
    if (E.kind == EK_SWIGLU) {
        const int row0 = u.pm * BM + wr * 64 + fr, col0 = u.pn * 128 + wc * 32 + 8 * fq;
#pragma unroll
        for (int ai = 0; ai < 2; ++ai)
#pragma unroll
            for (int m = 0; m < 4; ++m) {
                const f32x4 a0 = acc[ai][0][m][0], a1 = acc[ai][0][m][1], b0 = acc[ai][1][m][0], b1 = acc[ai][1][m][1];
                float r[8];
#pragma unroll
                for (int e = 0; e < 4; ++e) { r[e] = a0[e] * sigmoidf_(a0[e]) * b0[e]; r[4 + e] = a1[e] * sigmoidf_(a1[e]) * b1[e]; }
                u32x4 w; w.x = cvt_pk_bf16(r[0], r[1]); w.y = cvt_pk_bf16(r[2], r[3]); w.z = cvt_pk_bf16(r[4], r[5]); w.w = cvt_pk_bf16(r[6], r[7]);
                *(u32x4*)(E.o16 + (size_t)(row0 + ai * HALF + m * 16) * DFF + col0) = w;
            }
    } else if (E.kind == EK_PROJ) {
        const int row0 = u.pm * BM + wr * 64 + fr;
        const bool isgate = u.pn >= 11;
        bf16_t* base = isgate ? E.o16b : E.o16; const int ld = isgate ? GATEW : PROJW;
        const int col0 = (isgate ? (u.pn - 11) * BM : u.pn * BM) + wc * 32 + 8 * fq;
#pragma unroll
        for (int ai = 0; ai < 2; ++ai)
#pragma unroll
            for (int m = 0; m < 4; ++m)
#pragma unroll
                for (int bj = 0; bj < 2; ++bj) {
                    f32x4 v0 = acc[ai][bj][m][0], v1 = acc[ai][bj][m][1];
                    if (isgate) {
#pragma unroll
                        for (int e = 0; e < 4; ++e) { v0[e] = sigmoidf_(v0[e]); v1[e] = sigmoidf_(v1[e]); }
                    }
                    u32x4 w; w.x = cvt_pk_bf16(v0[0], v0[1]); w.y = cvt_pk_bf16(v0[2], v0[3]); w.z = cvt_pk_bf16(v1[0], v1[1]); w.w = cvt_pk_bf16(v1[2], v1[3]);
                    *(u32x4*)(base + (size_t)(row0 + ai * HALF + m * 16) * ld + col0 + bj * HALF) = w;
                }
    } else if (E.kind == EK_RESID) {
        const int cond = (u.pm < 16) ? 0 : 1 + ((u.pm - 16) >> 3);
        const float* gv = E.g + (size_t)cond * (4 * 9 * 1024);
        const int row0 = u.pm * BM + wr * 64 + fr, col0 = u.pn * BM + wc * 32 + 4 * fq;
#pragma unroll
        for (int bj = 0; bj < 2; ++bj)
#pragma unroll
            for (int n = 0; n < 2; ++n) {
                const int col = col0 + bj * HALF + n * 16;
                const f32x4 g4 = *(const f32x4*)(gv + col) * E.scale;
#pragma unroll
                for (int ai = 0; ai < 2; ++ai)
#pragma unroll
                    for (int m = 0; m < 4; ++m) {
                        f32x4* px = (f32x4*)(E.of + (size_t)(row0 + ai * HALF + m * 16) * DM + col);
                        *px = *px + g4 * acc[ai][bj][m][n];
                    }
            }
    } else {
        const int bi = u.pm / 80, pm = u.pm - bi * 80, pn = u.pn & 3;
        const int row0 = pm * BM + wr * 64 + fr, col0 = pn * BM + wc * 32 + 4 * fq;
#pragma unroll
        for (int bj = 0; bj < 2; ++bj)
#pragma unroll
            for (int n = 0; n < 2; ++n) {
                const int col = col0 + bj * HALF + n * 16;
#pragma unroll
                for (int ai = 0; ai < 2; ++ai)
#pragma unroll
                    for (int m = 0; m < 4; ++m) {
                        const size_t row = (size_t)(row0 + ai * HALF + m * 16);
                        const u32x2 gw = *(const u32x2*)(E.gates + row * GATEW + bi * 1024 + col);
                        f32x4 gt; gt[0] = bflo(gw.x); gt[1] = bfhi(gw.x); gt[2] = bflo(gw.y); gt[3] = bfhi(gw.y);
                        f32x4* pmf = (f32x4*)(E.of + row * DM + col);
                        f32x4 v = gt * acc[ai][bj][m][n];
                        if (bi > 0) v = v + *pmf;
                        if (bi < 3) *pmf = v;
                        else { u32x2 w; w.x = cvt_pk_bf16(v[0], v[1]); w.y = cvt_pk_bf16(v[2], v[3]); *(u32x2*)(E.o16 + row * DM + col) = w; }
                    }
            }
    }
}

__device__ __forceinline__ void gemm_phase(LAS unsigned char* lds, const Gemm g, const Sched& S, const Epi& E, const bool perm) {
    const int tid = opaque_tid(), wid = __builtin_amdgcn_readfirstlane(tid >> 6), lane = tid & 63, wr = wid >> 2, wc = wid & 3, fr = lane & 15, fq = lane >> 4;
    const int K = g.K, nt = K / BK;
    unsigned voffA[2], voffB[2];
#pragma unroll
    for (int i = 0; i < 2; ++i) { int R, C; stage_rc(tid * 16 + i * 8192, R, C); const int Rb = perm ? ((R & ~31) + perm32(R & 31)) : R;
        voffA[i] = (unsigned)(R * K + C) * 2u; voffB[i] = (unsigned)(Rb * K + C) * 2u; }
    const size_t kstep = (size_t)(BK * 2);
    const size_t hstep = (size_t)HALF * K * 2;
    const size_t tstep = 2 * hstep;
    const unsigned ldsw = (unsigned)wid * 1024u;
    const int aoff = lds_byte(wr * 64 + fr, fq * 8), boff = lds_byte(wc * 32 + fr, fq * 8);
#define PG8_SA(b, h) (((b) * 2 + (h)) * HTB)
#define PG8_SB(b, h) ((4 + (b) * 2 + (h)) * HTB)
#define PG8_STAGE(bufoff, gbase, voff) do { _Pragma("unroll") for (int _i = 0; _i < 2; ++_i) \
        __builtin_amdgcn_global_load_lds((const unsigned*)((const char*)(gbase) + (voff)[_i]), (LAS unsigned*)(lds + (bufoff) + ldsw + _i * 8192), 16, 0, 0); } while (0)
#define PG8_LDA(dst, b, h) do { _Pragma("unroll") for (int m = 0; m < 4; ++m) _Pragma("unroll") for (int k = 0; k < 2; ++k) dst[m][k] = *(const LAS bf16x8*)(lds + PG8_SA(b, h) + aoff + m * 2048 + k * 1024); } while (0)
#define PG8_LDB(dst, b, h) do { _Pragma("unroll") for (int n = 0; n < 2; ++n) _Pragma("unroll") for (int k = 0; k < 2; ++k) dst[n][k] = *(const LAS bf16x8*)(lds + PG8_SB(b, h) + boff + n * 2048 + k * 1024); } while (0)
#define PG8_MMA(ai, bj, At, Bt) do { __builtin_amdgcn_s_setprio(1); _Pragma("unroll") for (int m = 0; m < 4; ++m) _Pragma("unroll") for (int n = 0; n < 2; ++n) _Pragma("unroll") for (int k = 0; k < 2; ++k) \
        acc[ai][bj][m][n] = __builtin_amdgcn_mfma_f32_16x16x32_bf16(Bt[n][k], At[m][k], acc[ai][bj][m][n], 0, 0, 0); __builtin_amdgcn_s_setprio(0); } while (0)
#define PG8_WAIT_V(n) asm volatile("s_waitcnt vmcnt(" #n ")" ::: "memory")
#define PG8_WAIT_L(n) asm volatile("s_waitcnt lgkmcnt(" #n ")" ::: "memory")
#define PG8_BAR __builtin_amdgcn_s_barrier()
#define PG8_SCHED __builtin_amdgcn_sched_barrier(0)
    Unit cur, nxt; int ui = 0;
    if (!sched_next(S, 0, cur)) return;
    f32x4 acc[2][2][4][2];
#pragma unroll
    for (int a = 0; a < 2; ++a)
#pragma unroll
        for (int b = 0; b < 2; ++b)
#pragma unroll
            for (int m = 0; m < 4; ++m)
#pragma unroll
                for (int n = 0; n < 2; ++n) acc[a][b][m][n] = (f32x4){0.f, 0.f, 0.f, 0.f};
    bf16x8 At[4][2], B0[2][2], B1[2][2];
    const char* cA = (const char*)g.A + (size_t)cur.pm * tstep; const char* cB = (const char*)g.Bt + (size_t)cur.pn * tstep;
    PG8_STAGE(PG8_SB(0, 0), cB, voffB); PG8_STAGE(PG8_SB(0, 1), cB + hstep, voffB); PG8_STAGE(PG8_SA(0, 0), cA, voffA); PG8_STAGE(PG8_SA(0, 1), cA + hstep, voffA);
    if (wr == 1) PG8_BAR;
    PG8_WAIT_V(2); PG8_BAR;
    PG8_STAGE(PG8_SB(1, 0), cB + kstep, voffB); PG8_STAGE(PG8_SA(1, 0), cA + kstep, voffA); PG8_STAGE(PG8_SB(1, 1), cB + hstep + kstep, voffB);
    PG8_WAIT_V(6); PG8_BAR;
    for (;;) {
        const bool has_next = sched_next(S, ui + 1, nxt);
        const char* nA = has_next ? (const char*)g.A + (size_t)nxt.pm * tstep : cA; const char* nB = has_next ? (const char*)g.Bt + (size_t)nxt.pn * tstep : cB;
        for (int t = 0; t < nt; t += 2) {
            const bool last = (t == nt - 2);
            const char* a1 = cA + (size_t)(t + 1) * kstep;
            const char* a2 = last ? nA : cA + (size_t)(t + 2) * kstep; const char* b2 = last ? nB : cB + (size_t)(t + 2) * kstep;
            const char* a3 = a2 + kstep; const char* b3 = b2 + kstep;
            PG8_LDB(B0, 0, 0); PG8_LDB(B1, 0, 1); PG8_SCHED; PG8_LDA(At, 0, 0); PG8_STAGE(PG8_SA(1, 1), a1 + hstep, voffA);
            PG8_WAIT_V(8); PG8_WAIT_L(0); PG8_BAR; PG8_MMA(0, 0, At, B0); PG8_MMA(0, 1, At, B1); PG8_BAR; PG8_SCHED;
            PG8_LDA(At, 0, 1); PG8_STAGE(PG8_SB(0, 0), b2, voffB); PG8_STAGE(PG8_SB(0, 1), b2 + hstep, voffB); PG8_STAGE(PG8_SA(0, 0), a2, voffA);
            PG8_WAIT_V(8); PG8_WAIT_L(0); PG8_BAR; PG8_MMA(1, 0, At, B0); PG8_MMA(1, 1, At, B1); PG8_BAR; PG8_SCHED;
            PG8_LDB(B0, 1, 0); PG8_LDB(B1, 1, 1); PG8_SCHED; PG8_LDA(At, 1, 0); PG8_STAGE(PG8_SA(0, 1), a2 + hstep, voffA);
            PG8_WAIT_V(8); PG8_WAIT_L(0); PG8_BAR; PG8_MMA(0, 0, At, B0); PG8_MMA(0, 1, At, B1); PG8_BAR; PG8_SCHED;
            PG8_LDA(At, 1, 1); PG8_STAGE(PG8_SB(1, 0), b3, voffB); PG8_STAGE(PG8_SB(1, 1), b3 + hstep, voffB); PG8_STAGE(PG8_SA(1, 0), a3, voffA);
            PG8_WAIT_V(8); PG8_WAIT_L(0); PG8_BAR; PG8_MMA(1, 0, At, B0); PG8_MMA(1, 1, At, B1); PG8_BAR; PG8_SCHED;
        }
        if (wr == 0) PG8_BAR;
        epilogue(E, acc, cur, wr, wc, fr, fq);
        if (!has_next) break;
#pragma unroll
        for (int a = 0; a < 2; ++a)
#pragma unroll
            for (int b = 0; b < 2; ++b)
#pragma unroll
                for (int m = 0; m < 4; ++m)
#pragma unroll
                    for (int n = 0; n < 2; ++n) acc[a][b][m][n] = (f32x4){0.f, 0.f, 0.f, 0.f};
        cur = nxt; cA = nA; cB = nB; ++ui;
        if (wr == 1) PG8_BAR;
    }
    PG8_WAIT_V(0);
    PG8_BAR;
#undef PG8_SA
#undef PG8_SB
#undef PG8_STAGE
#undef PG8_LDA
#undef PG8_LDB
#undef PG8_MMA
#undef PG8_WAIT_V
#undef PG8_WAIT_L
#undef PG8_BAR
#undef PG8_SCHED
}
}


__device__ __forceinline__ void transpose_item(const float* W, int K, int N, bf16_t* WT, int dst_row0, LAS float* scr, int k0, int n0, int lane) {
#pragma unroll 8
    for (int i = 0; i < 32; ++i) { const int kk = 2 * i + (lane >> 5); scr[kk * 33 + (lane & 31)] = W[(size_t)(k0 + kk) * N + n0 + (lane & 31)]; }
    asm volatile("s_waitcnt lgkmcnt(0)" ::: "memory");
    const int c = lane & 7;
#pragma unroll
    for (int j = 0; j < 4; ++j) { const int n = (lane >> 3) + 8 * j; const LAS float* s = scr + (8 * c) * 33 + n;
        u32x4 o; o.x = cvt_pk_bf16(s[0 * 33], s[1 * 33]); o.y = cvt_pk_bf16(s[2 * 33], s[3 * 33]); o.z = cvt_pk_bf16(s[4 * 33], s[5 * 33]); o.w = cvt_pk_bf16(s[6 * 33], s[7 * 33]);
        *(u32x4*)(WT + (size_t)(dst_row0 + n) * K + k0 + 8 * c) = o; }
    asm volatile("s_waitcnt lgkmcnt(0)" ::: "memory");
}

__device__ __forceinline__ void prep_layer(const Ctx& p, LAS unsigned char* lds, int l) {
    const int tid = opaque_tid(), lane = tid & 63, wave = tid >> 6;
    const int G = gridDim.x, gw = blockIdx.x * 8 + wave, NGW = G * 8;
    unsigned char* ws = p.ws;
    LAS float* scr = (LAS float*)(lds + wave * 16896);
    {
        constexpr int I_UP = 16 * 88, I_DN = 44 * 32, I_IN = 16 * 216, I_BR = 4 * 32, I_OUT = 16 * 32;
        constexpr int NIT = 4 * I_UP + 2 * I_DN + I_IN + 4 * I_BR + I_OUT;
        for (int it = gw; it < NIT; it += NGW) {
            int r = it;
            if (r < 4 * I_UP) {
                const int which = r / I_UP; r -= which * I_UP; const int kb = r / 88, nb = r % 88, n0 = nb * 32;
                const float* W = inp(p.ws, (which >> 1) ? ((which & 1) ? I_F2W3 : I_F2W1) : ((which & 1) ? I_F1W3 : I_F1W1)) + (size_t)l * DM * DFF;
                bf16_t* WT = (bf16_t*)(ws + WS_W + ((which >> 1) ? W_F2UP : W_F1UP));
                const int drow = 256 * (n0 >> 7) + (which & 1) * 128 + (n0 & 127);
                transpose_item(W, DM, DFF, WT, drow, scr, kb * 64, n0, lane); continue;
            }
            r -= 4 * I_UP;
            if (r < 2 * I_DN) {
                const int which = r / I_DN; r -= which * I_DN; const int kb = r / 32, nb = r % 32;
                const float* W = inp(p.ws, which ? I_F2W2 : I_F1W2) + (size_t)l * DFF * DM;
                bf16_t* WT = (bf16_t*)(ws + WS_W + (which ? W_F2DN : W_F1DN));
                transpose_item(W, DFF, DM, WT, nb * 32, scr, kb * 64, nb * 32, lane); continue;
            }
            r -= 2 * I_DN;
            if (r < I_IN) { const int kb = r / 216, nb = r % 216;
                transpose_item(inp(p.ws, I_WIN) + (size_t)l * DM * INW, DM, INW, (bf16_t*)(ws + WS_W + W_IN), nb * 32, scr, kb * 64, nb * 32, lane); continue; }
            r -= I_IN;
            if (r < 4 * I_BR) { const int bi = r / I_BR; r -= bi * I_BR; const int kb = r / 32, nb = r % 32;
                transpose_item(inp(p.ws, I_WBR) + ((size_t)l * 4 + bi) * 256 * DM, 256, DM, (bf16_t*)(ws + WS_W + W_BR) + (size_t)bi * 1024 * 256, nb * 32, scr, kb * 64, nb * 32, lane); continue; }
            r -= 4 * I_BR;
            { const int kb = r / 32, nb = r % 32;
              transpose_item(inp(p.ws, I_WOUT) + (size_t)l * DM * DM, DM, DM, (bf16_t*)(ws + WS_W + W_OUT), nb * 32, scr, kb * 64, nb * 32, lane); }
        }
    }
    {
        bf16_t* CK = (bf16_t*)(ws + WS_CK);
        const int gt = blockIdx.x * 512 + tid, NT = G * 512;
        for (int it = gt; it < 327680; it += NT) {
            int e = it * 8; const float* src; bf16_t* dst; int per_b;
            if (e < 1048576) { src = inp(p.ws, I_CNAK); dst = CK + CK_NA; per_b = 131072; }
            else if (e < 1572864) { e -= 1048576; src = inp(p.ws, I_CSWK); dst = CK + CK_SW; per_b = 65536; }
            else { e -= 1572864; src = inp(p.ws, I_CDFK); dst = CK + CK_DF; per_b = 131072; }
            const int b = e / per_b, r = e - b * per_b;
            const float* s = src + ((size_t)(b * 4 + l)) * per_b + r;
            const f32x4 v0 = *(const f32x4*)s, v1 = *(const f32x4*)(s + 4);
            u32x4 o; o.x = cvt_pk_bf16(v0[0], v0[1]); o.y = cvt_pk_bf16(v0[2], v0[3]); o.z = cvt_pk_bf16(v1[0], v1[1]); o.w = cvt_pk_bf16(v1[2], v1[3]);
            *(u32x4*)(dst + e) = o;
        }
    }
    {
        bf16_t* CV = (bf16_t*)(ws + WS_CK) + CK_HALF;
        for (int it = gw; it < 640; it += NGW) {
            int r = it; const float* src; bf16_t* dst; int H;
            if (r < 256) { src = inp(p.ws, I_CNAV); dst = CV + CK_NA; H = 4; }
            else if (r < 384) { r -= 256; src = inp(p.ws, I_CSWV); dst = CV + CK_SW; H = 2; }
            else { r -= 384; src = inp(p.ws, I_CDFV); dst = CV + CK_DF; H = 4; }
            const int kb = r & 7, bh = r >> 3, b = bh / H, h = bh - b * H;
            const float* s = src + (((size_t)(b * 4 + l) * H + h) * 512 + kb * 64) * 64;
#pragma unroll 8
            for (int i = 0; i < 64; ++i) scr[i * 65 + lane] = s[i * 64 + lane];
            asm volatile("s_waitcnt lgkmcnt(0)" ::: "memory");
            bf16_t* d = dst + ((size_t)bh * 64 + lane) * 512 + kb * 64;
#pragma unroll
            for (int j = 0; j < 8; ++j) {
                const LAS float* q = scr + (j * 8) * 65 + lane;
                u32x4 o; o.x = cvt_pk_bf16(q[0], q[65]); o.y = cvt_pk_bf16(q[2 * 65], q[3 * 65]); o.z = cvt_pk_bf16(q[4 * 65], q[5 * 65]); o.w = cvt_pk_bf16(q[6 * 65], q[7 * 65]);
                *(u32x4*)(d + j * 8) = o;
            }
            asm volatile("s_waitcnt lgkmcnt(0)" ::: "memory");
        }
    }
    __syncthreads();
    {
        LAS float* Z = (LAS float*)lds;
        LAS float* G1 = Z + 8 * 33;
        LAS float* G2 = G1 + 8 * 64;
        float* HF = (float*)(ws + WS_HFIL);
        const float* w1 = inp(p.ws, I_HW1) + (size_t)l * 33 * 64; const float* b1 = inp(p.ws, I_HB1) + l * 64;
        const float* w2 = inp(p.ws, I_HW2) + (size_t)l * 64 * 64; const float* b2 = inp(p.ws, I_HB2) + l * 64;
        const float* w3 = inp(p.ws, I_HW3) + (size_t)l * 64 * 1024; const float* sf = inp(p.ws, I_HSF) + l * 64; const float* ld = inp(p.ws, I_HLD) + l * 1024;
        for (int it = blockIdx.x; it < 288; it += G) {
            const int Lsel = it >= 32, L = Lsel ? 2048 : 256, n0 = (Lsel ? it - 32 : it) * 8;
            const float invL = 1.f / (float)L;
            if (tid < 8 * 33) { const int nn = tid / 33, i = tid - nn * 33; const float tn = (float)(n0 + nn) * invL; float v;
                if (i == 0) v = tn; else if (i <= 16) v = __cosf(6.283185307179586f * tn * (float)i); else v = __sinf(6.283185307179586f * tn * (float)(i - 16));
                Z[nn * 33 + i] = v; }
            __syncthreads();
            { const int nn = tid >> 6, j = tid & 63; float a = b1[j];
#pragma unroll 3
              for (int i = 0; i < 33; ++i) a += Z[nn * 33 + i] * w1[i * 64 + j];
              G1[nn * 64 + j] = __sinf(sf[j] * a); }
            __syncthreads();
            { const int nn = tid >> 6, j = tid & 63; float a = b2[j];
#pragma unroll 4
              for (int i = 0; i < 64; ++i) a += G1[nn * 64 + i] * w2[i * 64 + j];
              G2[nn * 64 + j] = __sinf(sf[j] * a); }
            __syncthreads();
#pragma unroll 1
            for (int cc = 0; cc < 2; ++cc) {
                const int col = cc * 512 + tid;
                float a[8];
#pragma unroll
                for (int nn = 0; nn < 8; ++nn) a[nn] = 0.f;
#pragma unroll 4
                for (int i = 0; i < 64; ++i) { const float w = w3[i * 1024 + col];
#pragma unroll
                    for (int nn = 0; nn < 8; ++nn) a[nn] += G2[nn * 64 + i] * w; }
                const float rate = __expf(ld[col]);
#pragma unroll
                for (int nn = 0; nn < 8; ++nn) a[nn] *= __expf(-rate * (float)(n0 + nn) * invL);
                float* o = HF + (Lsel ? 262144 : 0) + (size_t)col * L + n0;
                *(f32x4*)o = (f32x4){a[0], a[1], a[2], a[3]}; *(f32x4*)(o + 4) = (f32x4){a[4], a[5], a[6], a[7]};
            }
            __syncthreads();
        }
    }
    if (blockIdx.x == 0 && tid == 0) {
        const float* lv = inp(p.ws, I_DLAM) + l * 128; float s01 = 0.f, s23 = 0.f;
        for (int i = 0; i < 32; ++i) { s01 += lv[i] * lv[32 + i]; s23 += lv[64 + i] * lv[96 + i]; }
        const float lam_init = 0.8f - 0.6f * __expf(-0.3f * (float)l);
        ((float*)(ws + WS_LAM))[l] = __expf(s01) - __expf(s23) + lam_init;
    }
}

__device__ __forceinline__ void prep_mod(const Ctx& p, LAS unsigned char* lds) {
    const int tid = opaque_tid(), lane = tid & 63, wave = tid >> 6;
    const int G = gridDim.x;
    LAS float* SC = (LAS float*)lds;
    LAS float* PART = (LAS float*)(lds + 40960);
    for (int i = tid; i < 9 * 1024; i += 512) { const float v = (i < 1024) ? inp(p.ws, I_CCTX)[i] : inp(p.ws, I_C)[i - 1024]; SC[i] = v * sigmoidf_(v); }
    __syncthreads();
    float* mod = (float*)(p.ws + WS_MOD);
    for (int it = blockIdx.x; it < 4 * 36; it += G) {
        const int cb = it % 36, l = it / 36;
        const int col = cb * 256 + lane * 4, k0 = wave * 128;
        const float* W = inp(p.ws, I_WADA) + ((size_t)l * DM + k0) * 9216 + col;
        f32x4 a[9];
#pragma unroll
        for (int c = 0; c < 9; ++c) a[c] = (f32x4){0.f, 0.f, 0.f, 0.f};
#pragma unroll 8
        for (int k = 0; k < 128; ++k) { const f32x4 w = *(const f32x4*)(W + (size_t)k * 9216);
#pragma unroll
            for (int c = 0; c < 9; ++c) a[c] += w * SC[c * 1024 + k0 + k]; }
#pragma unroll
        for (int c = 0; c < 9; ++c) *(LAS f32x4*)(PART + (wave * 9 + c) * 256 + lane * 4) = a[c];
        __syncthreads();
        for (int o = tid; o < 9 * 256; o += 512) { const int c = o >> 8, cc = o & 255;
            float v = inp(p.ws, I_BADA)[(size_t)l * 9216 + cb * 256 + cc];
#pragma unroll
            for (int w = 0; w < 8; ++w) v += PART[(w * 9 + c) * 256 + cc];
            mod[((size_t)(c * 4 + l)) * 9216 + cb * 256 + cc] = v; }
        __syncthreads();
    }
}

__device__ __forceinline__ void norm_phase(const Ctx& p, int l, int which  ) {
    const int tid_ = opaque_tid(), lane = tid_ & 63, wave = tid_ >> 6, gw = blockIdx.x * 8 + wave, NGW = gridDim.x * 8;
    float* X = (float*)(p.ws + WS_X); bf16_t* ACT = (bf16_t*)(p.ws + WS_ACT);
    const float* gsrc = inp(p.ws, which == 0 ? I_NF1 : (which == 1 ? I_NMIX : I_NF2)) + l * DM;
    const bool from_in = (l == 0 && which == 0);
    f32x4 gv[4];
#pragma unroll
    for (int j = 0; j < 4; ++j) gv[j] = *(const f32x4*)(gsrc + j * 256 + lane * 4);
    for (int row = gw; row < M_TOT; row += NGW) {
        const float* xr = from_in ? (row < M_CTX ? inp(p.ws, I_XP) + (size_t)row * DM : inp(p.ws, I_XS) + (size_t)(row - M_CTX) * DM) : X + (size_t)row * DM;
        f32x4 v[4]; float s = 0.f;
#pragma unroll
        for (int j = 0; j < 4; ++j) { v[j] = *(const f32x4*)(xr + j * 256 + lane * 4); s += (v[j][0] * v[j][0] + v[j][1] * v[j][1]) + (v[j][2] * v[j][2] + v[j][3] * v[j][3]); }
        if (from_in) {
#pragma unroll
            for (int j = 0; j < 4; ++j) *(f32x4*)(X + (size_t)row * DM + j * 256 + lane * 4) = v[j];
        }
        const float rstd = rsqrtf(wave_sum(s) * (1.f / DM) + EPSF);
        const int cond = cond_of_row(row);
        const float* sh = mod_ptr(p.ws, cond, l, which * 3 + 0); const float* sc = mod_ptr(p.ws, cond, l, which * 3 + 1);
#pragma unroll
        for (int j = 0; j < 4; ++j) {
            const f32x4 s4 = *(const f32x4*)(sc + j * 256 + lane * 4), h4 = *(const f32x4*)(sh + j * 256 + lane * 4);
            const f32x4 o = (v[j] * rstd) * gv[j] * (s4 + 1.f) + h4;
            u32x2 w; w.x = cvt_pk_bf16(o[0], o[1]); w.y = cvt_pk_bf16(o[2], o[3]);
            *(u32x2*)(ACT + (size_t)row * DM + j * 256 + lane * 4) = w;
        }
    }
}
__device__ __forceinline__ void final_norm_phase(const Ctx& p) {
    const int tid_ = opaque_tid(), lane = tid_ & 63, wave = tid_ >> 6, gw = blockIdx.x * 8 + wave, NGW = gridDim.x * 8;
    const float* X = (const float*)(p.ws + WS_X); const float* gsrc = inp(p.ws, I_FNORM);
    f32x4 gv[4];
#pragma unroll
    for (int j = 0; j < 4; ++j) gv[j] = *(const f32x4*)(gsrc + j * 256 + lane * 4);
    for (int row = gw; row < M_TOT; row += NGW) {
        const float* xr = X + (size_t)row * DM; f32x4 v[4]; float s = 0.f;
#pragma unroll
        for (int j = 0; j < 4; ++j) { v[j] = *(const f32x4*)(xr + j * 256 + lane * 4); s += (v[j][0] * v[j][0] + v[j][1] * v[j][1]) + (v[j][2] * v[j][2] + v[j][3] * v[j][3]); }
        const float rstd = rsqrtf(wave_sum(s) * (1.f / DM) + EPSF);
#pragma unroll
        for (int j = 0; j < 4; ++j) *(f32x4*)(p.out + O_Y + (size_t)row * DM + j * 256 + lane * 4) = (v[j] * rstd) * gv[j];
    }
}

__device__ __forceinline__ void mixprep_phase(const Ctx& p, LAS unsigned char* lds, int l) {
    const int tid = opaque_tid(), G = gridDim.x;
    bf16_t* PROJ = (bf16_t*)(p.ws + WS_PROJ); bf16_t* TR = (bf16_t*)(p.ws + WS_TR);
    {
        LAS float* T = (LAS float*)lds;
        const float* sw = inp(p.ws, I_HSW) + (size_t)l * 3 * 768; const float* sb = inp(p.ws, I_HSB) + (size_t)l * 768;
        for (int it = blockIdx.x; it < 320 * 22; it += G) {
            const int cb = it % 22, rb = it / 22, row0 = rb * 64, tcol0 = cb * 64;
            int src; bool hy = false;
            if (tcol0 < 256) src = 512 + tcol0; else if (tcol0 < 384) src = 1152 + (tcol0 - 256); else if (tcol0 < 640) src = 2560 + (tcol0 - 384); else { src = 1280 + (tcol0 - 640); hy = true; }
            const bool seq_start = row0 < M_CTX ? ((row0 & 255) == 0) : (((row0 - M_CTX) & 2047) == 0);
            const int rend = row0 + 64; const bool seq_end = rend <= M_CTX ? ((rend & 255) == 0) : (((rend - M_CTX) & 2047) == 0);
            for (int idx = tid; idx < 66 * 8; idx += 512) {
                const int rr = idx >> 3, cg8 = idx & 7, grow = row0 - 1 + rr;
                const bool ok = !((rr == 0 && seq_start) || (rr == 65 && seq_end)) && (hy || (rr >= 1 && rr <= 64));
                u32x4 w = (u32x4){0u, 0u, 0u, 0u};
                if (ok) w = *(const u32x4*)(PROJ + (size_t)grow * PROJW + src + cg8 * 8);
                LAS float* d = T + rr * 65 + cg8 * 8;
                d[0] = bflo(w.x); d[1] = bfhi(w.x); d[2] = bflo(w.y); d[3] = bfhi(w.y); d[4] = bflo(w.z); d[5] = bfhi(w.z); d[6] = bflo(w.w); d[7] = bfhi(w.w);
            }
            __syncthreads();
            {
                const int col = tid >> 3, rg = tid & 7; float o[8];
                if (hy) { const int ch = tcol0 - 640 + col; const float w0 = sw[ch], w1 = sw[768 + ch], w2 = sw[1536 + ch], bb = sb[ch];
#pragma unroll
                    for (int j = 0; j < 8; ++j) { const int rr = rg * 8 + j + 1; o[j] = T[(rr - 1) * 65 + col] * w0 + T[rr * 65 + col] * w1 + T[(rr + 1) * 65 + col] * w2 + bb; }
                } else {
#pragma unroll
                    for (int j = 0; j < 8; ++j) o[j] = T[(rg * 8 + j + 1) * 65 + col];
                }
                u32x4 w; w.x = cvt_pk_bf16(o[0], o[1]); w.y = cvt_pk_bf16(o[2], o[3]); w.z = cvt_pk_bf16(o[4], o[5]); w.w = cvt_pk_bf16(o[6], o[7]);
                *(u32x4*)(TR + (size_t)(tcol0 + col) * M_TOT + row0 + rg * 8) = w;
            }
            __syncthreads();
        }
    }
    const int gt = blockIdx.x * 512 + tid, NT = G * 512;
    for (int it = gt; it < M_CTX * 160; it += NT) {
        const int row = it / 160, ch = it - row * 160; int pc, H; size_t ob; int c8;
        if (ch < 32) { pc = 256; H = 4; ob = O_NAK; c8 = ch * 8; }
        else if (ch < 64) { pc = 512; H = 4; ob = O_NAV; c8 = (ch - 32) * 8; }
        else if (ch < 80) { pc = 1024; H = 2; ob = O_SWK; c8 = (ch - 64) * 8; }
        else if (ch < 96) { pc = 1152; H = 2; ob = O_SWV; c8 = (ch - 80) * 8; }
        else if (ch < 128) { pc = 2304; H = 4; ob = O_DFK; c8 = (ch - 96) * 8; }
        else { pc = 2560; H = 4; ob = O_DFV; c8 = (ch - 128) * 8; }
        const u32x4 w = *(const u32x4*)(PROJ + (size_t)row * PROJW + pc + c8);
        const int b = row >> 8, t = row & 255, h = c8 >> 6, d = c8 & 63;
        float* o = p.out + ob + ((((size_t)(b * 4 + l) * H + h) * 256 + t) * 64 + d);
        *(f32x4*)o = (f32x4){bflo(w.x), bfhi(w.x), bflo(w.y), bfhi(w.y)}; *(f32x4*)(o + 4) = (f32x4){bflo(w.z), bfhi(w.z), bflo(w.w), bfhi(w.w)};
    }
    for (int it = gt; it < M_DEC * 448; it += NT) {
        const int rowd = it / 448, pi = it - rowd * 448, t = rowd & 2047, gr = t >> 6, gc = t & 63;
        int a; int bofs; float ang;
        if (pi < 192) {
            const int base = pi < 128 ? 768 : 1024, pj = pi < 128 ? pi : pi - 128, h = pj >> 5, w = pj & 31, i = w & 15;
            const float f = fast_exp2(-(float)i * (13.287712379549449f / 16.f));
            a = base + h * 64 + (w < 16 ? i : 32 + i); bofs = 16; ang = (w < 16 ? (float)gr : (float)gc) * f;
        } else {
            const int base = pi < 320 ? 2048 : 2304, pj = pi < 320 ? pi - 192 : pi - 320, hh = pj >> 4, w = pj & 15, i = w & 7;
            const float f = fast_exp2(-(float)i * (13.287712379549449f / 8.f));
            a = base + hh * 32 + (w < 8 ? i : 16 + i); bofs = 8; ang = (w < 8 ? (float)gr : (float)gc) * f;
        }
        bf16_t* pa = PROJ + (size_t)(M_CTX + rowd) * PROJW + a;
        const float xa = bf2f(pa[0]), xb = bf2f(pa[bofs]);
        const float cs = __cosf(ang), sn = __sinf(ang);
        pa[0] = f2bf1(xa * cs - xb * sn); pa[bofs] = f2bf1(xb * cs + xa * sn);
    }
}

struct AttnState { float m, l; f32x4 o[4]; };
__device__ __forceinline__ f32x4 mfma16(bf16x8 a, bf16x8 b, f32x4 c) { return __builtin_amdgcn_mfma_f32_16x16x32_bf16(a, b, c, 0, 0, 0); }

__device__ __forceinline__ bf16x8 softmax_p(AttnState& st, const float (&s2)[8], unsigned vm, float& alpha) {
    float mx = -1e30f;
#pragma unroll
    for (int j = 0; j < 8; ++j) mx = fmaxf(mx, ((vm >> j) & 1u) ? s2[j] : -1e30f);
    mx = fmaxf(mx, __shfl_xor(mx, 16)); mx = fmaxf(mx, __shfl_xor(mx, 32));
    const float mn = fmaxf(st.m, mx); alpha = fast_exp2(st.m - mn);
    float pr[8]; float sum = 0.f;
#pragma unroll
    for (int j = 0; j < 8; ++j) { pr[j] = ((vm >> j) & 1u) ? fast_exp2(s2[j] - mn) : 0.f; sum += pr[j]; }
    sum += __shfl_xor(sum, 16); sum += __shfl_xor(sum, 32);
    st.l = st.l * alpha + sum; st.m = mn;
    u32x4 pw; pw.x = cvt_pk_bf16(pr[0], pr[1]); pw.y = cvt_pk_bf16(pr[2], pr[3]); pw.z = cvt_pk_bf16(pr[4], pr[5]); pw.w = cvt_pk_bf16(pr[6], pr[7]);
    return __builtin_bit_cast(bf16x8, pw);
}
__device__ __forceinline__ void st_init(AttnState& st, float m0, float l0) { st.m = m0; st.l = l0;
#pragma unroll
    for (int i = 0; i < 4; ++i) st.o[i] = (f32x4){0.f, 0.f, 0.f, 0.f}; }

constexpr int AT_ROWB = 144;
constexpr int AT_TILEB = 64 * AT_ROWB;
template <int TYPE>
__device__ __forceinline__ void attn_block(const Ctx& p, LAS unsigned char* lds, int l, bool dec, int b, int h, int qblk) {
    const int tid = opaque_tid(), lane = tid & 63, wave = __builtin_amdgcn_readfirstlane(tid >> 6), l15 = lane & 15, quad = lane >> 4;
    const bf16_t* PROJ = (const bf16_t*)(p.ws + WS_PROJ); const bf16_t* TR = (const bf16_t*)(p.ws + WS_TR);
    const bf16_t* CK = (const bf16_t*)(p.ws + WS_CK); const bf16_t* CV = CK + CK_HALF;
    bf16_t* BR = (bf16_t*)(p.ws + WS_BR);
    const int L = dec ? 2048 : 256, rowbase = dec ? M_CTX + b * 2048 : b * 256, q0 = qblk * 128 + wave * 16;
    const bf16_t* Pb = PROJ + (size_t)rowbase * PROJW;
    const size_t qrow = (size_t)(q0 + l15) * PROJW;
    LAS unsigned char* KL = lds; LAS unsigned char* VL = lds + 2 * AT_TILEB;
    int qcol, kcol, vcol, hk, Hc; size_t ckoff;
    if (TYPE == 0) { qcol = h * 64; kcol = 256 + h * 64; vcol = h * 64; hk = h; Hc = 4; ckoff = CK_NA; }
    else if (TYPE == 1) { qcol = 768 + h * 64; kcol = 1024 + (h >> 1) * 64; vcol = 256 + (h >> 1) * 64; hk = h >> 1; Hc = 2; ckoff = CK_SW; }
    else { qcol = 2048 + h * 64; kcol = 2304 + h * 64; vcol = 384 + h * 64; hk = h; Hc = 4; ckoff = CK_DF; }
    int lat0, nlat; const int ncache = dec ? 8 : 0;
    int rs_w = 0, r_w = 0, cg4 = 0;
    if (!dec) { lat0 = 0; nlat = 4; }
    else if (TYPE == 0) { const int r0 = qblk * 2; const int rsA = min(max(r0 - 4, 0), 24), rsB = min(max(r0 - 3, 0), 24); lat0 = rsA; nlat = rsB + 8 - rsA;
        r_w = r0 + (wave >> 2); rs_w = min(max(r_w - 4, 0), 24); cg4 = wave & 3; }
    else if (TYPE == 1) { const int q0b = qblk * 128; lat0 = max(q0b - 128, 0) >> 6; nlat = (min(q0b + 256, L) >> 6) - lat0; }
    else { lat0 = 0; nlat = 32; }
    const int ntile = nlat + ncache;
    const int srow = tid >> 3, sch = tid & 7;
    const int kst_off = srow * AT_ROWB + ((sch ^ (((srow >> 4) & 1) << 2)) << 4), vst_off = srow * AT_ROWB + (sch << 4);
    const bf16_t* klat = Pb + kcol + (size_t)srow * PROJW + sch * 8;
    const bf16_t* vlat = TR + (size_t)(vcol + srow) * M_TOT + rowbase + sch * 8;
    const bf16_t* kcac = CK + ckoff + ((size_t)(b * Hc + hk) * 512 + srow) * 64 + sch * 8;
    const bf16_t* vcac = CV + ckoff + ((size_t)(b * Hc + hk) * 64 + srow) * 512 + sch * 8;
    const int kr0 = (l15 >> 2) * 8 + (l15 & 3);
    bf16x8 qf[2];
    qf[0] = *(const bf16x8*)(Pb + qrow + qcol + quad * 8); qf[1] = *(const bf16x8*)(Pb + qrow + qcol + 32 + quad * 8);
    AttnState sa, sb;
    float sc2;
    if (TYPE == 1) { st_init(sa, inp(p.ws, I_SINK)[l * 4 + h] * LOG2E, 1.f); sc2 = 0.125f * LOG2E; }
    else if (TYPE == 0) { st_init(sa, -1e30f, 0.f); sc2 = 0.125f * LOG2E; }
    else { st_init(sa, -1e30f, 0.f); sc2 = 0.17677669529663687f * LOG2E; }
    st_init(sb, -1e30f, 0.f);
    const float* rpb = inp(p.ws, I_RPB) + ((size_t)(l * 4 + h)) * 15 * 31;
    const int qc = cg4 * 16 + l15, c0 = min(max(qc - 8, 0), 48), qt = q0 + l15;
    u32x4 kreg, vreg;
    { const bool lat = 0 < nlat; const bf16_t* ks = lat ? klat + (size_t)lat0 * 64 * PROJW : kcac; const bf16_t* vs = lat ? vlat + lat0 * 64 : vcac;
      kreg = *(const u32x4*)ks; vreg = *(const u32x4*)vs; }
    *(LAS u32x4*)(KL + kst_off) = kreg; *(LAS u32x4*)(VL + vst_off) = vreg;
    __syncthreads();
#pragma unroll 1
    for (int i = 0; i < ntile; ++i) {
        const int buf = i & 1;
        if (i + 1 < ntile) { const int n = i + 1; const bool lat = n < nlat; const int j = n - nlat;
            const bf16_t* ks = lat ? klat + (size_t)(lat0 + n) * 64 * PROJW : kcac + (size_t)j * 4096; const bf16_t* vs = lat ? vlat + (lat0 + n) * 64 : vcac + j * 64;
            kreg = *(const u32x4*)ks; vreg = *(const u32x4*)vs; }
        const bool masked = dec && (i < nlat) && (TYPE != 2);
        bool tile_on = true;
        if (TYPE == 0 && masked) { const int krow = lat0 + i; tile_on = (krow >= rs_w) && (krow < rs_w + 8); }
        if (tile_on) {
            const LAS unsigned char* kt = KL + buf * AT_TILEB; const LAS unsigned char* vt = VL + buf * AT_TILEB;
#pragma unroll
            for (int ss = 0; ss < 2; ++ss) {
                bool on = true;
                if (TYPE == 0 && masked) on = !((cg4 == 0 && ss == 1) || (cg4 == 3 && ss == 0));
                if (TYPE == 1 && masked) { const int k0 = (lat0 + i) * 64 + ss * 32; on = (k0 + 31 >= q0 - 128) && (k0 <= q0 + 15 + 128); }
                if (on) {
                    const int krA = ss * 32 + kr0, krB = krA + 4;
                    const int swA = ((krA >> 4) & 1) << 2, swB = ((krB >> 4) & 1) << 2;
                    bf16x8 kf[2][2];
#pragma unroll
                    for (int c = 0; c < 2; ++c) { kf[0][c] = *(const LAS bf16x8*)(kt + krA * AT_ROWB + (((c * 4 + quad) ^ swA) << 4)); kf[1][c] = *(const LAS bf16x8*)(kt + krB * AT_ROWB + (((c * 4 + quad) ^ swB) << 4)); }
                    bf16x8 vf[4];
#pragma unroll
                    for (int nt = 0; nt < 4; ++nt) vf[nt] = *(const LAS bf16x8*)(vt + (nt * 16 + l15) * AT_ROWB + ss * 64 + (quad << 4));
                    const f32x4 z4 = (f32x4){0.f, 0.f, 0.f, 0.f};
                    if (TYPE == 2) {
                        const f32x4 a0 = mfma16(kf[0][0], qf[0], z4), a1 = mfma16(kf[1][0], qf[0], z4), b0 = mfma16(kf[0][1], qf[1], z4), b1 = mfma16(kf[1][1], qf[1], z4);
                        float s2[8], t2[8];
#pragma unroll
                        for (int e = 0; e < 4; ++e) { s2[e] = a0[e] * sc2; s2[4 + e] = a1[e] * sc2; t2[e] = b0[e] * sc2; t2[4 + e] = b1[e] * sc2; }
                        float alA, alB; const bf16x8 pA = softmax_p(sa, s2, 0xffu, alA); const bf16x8 pB = softmax_p(sb, t2, 0xffu, alB);
#pragma unroll
                        for (int nt = 0; nt < 4; ++nt) { sa.o[nt] = mfma16(vf[nt], pA, sa.o[nt] * alA); sb.o[nt] = mfma16(vf[nt], pB, sb.o[nt] * alB); }
                    } else {
                        f32x4 a0 = mfma16(kf[0][0], qf[0], z4), a1 = mfma16(kf[1][0], qf[0], z4); a0 = mfma16(kf[0][1], qf[1], a0); a1 = mfma16(kf[1][1], qf[1], a1);
                        float s2[8]; unsigned vm = 0xffu;
#pragma unroll
                        for (int e = 0; e < 4; ++e) { s2[e] = a0[e]; s2[4 + e] = a1[e]; }
                        if (TYPE == 0 && masked) {
                            const float* rp = rpb + (lat0 + i - r_w + 7) * 31; vm = 0u;
#pragma unroll
                            for (int j = 0; j < 8; ++j) { const int kc = ss * 32 + quad * 8 + j; const bool ok = (kc >= c0) && (kc < c0 + 16);
                                const int dc = min(max(kc - qc + 15, 0), 30); s2[j] = (s2[j] * 0.125f + rp[dc]) * LOG2E; vm |= ok ? (1u << j) : 0u; }
                        } else if (TYPE == 1 && masked) {
                            vm = 0u;
#pragma unroll
                            for (int j = 0; j < 8; ++j) { const int dd = (lat0 + i) * 64 + ss * 32 + quad * 8 + j - qt; const bool ok = (dd <= 128) && (dd >= -128); s2[j] *= sc2; vm |= ok ? (1u << j) : 0u; }
                        } else {
#pragma unroll
                            for (int j = 0; j < 8; ++j) s2[j] *= sc2;
                        }
                        float al; const bf16x8 pA = softmax_p(sa, s2, vm, al);
#pragma unroll
                        for (int nt = 0; nt < 4; ++nt) sa.o[nt] = mfma16(vf[nt], pA, sa.o[nt] * al);
                    }
                }
            }
        }
        if (i + 1 < ntile) { const int nb = (i + 1) & 1; *(LAS u32x4*)(KL + nb * AT_TILEB + kst_off) = kreg; *(LAS u32x4*)(VL + nb * AT_TILEB + vst_off) = vreg; }
        __syncthreads();
    }
    const size_t orow = (size_t)(rowbase + q0 + l15) * 256 + h * 64 + quad * 4;
    if (TYPE != 2) {
        const float il = fast_rcp(sa.l);
        bf16_t* o = BR + (TYPE == 1 ? (size_t)M_TOT * 256 : 0) + orow;
#pragma unroll
        for (int nt = 0; nt < 4; ++nt) { u32x2 w; w.x = cvt_pk_bf16(sa.o[nt][0] * il, sa.o[nt][1] * il); w.y = cvt_pk_bf16(sa.o[nt][2] * il, sa.o[nt][3] * il); *(u32x2*)(o + nt * 16) = w; }
    } else {
        const float lam = ((const float*)(p.ws + WS_LAM))[l], lam_init = 0.8f - 0.6f * __expf(-0.3f * (float)l);
        const float i0 = fast_rcp(sa.l), i1 = lam * fast_rcp(sb.l);
        f32x4 d[4]; float ss = 0.f;
#pragma unroll
        for (int i = 0; i < 4; ++i) { d[i] = sa.o[i] * i0 - sb.o[i] * i1; ss += (d[i][0] * d[i][0] + d[i][1] * d[i][1]) + (d[i][2] * d[i][2] + d[i][3] * d[i][3]); }
        ss += __shfl_xor(ss, 16); ss += __shfl_xor(ss, 32);
        const float rs = rsqrtf(ss * (1.f / 64.f) + EPSF) * (1.f - lam_init);
        const float* sg = inp(p.ws, I_DSUB) + l * 64 + quad * 4;
        bf16_t* o = BR + (size_t)3 * M_TOT * 256 + orow;
#pragma unroll
        for (int nt = 0; nt < 4; ++nt) { const f32x4 g4 = *(const f32x4*)(sg + nt * 16); const f32x4 v = d[nt] * rs * g4;
            u32x2 w; w.x = cvt_pk_bf16(v[0], v[1]); w.y = cvt_pk_bf16(v[2], v[3]); *(u32x2*)(o + nt * 16) = w; }
    }
}

__device__ __forceinline__ void hyena_unit(const Ctx& p, LAS unsigned char* lds, int l, int c, bool dec) {
    const int tid = opaque_tid(), lane = tid & 63, wave = __builtin_amdgcn_readfirstlane(tid >> 6), l15 = lane & 15, quad = lane >> 4;
    const int L = dec ? 2048 : 256, B = dec ? 8 : 16, LP = L + 8, rowbase = dec ? M_CTX : 0, L2 = 2 * L;
    LAS bf16_t* COP = (LAS bf16_t*)lds;
    LAS bf16_t* YA = (LAS bf16_t*)(lds + 65536);
    LAS bf16_t* YB = (LAS bf16_t*)(lds + 65536 + 33024);
    LAS float* RED = (LAS float*)(lds + 65536 + 2 * 33024);
    const bf16_t* TR = (const bf16_t*)(p.ws + WS_TR);
    bf16_t* BR2 = (bf16_t*)(p.ws + WS_BR) + (size_t)2 * M_TOT * 256;
    const float* HF = (const float*)(p.ws + WS_HFIL) + (dec ? 262144 : 0);
    { const bf16_t* src = TR + (size_t)(640 + c) * M_TOT + rowbase;
      for (int i = tid; i < B * L / 8; i += 512) { const int e = i * 8, b = e / L, t = e - b * L; *(LAS u32x4*)(YA + b * LP + t) = *(const u32x4*)(src + e); } }
#pragma unroll 1
    for (int o = 0; o < 2; ++o) {
        LAS float* RF = (LAS float*)(o == 0 ? YB : YA);
        __syncthreads();
        const float* raw0 = HF + ((size_t)((o * 2 + 0) * 256 + c)) * L; const float* raw1 = HF + ((size_t)((o * 2 + 1) * 256 + c)) * L;
        float part = 0.f;
        for (int u = tid; u < L2; u += 512) { const int lag = L - 1 - u; float v = 0.f; if (lag >= 0) v = raw0[lag]; else if (lag > -L) v = raw1[-lag]; RF[u] = v; part += fabsf(v); }
        part = wave_sum(part);
        if (lane == 0) RED[wave] = part;
        __syncthreads();
        float tot = 0.f;
#pragma unroll
        for (int w = 0; w < 8; ++w) tot += RED[w];
        const float inv = 1.f / (tot + EPSF);
        const int ng = L2 / 8;
        for (int idx = tid; idx < 8 * ng; idx += 512) { const int m = idx / ng, x = (idx - m * ng) * 8; float v[8];
#pragma unroll
            for (int j = 0; j < 8; ++j) { const int u = x + m + j; v[j] = (u < L2) ? RF[u] * inv : 0.f; }
            u32x4 w; w.x = cvt_pk_bf16(v[0], v[1]); w.y = cvt_pk_bf16(v[2], v[3]); w.z = cvt_pk_bf16(v[4], v[5]); w.w = cvt_pk_bf16(v[6], v[7]);
            *(LAS u32x4*)(COP + m * L2 + x) = w; }
        __syncthreads();
        const LAS bf16_t* Y = (o == 0) ? YA : YB;
        const LAS bf16_t* cpb = COP + (7 - (l15 & 7)) * L2 + (L - 8 - 8 * (l15 >> 3) + quad * 8);
        const float skip = inp(p.ws, I_HSKIP)[(l * 2 + o) * 256 + c];
        const bf16_t* gate = TR + (size_t)((o == 0 ? 896 : 1152) + c) * M_TOT + rowbase;
        const int ngroups = L / 64;
        const bf16x8 zero8 = (bf16x8){0, 0, 0, 0, 0, 0, 0, 0};
        for (int g = wave; g < ngroups; g += 8) {
            const int t0 = (g >> 1) * 128 + (g & 1) * 16;
            f32x4 a0 = (f32x4){0.f, 0.f, 0.f, 0.f}, a1 = a0, a2 = a0, a3 = a0;
#define HY_D(s) (*(const LAS bf16x8*)(cpb + (32 * (s) - t0)))
#define HY_Y(s) ((l15 < B) ? *(const LAS bf16x8*)(Y + l15 * LP + 32 * (s) + quad * 8) : zero8)
            bf16x8 d0, d1 = HY_D(-1), d2 = HY_D(-2), d3 = HY_D(-3), y;
            for (int s = 0; s < L / 32; s += 4) {
                d0 = HY_D(s);     y = HY_Y(s);     a0 = mfma16(d0, y, a0); a1 = mfma16(d1, y, a1); a2 = mfma16(d2, y, a2); a3 = mfma16(d3, y, a3);
                d3 = HY_D(s + 1); y = HY_Y(s + 1); a0 = mfma16(d3, y, a0); a1 = mfma16(d0, y, a1); a2 = mfma16(d1, y, a2); a3 = mfma16(d2, y, a3);
                d2 = HY_D(s + 2); y = HY_Y(s + 2); a0 = mfma16(d2, y, a0); a1 = mfma16(d3, y, a1); a2 = mfma16(d0, y, a2); a3 = mfma16(d1, y, a3);
                d1 = HY_D(s + 3); y = HY_Y(s + 3); a0 = mfma16(d1, y, a0); a1 = mfma16(d2, y, a1); a2 = mfma16(d3, y, a2); a3 = mfma16(d0, y, a3);
            }
#undef HY_D
#undef HY_Y
            if (l15 < B) {
#pragma unroll
                for (int a = 0; a < 4; ++a) {
                    const f32x4 cv = a == 0 ? a0 : (a == 1 ? a1 : (a == 2 ? a2 : a3));
                    const int t = t0 + 32 * a + quad * 4;
                    const u32x2 gw = *(const u32x2*)(gate + (size_t)l15 * L + t);
                    const u32x2 yw = *(const LAS u32x2*)(Y + l15 * LP + t);
                    f32x4 r;
                    r[0] = bflo(gw.x) * (cv[0] + skip * bflo(yw.x)); r[1] = bfhi(gw.x) * (cv[1] + skip * bfhi(yw.x));
                    r[2] = bflo(gw.y) * (cv[2] + skip * bflo(yw.y)); r[3] = bfhi(gw.y) * (cv[3] + skip * bfhi(yw.y));
                    if (o == 0) { u32x2 w; w.x = cvt_pk_bf16(r[0], r[1]); w.y = cvt_pk_bf16(r[2], r[3]); *(LAS u32x2*)(YB + l15 * LP + t) = w; }
                    else { bf16_t* op = BR2 + (size_t)(rowbase + l15 * L + t) * 256 + c;
                        op[0] = f2bf1(r[0]); op[256] = f2bf1(r[1]); op[512] = f2bf1(r[2]); op[768] = f2bf1(r[3]); }
                }
            }
        }
    }
    __syncthreads();
}

__device__ __forceinline__ void mix_phase(const Ctx& p, LAS unsigned char* lds, int l) {
    const int G = gridDim.x;
    for (int u = blockIdx.x; u < 512; u += G) hyena_unit(p, lds, l, u & 255, u < 256);
#ifdef PROBE_HY2
    for (int u = blockIdx.x; u < 512; u += G) hyena_unit(p, lds, l, u & 255, u < 256);
#endif
    const int vcu = (G % 8 == 0) ? ((int)blockIdx.x % 8) * (G / 8) + (int)blockIdx.x / 8 : (int)blockIdx.x;
#pragma unroll 1
    for (int it = vcu; it < 1920; it += G) {
        if (it < 1536) { const int k = it >> 9, r = it & 511, qblk = r & 15, bh = r >> 4;
            if (k == 0) attn_block<2>(p, lds, l, true, bh >> 2, bh & 3, qblk); else if (k == 1) attn_block<1>(p, lds, l, true, bh >> 2, bh & 3, qblk); else attn_block<0>(p, lds, l, true, bh >> 2, bh & 3, qblk); }
        else { const int q = it - 1536, k = q >> 7, r = q & 127, qblk = r & 1, bh = r >> 1;
            if (k == 0) attn_block<2>(p, lds, l, false, bh >> 2, bh & 3, qblk); else if (k == 1) attn_block<1>(p, lds, l, false, bh >> 2, bh & 3, qblk); else attn_block<0>(p, lds, l, false, bh >> 2, bh & 3, qblk); }
    }
}

#define XB_TMO      128
#define XB_XCNT(j)  (256  + 64 * (j))
#define XB_XSUB(j)  (1280 + 64 * (j))
#define XB_XGEN(j)  (2304 + 64 * (j))
#define XB_TOP      3328
#define XB_TOPGEN   3392
#define XB_SPIN_CAP (1u << 22)
__device__ __forceinline__ unsigned xb_ld(unsigned* p)              { return __hip_atomic_load(p, __ATOMIC_RELAXED, __HIP_MEMORY_SCOPE_AGENT); }
__device__ __forceinline__ unsigned xb_add(unsigned* p, unsigned v) { return __hip_atomic_fetch_add(p, v, __ATOMIC_RELAXED, __HIP_MEMORY_SCOPE_AGENT); }
__device__ __forceinline__ unsigned xb_xcc_id() { return (unsigned)__builtin_amdgcn_s_getreg((3 << 11) | 20) & 0xFu; }
#define XB_SPIN(cond, bar) do { unsigned _sp = 0; while (cond) { __builtin_amdgcn_s_sleep(1); \
    if ((++_sp & 255u) == 0u) { if (xb_ld(&(bar)[XB_TMO])) break; if (_sp > XB_SPIN_CAP) { atomicAdd(&(bar)[XB_TMO], 1u); break; } } } } while (0)
struct XcdBarrier { unsigned* bar; unsigned x; volatile LAS unsigned* st; };
__device__ __forceinline__ XcdBarrier xcd_barrier_post(unsigned* bar, volatile LAS unsigned* st) {
    XcdBarrier b; b.bar = bar; b.x = xb_xcc_id(); b.st = st;
    if (threadIdx.x == 0) (void)xb_add(&bar[XB_XCNT(b.x)], 1u);
    return b;
}
__device__ __forceinline__ void xcd_barrier_complete(unsigned* bar, unsigned x, unsigned& nloc, unsigned& nx) {
    const unsigned G = gridDim.x * gridDim.y * gridDim.z;
    unsigned sum, cnt, mine, sp = 0u;
    for (;;) {
        sum = 0u; cnt = 0u; mine = 0u;
#pragma unroll
        for (unsigned j = 0; j < 16; ++j) { const unsigned c = xb_ld(&bar[XB_XCNT(j)]); sum += c; cnt += (c > 0u) ? 1u : 0u; mine = (j == x) ? c : mine; }
        if (sum == G) break;
        __builtin_amdgcn_s_sleep(1);
        if ((++sp & 255u) == 0u) { if (xb_ld(&bar[XB_TMO])) break; if (sp > XB_SPIN_CAP) { atomicAdd(&bar[XB_TMO], 1u); break; } }
    }
    nloc = mine > 0u ? mine : 1u; nx = cnt > 0u ? cnt : 1u;
}
__device__ __forceinline__ void xcd_barrier(const XcdBarrier& b) {
    asm volatile("s_waitcnt vmcnt(0)" ::: "memory");
    __syncthreads();
    if (threadIdx.x == 0) {
        unsigned* bar = b.bar;
        __builtin_amdgcn_s_waitcnt(0);
        unsigned nloc = b.st[0], nx = b.st[1];
        if (nloc == 0u) { xcd_barrier_complete(bar, b.x, nloc, nx); b.st[0] = nloc; b.st[1] = nx; }
        const unsigned old = xb_add(&bar[XB_XSUB(b.x)], 1u);
        const unsigned gen = old / nloc;
        if (old + 1u == (gen + 1u) * nloc) {
            __builtin_amdgcn_fence(__ATOMIC_RELEASE, "agent");
            asm volatile("s_waitcnt vmcnt(0)" ::: "memory");
            const unsigned og = xb_add(&bar[XB_TOP], 1u);
            const unsigned tg = og / nx;
            if (og + 1u == (tg + 1u) * nx) xb_add(&bar[XB_TOPGEN], 1u);
            else XB_SPIN(xb_ld(&bar[XB_TOPGEN]) == tg, bar);
            __builtin_amdgcn_fence(__ATOMIC_ACQUIRE, "agent");
            xb_add(&bar[XB_XGEN(b.x)], 1u);
            asm volatile("s_waitcnt vmcnt(0)" ::: "memory");
        } else {
            XB_SPIN(xb_ld(&bar[XB_XGEN(b.x)]) == gen, bar);
            __builtin_amdgcn_fence(__ATOMIC_ACQUIRE, "agent");
            asm volatile("s_waitcnt vmcnt(0)" ::: "memory");
        }
    }
    __syncthreads();
}

__global__ void __launch_bounds__(512, 2) mega(Params P) {
    extern __shared__ __attribute__((aligned(16))) unsigned char lds_raw[];
    LAS unsigned char* lds = (LAS unsigned char*)lds_raw;
    cg::grid_group grid = cg::this_grid();
    volatile LAS unsigned* MISC = (volatile LAS unsigned*)(lds + LDS_BYTES - 64);
    if (threadIdx.x < 16) MISC[threadIdx.x] = 0u;
    __syncthreads();
    (void)xcd_barrier_post((unsigned*)(P.ws + WS_CTL) + 1024, MISC);
#pragma unroll 1
    for (int ph = P.ph_lo; ph < P.ph_hi; ++ph) {
        GAS unsigned char* ws_g = (GAS unsigned char*)P.ws; GAS float* out_g = (GAS float*)P.out; asm volatile("" : "+s"(ws_g), "+s"(out_g));
        Ctx p; p.ws = (unsigned char*)ws_g; p.out = (float*)out_g;
        unsigned char* ws = p.ws;
        if (ph == 0) {
            if (threadIdx.x < N_IN) { ((unsigned long long*)(ws + WS_TAB))[threadIdx.x] = (unsigned long long)P.in[threadIdx.x]; }
            asm volatile("s_waitcnt vmcnt(0)" ::: "memory"); __syncthreads();
#ifndef NO_PREP
            prep_mod(p, lds); __syncthreads(); prep_layer(p, lds, 0);
#endif
        }
        else if (ph == 49) final_norm_phase(p);
        else {
            const int l = (ph - 1) / 12, s = (ph - 1) % 12;
            const bool is_gemm = (s == 1 || s == 2 || s == 4 || s == 7 || s == 8 || s == 10 || s == 11);
            if (is_gemm) {
                pg8::Gemm g; pg8::Sched S; pg8::Epi E; bool perm;
                S.G = gridDim.x; S.c = blockIdx.x; S.mode = 0; S.nM = M_TOT / 256;
                E.o16 = nullptr; E.o16b = nullptr; E.of = nullptr; E.g = nullptr; E.gates = nullptr; E.scale = 1.f;
                bf16_t* ACT = (bf16_t*)(ws + WS_ACT); bf16_t* BIG = (bf16_t*)(ws + WS_BIG); float* X = (float*)(ws + WS_X);
                if (s == 1 || s == 10) { g.A = ACT; g.Bt = (const bf16_t*)(ws + WS_W + (s == 1 ? W_F1UP : W_F2UP)); g.K = DM; S.nN = 22; E.kind = pg8::EK_SWIGLU; E.o16 = BIG; perm = true; }
                else if (s == 2 || s == 11) { g.A = BIG; g.Bt = (const bf16_t*)(ws + WS_W + (s == 2 ? W_F1DN : W_F2DN)); g.K = DFF; S.nN = 4; E.kind = pg8::EK_RESID; E.of = X;
                    E.g = mod_ptr(ws, 0, l, s == 2 ? 2 : 8); E.scale = 0.5f; perm = false; }
                else if (s == 4) { g.A = ACT; g.Bt = (const bf16_t*)(ws + WS_W + W_IN); g.K = DM; S.nN = 27; E.kind = pg8::EK_PROJ; E.o16 = (bf16_t*)(ws + WS_PROJ); E.o16b = BIG; perm = true; }
                else if (s == 7) { g.A = (const bf16_t*)(ws + WS_BR); g.Bt = (const bf16_t*)(ws + WS_W + W_BR); g.K = 256; S.mode = 1; S.nN = 4; E.kind = pg8::EK_BRANCH; E.of = (float*)(ws + WS_PROJ);
                    E.o16 = ACT; E.gates = BIG; perm = false; }
                else { g.A = ACT; g.Bt = (const bf16_t*)(ws + WS_W + W_OUT); g.K = DM; S.nN = 4; E.kind = pg8::EK_RESID; E.of = X; E.g = mod_ptr(ws, 0, l, 5); E.scale = 1.f; perm = false; }
                S.nwg = S.nM * S.nN;
                #ifndef NO_GEMM
                pg8::gemm_phase(lds, g, S, E, perm);
#endif
            } else if (s == 0 || s == 3 || s == 9) {
                norm_phase(p, l, s == 0 ? 0 : (s == 3 ? 1 : 2));
                #ifndef NO_PREP
                if (s == 0 && l > 0) prep_layer(p, lds, l);
#endif
            } else if (s == 5) {
#ifndef NO_MIXPREP
                mixprep_phase(p, lds, l);
#endif
            } else {
#ifndef NO_MIX
                mix_phase(p, lds, l);
#ifdef PROBE_MIX2
                __syncthreads(); mix_phase(p, lds, l);
#endif
#endif
            }
        }
        if (ph + 1 < P.ph_hi) { if (ph == P.ph_lo) grid.sync(); else { XcdBarrier bar; bar.bar = (unsigned*)(p.ws + WS_CTL) + 1024; bar.x = xb_xcc_id(); bar.st = (volatile LAS unsigned*)(lds + LDS_BYTES - 64); xcd_barrier(bar); } }
    }
}

extern "C" void kernel_launch(void* const* d_in, const int* in_sizes, int n_in, void* d_out, int out_size, void* d_ws, size_t ws_size, hipStream_t stream) {
    static int grid = 0;
    if (grid == 0) {
        if (n_in != N_IN || ws_size < WS_END) { fprintf(stderr, "kernel_launch: unexpected n_in %d / ws_size %zu (need %zu)\n", n_in, ws_size, (size_t)WS_END); grid = -1; return; }
        int dev = 0, cus = 0, per_cu = 0;
        hipGetDevice(&dev); hipDeviceGetAttribute(&cus, hipDeviceAttributeMultiprocessorCount, dev);
        if (hipFuncSetAttribute((const void*)mega, hipFuncAttributeMaxDynamicSharedMemorySize, LDS_BYTES) != hipSuccess) { fprintf(stderr, "kernel_launch: hipFuncSetAttribute failed\n"); grid = -1; return; }
        if (hipOccupancyMaxActiveBlocksPerMultiprocessor(&per_cu, (const void*)mega, 512, LDS_BYTES) != hipSuccess || per_cu < 1) per_cu = 1;
        (void)hipGetLastError();
        grid = cus * 1;
        fprintf(stderr, "kernel_launch: grid %d (per_cu %d), ws %zu\n", grid, per_cu, ws_size);
    }
    if (grid < 0) return;
    hipMemsetAsync(d_ws, 0, WS_ZERO_BYTES, stream);
    Params p{};
    for (int i = 0; i < N_IN; ++i) p.in[i] = (const float*)d_in[i];
    p.out = (float*)d_out; p.ws = (unsigned char*)d_ws; p.ph_lo = 0; p.ph_hi = 50;
    void* args[] = {&p};
    hipError_t e = hipLaunchCooperativeKernel((const void*)mega, dim3(grid), dim3(512), args, LDS_BYTES, stream);
    if (e != hipSuccess) fprintf(stderr, "cooperative launch failed: %s (grid %d)\n", hipGetErrorString(e), grid);
}
```

```cpp
#ifndef RESID_WGM
#define RESID_WGM 1
#endif
#include <hip/hip_runtime.h>
#include <hip/hip_cooperative_groups.h>
#include <cstdio>
#include <cstdint>
namespace cg = cooperative_groups;

#define LAS __attribute__((address_space(3)))
#define GAS __attribute__((address_space(1)))
typedef unsigned short bf16_t;
typedef short bf16x8 __attribute__((ext_vector_type(8)));
typedef float f32x4 __attribute__((ext_vector_type(4)));
typedef float f32x2 __attribute__((ext_vector_type(2)));
typedef unsigned u32x4 __attribute__((ext_vector_type(4)));
typedef unsigned u32x2 __attribute__((ext_vector_type(2)));

constexpr int DM = 1024, DFF = 2816, INW = 6912, PROJW = 2816, GATEW = 4096;
constexpr int M_CTX = 4096, M_DEC = 16384, M_TOT = 20480;
constexpr int NLAYER = 4;
constexpr float EPSF = 1e-6f;
constexpr float LOG2E = 1.4426950408889634f;
constexpr size_t O_Y = 0, O_NAK = 20971520, O_NAV = 25165824, O_SWK = 29360128, O_SWV = 31457280, O_DFK = 33554432, O_DFV = 37748736;
enum { I_XP = 0, I_XS, I_CNAK, I_CNAV, I_CSWK, I_CSWV, I_CDFK, I_CDFV, I_C, I_CCTX, I_WADA, I_BADA, I_NF1, I_NMIX, I_NF2, I_FNORM,
       I_F1W1, I_F1W3, I_F1W2, I_F2W1, I_F2W3, I_F2W2, I_WIN, I_WBR, I_WOUT, I_RPB, I_SINK, I_HSW, I_HSB, I_HW1, I_HB1, I_HW2, I_HB2, I_HW3,
       I_HSF, I_HLD, I_HSKIP, I_DLAM, I_DSUB, N_IN };

constexpr size_t MiB = 1u << 20;
constexpr size_t WS_CTL = 0;
constexpr size_t WS_MOD = 1 * MiB;
constexpr size_t WS_ZERO_BYTES = 65536;
constexpr size_t WS_LAM = 3 * MiB;
constexpr size_t WS_W = 4 * MiB;
constexpr size_t W_F1UP = 0, W_F1DN = W_F1UP + (size_t)5632 * 1024 * 2, W_F2UP = W_F1DN + (size_t)1024 * 2816 * 2, W_F2DN = W_F2UP + (size_t)5632 * 1024 * 2,
                 W_IN = W_F2DN + (size_t)1024 * 2816 * 2, W_BR = W_IN + (size_t)6912 * 1024 * 2, W_OUT = W_BR + (size_t)4 * 1024 * 256 * 2, W_END = W_OUT + (size_t)1024 * 1024 * 2;
static_assert(W_END <= 52 * MiB, "weights");
constexpr size_t WS_X = 56 * MiB;
constexpr size_t WS_ACT = 136 * MiB;
constexpr size_t WS_BR = 176 * MiB;
constexpr size_t WS_BIG = 216 * MiB;
constexpr size_t WS_PROJ = 376 * MiB;
constexpr size_t WS_TR = 486 * MiB;
constexpr size_t WS_CK = 541 * MiB;
constexpr size_t WS_HFIL = 551 * MiB;
constexpr size_t WS_W2 = 560 * MiB;
constexpr size_t WS_END = 612 * MiB;
constexpr int TRW = 1408;
constexpr size_t CK_NA = 0, CK_SW = 1048576, CK_DF = 1572864, CK_HALF = 2621440;
constexpr int LDS_BYTES = 147456;

#ifdef PROBE_S
constexpr int NPH = 54;
#else
constexpr int NPH = 50;
#endif
struct Params { const float* in[N_IN]; float* out; unsigned char* ws; int ph_lo, ph_hi; };
struct Ctx { float* out; unsigned char* ws; };
__device__ __forceinline__ size_t wbase(int l) { return (l & 1) ? WS_W2 : WS_W; }
constexpr size_t WS_TAB = 3 * MiB + 65536;
__device__ __forceinline__ const float* inp(const unsigned char* ws, int i) {
    const unsigned long long v = __hip_atomic_load((const unsigned long long*)(ws + WS_TAB) + i, __ATOMIC_RELAXED, __HIP_MEMORY_SCOPE_AGENT);
    const unsigned lo = __builtin_amdgcn_readfirstlane((unsigned)v), hi = __builtin_amdgcn_readfirstlane((unsigned)(v >> 32));
    return (const float*)(const GAS float*)(((unsigned long long)hi << 32) | lo);
}


__device__ __forceinline__ unsigned cvt_pk_bf16(float lo, float hi) { unsigned r; asm volatile("v_cvt_pk_bf16_f32 %0, %1, %2" : "=v"(r) : "v"(lo), "v"(hi)); return r; }
__device__ __forceinline__ float bf2f(unsigned short v) { return __uint_as_float(((unsigned)v) << 16); }
__device__ __forceinline__ float bflo(unsigned v) { return __uint_as_float(v << 16); }
__device__ __forceinline__ float bfhi(unsigned v) { return __uint_as_float(v & 0xffff0000u); }
__device__ __forceinline__ bf16_t f2bf1(float f) { return (bf16_t)(cvt_pk_bf16(f, 0.f) & 0xffffu); }
__device__ __forceinline__ float fast_exp2(float x) { return __builtin_amdgcn_exp2f(x); }
__device__ __forceinline__ float fast_rcp(float x) { return __builtin_amdgcn_rcpf(x); }
__device__ __forceinline__ float sigmoidf_(float x) { return fast_rcp(1.f + fast_exp2(-x * LOG2E)); }
__device__ __forceinline__ float wave_sum(float v) {
#pragma unroll
    for (int o = 1; o < 64; o <<= 1) v += __shfl_xor(v, o);
    return v;
}
__device__ __forceinline__ int cond_of_row(int row) { return row < M_CTX ? 0 : 1 + ((row - M_CTX) >> 11); }
__device__ __forceinline__ const float* mod_ptr(const unsigned char* ws, int cond, int l, int chunk) { return (const float*)(ws + WS_MOD) + ((size_t)(cond * 4 + l) * 9 + chunk) * 1024; }

__device__ __forceinline__ int opaque_tid() { int t; asm volatile("v_mov_b32 %0, %1" : "=v"(t) : "v"((int)threadIdx.x)); return t; }
namespace pg8 {
constexpr int BM = 256, BK = 64, HALF = 128, HTB = HALF * BK * 2, STAGE_BYTES = 8 * HTB, NXCD = 8, WGM = 4;
__device__ __forceinline__ int lds_byte(int r, int c) { const int st = (r >> 4) * 2 + (c >> 5), rr = r & 15, cc = c & 31, ob = rr * 64 + cc * 2; return st * 1024 + (ob ^ (((ob >> 9) & 1) << 5)); }
__device__ __forceinline__ void stage_rc(int b, int& R, int& C) { const int st = b / 1024, sb = b % 1024, swz = sb ^ (((sb >> 9) & 1) << 5); R = (st >> 1) * 16 + swz / 64; C = (st & 1) * 32 + (swz % 64) / 2; }
__device__ __forceinline__ int perm32(int rho) { const int n = rho >> 4, i = rho & 15; return 8 * (i >> 2) + 4 * n + (i & 3); }
struct Unit { int pm, pn; };
struct Sched { int mode, nM, nN, nwg, G, c, wgm; };
__device__ __forceinline__ bool sched_next(const Sched& S, int i, Unit& u) {
    const int j = (S.mode == 1) ? (i >> 2) : i;
    const long L = (long)j * S.G + S.c; if (L >= S.nwg) return false;
    int wgid = (int)L; { const int q = S.nwg / NXCD, r = S.nwg % NXCD, xcd = wgid % NXCD, off = wgid / NXCD; wgid = (xcd < r ? xcd * (q + 1) : r * (q + 1) + (xcd - r) * q) + off; }
    const int nig = S.wgm * S.nN, gid = wgid / nig, fm = gid * S.wgm, gsz = (S.nM - fm) < S.wgm ? (S.nM - fm) : S.wgm;
    const int pm = fm + ((wgid % nig) % gsz), pn = (wgid % nig) / gsz;
    if (S.mode == 1) { const int b = i & 3; u.pm = b * S.nM + pm; u.pn = b * S.nN + pn; } else { u.pm = pm; u.pn = pn; }
    return true;
}
enum { EK_SWIGLU = 0, EK_RESID = 1, EK_PROJ = 2, EK_BRANCH = 3 };
struct Epi { int kind; bf16_t* o16; bf16_t* o16b; float* of; const float* g; const bf16_t* gates; float scale; };
struct Gemm { const bf16_t* A; const bf16_t* Bt; int K; };

template <bool BR>
__device__ __forceinline__ void epilogue(const Epi& E, f32x4 (&acc)[2][2][4][2], const Unit& u, int wr, int wc, int fr, int fq) {
    if (BR) {
        const int bi = u.pm / 80, pm = u.pm - bi * 80, pn = u.pn & 7;
        const int row0 = pm * BM + wr * 64 + fr, col0 = pn * HALF + wc * 32 + 4 * fq;
        u32x2 gw[2][2][4];
#pragma unroll
        for (int n = 0; n < 2; ++n)
#pragma unroll
            for (int ai = 0; ai < 2; ++ai)
#pragma unroll
                for (int m = 0; m < 4; ++m) gw[n][ai][m] = *(const u32x2*)(E.gates + (size_t)(row0 + ai * HALF + m * 16) * GATEW + bi * 1024 + col0 + n * 16);
#pragma unroll
        for (int n = 0; n < 2; ++n)
#pragma unroll
            for (int ai = 0; ai < 2; ++ai)
#pragma unroll
                for (int m = 0; m < 4; ++m) {
                    const u32x2 g2 = gw[n][ai][m];
                    f32x4 gt; gt[0] = bflo(g2.x); gt[1] = bfhi(g2.x); gt[2] = bflo(g2.y); gt[3] = bfhi(g2.y);
                    f32x4 v = gt * acc[ai][0][m][n];
                    if (bi > 0) v = v + acc[ai][1][m][n];
                    acc[ai][1][m][n] = v;
                    if (bi == 3) { u32x2 w; w.x = cvt_pk_bf16(v[0], v[1]); w.y = cvt_pk_bf16(v[2], v[3]); *(u32x2*)(E.o16 + (size_t)(row0 + ai * HALF + m * 16) * DM + col0 + n * 16) = w; }
                }
    } else if (E.kind == EK_SWIGLU) {
        const int row0 = u.pm * BM + wr * 64 + fr, col0 = u.pn * 128 + wc * 32 + 8 * fq;
#pragma unroll
        for (int ai = 0; ai < 2; ++ai)
#pragma unroll
            for (int m = 0; m < 4; ++m) {
                const f32x4 a0 = acc[ai][0][m][0], a1 = acc[ai][0][m][1], b0 = acc[ai][1][m][0], b1 = acc[ai][1][m][1];
                float r[8];
#pragma unroll
                for (int e = 0; e < 4; ++e) { r[e] = a0[e] * sigmoidf_(a0[e]) * b0[e]; r[4 + e] = a1[e] * sigmoidf_(a1[e]) * b1[e]; }
                u32x4 w; w.x = cvt_pk_bf16(r[0], r[1]); w.y = cvt_pk_bf16(r[2], r[3]); w.z = cvt_pk_bf16(r[4], r[5]); w.w = cvt_pk_bf16(r[6], r[7]);
                *(u32x4*)(E.o16 + (size_t)(row0 + ai * HALF + m * 16) * DFF + col0) = w;
            }
    } else if (E.kind == EK_PROJ) {
        const int row0 = u.pm * BM + wr * 64 + fr;
        const bool isgate = u.pn >= 11;
        bf16_t* base = isgate ? E.o16b : E.o16; const int ld = isgate ? GATEW : PROJW;
        const int col0 = (isgate ? (u.pn - 11) * BM : u.pn * BM) + wc * 32 + 8 * fq;
#pragma unroll
        for (int ai = 0; ai < 2; ++ai)
#pragma unroll
            for (int m = 0; m < 4; ++m)
#pragma unroll
                for (int bj = 0; bj < 2; ++bj) {
                    f32x4 v0 = acc[ai][bj][m][0], v1 = acc[ai][bj][m][1];
                    if (isgate) {
#pragma unroll
                        for (int e = 0; e < 4; ++e) { v0[e] = sigmoidf_(v0[e]); v1[e] = sigmoidf_(v1[e]); }
                    }
                    u32x4 w; w.x = cvt_pk_bf16(v0[0], v0[1]); w.y = cvt_pk_bf16(v0[2], v0[3]); w.z = cvt_pk_bf16(v1[0], v1[1]); w.w = cvt_pk_bf16(v1[2], v1[3]);
                    *(u32x4*)(base + (size_t)(row0 + ai * HALF + m * 16) * ld + col0 + bj * HALF) = w;
                }
    } else if (E.kind == EK_RESID) {
        const int cond = (u.pm < 16) ? 0 : 1 + ((u.pm - 16) >> 3);
        const float* gv = E.g + (size_t)cond * (4 * 9 * 1024);
        const int row0 = u.pm * BM + wr * 64 + fr, col0 = u.pn * BM + wc * 32 + 4 * fq;
        f32x4 g4[2][2];
#pragma unroll
        for (int bj = 0; bj < 2; ++bj)
#pragma unroll
            for (int n = 0; n < 2; ++n) g4[bj][n] = *(const f32x4*)(gv + col0 + bj * HALF + n * 16) * E.scale;
#pragma unroll
        for (int bj = 0; bj < 2; ++bj)
#pragma unroll
            for (int n = 0; n < 2; ++n) {
                const int col = col0 + bj * HALF + n * 16;
                f32x4 xv[2][4];
#pragma unroll
                for (int ai = 0; ai < 2; ++ai)
#pragma unroll
                    for (int m = 0; m < 4; ++m) xv[ai][m] = *(const f32x4*)(E.of + (size_t)(row0 + ai * HALF + m * 16) * DM + col);
#pragma unroll
                for (int ai = 0; ai < 2; ++ai)
#pragma unroll
                    for (int m = 0; m < 4; ++m) *(f32x4*)(E.of + (size_t)(row0 + ai * HALF + m * 16) * DM + col) = xv[ai][m] + g4[bj][n] * acc[ai][bj][m][n];
            }
    }
}

template <bool BR>
__device__ __forceinline__ void gemm_phase(LAS unsigned char* lds, const Gemm g, const Sched& S, const Epi& E, const bool perm) {
    const int tid = opaque_tid(), wid = __builtin_amdgcn_readfirstlane(tid >> 6), lane = tid & 63, wr = wid >> 2, wc = wid & 3, fr = lane & 15, fq = lane >> 4;
    const int K = g.K, nt = K / BK;
    const bool align = !(E.kind == EK_RESID);
    unsigned voffA[2], voffB[2];
#pragma unroll
    for (int i = 0; i < 2; ++i) { int R, C; stage_rc(tid * 16 + i * 8192, R, C); const int Rb = perm ? ((R & ~31) + perm32(R & 31)) : R;
        voffA[i] = (unsigned)(R * K + C) * 2u; voffB[i] = (unsigned)(Rb * K + C) * 2u; }
    const size_t kstep = (size_t)(BK * 2);
    const size_t hstep = (size_t)HALF * K * 2;
    const size_t tstep = 2 * hstep;
    const size_t bstep = BR ? hstep : tstep;
    const unsigned ldsw = (unsigned)wid * 1024u;
    const int aoff = lds_byte(wr * 64 + fr, fq * 8), boff = lds_byte(wc * 32 + fr, fq * 8);
#define PG8_SA(b, h) (((b) * 2 + (h)) * HTB)
#define PG8_SB(b, h) ((4 + (b) * 2 + (h)) * HTB)
#define PG8_STAGE(bufoff, gbase, voff) do { _Pragma("unroll") for (int _i = 0; _i < 2; ++_i) \
        __builtin_amdgcn_global_load_lds((const unsigned*)((const char*)(gbase) + (voff)[_i]), (LAS unsigned*)(lds + (bufoff) + ldsw + _i * 8192), 16, 0, 0); } while (0)
#define PG8_LDA(dst, b, h) do { _Pragma("unroll") for (int m = 0; m < 4; ++m) _Pragma("unroll") for (int k = 0; k < 2; ++k) dst[m][k] = *(const LAS bf16x8*)(lds + PG8_SA(b, h) + aoff + m * 2048 + k * 1024); } while (0)
#define PG8_LDB(dst, b, h) do { _Pragma("unroll") for (int n = 0; n < 2; ++n) _Pragma("unroll") for (int k = 0; k < 2; ++k) dst[n][k] = *(const LAS bf16x8*)(lds + PG8_SB(b, h) + boff + n * 2048 + k * 1024); } while (0)
#define PG8_MMA(ai, bj, At, Bt) do { __builtin_amdgcn_s_setprio(1); _Pragma("unroll") for (int m = 0; m < 4; ++m) _Pragma("unroll") for (int n = 0; n < 2; ++n) _Pragma("unroll") for (int k = 0; k < 2; ++k) \
        acc[ai][bj][m][n] = __builtin_amdgcn_mfma_f32_16x16x32_bf16(Bt[n][k], At[m][k], acc[ai][bj][m][n], 0, 0, 0); __builtin_amdgcn_s_setprio(0); } while (0)
#define PG8_WAIT_V(n) asm volatile("s_waitcnt vmcnt(" #n ")" ::: "memory")
#define PG8_WAIT_L(n) asm volatile("s_waitcnt lgkmcnt(" #n ")" ::: "memory")
#define PG8_BAR __builtin_amdgcn_s_barrier()
#define PG8_SCHED __builtin_amdgcn_sched_barrier(0)
    Unit cur, nxt; int ui = 0;
    if (!sched_next(S, 0, cur)) return;
    f32x4 acc[2][2][4][2];
#pragma unroll
    for (int a = 0; a < 2; ++a)
#pragma unroll
        for (int b = 0; b < 2; ++b)
#pragma unroll
            for (int m = 0; m < 4; ++m)
#pragma unroll
                for (int n = 0; n < 2; ++n) acc[a][b][m][n] = (f32x4){0.f, 0.f, 0.f, 0.f};
    bf16x8 At[4][2], B0[2][2], B1[2][2];
    const char* cA = (const char*)g.A + (size_t)cur.pm * tstep; const char* cB = (const char*)g.Bt + (size_t)cur.pn * bstep;
    PG8_STAGE(PG8_SB(0, 0), cB, voffB); PG8_STAGE(PG8_SB(0, 1), cB + hstep, voffB); PG8_STAGE(PG8_SA(0, 0), cA, voffA); PG8_STAGE(PG8_SA(0, 1), cA + hstep, voffA);
    if (wr == 1) PG8_BAR;
    PG8_WAIT_V(2); PG8_BAR;
    PG8_STAGE(PG8_SB(1, 0), cB + kstep, voffB); PG8_STAGE(PG8_SA(1, 0), cA + kstep, voffA); PG8_STAGE(PG8_SB(1, 1), cB + hstep + kstep, voffB);
    PG8_WAIT_V(6); PG8_BAR;
    for (;;) {
        const bool has_next = sched_next(S, ui + 1, nxt);
        const char* nA = has_next ? (const char*)g.A + (size_t)nxt.pm * tstep : cA; const char* nB = has_next ? (const char*)g.Bt + (size_t)nxt.pn * bstep : cB;
        for (int t = 0; t < nt; t += 2) {
            const bool last = (t == nt - 2);
            const char* a1 = cA + (size_t)(t + 1) * kstep;
            const char* a2 = last ? nA : cA + (size_t)(t + 2) * kstep; const char* b2 = last ? nB : cB + (size_t)(t + 2) * kstep;
            const char* a3 = a2 + kstep; const char* b3 = b2 + kstep;
            PG8_LDB(B0, 0, 0); PG8_LDB(B1, 0, 1); PG8_SCHED; PG8_LDA(At, 0, 0); PG8_STAGE(PG8_SA(1, 1), a1 + hstep, voffA);
            PG8_WAIT_V(8); PG8_WAIT_L(0); PG8_BAR; PG8_MMA(0, 0, At, B0); if (!BR) { PG8_MMA(0, 1, At, B1); } PG8_BAR; PG8_SCHED;
            PG8_LDA(At, 0, 1); PG8_STAGE(PG8_SB(0, 0), b2, voffB); PG8_STAGE(PG8_SB(0, 1), b2 + hstep, voffB); PG8_STAGE(PG8_SA(0, 0), a2, voffA);
            PG8_WAIT_V(8); PG8_WAIT_L(0); PG8_BAR; PG8_MMA(1, 0, At, B0); if (!BR) { PG8_MMA(1, 1, At, B1); } PG8_BAR; PG8_SCHED;
            PG8_LDB(B0, 1, 0); PG8_LDB(B1, 1, 1); PG8_SCHED; PG8_LDA(At, 1, 0); PG8_STAGE(PG8_SA(0, 1), a2 + hstep, voffA);
            PG8_WAIT_V(8); PG8_WAIT_L(0); PG8_BAR; PG8_MMA(0, 0, At, B0); if (!BR) { PG8_MMA(0, 1, At, B1); } PG8_BAR; PG8_SCHED;
            PG8_LDA(At, 1, 1); PG8_STAGE(PG8_SB(1, 0), b3, voffB); PG8_STAGE(PG8_SB(1, 1), b3 + hstep, voffB); PG8_STAGE(PG8_SA(1, 0), a3, voffA);
            PG8_WAIT_V(8); PG8_WAIT_L(0); PG8_BAR; PG8_MMA(1, 0, At, B0); if (!BR) { PG8_MMA(1, 1, At, B1); } PG8_BAR; PG8_SCHED;
        }
        if (align && wr == 0) PG8_BAR;
        epilogue<BR>(E, acc, cur, wr, wc, fr, fq);
        if (!has_next) break;
#pragma unroll
        for (int a = 0; a < 2; ++a)
#pragma unroll
            for (int b = 0; b < (BR ? 1 : 2); ++b)
#pragma unroll
                for (int m = 0; m < 4; ++m)
#pragma unroll
                    for (int n = 0; n < 2; ++n) acc[a][b][m][n] = (f32x4){0.f, 0.f, 0.f, 0.f};
        cur = nxt; cA = nA; cB = nB; ++ui;
        if (align && wr == 1) PG8_BAR;
    }
    PG8_WAIT_V(0);
    if (!align && wr == 0) PG8_BAR;
    PG8_BAR;
#undef PG8_SA
#undef PG8_SB
#undef PG8_STAGE
#undef PG8_LDA
#undef PG8_LDB
#undef PG8_MMA
#undef PG8_WAIT_V
#undef PG8_WAIT_L
#undef PG8_BAR
#undef PG8_SCHED
}
}


__device__ __forceinline__ void transpose_item(const float* W, int K, int N, bf16_t* WT, int dst_row0, LAS float* scr, int k0, int n0, int lane) {
    f32x4 v[16];
    const int rr = lane >> 4, cc = (lane & 15) * 4;
#pragma unroll
    for (int i = 0; i < 16; ++i) v[i] = *(const f32x4*)(W + (size_t)(k0 + 4 * i + rr) * N + n0 + cc);
#pragma unroll
    for (int i = 0; i < 16; ++i) { LAS float* d = scr + (4 * i + rr) * 65 + cc; d[0] = v[i][0]; d[1] = v[i][1]; d[2] = v[i][2]; d[3] = v[i][3]; }
    asm volatile("s_waitcnt lgkmcnt(0)" ::: "memory");
    const int c = lane & 7, r = lane >> 3;
#pragma unroll
    for (int j = 0; j < 8; ++j) { const int n = 8 * j + r; const LAS float* q = scr + (8 * c) * 65 + n;
        u32x4 o; o.x = cvt_pk_bf16(q[0], q[65]); o.y = cvt_pk_bf16(q[2 * 65], q[3 * 65]); o.z = cvt_pk_bf16(q[4 * 65], q[5 * 65]); o.w = cvt_pk_bf16(q[6 * 65], q[7 * 65]);
        *(u32x4*)(WT + (size_t)(dst_row0 + n) * K + k0 + 8 * c) = o; }
    asm volatile("s_waitcnt lgkmcnt(0)" ::: "memory");
}

__device__ __forceinline__ void prep_layer(const Ctx& p, LAS unsigned char* lds, int l, int bidx, int G, int part) {
    const int tid = opaque_tid(), lane = tid & 63, wave = tid >> 6;
    const int gw = bidx * 8 + wave, NGW = G * 8;
    unsigned char* ws = p.ws; unsigned char* wsw = p.ws + wbase(l);
    LAS float* scr = (LAS float*)(lds + wave * 16896);
    {
        constexpr int I_UP = 16 * 44, I_DN = 44 * 16, I_IN = 16 * 108, I_BR = 4 * 16, I_OUT = 16 * 16;
        constexpr int NIT = 4 * I_UP + 2 * I_DN + I_IN + 4 * I_BR + I_OUT;
        for (int it = gw; it < NIT; it += NGW) {
            int r = it;
            { const int cls = (r < 4 * I_UP) ? ((r < 2 * I_UP) ? 1 : 4) : ((r < 4 * I_UP + 2 * I_DN) ? ((r < 4 * I_UP + I_DN) ? 1 : 4) : 2); if (!(part & cls)) continue; }
            if (r < 4 * I_UP) {
                const int which = r / I_UP; r -= which * I_UP; const int kb = r / 44, nb = r % 44, n0 = nb * 64;
                const float* W = inp(p.ws, (which >> 1) ? ((which & 1) ? I_F2W3 : I_F2W1) : ((which & 1) ? I_F1W3 : I_F1W1)) + (size_t)l * DM * DFF;
                bf16_t* WT = (bf16_t*)(wsw + ((which >> 1) ? W_F2UP : W_F1UP));
                const int drow = 256 * (n0 >> 7) + (which & 1) * 128 + (n0 & 127);
                transpose_item(W, DM, DFF, WT, drow, scr, kb * 64, n0, lane); continue;
            }
            r -= 4 * I_UP;
            if (r < 2 * I_DN) {
                const int which = r / I_DN; r -= which * I_DN; const int kb = r / 16, nb = r % 16;
                const float* W = inp(p.ws, which ? I_F2W2 : I_F1W2) + (size_t)l * DFF * DM;
                bf16_t* WT = (bf16_t*)(wsw + (which ? W_F2DN : W_F1DN));
                transpose_item(W, DFF, DM, WT, nb * 64, scr, kb * 64, nb * 64, lane); continue;
            }
            r -= 2 * I_DN;
            if (r < I_IN) { const int kb = r / 108, nb = r % 108;
                transpose_item(inp(p.ws, I_WIN) + (size_t)l * DM * INW, DM, INW, (bf16_t*)(wsw + W_IN), nb * 64, scr, kb * 64, nb * 64, lane); continue; }
            r -= I_IN;
            if (r < 4 * I_BR) { const int bi = r / I_BR; r -= bi * I_BR; const int kb = r / 16, nb = r % 16;
                transpose_item(inp(p.ws, I_WBR) + ((size_t)l * 4 + bi) * 256 * DM, 256, DM, (bf16_t*)(wsw + W_BR) + (size_t)bi * 1024 * 256, nb * 64, scr, kb * 64, nb * 64, lane); continue; }
            r -= 4 * I_BR;
            { const int kb = r / 16, nb = r % 16;
              transpose_item(inp(p.ws, I_WOUT) + (size_t)l * DM * DM, DM, DM, (bf16_t*)(wsw + W_OUT), nb * 64, scr, kb * 64, nb * 64, lane); }
        }
    }
    if (!(part & 2)) return;
    {
        bf16_t* CK = (bf16_t*)(ws + WS_CK);
        const int gt = bidx * 512 + tid, NT = G * 512;
        for (int it = gt; it < 327680; it += NT) {
            int e = it * 8; const float* src; bf16_t* dst; int per_b;
            if (e < 1048576) { src = inp(p.ws, I_CNAK); dst = CK + CK_NA; per_b = 131072; }
            else if (e < 1572864) { e -= 1048576; src = inp(p.ws, I_CSWK); dst = CK + CK_SW; per_b = 65536; }
            else { e -= 1572864; src = inp(p.ws, I_CDFK); dst = CK + CK_DF; per_b = 131072; }
            const int b = e / per_b, r = e - b * per_b;
            const float* s = src + ((size_t)(b * 4 + l)) * per_b + r;
            const f32x4 v0 = *(const f32x4*)s, v1 = *(const f32x4*)(s + 4);
            u32x4 o; o.x = cvt_pk_bf16(v0[0], v0[1]); o.y = cvt_pk_bf16(v0[2], v0[3]); o.z = cvt_pk_bf16(v1[0], v1[1]); o.w = cvt_pk_bf16(v1[2], v1[3]);
            *(u32x4*)(dst + e) = o;
        }
    }
    {
        bf16_t* CV = (bf16_t*)(ws + WS_CK) + CK_HALF;
        for (int it = gw; it < 640; it += NGW) {
            int r = it; const float* src; bf16_t* dst; int H;
            if (r < 256) { src = inp(p.ws, I_CNAV); dst = CV + CK_NA; H = 4; }
            else if (r < 384) { r -= 256; src = inp(p.ws, I_CSWV); dst = CV + CK_SW; H = 2; }
            else { r -= 384; src = inp(p.ws, I_CDFV); dst = CV + CK_DF; H = 4; }
            const int kb = r & 7, bh = r >> 3, b = bh / H, h = bh - b * H;
            transpose_item(src + ((size_t)(b * 4 + l) * H + h) * 512 * 64, 512, 64, dst + (size_t)bh * 64 * 512, 0, scr, kb * 64, 0, lane);
        }
    }
    __syncthreads();
    {
        LAS float* Z = (LAS float*)lds;
        LAS float* G1 = Z + 8 * 33;
        LAS float* G2 = G1 + 8 * 64;
        float* HF = (float*)(ws + WS_HFIL);
        const float* w1 = inp(p.ws, I_HW1) + (size_t)l * 33 * 64; const float* b1 = inp(p.ws, I_HB1) + l * 64;
        const float* w2 = inp(p.ws, I_HW2) + (size_t)l * 64 * 64; const float* b2 = inp(p.ws, I_HB2) + l * 64;
        const float* w3 = inp(p.ws, I_HW3) + (size_t)l * 64 * 1024; const float* sf = inp(p.ws, I_HSF) + l * 64; const float* ld = inp(p.ws, I_HLD) + l * 1024;
        for (int it = bidx; it < 288; it += G) {
            const int Lsel = it >= 32, L = Lsel ? 2048 : 256, n0 = (Lsel ? it - 32 : it) * 8;
            const float invL = 1.f / (float)L;
            if (tid < 8 * 33) { const int nn = tid / 33, i = tid - nn * 33; const float tn = (float)(n0 + nn) * invL; float v;
                if (i == 0) v = tn; else if (i <= 16) v = __cosf(6.283185307179586f * tn * (float)i); else v = __sinf(6.283185307179586f * tn * (float)(i - 16));
                Z[nn * 33 + i] = v; }
            __syncthreads();
            { const int nn = tid >> 6, j = tid & 63; float a = b1[j];
#pragma unroll 11
              for (int i = 0; i < 33; ++i) a += Z[nn * 33 + i] * w1[i * 64 + j];
              G1[nn * 64 + j] = __sinf(sf[j] * a); }
            __syncthreads();
            { const int nn = tid >> 6, j = tid & 63; float a = b2[j];
#pragma unroll 16
              for (int i = 0; i < 64; ++i) a += G1[nn * 64 + i] * w2[i * 64 + j];
              G2[nn * 64 + j] = __sinf(sf[j] * a); }
            __syncthreads();
#pragma unroll 1
            for (int cc = 0; cc < 2; ++cc) {
                const int col = cc * 512 + tid;
                float a[8];
#pragma unroll
                for (int nn = 0; nn < 8; ++nn) a[nn] = 0.f;
#pragma unroll 16
                for (int i = 0; i < 64; ++i) { const float w = w3[i * 1024 + col];
#pragma unroll
                    for (int nn = 0; nn < 8; ++nn) a[nn] += G2[nn * 64 + i] * w; }
                const float rate = __expf(ld[col]);
#pragma unroll
                for (int nn = 0; nn < 8; ++nn) a[nn] *= __expf(-rate * (float)(n0 + nn) * invL);
                float* o = HF + (Lsel ? 262144 : 0) + (size_t)col * L + n0;
                *(f32x4*)o = (f32x4){a[0], a[1], a[2], a[3]}; *(f32x4*)(o + 4) = (f32x4){a[4], a[5], a[6], a[7]};
            }
            __syncthreads();
        }
    }
    if (bidx == 0 && tid == 0) {
        const float* lv = inp(p.ws, I_DLAM) + l * 128; float s01 = 0.f, s23 = 0.f;
        for (int i = 0; i < 32; ++i) { s01 += lv[i] * lv[32 + i]; s23 += lv[64 + i] * lv[96 + i]; }
        float c08; asm volatile("v_mov_b32 %0, 0x3f4ccccd" : "=v"(c08));
        const float lam_init = c08 - 0.6f * __expf(-0.3f * (float)l);
        ((float*)(ws + WS_LAM))[l] = __expf(s01) - __expf(s23) + lam_init; ((float*)(ws + WS_LAM))[4 + l] = lam_init;
    }
}

__device__ __forceinline__ void prep_mod(const Ctx& p, LAS unsigned char* lds) {
    const int tid = opaque_tid(), lane = tid & 63, wave = tid >> 6;
    const int G = gridDim.x;
    LAS float* SC = (LAS float*)lds;
    LAS float* PART = (LAS float*)(lds + 40960);
    for (int i = tid; i < 9 * 1024; i += 512) { const float v = (i < 1024) ? inp(p.ws, I_CCTX)[i] : inp(p.ws, I_C)[i - 1024]; SC[i] = v * sigmoidf_(v); }
    __syncthreads();
    float* mod = (float*)(p.ws + WS_MOD);
    for (int it = blockIdx.x; it < 4 * 36; it += G) {
        const int cb = it % 36, l = it / 36;
        const int col = cb * 256 + lane * 4, k0 = wave * 128;
        const float* W = inp(p.ws, I_WADA) + ((size_t)l * DM + k0) * 9216 + col;
        f32x4 a[9];
#pragma unroll
        for (int c = 0; c < 9; ++c) a[c] = (f32x4){0.f, 0.f, 0.f, 0.f};
#pragma unroll 16
        for (int k = 0; k < 128; ++k) { const f32x4 w = *(const f32x4*)(W + (size_t)k * 9216);
#pragma unroll
            for (int c = 0; c < 9; ++c) a[c] += w * SC[c * 1024 + k0 + k]; }
#pragma unroll
        for (int c = 0; c < 9; ++c) *(LAS f32x4*)(PART + (wave * 9 + c) * 256 + lane * 4) = a[c];
        __syncthreads();
        for (int o = tid; o < 9 * 256; o += 512) { const int c = o >> 8, cc = o & 255;
            float v = inp(p.ws, I_BADA)[(size_t)l * 9216 + cb * 256 + cc];
#pragma unroll
            for (int w = 0; w < 8; ++w) v += PART[(w * 9 + c) * 256 + cc];
            mod[((size_t)(c * 4 + l)) * 9216 + cb * 256 + cc] = v; }
        __syncthreads();
    }
}

__device__ __forceinline__ void norm_phase(const Ctx& p, int l, int which  ) {
    const int tid_ = opaque_tid(), lane = tid_ & 63, wave = tid_ >> 6, gw = blockIdx.x * 8 + wave, NGW = gridDim.x * 8;
    float* X = (float*)(p.ws + WS_X); bf16_t* ACT = (bf16_t*)(p.ws + WS_ACT);
    const float* gsrc = inp(p.ws, which == 0 ? I_NF1 : (which == 1 ? I_NMIX : I_NF2)) + l * DM;
    const bool from_in = (l == 0 && which == 0);
    f32x4 gv[4];
#pragma unroll
    for (int j = 0; j < 4; ++j) gv[j] = *(const f32x4*)(gsrc + j * 256 + lane * 4);
    constexpr int NR = 4;
    for (int row0 = gw * NR; row0 < M_TOT; row0 += NGW * NR) {
        f32x4 v[NR][4]; float s[NR];
#pragma unroll
        for (int r = 0; r < NR; ++r) {
            const int row = row0 + r;
            const float* xr = from_in ? (row < M_CTX ? inp(p.ws, I_XP) + (size_t)row * DM : inp(p.ws, I_XS) + (size_t)(row - M_CTX) * DM) : X + (size_t)row * DM;
#pragma unroll
            for (int j = 0; j < 4; ++j) v[r][j] = *(const f32x4*)(xr + j * 256 + lane * 4);
        }
        const int cond = cond_of_row(row0);
        const float* sh = mod_ptr(p.ws, cond, l, which * 3 + 0); const float* sc = mod_ptr(p.ws, cond, l, which * 3 + 1);
        f32x4 s4[4], h4[4];
#pragma unroll
        for (int j = 0; j < 4; ++j) { s4[j] = *(const f32x4*)(sc + j * 256 + lane * 4) + 1.f; h4[j] = *(const f32x4*)(sh + j * 256 + lane * 4); }
#pragma unroll
        for (int r = 0; r < NR; ++r) { float a = 0.f;
#pragma unroll
            for (int j = 0; j < 4; ++j) a += (v[r][j][0] * v[r][j][0] + v[r][j][1] * v[r][j][1]) + (v[r][j][2] * v[r][j][2] + v[r][j][3] * v[r][j][3]);
            s[r] = a; }
        if (from_in) {
#pragma unroll
            for (int r = 0; r < NR; ++r)
#pragma unroll
                for (int j = 0; j < 4; ++j) *(f32x4*)(X + (size_t)(row0 + r) * DM + j * 256 + lane * 4) = v[r][j];
        }
#pragma unroll
        for (int o = 1; o < 64; o <<= 1) {
#pragma unroll
            for (int r = 0; r < NR; ++r) s[r] += __shfl_xor(s[r], o);
        }
#pragma unroll
        for (int r = 0; r < NR; ++r) {
            const float rstd = rsqrtf(s[r] * (1.f / DM) + EPSF);
#pragma unroll
            for (int j = 0; j < 4; ++j) {
                const f32x4 o = (v[r][j] * rstd) * gv[j] * s4[j] + h4[j];
                u32x2 w; w.x = cvt_pk_bf16(o[0], o[1]); w.y = cvt_pk_bf16(o[2], o[3]);
                *(u32x2*)(ACT + (size_t)(row0 + r) * DM + j * 256 + lane * 4) = w;
            }
        }
    }
}
__device__ __forceinline__ void final_norm_phase(const Ctx& p) {
    const int tid_ = opaque_tid(), lane = tid_ & 63, wave = tid_ >> 6, gw = blockIdx.x * 8 + wave, NGW = gridDim.x * 8;
    const float* X = (const float*)(p.ws + WS_X); const float* gsrc = inp(p.ws, I_FNORM);
    f32x4 gv[4];
#pragma unroll
    for (int j = 0; j < 4; ++j) gv[j] = *(const f32x4*)(gsrc + j * 256 + lane * 4);
    constexpr int NR = 4;
    for (int row0 = gw * NR; row0 < M_TOT; row0 += NGW * NR) {
        f32x4 v[NR][4]; float s[NR];
#pragma unroll
        for (int r = 0; r < NR; ++r) { const float* xr = X + (size_t)(row0 + r) * DM;
#pragma unroll
            for (int j = 0; j < 4; ++j) v[r][j] = *(const f32x4*)(xr + j * 256 + lane * 4); }
#pragma unroll
        for (int r = 0; r < NR; ++r) { float a = 0.f;
#pragma unroll
            for (int j = 0; j < 4; ++j) a += (v[r][j][0] * v[r][j][0] + v[r][j][1] * v[r][j][1]) + (v[r][j][2] * v[r][j][2] + v[r][j][3] * v[r][j][3]);
            s[r] = a; }
#pragma unroll
        for (int o = 1; o < 64; o <<= 1) {
#pragma unroll
            for (int r = 0; r < NR; ++r) s[r] += __shfl_xor(s[r], o);
        }
#pragma unroll
        for (int r = 0; r < NR; ++r) { const float rstd = rsqrtf(s[r] * (1.f / DM) + EPSF);
#pragma unroll
            for (int j = 0; j < 4; ++j) *(f32x4*)(p.out + O_Y + (size_t)(row0 + r) * DM + j * 256 + lane * 4) = (v[r][j] * rstd) * gv[j]; }
    }
}

__device__ __forceinline__ void mixprep_phase(const Ctx& p, LAS unsigned char* lds, int l) {
    const int tid = opaque_tid(), G = gridDim.x;
    bf16_t* PROJ = (bf16_t*)(p.ws + WS_PROJ); bf16_t* TR = (bf16_t*)(p.ws + WS_TR);
    {
        const int lane = tid & 63, wave = tid >> 6, gw = blockIdx.x * 8 + wave, NGW = G * 8;
        LAS float* T = (LAS float*)(lds + wave * 17168);
        const float* sw = inp(p.ws, I_HSW) + (size_t)l * 3 * 768; const float* sb = inp(p.ws, I_HSB) + (size_t)l * 768;
        const int lr = lane >> 3, lc = lane & 7;
        for (int it = gw; it < 320 * 22; it += NGW) {
            const int cb = it % 22, rb = it / 22, row0 = rb * 64, tcol0 = cb * 64;
            int src; bool hy = false;
            if (tcol0 < 256) src = 512 + tcol0; else if (tcol0 < 384) src = 1152 + (tcol0 - 256); else if (tcol0 < 640) src = 2560 + (tcol0 - 384); else { src = 1280 + (tcol0 - 640); hy = true; }
            const bool seq_start = row0 < M_CTX ? ((row0 & 255) == 0) : (((row0 - M_CTX) & 2047) == 0);
            const int rend = row0 + 64; const bool seq_end = rend <= M_CTX ? ((rend & 255) == 0) : (((rend - M_CTX) & 2047) == 0);
            const bf16_t* sp = PROJ + (size_t)row0 * PROJW + src + lc * 8;
            u32x4 w[8], wh = (u32x4){0u, 0u, 0u, 0u};
#pragma unroll
            for (int i = 0; i < 8; ++i) w[i] = *(const u32x4*)(sp + (size_t)(i * 8 + lr) * PROJW);
            if (hy && lane < 16) { const bool top = lane < 8; const bool ok = top ? !seq_start : !seq_end;
                if (ok) wh = *(const u32x4*)(sp + (top ? -(ptrdiff_t)PROJW : (ptrdiff_t)64 * PROJW)); }
#pragma unroll
            for (int i = 0; i < 8; ++i) { LAS float* d = T + (1 + i * 8 + lr) * 65 + lc * 8;
                d[0] = bflo(w[i].x); d[1] = bfhi(w[i].x); d[2] = bflo(w[i].y); d[3] = bfhi(w[i].y); d[4] = bflo(w[i].z); d[5] = bfhi(w[i].z); d[6] = bflo(w[i].w); d[7] = bfhi(w[i].w); }
            if (hy && lane < 16) { LAS float* d = T + (lane < 8 ? 0 : 65) * 65 + lc * 8;
                d[0] = bflo(wh.x); d[1] = bfhi(wh.x); d[2] = bflo(wh.y); d[3] = bfhi(wh.y); d[4] = bflo(wh.z); d[5] = bfhi(wh.z); d[6] = bflo(wh.w); d[7] = bfhi(wh.w); }
            asm volatile("s_waitcnt lgkmcnt(0)" ::: "memory");
            const int rg = lane & 7, csub = lane >> 3;
#pragma unroll 2
            for (int j = 0; j < 8; ++j) {
                const int col = j * 8 + csub; float o[8];
                const LAS float* tp = T + (rg * 8) * 65 + col;
                if (hy) { const int ch = tcol0 - 640 + col; const float w0 = sw[ch], w1 = sw[768 + ch], w2 = sw[1536 + ch], bb = sb[ch];
                    float x[10];
#pragma unroll
                    for (int k = 0; k < 10; ++k) x[k] = tp[k * 65];
#pragma unroll
                    for (int k = 0; k < 8; ++k) o[k] = x[k] * w0 + x[k + 1] * w1 + x[k + 2] * w2 + bb;
                } else {
#pragma unroll
                    for (int k = 0; k < 8; ++k) o[k] = tp[(k + 1) * 65];
                }
                u32x4 ww; ww.x = cvt_pk_bf16(o[0], o[1]); ww.y = cvt_pk_bf16(o[2], o[3]); ww.z = cvt_pk_bf16(o[4], o[5]); ww.w = cvt_pk_bf16(o[6], o[7]);
                *(u32x4*)(TR + (size_t)(tcol0 + col) * M_TOT + row0 + rg * 8) = ww;
            }
            asm volatile("s_waitcnt lgkmcnt(0)" ::: "memory");
        }
    }
    const int gt = blockIdx.x * 512 + tid, NT = G * 512;
    for (int it = gt; it < M_CTX * 160; it += NT) {
        const int row = it / 160, ch = it - row * 160; int pc, H; size_t ob; int c8;
        if (ch < 32) { pc = 256; H = 4; ob = O_NAK; c8 = ch * 8; }
        else if (ch < 64) { pc = 512; H = 4; ob = O_NAV; c8 = (ch - 32) * 8; }
        else if (ch < 80) { pc = 1024; H = 2; ob = O_SWK; c8 = (ch - 64) * 8; }
        else if (ch < 96) { pc = 1152; H = 2; ob = O_SWV; c8 = (ch - 80) * 8; }
        else if (ch < 128) { pc = 2304; H = 4; ob = O_DFK; c8 = (ch - 96) * 8; }
        else { pc = 2560; H = 4; ob = O_DFV; c8 = (ch - 128) * 8; }
        const u32x4 w = *(const u32x4*)(PROJ + (size_t)row * PROJW + pc + c8);
        const int b = row >> 8, t = row & 255, h = c8 >> 6, d = c8 & 63;
        float* o = p.out + ob + ((((size_t)(b * 4 + l) * H + h) * 256 + t) * 64 + d);
        *(f32x4*)o = (f32x4){bflo(w.x), bfhi(w.x), bflo(w.y), bfhi(w.y)}; *(f32x4*)(o + 4) = (f32x4){bflo(w.z), bfhi(w.z), bflo(w.w), bfhi(w.w)};
    }
    for (int it = gt; it < M_DEC * 56; it += NT) {
        const int rowd = it / 56, q = it - rowd * 56, t = rowd & 2047, gr = t >> 6, gc = t & 63;
        int a, bofs, i0; float pos, fstep;
        if (q < 24) {
            const int base = q < 16 ? 768 : 1024, qq = q < 16 ? q : q - 16, h = qq >> 2, half = (qq >> 1) & 1, grp = qq & 1;
            a = base + h * 64 + half * 32 + grp * 8; bofs = 16; i0 = grp * 8; pos = half ? (float)gc : (float)gr; fstep = 13.287712379549449f / 16.f;
        } else {
            const int base = q < 40 ? 2048 : 2304, qq = q < 40 ? q - 24 : q - 40, mp32 = qq >> 1, half = qq & 1;
            a = base + mp32 * 32 + half * 16; bofs = 8; i0 = 0; pos = half ? (float)gc : (float)gr; fstep = 13.287712379549449f / 8.f;
        }
        bf16_t* pa = PROJ + (size_t)(M_CTX + rowd) * PROJW + a;
        const u32x4 wa = *(const u32x4*)pa, wb = *(const u32x4*)(pa + bofs);
        float xa[8], xb[8];
        xa[0] = bflo(wa.x); xa[1] = bfhi(wa.x); xa[2] = bflo(wa.y); xa[3] = bfhi(wa.y); xa[4] = bflo(wa.z); xa[5] = bfhi(wa.z); xa[6] = bflo(wa.w); xa[7] = bfhi(wa.w);
        xb[0] = bflo(wb.x); xb[1] = bfhi(wb.x); xb[2] = bflo(wb.y); xb[3] = bfhi(wb.y); xb[4] = bflo(wb.z); xb[5] = bfhi(wb.z); xb[6] = bflo(wb.w); xb[7] = bfhi(wb.w);
        float oa[8], ob[8];
#pragma unroll
        for (int j = 0; j < 8; ++j) { const float ang = pos * fast_exp2(-(float)(i0 + j) * fstep); const float cs = __cosf(ang), sn = __sinf(ang);
            oa[j] = xa[j] * cs - xb[j] * sn; ob[j] = xb[j] * cs + xa[j] * sn; }
        u32x4 ra, rb;
        ra.x = cvt_pk_bf16(oa[0], oa[1]); ra.y = cvt_pk_bf16(oa[2], oa[3]); ra.z = cvt_pk_bf16(oa[4], oa[5]); ra.w = cvt_pk_bf16(oa[6], oa[7]);
        rb.x = cvt_pk_bf16(ob[0], ob[1]); rb.y = cvt_pk_bf16(ob[2], ob[3]); rb.z = cvt_pk_bf16(ob[4], ob[5]); rb.w = cvt_pk_bf16(ob[6], ob[7]);
        *(u32x4*)pa = ra; *(u32x4*)(pa + bofs) = rb;
    }
}

struct AttnState { float m, l; f32x4 o[4]; };
__device__ __forceinline__ f32x4 mfma16(bf16x8 a, bf16x8 b, f32x4 c) { return __builtin_amdgcn_mfma_f32_16x16x32_bf16(a, b, c, 0, 0, 0); }

__device__ __forceinline__ float xmax16(float x) { const u32x2 r = __builtin_amdgcn_permlane16_swap(__float_as_uint(x), __float_as_uint(x), false, false); return fmaxf(__uint_as_float(r.x), __uint_as_float(r.y)); }
__device__ __forceinline__ float xmax32(float x) { const u32x2 r = __builtin_amdgcn_permlane32_swap(__float_as_uint(x), __float_as_uint(x), false, false); return fmaxf(__uint_as_float(r.x), __uint_as_float(r.y)); }
__device__ __forceinline__ float xadd16(float x) { const u32x2 r = __builtin_amdgcn_permlane16_swap(__float_as_uint(x), __float_as_uint(x), false, false); return __uint_as_float(r.x) + __uint_as_float(r.y); }
__device__ __forceinline__ float xadd32(float x) { const u32x2 r = __builtin_amdgcn_permlane32_swap(__float_as_uint(x), __float_as_uint(x), false, false); return __uint_as_float(r.x) + __uint_as_float(r.y); }
__device__ __forceinline__ void softmax_d16(AttnState& st, float (&s)[16], bool first, float& alpha, bool& resc, bf16x8& p0, bf16x8& p1) {
    float mx = fmaxf(fmaxf(fmaxf(s[0], s[1]), fmaxf(s[2], s[3])), fmaxf(fmaxf(s[4], s[5]), fmaxf(s[6], s[7])));
    mx = fmaxf(mx, fmaxf(fmaxf(fmaxf(s[8], s[9]), fmaxf(s[10], s[11])), fmaxf(fmaxf(s[12], s[13]), fmaxf(s[14], s[15]))));
    resc = first || (__builtin_amdgcn_ballot_w64(mx > 8.f) != 0ull);
    alpha = 1.f;
    if (resc) {
        mx = xmax16(mx); mx = xmax32(mx);
        const float d = first ? mx : fmaxf(mx, 0.f);
        alpha = first ? 0.f : fast_exp2(-d);
        st.m = first ? mx : st.m + d;
#pragma unroll
        for (int j = 0; j < 16; ++j) s[j] -= d;
    }
    float pr[16];
#pragma unroll
    for (int j = 0; j < 16; ++j) pr[j] = fast_exp2(s[j]);
    float sum = (((pr[0] + pr[1]) + (pr[2] + pr[3])) + ((pr[4] + pr[5]) + (pr[6] + pr[7]))) + (((pr[8] + pr[9]) + (pr[10] + pr[11])) + ((pr[12] + pr[13]) + (pr[14] + pr[15])));
    sum = xadd16(sum); sum = xadd32(sum);
    st.l = st.l * alpha + sum;
    u32x4 w0, w1;
    w0.x = cvt_pk_bf16(pr[0], pr[1]); w0.y = cvt_pk_bf16(pr[2], pr[3]); w0.z = cvt_pk_bf16(pr[4], pr[5]); w0.w = cvt_pk_bf16(pr[6], pr[7]);
    w1.x = cvt_pk_bf16(pr[8], pr[9]); w1.y = cvt_pk_bf16(pr[10], pr[11]); w1.z = cvt_pk_bf16(pr[12], pr[13]); w1.w = cvt_pk_bf16(pr[14], pr[15]);
    p0 = __builtin_bit_cast(bf16x8, w0); p1 = __builtin_bit_cast(bf16x8, w1);
}
__device__ __forceinline__ bf16x8 softmax_p(AttnState& st, const float (&s2)[8], unsigned vm, float& alpha) {
    float mx = -1e30f;
#pragma unroll
    for (int j = 0; j < 8; ++j) mx = fmaxf(mx, ((vm >> j) & 1u) ? s2[j] : -1e30f);
    mx = xmax16(mx); mx = xmax32(mx);
    const float mn = fmaxf(st.m, mx); alpha = fast_exp2(st.m - mn);
    float pr[8]; float sum = 0.f;
#pragma unroll
    for (int j = 0; j < 8; ++j) { pr[j] = ((vm >> j) & 1u) ? fast_exp2(s2[j] - mn) : 0.f; sum += pr[j]; }
    sum += __shfl_xor(sum, 16); sum += __shfl_xor(sum, 32);
    st.l = st.l * alpha + sum; st.m = mn;
    u32x4 pw; pw.x = cvt_pk_bf16(pr[0], pr[1]); pw.y = cvt_pk_bf16(pr[2], pr[3]); pw.z = cvt_pk_bf16(pr[4], pr[5]); pw.w = cvt_pk_bf16(pr[6], pr[7]);
    return __builtin_bit_cast(bf16x8, pw);
}
__device__ __forceinline__ bf16x8 softmax_d(AttnState& st, const float (&s2)[8], float& alpha, bool& resc) {
    float mx = fmaxf(fmaxf(fmaxf(s2[0], s2[1]), fmaxf(s2[2], s2[3])), fmaxf(fmaxf(s2[4], s2[5]), fmaxf(s2[6], s2[7])));
    mx = fmaxf(mx, __shfl_xor(mx, 16)); mx = fmaxf(mx, __shfl_xor(mx, 32));
    const float mn = fmaxf(st.m, mx);
    resc = __builtin_amdgcn_ballot_w64(mn > st.m) != 0ull;
    alpha = fast_exp2(st.m - mn);
    float pr[8];
#pragma unroll
    for (int j = 0; j < 8; ++j) pr[j] = fast_exp2(s2[j] - mn);
    float sum = ((pr[0] + pr[1]) + (pr[2] + pr[3])) + ((pr[4] + pr[5]) + (pr[6] + pr[7]));
    sum = xadd16(sum); sum = xadd32(sum);
    st.l = st.l * alpha + sum; st.m = mn;
    u32x4 pw; pw.x = cvt_pk_bf16(pr[0], pr[1]); pw.y = cvt_pk_bf16(pr[2], pr[3]); pw.z = cvt_pk_bf16(pr[4], pr[5]); pw.w = cvt_pk_bf16(pr[6], pr[7]);
    return __builtin_bit_cast(bf16x8, pw);
}
__device__ __forceinline__ void st_init(AttnState& st, float m0, float l0) { st.m = m0; st.l = l0;
#pragma unroll
    for (int i = 0; i < 4; ++i) st.o[i] = (f32x4){0.f, 0.f, 0.f, 0.f}; }

constexpr int AT_ROWB = 144;
constexpr int AT_TILEB = 64 * AT_ROWB;
struct ATC { int l15, quad, kr0, lat0, nlat, rs_w, r_w; int cg4[2], qc[2], c0[2], qt[2], q0[2]; bool dec; const float* rpb; };

template <int TYPE>
__device__ __forceinline__ void attn_tile(AttnState (&sa)[2], AttnState (&sb)[2], const bf16x8 (&qf)[2][2], const ATC& c, const LAS unsigned char* kt, const LAS unsigned char* vt, int i) {
    const bool masked = c.dec && (i < c.nlat) && (TYPE != 2);
    if (TYPE == 0 && masked) { const int krow = c.lat0 + i; if (!((krow >= c.rs_w) && (krow < c.rs_w + 8))) return; }
    const f32x4 z4 = (f32x4){0.f, 0.f, 0.f, 0.f};
    if (!masked) {
        bf16x8 pA[2][2], pB[2][2]; float alA[2], alB[2]; bool rA[2], rB[2];
        const bool first = (TYPE != 1) && (i == 0);
        if (TYPE == 2) {
#pragma unroll
            for (int qi = 0; qi < 2; ++qi)
#pragma unroll
                for (int mp = 0; mp < 2; ++mp) {
                    float s2[16];
#pragma unroll
                    for (int ss = 0; ss < 2; ++ss)
#pragma unroll
                        for (int t = 0; t < 2; ++t) { const int kr = ss * 32 + c.kr0 + 4 * t, sw = ((kr >> 4) & 1) << 2;
                            const bf16x8 kf = *(const LAS bf16x8*)(kt + kr * AT_ROWB + (((mp * 4 + c.quad) ^ sw) << 4));
                            const float nm = first ? 0.f : -(mp == 0 ? sa[qi].m : sb[qi].m);
                            const f32x4 a = mfma16(kf, qf[qi][mp], (f32x4){nm, nm, nm, nm});
#pragma unroll
                            for (int e = 0; e < 4; ++e) s2[ss * 8 + t * 4 + e] = a[e]; }
                    if (mp == 0) softmax_d16(sa[qi], s2, first, alA[qi], rA[qi], pA[qi][0], pA[qi][1]); else softmax_d16(sb[qi], s2, first, alB[qi], rB[qi], pB[qi][0], pB[qi][1]);
                    asm volatile("" ::: "memory");
                }
        } else {
            bf16x8 kf[2][2][2];
#pragma unroll
            for (int ss = 0; ss < 2; ++ss)
#pragma unroll
                for (int t = 0; t < 2; ++t) { const int kr = ss * 32 + c.kr0 + 4 * t, sw = ((kr >> 4) & 1) << 2;
#pragma unroll
                    for (int cc = 0; cc < 2; ++cc) kf[ss][t][cc] = *(const LAS bf16x8*)(kt + kr * AT_ROWB + (((cc * 4 + c.quad) ^ sw) << 4)); }
#pragma unroll
            for (int qi = 0; qi < 2; ++qi) {
                float s2[16];
#pragma unroll
                for (int ss = 0; ss < 2; ++ss)
#pragma unroll
                    for (int t = 0; t < 2; ++t) { const float nm = first ? 0.f : -sa[qi].m; f32x4 a = mfma16(kf[ss][t][0], qf[qi][0], (f32x4){nm, nm, nm, nm}); a = mfma16(kf[ss][t][1], qf[qi][1], a);
#pragma unroll
                        for (int e = 0; e < 4; ++e) s2[ss * 8 + t * 4 + e] = a[e]; }
                softmax_d16(sa[qi], s2, first, alA[qi], rA[qi], pA[qi][0], pA[qi][1]);
            }
        }
#pragma unroll
        for (int qi = 0; qi < 2; ++qi) {
            if (rA[qi]) {
#pragma unroll
                for (int nt = 0; nt < 4; ++nt) sa[qi].o[nt] = sa[qi].o[nt] * alA[qi]; }
            if (TYPE == 2) { if (rB[qi]) {
#pragma unroll
                for (int nt = 0; nt < 4; ++nt) sb[qi].o[nt] = sb[qi].o[nt] * alB[qi]; } }
        }
#pragma unroll
        for (int ss = 0; ss < 2; ++ss) {
            bf16x8 vf[4];
#pragma unroll
            for (int nt = 0; nt < 4; ++nt) vf[nt] = *(const LAS bf16x8*)(vt + (nt * 16 + c.l15) * AT_ROWB + ss * 64 + (c.quad << 4));
#pragma unroll
            for (int qi = 0; qi < 2; ++qi)
#pragma unroll
                for (int nt = 0; nt < 4; ++nt) { sa[qi].o[nt] = mfma16(vf[nt], pA[qi][ss], sa[qi].o[nt]); if (TYPE == 2) sb[qi].o[nt] = mfma16(vf[nt], pB[qi][ss], sb[qi].o[nt]); }
        }
        return;
    }
#pragma unroll 1
    for (int ss = 0; ss < 2; ++ss) {
        bool on[2];
#pragma unroll
        for (int qi = 0; qi < 2; ++qi) {
            on[qi] = true;
            if (TYPE == 0) on[qi] = !((c.cg4[qi] == 0 && ss == 1) || (c.cg4[qi] == 3 && ss == 0));
            if (TYPE == 1) { const int k0 = (c.lat0 + i) * 64 + ss * 32; on[qi] = (k0 + 31 >= c.q0[qi] - 128) && (k0 <= c.q0[qi] + 15 + 128); }
        }
        if (on[0] || on[1]) {
            const int krA = ss * 32 + c.kr0, krB = krA + 4;
            const int swA = ((krA >> 4) & 1) << 2, swB = ((krB >> 4) & 1) << 2;
            bf16x8 kf[2][2];
#pragma unroll
            for (int cc = 0; cc < 2; ++cc) { kf[0][cc] = *(const LAS bf16x8*)(kt + krA * AT_ROWB + (((cc * 4 + c.quad) ^ swA) << 4)); kf[1][cc] = *(const LAS bf16x8*)(kt + krB * AT_ROWB + (((cc * 4 + c.quad) ^ swB) << 4)); }
            bf16x8 vf[4];
#pragma unroll
            for (int nt = 0; nt < 4; ++nt) vf[nt] = *(const LAS bf16x8*)(vt + (nt * 16 + c.l15) * AT_ROWB + ss * 64 + (c.quad << 4));
#pragma unroll
            for (int qi = 0; qi < 2; ++qi) {
                if (on[qi]) {
                    f32x4 a0 = mfma16(kf[0][0], qf[qi][0], z4), a1 = mfma16(kf[1][0], qf[qi][0], z4); a0 = mfma16(kf[0][1], qf[qi][1], a0); a1 = mfma16(kf[1][1], qf[qi][1], a1);
                    float s2[8]; unsigned vm = 0u;
#pragma unroll
                    for (int e = 0; e < 4; ++e) { s2[e] = a0[e]; s2[4 + e] = a1[e]; }
                    if (TYPE == 0) {
                        const float* rp = c.rpb + (c.lat0 + i - c.r_w + 7) * 31;
#pragma unroll
                        for (int j = 0; j < 8; ++j) { const int kc = ss * 32 + c.quad * 8 + j; const bool ok = (kc >= c.c0[qi]) && (kc < c.c0[qi] + 16);
                            const int dc = min(max(kc - c.qc[qi] + 15, 0), 30); s2[j] = s2[j] + rp[dc] * LOG2E; vm |= ok ? (1u << j) : 0u; }
                    } else {
#pragma unroll
                        for (int j = 0; j < 8; ++j) { const int dd = (c.lat0 + i) * 64 + ss * 32 + c.quad * 8 + j - c.qt[qi]; const bool ok = (dd <= 128) && (dd >= -128); vm |= ok ? (1u << j) : 0u; }
                    }
                    float al; const bf16x8 pA = softmax_p(sa[qi], s2, vm, al);
#pragma unroll
                    for (int nt = 0; nt < 4; ++nt) sa[qi].o[nt] = mfma16(vf[nt], pA, sa[qi].o[nt] * al);
                }
            }
        }
    }
}

template <int TYPE>
__device__ __forceinline__ void attn_block(const Ctx& p, LAS unsigned char* lds, int l, bool dec, int b, int h, int qblk) {
    const int tid = opaque_tid(), lane = tid & 63, wave = __builtin_amdgcn_readfirstlane(tid >> 6);
    ATC c; c.l15 = lane & 15; c.quad = lane >> 4; c.dec = dec;
    const bf16_t* PROJ = (const bf16_t*)(p.ws + WS_PROJ); const bf16_t* TR = (const bf16_t*)(p.ws + WS_TR);
    const bf16_t* CK = (const bf16_t*)(p.ws + WS_CK); const bf16_t* CV = CK + CK_HALF;
    bf16_t* BR = (bf16_t*)(p.ws + WS_BR);
    const int L = dec ? 2048 : 256, rowbase = dec ? M_CTX + b * 2048 : b * 256, q0 = qblk * 256 + wave * 32;
    const bf16_t* Pb = PROJ + (size_t)rowbase * PROJW;
    LAS unsigned char* KL = lds; LAS unsigned char* VL = lds + 2 * AT_TILEB;
    int qcol, kcol, vcol, hk, Hc; size_t ckoff;
    if (TYPE == 0) { qcol = h * 64; kcol = 256 + h * 64; vcol = h * 64; hk = h; Hc = 4; ckoff = CK_NA; }
    else if (TYPE == 1) { qcol = 768 + h * 64; kcol = 1024 + (h >> 1) * 64; vcol = 256 + (h >> 1) * 64; hk = h >> 1; Hc = 2; ckoff = CK_SW; }
    else { qcol = 2048 + h * 64; kcol = 2304 + h * 64; vcol = 384 + h * 64; hk = h; Hc = 4; ckoff = CK_DF; }
    const int ncache = dec ? 8 : 0;
    c.rs_w = 0; c.r_w = 0;
    int cgb = 0;
    if (!dec) { c.lat0 = 0; c.nlat = 4; }
    else if (TYPE == 0) { const int r0 = qblk * 4; const int rsA = min(max(r0 - 4, 0), 24), rsB = min(max(r0 - 1, 0), 24); c.lat0 = rsA; c.nlat = rsB + 8 - rsA;
        c.r_w = r0 + (wave >> 1); c.rs_w = min(max(c.r_w - 4, 0), 24); cgb = (wave & 1) * 2; }
    else if (TYPE == 1) { const int q0b = qblk * 256; c.lat0 = max(q0b - 128, 0) >> 6; c.nlat = (min(q0b + 384, L) >> 6) - c.lat0; }
    else { c.lat0 = 0; c.nlat = 32; }
#pragma unroll
    for (int qi = 0; qi < 2; ++qi) { c.cg4[qi] = cgb + qi; c.q0[qi] = q0 + 16 * qi; c.qt[qi] = q0 + 16 * qi + c.l15; c.qc[qi] = c.cg4[qi] * 16 + c.l15; c.c0[qi] = min(max(c.qc[qi] - 8, 0), 48); }
    const int ntile = c.nlat + ncache;
    const int srow = tid >> 3, sch = tid & 7;
    const int kst_off = srow * AT_ROWB + ((sch ^ (((srow >> 4) & 1) << 2)) << 4), vst_off = srow * AT_ROWB + (sch << 4);
    const bf16_t* klat = Pb + kcol + (size_t)(c.lat0 * 64 + srow) * PROJW + sch * 8;
    const bf16_t* vlat = TR + (size_t)(vcol + srow) * M_TOT + rowbase + c.lat0 * 64 + sch * 8;
    const bf16_t* kcac = CK + ckoff + ((size_t)(b * Hc + hk) * 512 + srow) * 64 + sch * 8;
    const bf16_t* vcac = CV + ckoff + ((size_t)(b * Hc + hk) * 64 + srow) * 512 + sch * 8;
    c.kr0 = (c.l15 >> 2) * 8 + (c.l15 & 3);
    bf16x8 qf[2][2];
    AttnState sa[2], sb[2];
    float sc2, m0, l0;
    if (TYPE == 1) { m0 = inp(p.ws, I_SINK)[l * 4 + h] * LOG2E; l0 = 1.f; sc2 = 0.125f * LOG2E; }
    else if (TYPE == 0) { m0 = -1e30f; l0 = 0.f; sc2 = 0.125f * LOG2E; }
    else { m0 = -1e30f; l0 = 0.f; sc2 = 0.17677669529663687f * LOG2E; }
#pragma unroll
    for (int qi = 0; qi < 2; ++qi) {
        st_init(sa[qi], m0, l0); st_init(sb[qi], -1e30f, 0.f);
        const size_t qrow = (size_t)(q0 + 16 * qi + c.l15) * PROJW;
        const u32x4 q0w = *(const u32x4*)(Pb + qrow + qcol + c.quad * 8), q1w = *(const u32x4*)(Pb + qrow + qcol + 32 + c.quad * 8);
        u32x4 a, bq;
        a.x = cvt_pk_bf16(bflo(q0w.x) * sc2, bfhi(q0w.x) * sc2); a.y = cvt_pk_bf16(bflo(q0w.y) * sc2, bfhi(q0w.y) * sc2); a.z = cvt_pk_bf16(bflo(q0w.z) * sc2, bfhi(q0w.z) * sc2); a.w = cvt_pk_bf16(bflo(q0w.w) * sc2, bfhi(q0w.w) * sc2);
        bq.x = cvt_pk_bf16(bflo(q1w.x) * sc2, bfhi(q1w.x) * sc2); bq.y = cvt_pk_bf16(bflo(q1w.y) * sc2, bfhi(q1w.y) * sc2); bq.z = cvt_pk_bf16(bflo(q1w.z) * sc2, bfhi(q1w.z) * sc2); bq.w = cvt_pk_bf16(bflo(q1w.w) * sc2, bfhi(q1w.w) * sc2);
        qf[qi][0] = __builtin_bit_cast(bf16x8, a); qf[qi][1] = __builtin_bit_cast(bf16x8, bq);
    }
    c.rpb = inp(p.ws, I_RPB) + ((size_t)(l * 4 + h)) * 15 * 31;
#define AT_KSRC(n) (((n) < c.nlat) ? klat + (size_t)(n) * 64 * PROJW : kcac + (size_t)((n) - c.nlat) * 4096)
#define AT_VSRC(n) (((n) < c.nlat) ? vlat + (n) * 64 : vcac + ((n) - c.nlat) * 64)
    u32x4 kA, vA, kB, vB;
    kA = *(const u32x4*)AT_KSRC(0); vA = *(const u32x4*)AT_VSRC(0);
    { const int n1 = min(1, ntile - 1); kB = *(const u32x4*)AT_KSRC(n1); vB = *(const u32x4*)AT_VSRC(n1); }
    *(LAS u32x4*)(KL + kst_off) = kA; *(LAS u32x4*)(VL + vst_off) = vA;
    __syncthreads();
#pragma unroll 1
    for (int i = 0; i < ntile; i += 2) {
        { const int n2 = min(i + 2, ntile - 1); kA = *(const u32x4*)AT_KSRC(n2); vA = *(const u32x4*)AT_VSRC(n2); }
        attn_tile<TYPE>(sa, sb, qf, c, KL, VL, i);
        *(LAS u32x4*)(KL + AT_TILEB + kst_off) = kB; *(LAS u32x4*)(VL + AT_TILEB + vst_off) = vB;
        __syncthreads();
        if (i + 1 >= ntile) break;
        { const int n3 = min(i + 3, ntile - 1); kB = *(const u32x4*)AT_KSRC(n3); vB = *(const u32x4*)AT_VSRC(n3); }
        attn_tile<TYPE>(sa, sb, qf, c, KL + AT_TILEB, VL + AT_TILEB, i + 1);
        *(LAS u32x4*)(KL + kst_off) = kA; *(LAS u32x4*)(VL + vst_off) = vA;
        __syncthreads();
    }
#undef AT_KSRC
#undef AT_VSRC
#pragma unroll
    for (int qi = 0; qi < 2; ++qi) {
        const size_t orow = (size_t)(rowbase + q0 + 16 * qi + c.l15) * 256 + h * 64 + c.quad * 4;
        if (TYPE != 2) {
            const float il = fast_rcp(sa[qi].l);
            bf16_t* o = BR + (TYPE == 1 ? (size_t)M_TOT * 256 : 0) + orow;
#pragma unroll
            for (int nt = 0; nt < 4; ++nt) { u32x2 w; w.x = cvt_pk_bf16(sa[qi].o[nt][0] * il, sa[qi].o[nt][1] * il); w.y = cvt_pk_bf16(sa[qi].o[nt][2] * il, sa[qi].o[nt][3] * il); *(u32x2*)(o + nt * 16) = w; }
        } else {
            const float lam = ((const float*)(p.ws + WS_LAM))[l], lam_init = ((const float*)(p.ws + WS_LAM))[4 + l];
            const float i0 = fast_rcp(sa[qi].l), i1 = lam * fast_rcp(sb[qi].l);
            f32x4 d[4]; float ss = 0.f;
#pragma unroll
            for (int i = 0; i < 4; ++i) { d[i] = sa[qi].o[i] * i0 - sb[qi].o[i] * i1; ss += (d[i][0] * d[i][0] + d[i][1] * d[i][1]) + (d[i][2] * d[i][2] + d[i][3] * d[i][3]); }
            ss = xadd16(ss); ss = xadd32(ss);
            const float rs = rsqrtf(ss * (1.f / 64.f) + EPSF) * (1.f - lam_init);
            const float* sg = inp(p.ws, I_DSUB) + l * 64 + c.quad * 4;
            bf16_t* o = BR + (size_t)3 * M_TOT * 256 + orow;
#pragma unroll
            for (int nt = 0; nt < 4; ++nt) { const f32x4 g4 = *(const f32x4*)(sg + nt * 16); const f32x4 v = d[nt] * rs * g4;
                u32x2 w; w.x = cvt_pk_bf16(v[0], v[1]); w.y = cvt_pk_bf16(v[2], v[3]); *(u32x2*)(o + nt * 16) = w; }
        }
    }
}

__device__ __forceinline__ void hyena_unit(const Ctx& p, LAS unsigned char* lds, int l, int c, bool dec) {
    const int tid = opaque_tid(), lane = tid & 63, wave = __builtin_amdgcn_readfirstlane(tid >> 6), l15 = lane & 15, quad = lane >> 4;
    const int L = dec ? 2048 : 256, B = dec ? 8 : 16, LP = L + 8, rowbase = dec ? M_CTX : 0, L2 = 2 * L, CS = L2 + 16;
    LAS bf16_t* COP = (LAS bf16_t*)lds;
    LAS bf16_t* YA = (LAS bf16_t*)(lds + 66048);
    LAS bf16_t* YB = (LAS bf16_t*)(lds + 66048 + 33024);
    LAS float* RED = (LAS float*)(lds + 66048 + 2 * 33024);
    const bf16_t* TR = (const bf16_t*)(p.ws + WS_TR);
    bf16_t* BR2 = (bf16_t*)(p.ws + WS_BR) + (size_t)2 * M_TOT * 256;
    const float* HF = (const float*)(p.ws + WS_HFIL) + (dec ? 262144 : 0);
    { const bf16_t* src = TR + (size_t)(640 + c) * M_TOT + rowbase;
      for (int i = tid; i < B * L / 8; i += 512) { const int e = i * 8, b = e / L, t = e - b * L; *(LAS u32x4*)(YA + b * LP + t) = *(const u32x4*)(src + e); } }
#pragma unroll 1
    for (int o = 0; o < 2; ++o) {
        LAS float* RF = (LAS float*)(o == 0 ? YB : YA);
        __syncthreads();
        const float* raw0 = HF + ((size_t)((o * 2 + 0) * 256 + c)) * L; const float* raw1 = HF + ((size_t)((o * 2 + 1) * 256 + c)) * L;
        float part = 0.f;
        for (int u = tid; u < L2; u += 512) { const int lag = L - 1 - u; float v = 0.f; if (lag >= 0) v = raw0[lag]; else if (lag > -L) v = raw1[-lag]; RF[u] = v; part += fabsf(v); }
        part = wave_sum(part);
        if (lane == 0) RED[wave] = part;
        __syncthreads();
        float tot = 0.f;
#pragma unroll
        for (int w = 0; w < 8; ++w) tot += RED[w];
        const float inv = 1.f / (tot + EPSF);
        const int ng = L2 / 8;
        for (int idx = tid; idx < 8 * ng; idx += 512) { const int m = idx / ng, x = (idx - m * ng) * 8; float v[8];
#pragma unroll
            for (int j = 0; j < 8; ++j) { const int u = x + m + j; v[j] = (u < L2) ? RF[u] * inv : 0.f; }
            u32x4 w; w.x = cvt_pk_bf16(v[0], v[1]); w.y = cvt_pk_bf16(v[2], v[3]); w.z = cvt_pk_bf16(v[4], v[5]); w.w = cvt_pk_bf16(v[6], v[7]);
            *(LAS u32x4*)(COP + m * CS + x) = w; }
        __syncthreads();
        const LAS bf16_t* Y = (o == 0) ? YA : YB;
        const LAS bf16_t* cpb = COP + (7 - (l15 & 7)) * CS + (L - 8 - 8 * (l15 >> 3) + quad * 8);
        const float skip = inp(p.ws, I_HSKIP)[(l * 2 + o) * 256 + c];
        const bf16_t* gate = TR + (size_t)((o == 0 ? 896 : 1152) + c) * M_TOT + rowbase;
        const int ngroups = L / 64;
        const bf16x8 zero8 = (bf16x8){0, 0, 0, 0, 0, 0, 0, 0};
        for (int g = wave; g < ngroups; g += 8) {
            const int t0 = (g >> 1) * 128 + (g & 1) * 16;
            f32x4 a0 = (f32x4){0.f, 0.f, 0.f, 0.f}, a1 = a0, a2 = a0, a3 = a0;
#define HY_D(s) (*(const LAS bf16x8*)(cpb + (32 * (s) - t0)))
#define HY_Y(s) ((l15 < B) ? *(const LAS bf16x8*)(Y + l15 * LP + 32 * (s) + quad * 8) : zero8)
            bf16x8 d0, d1 = HY_D(-1), d2 = HY_D(-2), d3 = HY_D(-3), y;
            for (int s = 0; s < L / 32; s += 4) {
                d0 = HY_D(s);     y = HY_Y(s);     a0 = mfma16(d0, y, a0); a1 = mfma16(d1, y, a1); a2 = mfma16(d2, y, a2); a3 = mfma16(d3, y, a3);
                d3 = HY_D(s + 1); y = HY_Y(s + 1); a0 = mfma16(d3, y, a0); a1 = mfma16(d0, y, a1); a2 = mfma16(d1, y, a2); a3 = mfma16(d2, y, a3);
                d2 = HY_D(s + 2); y = HY_Y(s + 2); a0 = mfma16(d2, y, a0); a1 = mfma16(d3, y, a1); a2 = mfma16(d0, y, a2); a3 = mfma16(d1, y, a3);
                d1 = HY_D(s + 3); y = HY_Y(s + 3); a0 = mfma16(d1, y, a0); a1 = mfma16(d2, y, a1); a2 = mfma16(d3, y, a2); a3 = mfma16(d0, y, a3);
            }
#undef HY_D
#undef HY_Y
            if (l15 < B) {
#pragma unroll
                for (int a = 0; a < 4; ++a) {
                    const f32x4 cv = a == 0 ? a0 : (a == 1 ? a1 : (a == 2 ? a2 : a3));
                    const int t = t0 + 32 * a + quad * 4;
                    const u32x2 gw = *(const u32x2*)(gate + (size_t)l15 * L + t);
                    const u32x2 yw = *(const LAS u32x2*)(Y + l15 * LP + t);
                    f32x4 r;
                    r[0] = bflo(gw.x) * (cv[0] + skip * bflo(yw.x)); r[1] = bfhi(gw.x) * (cv[1] + skip * bfhi(yw.x));
                    r[2] = bflo(gw.y) * (cv[2] + skip * bflo(yw.y)); r[3] = bfhi(gw.y) * (cv[3] + skip * bfhi(yw.y));
                    if (o == 0) { u32x2 w; w.x = cvt_pk_bf16(r[0], r[1]); w.y = cvt_pk_bf16(r[2], r[3]); *(LAS u32x2*)(YB + l15 * LP + t) = w; }
                    else { bf16_t* op = BR2 + (size_t)(rowbase + l15 * L + t) * 256 + c;
                        op[0] = f2bf1(r[0]); op[256] = f2bf1(r[1]); op[512] = f2bf1(r[2]); op[768] = f2bf1(r[3]); }
                }
            }
        }
    }
    __syncthreads();
}

__device__ __forceinline__ void mix_phase(const Ctx& p, LAS unsigned char* lds, int l) {
    const int G = gridDim.x;
    for (int u = blockIdx.x; u < 512; u += G) hyena_unit(p, lds, l, u & 255, u < 256);
#ifdef PROBE_HY2
    for (int u = blockIdx.x; u < 512; u += G) hyena_unit(p, lds, l, u & 255, u < 256);
#endif
    const int vcu = (G % 8 == 0) ? ((int)blockIdx.x % 8) * (G / 8) + (int)blockIdx.x / 8 : (int)blockIdx.x;
#pragma unroll 1
    for (int it = vcu; it < 960; it += G) {
        if (it < 768) { const int k = it >> 8, r = it & 255, qblk = r & 7, bh = r >> 3;
            if (k == 0) attn_block<2>(p, lds, l, true, bh >> 2, bh & 3, qblk); else if (k == 1) attn_block<1>(p, lds, l, true, bh >> 2, bh & 3, qblk); else attn_block<0>(p, lds, l, true, bh >> 2, bh & 3, qblk); }
        else { const int q = it - 768, k = q >> 6, bh = q & 63;
            if (k == 0) attn_block<2>(p, lds, l, false, bh >> 2, bh & 3, 0); else if (k == 1) attn_block<1>(p, lds, l, false, bh >> 2, bh & 3, 0); else attn_block<0>(p, lds, l, false, bh >> 2, bh & 3, 0); }
    }
}

#define XB_TMO      128
#define XB_XCNT(j)  (256  + 64 * (j))
#define XB_XSUB(j)  (1280 + 64 * (j))
#define XB_XGEN(j)  (2304 + 64 * (j))
#define XB_TOP      3328
#define XB_TOPGEN   3392
#define XB_SPIN_CAP (1u << 22)
__device__ __forceinline__ unsigned xb_ld(unsigned* p)              { return __hip_atomic_load(p, __ATOMIC_RELAXED, __HIP_MEMORY_SCOPE_AGENT); }
__device__ __forceinline__ unsigned xb_add(unsigned* p, unsigned v) { return __hip_atomic_fetch_add(p, v, __ATOMIC_RELAXED, __HIP_MEMORY_SCOPE_AGENT); }
__device__ __forceinline__ unsigned xb_xcc_id() { return (unsigned)__builtin_amdgcn_s_getreg((3 << 11) | 20) & 0xFu; }
#define XB_SPIN(cond, bar) do { unsigned _sp = 0; while (cond) { __builtin_amdgcn_s_sleep(1); \
    if ((++_sp & 255u) == 0u) { if (xb_ld(&(bar)[XB_TMO])) break; if (_sp > XB_SPIN_CAP) { atomicAdd(&(bar)[XB_TMO], 1u); break; } } } } while (0)
struct XcdBarrier { unsigned* bar; unsigned x; volatile LAS unsigned* st; };
__device__ __forceinline__ XcdBarrier xcd_barrier_post(unsigned* bar, volatile LAS unsigned* st) {
    XcdBarrier b; b.bar = bar; b.x = xb_xcc_id(); b.st = st;
    if (threadIdx.x == 0) (void)xb_add(&bar[XB_XCNT(b.x)], 1u);
    return b;
}
__device__ __forceinline__ void xcd_barrier_complete(unsigned* bar, unsigned x, unsigned& nloc, unsigned& nx) {
    const unsigned G = gridDim.x * gridDim.y * gridDim.z;
    unsigned sum, cnt, mine, sp = 0u;
    for (;;) {
        sum = 0u; cnt = 0u; mine = 0u;
#pragma unroll
        for (unsigned j = 0; j < 16; ++j) { const unsigned c = xb_ld(&bar[XB_XCNT(j)]); sum += c; cnt += (c > 0u) ? 1u : 0u; mine = (j == x) ? c : mine; }
        if (sum == G) break;
        __builtin_amdgcn_s_sleep(1);
        if ((++sp & 255u) == 0u) { if (xb_ld(&bar[XB_TMO])) break; if (sp > XB_SPIN_CAP) { atomicAdd(&bar[XB_TMO], 1u); break; } }
    }
    nloc = mine > 0u ? mine : 1u; nx = cnt > 0u ? cnt : 1u;
}
__device__ __forceinline__ void xcd_barrier(const XcdBarrier& b) {
    asm volatile("s_waitcnt vmcnt(0)" ::: "memory");
    __syncthreads();
    if (threadIdx.x == 0) {
        unsigned* bar = b.bar;
        __builtin_amdgcn_s_waitcnt(0);
        unsigned nloc = b.st[0], nx = b.st[1];
        if (nloc == 0u) { xcd_barrier_complete(bar, b.x, nloc, nx); b.st[0] = nloc; b.st[1] = nx; }
        const unsigned old = xb_add(&bar[XB_XSUB(b.x)], 1u);
        const unsigned gen = old / nloc;
        if (old + 1u == (gen + 1u) * nloc) {
            __builtin_amdgcn_fence(__ATOMIC_RELEASE, "agent");
            asm volatile("s_waitcnt vmcnt(0)" ::: "memory");
            const unsigned og = xb_add(&bar[XB_TOP], 1u);
            const unsigned tg = og / nx;
            if (og + 1u == (tg + 1u) * nx) xb_add(&bar[XB_TOPGEN], 1u);
            else XB_SPIN(xb_ld(&bar[XB_TOPGEN]) == tg, bar);
            __builtin_amdgcn_fence(__ATOMIC_ACQUIRE, "agent");
            xb_add(&bar[XB_XGEN(b.x)], 1u);
            asm volatile("s_waitcnt vmcnt(0)" ::: "memory");
        } else {
            XB_SPIN(xb_ld(&bar[XB_XGEN(b.x)]) == gen, bar);
            __builtin_amdgcn_fence(__ATOMIC_ACQUIRE, "agent");
            asm volatile("s_waitcnt vmcnt(0)" ::: "memory");
        }
    }
    __syncthreads();
}

__global__ void __launch_bounds__(512, 2) mega(Params P) {
    extern __shared__ __attribute__((aligned(16))) unsigned char lds_raw[];
    LAS unsigned char* lds = (LAS unsigned char*)lds_raw;
    cg::grid_group grid = cg::this_grid();
    volatile LAS unsigned* MISC = (volatile LAS unsigned*)(lds + LDS_BYTES - 64);
    if (threadIdx.x < 16) MISC[threadIdx.x] = 0u;
    __syncthreads();
    (void)xcd_barrier_post((unsigned*)(P.ws + WS_CTL) + 1024, MISC);
#pragma unroll 1
    for (int ph = P.ph_lo; ph < P.ph_hi; ++ph) {
        GAS unsigned char* ws_g = (GAS unsigned char*)P.ws; GAS float* out_g = (GAS float*)P.out; asm volatile("" : "+s"(ws_g), "+s"(out_g));
        Ctx p; p.ws = (unsigned char*)ws_g; p.out = (float*)out_g;
        unsigned char* ws = p.ws;
        int prep_part = 0, prep_l = 0, prep_b = blockIdx.x, prep_G = gridDim.x;
        if (ph == 0) {
            { const int t0_ = opaque_tid(); if (t0_ < N_IN) { ((unsigned long long*)(ws + WS_TAB))[t0_] = (unsigned long long)P.in[t0_]; } }
            asm volatile("s_waitcnt vmcnt(0)" ::: "memory"); __syncthreads();
#ifndef NO_PREP
            prep_mod(p, lds); __syncthreads(); prep_part = 1;
#endif
        }
        else if (ph == NPH - 1) final_norm_phase(p);
        else {
#ifdef PROBE_S
            const int l = (ph - 1) / 13, sv_ = (ph - 1) % 13, s = sv_ <= PROBE_S ? sv_ : sv_ - 1;
#else
            const int l = (ph - 1) / 12, s = (ph - 1) % 12;
#endif
            const bool is_gemm = (s == 1 || s == 2 || s == 4 || s == 7 || s == 8 || s == 10 || s == 11);
            if (is_gemm) {
                pg8::Gemm g; pg8::Sched S; pg8::Epi E; bool perm;
                S.G = gridDim.x; S.c = blockIdx.x; S.mode = 0; S.nM = M_TOT / 256; S.wgm = (s == 2 || s == 8 || s == 11) ? RESID_WGM : (s == 4 ? 8 : pg8::WGM);
                E.o16 = nullptr; E.o16b = nullptr; E.of = nullptr; E.g = nullptr; E.gates = nullptr; E.scale = 1.f;
                bf16_t* ACT = (bf16_t*)(ws + WS_ACT); bf16_t* BIG = (bf16_t*)(ws + WS_BIG); float* X = (float*)(ws + WS_X);
                if (s == 1 || s == 10) { g.A = ACT; g.Bt = (const bf16_t*)(ws + wbase(l) + (s == 1 ? W_F1UP : W_F2UP)); g.K = DM; S.nN = 22; E.kind = pg8::EK_SWIGLU; E.o16 = BIG; perm = true; }
                else if (s == 2 || s == 11) { g.A = BIG; g.Bt = (const bf16_t*)(ws + wbase(l) + (s == 2 ? W_F1DN : W_F2DN)); g.K = DFF; S.nN = 4; E.kind = pg8::EK_RESID; E.of = X;
                    E.g = mod_ptr(ws, 0, l, s == 2 ? 2 : 8); E.scale = 0.5f; perm = false; }
                else if (s == 4) { g.A = ACT; g.Bt = (const bf16_t*)(ws + wbase(l) + W_IN); g.K = DM; S.nN = 27; E.kind = pg8::EK_PROJ; E.o16 = (bf16_t*)(ws + WS_PROJ); E.o16b = BIG; perm = true; }
                else if (s == 7) { g.A = (const bf16_t*)(ws + WS_BR); g.Bt = (const bf16_t*)(ws + wbase(l) + W_BR); g.K = 256; S.mode = 1; S.nN = 8; E.kind = pg8::EK_BRANCH;
                    E.o16 = ACT; E.gates = BIG; perm = false; }
                else { g.A = ACT; g.Bt = (const bf16_t*)(ws + wbase(l) + W_OUT); g.K = DM; S.nN = 4; E.kind = pg8::EK_RESID; E.of = X; E.g = mod_ptr(ws, 0, l, 5); E.scale = 1.f; perm = false; }
                S.nwg = S.nM * S.nN;
                #ifndef NO_GEMM
                if (s == 7) pg8::gemm_phase<true>(lds, g, S, E, perm); else pg8::gemm_phase<false>(lds, g, S, E, perm);
                if (blockIdx.x >= 64) {
                    if (s == 2) { prep_part = 2; prep_l = l; } else if (s == 8) { prep_part = 4; prep_l = l; } else if (s == 11 && l < 3) { prep_part = 1; prep_l = l + 1; }
                    prep_b = blockIdx.x - 64; prep_G = gridDim.x - 64;
                }
#endif
            } else if (s == 0 || s == 3 || s == 9) {
                norm_phase(p, l, s == 0 ? 0 : (s == 3 ? 1 : 2));

            } else if (s == 5) {
#ifndef NO_MIXPREP
                mixprep_phase(p, lds, l);
#endif
            } else {
#ifndef NO_MIX
                mix_phase(p, lds, l);
#ifdef PROBE_MIX2
                __syncthreads(); mix_phase(p, lds, l);
#endif
#endif
            }
        }
#ifndef NO_PREP
        if (prep_part) prep_layer(p, lds, prep_l, prep_b, prep_G, prep_part);
#endif
        if (ph + 1 < P.ph_hi) { if (P.ph_hi > 100000) grid.sync();   { XcdBarrier bar; bar.bar = (unsigned*)(p.ws + WS_CTL) + 1024; bar.x = xb_xcc_id(); bar.st = (volatile LAS unsigned*)(lds + LDS_BYTES - 64); xcd_barrier(bar); } }
    }
}

extern "C" void kernel_launch(void* const* d_in, const int* in_sizes, int n_in, void* d_out, int out_size, void* d_ws, size_t ws_size, hipStream_t stream) {
    static int grid = 0;
    if (grid == 0) {
        if (n_in != N_IN || ws_size < WS_END) { fprintf(stderr, "kernel_launch: unexpected n_in %d / ws_size %zu (need %zu)\n", n_in, ws_size, (size_t)WS_END); grid = -1; return; }
        int dev = 0, cus = 0, per_cu = 0;
        hipGetDevice(&dev); hipDeviceGetAttribute(&cus, hipDeviceAttributeMultiprocessorCount, dev);
        if (hipFuncSetAttribute((const void*)mega, hipFuncAttributeMaxDynamicSharedMemorySize, LDS_BYTES) != hipSuccess) { fprintf(stderr, "kernel_launch: hipFuncSetAttribute failed\n"); grid = -1; return; }
        if (hipOccupancyMaxActiveBlocksPerMultiprocessor(&per_cu, (const void*)mega, 512, LDS_BYTES) != hipSuccess || per_cu < 1) per_cu = 1;
        (void)hipGetLastError();
        grid = cus * 1;
        fprintf(stderr, "kernel_launch: grid %d (per_cu %d), ws %zu\n", grid, per_cu, ws_size);
    }
    if (grid < 0) return;
    hipMemsetAsync(d_ws, 0, WS_ZERO_BYTES, stream);
    Params p{};
    for (int i = 0; i < N_IN; ++i) p.in[i] = (const float*)d_in[i];
    p.out = (float*)d_out; p.ws = (unsigned char*)d_ws; p.ph_lo = 0; p.ph_hi = NPH;
    void* args[] = {&p};
    hipError_t e = hipLaunchCooperativeKernel((const void*)mega, dim3(grid), dim3(512), args, LDS_BYTES, stream);
    if (e != hipSuccess) fprintf(stderr, "cooperative launch failed: %s (grid %d)\n", hipGetErrorString(e), grid);
}
```

```cpp
#ifndef RESID_WGM
#define RESID_WGM 1
#endif
#include <hip/hip_runtime.h>
#include <hip/hip_cooperative_groups.h>
#include <cstdio>
#include <cstdint>
namespace cg = cooperative_groups;

#define LAS __attribute__((address_space(3)))
#define GAS __attribute__((address_space(1)))
typedef unsigned short bf16_t;
typedef short bf16x8 __attribute__((ext_vector_type(8)));
typedef float f32x4 __attribute__((ext_vector_type(4)));
typedef float f32x2 __attribute__((ext_vector_type(2)));
typedef unsigned u32x4 __attribute__((ext_vector_type(4)));
typedef unsigned u32x2 __attribute__((ext_vector_type(2)));

constexpr int DM = 1024, DFF = 2816, INW = 6912, PROJW = 2816, GATEW = 4096;
constexpr int M_CTX = 4096, M_DEC = 16384, M_TOT = 20480;
constexpr int NLAYER = 4;
constexpr float EPSF = 1e-6f;
constexpr float LOG2E = 1.4426950408889634f;
constexpr size_t O_Y = 0, O_NAK = 20971520, O_NAV = 25165824, O_SWK = 29360128, O_SWV = 31457280, O_DFK = 33554432, O_DFV = 37748736;
enum { I_XP = 0, I_XS, I_CNAK, I_CNAV, I_CSWK, I_CSWV, I_CDFK, I_CDFV, I_C, I_CCTX, I_WADA, I_BADA, I_NF1, I_NMIX, I_NF2, I_FNORM,
       I_F1W1, I_F1W3, I_F1W2, I_F2W1, I_F2W3, I_F2W2, I_WIN, I_WBR, I_WOUT, I_RPB, I_SINK, I_HSW, I_HSB, I_HW1, I_HB1, I_HW2, I_HB2, I_HW3,
       I_HSF, I_HLD, I_HSKIP, I_DLAM, I_DSUB, N_IN };

constexpr size_t MiB = 1u << 20;
constexpr size_t WS_CTL = 0;
constexpr size_t WS_MOD = 1 * MiB;
constexpr size_t WS_ZERO_BYTES = 65536;
constexpr size_t WS_LAM = 3 * MiB;
constexpr size_t WS_W = 4 * MiB;
constexpr size_t W_F1UP = 0, W_F1DN = W_F1UP + (size_t)5632 * 1024 * 2, W_F2UP = W_F1DN + (size_t)1024 * 2816 * 2, W_F2DN = W_F2UP + (size_t)5632 * 1024 * 2,
                 W_IN = W_F2DN + (size_t)1024 * 2816 * 2, W_BR = W_IN + (size_t)6912 * 1024 * 2, W_OUT = W_BR + (size_t)4 * 1024 * 256 * 2, W_END = W_OUT + (size_t)1024 * 1024 * 2;
static_assert(W_END <= 52 * MiB, "weights");
constexpr size_t WS_X = 56 * MiB;
constexpr size_t WS_ACT = 136 * MiB;
constexpr size_t WS_BR = 176 * MiB;
constexpr size_t WS_BIG = 216 * MiB;
constexpr size_t WS_PROJ = 376 * MiB;
constexpr size_t WS_TR = 486 * MiB;
constexpr size_t WS_CK = 541 * MiB;
constexpr size_t WS_HFIL = 551 * MiB;
constexpr size_t WS_W2 = 560 * MiB;
constexpr size_t WS_END = 612 * MiB;
constexpr int TRW = 1408;
constexpr size_t CK_NA = 0, CK_SW = 1048576, CK_DF = 1572864, CK_HALF = 2621440;
constexpr int LDS_BYTES = 147456;

#ifdef PROBE_S
constexpr int NPH = 54;
#else
constexpr int NPH = 50;
#endif
struct Params { const float* in[N_IN]; float* out; unsigned char* ws; int ph_lo, ph_hi; };
struct Ctx { float* out; unsigned char* ws; };
__device__ __forceinline__ size_t wbase(int l) { return (l & 1) ? WS_W2 : WS_W; }
constexpr size_t WS_TAB = 3 * MiB + 65536;
__device__ __forceinline__ const float* inp(const unsigned char* ws, int i) {
    const unsigned long long v = __hip_atomic_load((const unsigned long long*)(ws + WS_TAB) + i, __ATOMIC_RELAXED, __HIP_MEMORY_SCOPE_AGENT);
    const unsigned lo = __builtin_amdgcn_readfirstlane((unsigned)v), hi = __builtin_amdgcn_readfirstlane((unsigned)(v >> 32));
    return (const float*)(const GAS float*)(((unsigned long long)hi << 32) | lo);
}


__device__ __forceinline__ unsigned cvt_pk_bf16(float lo, float hi) { unsigned r; asm volatile("v_cvt_pk_bf16_f32 %0, %1, %2" : "=v"(r) : "v"(lo), "v"(hi)); return r; }
__device__ __forceinline__ float bf2f(unsigned short v) { return __uint_as_float(((unsigned)v) << 16); }
__device__ __forceinline__ float bflo(unsigned v) { return __uint_as_float(v << 16); }
__device__ __forceinline__ float bfhi(unsigned v) { return __uint_as_float(v & 0xffff0000u); }
__device__ __forceinline__ bf16_t f2bf1(float f) { return (bf16_t)(cvt_pk_bf16(f, 0.f) & 0xffffu); }
__device__ __forceinline__ float fast_exp2(float x) { return __builtin_amdgcn_exp2f(x); }
__device__ __forceinline__ float fast_rcp(float x) { return __builtin_amdgcn_rcpf(x); }
__device__ __forceinline__ float sigmoidf_(float x) { return fast_rcp(1.f + fast_exp2(-x * LOG2E)); }
__device__ __forceinline__ float wave_sum(float v) {
#pragma unroll
    for (int o = 1; o < 64; o <<= 1) v += __shfl_xor(v, o);
    return v;
}
__device__ __forceinline__ int cond_of_row(int row) { return row < M_CTX ? 0 : 1 + ((row - M_CTX) >> 11); }
__device__ __forceinline__ const float* mod_ptr(const unsigned char* ws, int cond, int l, int chunk) { return (const float*)(ws + WS_MOD) + ((size_t)(cond * 4 + l) * 9 + chunk) * 1024; }

__device__ __forceinline__ int opaque_tid() { int t; asm volatile("v_mov_b32 %0, %1" : "=v"(t) : "v"((int)threadIdx.x)); return t; }
namespace pg8 {
constexpr int BM = 256, BK = 64, HALF = 128, HTB = HALF * BK * 2, STAGE_BYTES = 8 * HTB, NXCD = 8, WGM = 4;
__device__ __forceinline__ int lds_byte(int r, int c) { const int st = (r >> 4) * 2 + (c >> 5), rr = r & 15, cc = c & 31, ob = rr * 64 + cc * 2; return st * 1024 + (ob ^ (((ob >> 9) & 1) << 5)); }
__device__ __forceinline__ void stage_rc(int b, int& R, int& C) { const int st = b / 1024, sb = b % 1024, swz = sb ^ (((sb >> 9) & 1) << 5); R = (st >> 1) * 16 + swz / 64; C = (st & 1) * 32 + (swz % 64) / 2; }
__device__ __forceinline__ int perm32(int rho) { const int n = rho >> 4, i = rho & 15; return 8 * (i >> 2) + 4 * n + (i & 3); }
struct Unit { int pm, pn; };
struct Sched { int mode, nM, nN, nwg, G, c, wgm; };
__device__ __forceinline__ bool sched_next(const Sched& S, int i, Unit& u) {
    const int j = (S.mode == 1) ? (i >> 2) : i;
    const long L = (long)j * S.G + S.c; if (L >= S.nwg) return false;
    int wgid = (int)L; { const int q = S.nwg / NXCD, r = S.nwg % NXCD, xcd = wgid % NXCD, off = wgid / NXCD; wgid = (xcd < r ? xcd * (q + 1) : r * (q + 1) + (xcd - r) * q) + off; }
    const int nig = S.wgm * S.nN, gid = wgid / nig, fm = gid * S.wgm, gsz = (S.nM - fm) < S.wgm ? (S.nM - fm) : S.wgm;
    const int pm = fm + ((wgid % nig) % gsz), pn = (wgid % nig) / gsz;
    if (S.mode == 1) { const int b = i & 3; u.pm = b * S.nM + pm; u.pn = b * S.nN + pn; } else { u.pm = pm; u.pn = pn; }
    return true;
}
enum { EK_SWIGLU = 0, EK_RESID = 1, EK_PROJ = 2, EK_BRANCH = 3 };
struct Epi { int kind; bf16_t* o16; bf16_t* o16b; float* of; const float* g; const bf16_t* gates; float scale; };
struct Gemm { const bf16_t* A; const bf16_t* Bt; int K; };

template <bool BR>
__device__ __forceinline__ void epilogue(const Epi& E, f32x4 (&acc)[2][2][4][2], const Unit& u, int wr, int wc, int fr, int fq) {
    if (BR) {
        const int bi = u.pm / 80, pm = u.pm - bi * 80, pn = u.pn & 7;
        const int row0 = pm * BM + wr * 64 + fr, col0 = pn * HALF + wc * 32 + 4 * fq;
        u32x2 gw[2][2][4];
#pragma unroll
        for (int n = 0; n < 2; ++n)
#pragma unroll
            for (int ai = 0; ai < 2; ++ai)
#pragma unroll
                for (int m = 0; m < 4; ++m) gw[n][ai][m] = *(const u32x2*)(E.gates + (size_t)(row0 + ai * HALF + m * 16) * GATEW + bi * 1024 + col0 + n * 16);
#pragma unroll
        for (int n = 0; n < 2; ++n)
#pragma unroll
            for (int ai = 0; ai < 2; ++ai)
#pragma unroll
                for (int m = 0; m < 4; ++m) {
                    const u32x2 g2 = gw[n][ai][m];
                    f32x4 gt; gt[0] = bflo(g2.x); gt[1] = bfhi(g2.x); gt[2] = bflo(g2.y); gt[3] = bfhi(g2.y);
                    f32x4 v = gt * acc[ai][0][m][n];
                    if (bi > 0) v = v + acc[ai][1][m][n];
                    acc[ai][1][m][n] = v;
                    if (bi == 3) { u32x2 w; w.x = cvt_pk_bf16(v[0], v[1]); w.y = cvt_pk_bf16(v[2], v[3]); *(u32x2*)(E.o16 + (size_t)(row0 + ai * HALF + m * 16) * DM + col0 + n * 16) = w; }
                }
    } else if (E.kind == EK_SWIGLU) {
        const int row0 = u.pm * BM + wr * 64 + fr, col0 = u.pn * 128 + wc * 32 + 8 * fq;
#pragma unroll
        for (int ai = 0; ai < 2; ++ai)
#pragma unroll
            for (int m = 0; m < 4; ++m) {
                const f32x4 a0 = acc[ai][0][m][0], a1 = acc[ai][0][m][1], b0 = acc[ai][1][m][0], b1 = acc[ai][1][m][1];
                float r[8];
#pragma unroll
                for (int e = 0; e < 4; ++e) { r[e] = a0[e] * sigmoidf_(a0[e]) * b0[e]; r[4 + e] = a1[e] * sigmoidf_(a1[e]) * b1[e]; }
                u32x4 w; w.x = cvt_pk_bf16(r[0], r[1]); w.y = cvt_pk_bf16(r[2], r[3]); w.z = cvt_pk_bf16(r[4], r[5]); w.w = cvt_pk_bf16(r[6], r[7]);
                *(u32x4*)(E.o16 + (size_t)(row0 + ai * HALF + m * 16) * DFF + col0) = w;
            }
    } else if (E.kind == EK_PROJ) {
        const int row0 = u.pm * BM + wr * 64 + fr;
        const bool isgate = u.pn >= 11;
        bf16_t* base = isgate ? E.o16b : E.o16; const int ld = isgate ? GATEW : PROJW;
        const int col0 = (isgate ? (u.pn - 11) * BM : u.pn * BM) + wc * 32 + 8 * fq;
#pragma unroll
        for (int ai = 0; ai < 2; ++ai)
#pragma unroll
            for (int m = 0; m < 4; ++m)
#pragma unroll
                for (int bj = 0; bj < 2; ++bj) {
                    f32x4 v0 = acc[ai][bj][m][0], v1 = acc[ai][bj][m][1];
                    if (isgate) {
#pragma unroll
                        for (int e = 0; e < 4; ++e) { v0[e] = sigmoidf_(v0[e]); v1[e] = sigmoidf_(v1[e]); }
                    }
                    u32x4 w; w.x = cvt_pk_bf16(v0[0], v0[1]); w.y = cvt_pk_bf16(v0[2], v0[3]); w.z = cvt_pk_bf16(v1[0], v1[1]); w.w = cvt_pk_bf16(v1[2], v1[3]);
                    *(u32x4*)(base + (size_t)(row0 + ai * HALF + m * 16) * ld + col0 + bj * HALF) = w;
                }
    } else if (E.kind == EK_RESID) {
        const int cond = (u.pm < 16) ? 0 : 1 + ((u.pm - 16) >> 3);
        const float* gv = E.g + (size_t)cond * (4 * 9 * 1024);
        const int row0 = u.pm * BM + wr * 64 + fr, col0 = u.pn * BM + wc * 32 + 4 * fq;
        f32x4 g4[2][2];
#pragma unroll
        for (int bj = 0; bj < 2; ++bj)
#pragma unroll
            for (int n = 0; n < 2; ++n) g4[bj][n] = *(const f32x4*)(gv + col0 + bj * HALF + n * 16) * E.scale;
#pragma unroll
        for (int bj = 0; bj < 2; ++bj)
#pragma unroll
            for (int n = 0; n < 2; ++n) {
                const int col = col0 + bj * HALF + n * 16;
                f32x4 xv[2][4];
#pragma unroll
                for (int ai = 0; ai < 2; ++ai)
#pragma unroll
                    for (int m = 0; m < 4; ++m) xv[ai][m] = *(const f32x4*)(E.of + (size_t)(row0 + ai * HALF + m * 16) * DM + col);
#pragma unroll
                for (int ai = 0; ai < 2; ++ai)
#pragma unroll
                    for (int m = 0; m < 4; ++m) *(f32x4*)(E.of + (size_t)(row0 + ai * HALF + m * 16) * DM + col) = xv[ai][m] + g4[bj][n] * acc[ai][bj][m][n];
            }
    }
}

template <bool BR>
__device__ __forceinline__ void gemm_phase(LAS unsigned char* lds, const Gemm g, const Sched& S, const Epi& E, const bool perm) {
    const int tid = opaque_tid(), wid = __builtin_amdgcn_readfirstlane(tid >> 6), lane = tid & 63, wr = wid >> 2, wc = wid & 3, fr = lane & 15, fq = lane >> 4;
    const int K = g.K, nt = K / BK;
    const bool align = !(E.kind == EK_RESID);
    unsigned voffA[2], voffB[2];
#pragma unroll
    for (int i = 0; i < 2; ++i) { int R, C; stage_rc(tid * 16 + i * 8192, R, C); const int Rb = perm ? ((R & ~31) + perm32(R & 31)) : R;
        voffA[i] = (unsigned)(R * K + C) * 2u; voffB[i] = (unsigned)(Rb * K + C) * 2u; }
    const size_t kstep = (size_t)(BK * 2);
    const size_t hstep = (size_t)HALF * K * 2;
    const size_t tstep = 2 * hstep;
    const size_t bstep = BR ? hstep : tstep;
    const unsigned ldsw = (unsigned)wid * 1024u;
    const int aoff = lds_byte(wr * 64 + fr, fq * 8), boff = lds_byte(wc * 32 + fr, fq * 8);
#define PG8_SA(b, h) (((b) * 2 + (h)) * HTB)
#define PG8_SB(b, h) ((4 + (b) * 2 + (h)) * HTB)
#define PG8_STAGE(bufoff, gbase, voff) do { _Pragma("unroll") for (int _i = 0; _i < 2; ++_i) \
        __builtin_amdgcn_global_load_lds((const unsigned*)((const char*)(gbase) + (voff)[_i]), (LAS unsigned*)(lds + (bufoff) + ldsw + _i * 8192), 16, 0, 0); } while (0)
#define PG8_LDA(dst, b, h) do { _Pragma("unroll") for (int m = 0; m < 4; ++m) _Pragma("unroll") for (int k = 0; k < 2; ++k) dst[m][k] = *(const LAS bf16x8*)(lds + PG8_SA(b, h) + aoff + m * 2048 + k * 1024); } while (0)
#define PG8_LDB(dst, b, h) do { _Pragma("unroll") for (int n = 0; n < 2; ++n) _Pragma("unroll") for (int k = 0; k < 2; ++k) dst[n][k] = *(const LAS bf16x8*)(lds + PG8_SB(b, h) + boff + n * 2048 + k * 1024); } while (0)
#define PG8_MMA(ai, bj, At, Bt) do { __builtin_amdgcn_s_setprio(1); _Pragma("unroll") for (int m = 0; m < 4; ++m) _Pragma("unroll") for (int n = 0; n < 2; ++n) _Pragma("unroll") for (int k = 0; k < 2; ++k) \
        acc[ai][bj][m][n] = __builtin_amdgcn_mfma_f32_16x16x32_bf16(Bt[n][k], At[m][k], acc[ai][bj][m][n], 0, 0, 0); __builtin_amdgcn_s_setprio(0); } while (0)
#define PG8_WAIT_V(n) asm volatile("s_waitcnt vmcnt(" #n ")" ::: "memory")
#define PG8_WAIT_L(n) asm volatile("s_waitcnt lgkmcnt(" #n ")" ::: "memory")
#define PG8_BAR __builtin_amdgcn_s_barrier()
#define PG8_SCHED __builtin_amdgcn_sched_barrier(0)
    Unit cur, nxt; int ui = 0;
    if (!sched_next(S, 0, cur)) return;
    f32x4 acc[2][2][4][2];
#pragma unroll
    for (int a = 0; a < 2; ++a)
#pragma unroll
        for (int b = 0; b < 2; ++b)
#pragma unroll
            for (int m = 0; m < 4; ++m)
#pragma unroll
                for (int n = 0; n < 2; ++n) acc[a][b][m][n] = (f32x4){0.f, 0.f, 0.f, 0.f};
    bf16x8 At[4][2], B0[2][2], B1[2][2];
    const char* cA = (const char*)g.A + (size_t)cur.pm * tstep; const char* cB = (const char*)g.Bt + (size_t)cur.pn * bstep;
    PG8_STAGE(PG8_SB(0, 0), cB, voffB); PG8_STAGE(PG8_SB(0, 1), cB + hstep, voffB); PG8_STAGE(PG8_SA(0, 0), cA, voffA); PG8_STAGE(PG8_SA(0, 1), cA + hstep, voffA);
    if (wr == 1) PG8_BAR;
    PG8_WAIT_V(2); PG8_BAR;
    PG8_STAGE(PG8_SB(1, 0), cB + kstep, voffB); PG8_STAGE(PG8_SA(1, 0), cA + kstep, voffA); PG8_STAGE(PG8_SB(1, 1), cB + hstep + kstep, voffB);
    PG8_WAIT_V(6); PG8_BAR;
    for (;;) {
        const bool has_next = sched_next(S, ui + 1, nxt);
        const char* nA = has_next ? (const char*)g.A + (size_t)nxt.pm * tstep : cA; const char* nB = has_next ? (const char*)g.Bt + (size_t)nxt.pn * bstep : cB;
        for (int t = 0; t < nt; t += 2) {
            const bool last = (t == nt - 2);
            const char* a1 = cA + (size_t)(t + 1) * kstep;
            const char* a2 = last ? nA : cA + (size_t)(t + 2) * kstep; const char* b2 = last ? nB : cB + (size_t)(t + 2) * kstep;
            const char* a3 = a2 + kstep; const char* b3 = b2 + kstep;
            PG8_LDB(B0, 0, 0); PG8_LDB(B1, 0, 1); PG8_SCHED; PG8_LDA(At, 0, 0); PG8_STAGE(PG8_SA(1, 1), a1 + hstep, voffA);
            PG8_WAIT_V(8); PG8_WAIT_L(0); PG8_BAR; PG8_MMA(0, 0, At, B0); if (!BR) { PG8_MMA(0, 1, At, B1); } PG8_BAR; PG8_SCHED;
            PG8_LDA(At, 0, 1); PG8_STAGE(PG8_SB(0, 0), b2, voffB); PG8_STAGE(PG8_SB(0, 1), b2 + hstep, voffB); PG8_STAGE(PG8_SA(0, 0), a2, voffA);
            PG8_WAIT_V(8); PG8_WAIT_L(0); PG8_BAR; PG8_MMA(1, 0, At, B0); if (!BR) { PG8_MMA(1, 1, At, B1); } PG8_BAR; PG8_SCHED;
            PG8_LDB(B0, 1, 0); PG8_LDB(B1, 1, 1); PG8_SCHED; PG8_LDA(At, 1, 0); PG8_STAGE(PG8_SA(0, 1), a2 + hstep, voffA);
            PG8_WAIT_V(8); PG8_WAIT_L(0); PG8_BAR; PG8_MMA(0, 0, At, B0); if (!BR) { PG8_MMA(0, 1, At, B1); } PG8_BAR; PG8_SCHED;
            PG8_LDA(At, 1, 1); PG8_STAGE(PG8_SB(1, 0), b3, voffB); PG8_STAGE(PG8_SB(1, 1), b3 + hstep, voffB); PG8_STAGE(PG8_SA(1, 0), a3, voffA);
            PG8_WAIT_V(8); PG8_WAIT_L(0); PG8_BAR; PG8_MMA(1, 0, At, B0); if (!BR) { PG8_MMA(1, 1, At, B1); } PG8_BAR; PG8_SCHED;
        }
        if (align && wr == 0) PG8_BAR;
        epilogue<BR>(E, acc, cur, wr, wc, fr, fq);
        if (!has_next) break;
#pragma unroll
        for (int a = 0; a < 2; ++a)
#pragma unroll
            for (int b = 0; b < (BR ? 1 : 2); ++b)
#pragma unroll
                for (int m = 0; m < 4; ++m)
#pragma unroll
                    for (int n = 0; n < 2; ++n) acc[a][b][m][n] = (f32x4){0.f, 0.f, 0.f, 0.f};
        cur = nxt; cA = nA; cB = nB; ++ui;
        if (align && wr == 1) PG8_BAR;
    }
    PG8_WAIT_V(0);
    if (!align && wr == 0) PG8_BAR;
    PG8_BAR;
#undef PG8_SA
#undef PG8_SB
#undef PG8_STAGE
#undef PG8_LDA
#undef PG8_LDB
#undef PG8_MMA
#undef PG8_WAIT_V
#undef PG8_WAIT_L
#undef PG8_BAR
#undef PG8_SCHED
}
}


__device__ __forceinline__ void transpose_item(const float* W, int K, int N, bf16_t* WT, int dst_row0, LAS float* scr, int k0, int n0, int lane) {
    f32x4 v[16];
    const int rr = lane >> 4, cc = (lane & 15) * 4;
#pragma unroll
    for (int i = 0; i < 16; ++i) v[i] = *(const f32x4*)(W + (size_t)(k0 + 4 * i + rr) * N + n0 + cc);
#pragma unroll
    for (int i = 0; i < 16; ++i) { LAS float* d = scr + (4 * i + rr) * 65 + cc; d[0] = v[i][0]; d[1] = v[i][1]; d[2] = v[i][2]; d[3] = v[i][3]; }
    asm volatile("s_waitcnt lgkmcnt(0)" ::: "memory");
    const int c = lane & 7, r = lane >> 3;
#pragma unroll
    for (int j = 0; j < 8; ++j) { const int n = 8 * j + r; const LAS float* q = scr + (8 * c) * 65 + n;
        u32x4 o; o.x = cvt_pk_bf16(q[0], q[65]); o.y = cvt_pk_bf16(q[2 * 65], q[3 * 65]); o.z = cvt_pk_bf16(q[4 * 65], q[5 * 65]); o.w = cvt_pk_bf16(q[6 * 65], q[7 * 65]);
        *(u32x4*)(WT + (size_t)(dst_row0 + n) * K + k0 + 8 * c) = o; }
    asm volatile("s_waitcnt lgkmcnt(0)" ::: "memory");
}

__device__ __forceinline__ void prep_layer(const Ctx& p, LAS unsigned char* lds, int l, int bidx, int G, int part) {
    const int tid = opaque_tid(), lane = tid & 63, wave = tid >> 6;
    const int gw = bidx * 8 + wave, NGW = G * 8;
    unsigned char* ws = p.ws; unsigned char* wsw = p.ws + wbase(l);
    LAS float* scr = (LAS float*)(lds + wave * 16896);
    {
        constexpr int I_UP = 16 * 44, I_DN = 44 * 16, I_IN = 16 * 108, I_BR = 4 * 16, I_OUT = 16 * 16;
        constexpr int NIT = 4 * I_UP + 2 * I_DN + I_IN + 4 * I_BR + I_OUT;
        for (int it = gw; it < NIT; it += NGW) {
            int r = it;
            { const int cls = (r < 4 * I_UP) ? ((r < 2 * I_UP) ? 1 : 4) : ((r < 4 * I_UP + 2 * I_DN) ? ((r < 4 * I_UP + I_DN) ? 1 : 4) : 2); if (!(part & cls)) continue; }
            if (r < 4 * I_UP) {
                const int which = r / I_UP; r -= which * I_UP; const int kb = r / 44, nb = r % 44, n0 = nb * 64;
                const float* W = inp(p.ws, (which >> 1) ? ((which & 1) ? I_F2W3 : I_F2W1) : ((which & 1) ? I_F1W3 : I_F1W1)) + (size_t)l * DM * DFF;
                bf16_t* WT = (bf16_t*)(wsw + ((which >> 1) ? W_F2UP : W_F1UP));
                const int drow = 256 * (n0 >> 7) + (which & 1) * 128 + (n0 & 127);
                transpose_item(W, DM, DFF, WT, drow, scr, kb * 64, n0, lane); continue;
            }
            r -= 4 * I_UP;
            if (r < 2 * I_DN) {
                const int which = r / I_DN; r -= which * I_DN; const int kb = r / 16, nb = r % 16;
                const float* W = inp(p.ws, which ? I_F2W2 : I_F1W2) + (size_t)l * DFF * DM;
                bf16_t* WT = (bf16_t*)(wsw + (which ? W_F2DN : W_F1DN));
                transpose_item(W, DFF, DM, WT, nb * 64, scr, kb * 64, nb * 64, lane); continue;
            }
            r -= 2 * I_DN;
            if (r < I_IN) { const int kb = r / 108, nb = r % 108;
                transpose_item(inp(p.ws, I_WIN) + (size_t)l * DM * INW, DM, INW, (bf16_t*)(wsw + W_IN), nb * 64, scr, kb * 64, nb * 64, lane); continue; }
            r -= I_IN;
            if (r < 4 * I_BR) { const int bi = r / I_BR; r -= bi * I_BR; const int kb = r / 16, nb = r % 16;
                transpose_item(inp(p.ws, I_WBR) + ((size_t)l * 4 + bi) * 256 * DM, 256, DM, (bf16_t*)(wsw + W_BR) + (size_t)bi * 1024 * 256, nb * 64, scr, kb * 64, nb * 64, lane); continue; }
            r -= 4 * I_BR;
            { const int kb = r / 16, nb = r % 16;
              transpose_item(inp(p.ws, I_WOUT) + (size_t)l * DM * DM, DM, DM, (bf16_t*)(wsw + W_OUT), nb * 64, scr, kb * 64, nb * 64, lane); }
        }
    }
    if (!(part & 2)) return;
    {
        bf16_t* CK = (bf16_t*)(ws + WS_CK);
        const int gt = bidx * 512 + tid, NT = G * 512;
        for (int it = gt; it < 327680; it += NT) {
            int e = it * 8; const float* src; bf16_t* dst; int per_b;
            if (e < 1048576) { src = inp(p.ws, I_CNAK); dst = CK + CK_NA; per_b = 131072; }
            else if (e < 1572864) { e -= 1048576; src = inp(p.ws, I_CSWK); dst = CK + CK_SW; per_b = 65536; }
            else { e -= 1572864; src = inp(p.ws, I_CDFK); dst = CK + CK_DF; per_b = 131072; }
            const int b = e / per_b, r = e - b * per_b;
            const float* s = src + ((size_t)(b * 4 + l)) * per_b + r;
            const f32x4 v0 = *(const f32x4*)s, v1 = *(const f32x4*)(s + 4);
            u32x4 o; o.x = cvt_pk_bf16(v0[0], v0[1]); o.y = cvt_pk_bf16(v0[2], v0[3]); o.z = cvt_pk_bf16(v1[0], v1[1]); o.w = cvt_pk_bf16(v1[2], v1[3]);
            *(u32x4*)(dst + e) = o;
        }
    }
    {
        bf16_t* CV = (bf16_t*)(ws + WS_CK) + CK_HALF;
        for (int it = gw; it < 640; it += NGW) {
            int r = it; const float* src; bf16_t* dst; int H;
            if (r < 256) { src = inp(p.ws, I_CNAV); dst = CV + CK_NA; H = 4; }
            else if (r < 384) { r -= 256; src = inp(p.ws, I_CSWV); dst = CV + CK_SW; H = 2; }
            else { r -= 384; src = inp(p.ws, I_CDFV); dst = CV + CK_DF; H = 4; }
            const int kb = r & 7, bh = r >> 3, b = bh / H, h = bh - b * H;
            transpose_item(src + ((size_t)(b * 4 + l) * H + h) * 512 * 64, 512, 64, dst + (size_t)bh * 64 * 512, 0, scr, kb * 64, 0, lane);
        }
    }
    __syncthreads();
    {
        LAS float* Z = (LAS float*)lds;
        LAS float* G1 = Z + 8 * 33;
        LAS float* G2 = G1 + 8 * 64;
        float* HF = (float*)(ws + WS_HFIL);
        const float* w1 = inp(p.ws, I_HW1) + (size_t)l * 33 * 64; const float* b1 = inp(p.ws, I_HB1) + l * 64;
        const float* w2 = inp(p.ws, I_HW2) + (size_t)l * 64 * 64; const float* b2 = inp(p.ws, I_HB2) + l * 64;
        const float* w3 = inp(p.ws, I_HW3) + (size_t)l * 64 * 1024; const float* sf = inp(p.ws, I_HSF) + l * 64; const float* ld = inp(p.ws, I_HLD) + l * 1024;
        for (int it = bidx; it < 288; it += G) {
            const int Lsel = it >= 32, L = Lsel ? 2048 : 256, n0 = (Lsel ? it - 32 : it) * 8;
            const float invL = 1.f / (float)L;
            if (tid < 8 * 33) { const int nn = tid / 33, i = tid - nn * 33; const float tn = (float)(n0 + nn) * invL; float v;
                if (i == 0) v = tn; else if (i <= 16) v = __cosf(6.283185307179586f * tn * (float)i); else v = __sinf(6.283185307179586f * tn * (float)(i - 16));
                Z[nn * 33 + i] = v; }
            __syncthreads();
            { const int nn = tid >> 6, j = tid & 63; float a = b1[j];
#pragma unroll 11
              for (int i = 0; i < 33; ++i) a += Z[nn * 33 + i] * w1[i * 64 + j];
              G1[nn * 64 + j] = __sinf(sf[j] * a); }
            __syncthreads();
            { const int nn = tid >> 6, j = tid & 63; float a = b2[j];
#pragma unroll 16
              for (int i = 0; i < 64; ++i) a += G1[nn * 64 + i] * w2[i * 64 + j];
              G2[nn * 64 + j] = __sinf(sf[j] * a); }
            __syncthreads();
#pragma unroll 1
            for (int cc = 0; cc < 2; ++cc) {
                const int col = cc * 512 + tid;
                float a[8];
#pragma unroll
                for (int nn = 0; nn < 8; ++nn) a[nn] = 0.f;
#pragma unroll 16
                for (int i = 0; i < 64; ++i) { const float w = w3[i * 1024 + col];
#pragma unroll
                    for (int nn = 0; nn < 8; ++nn) a[nn] += G2[nn * 64 + i] * w; }
                const float rate = __expf(ld[col]);
#pragma unroll
                for (int nn = 0; nn < 8; ++nn) a[nn] *= __expf(-rate * (float)(n0 + nn) * invL);
                float* o = HF + (Lsel ? 262144 : 0) + (size_t)col * L + n0;
                *(f32x4*)o = (f32x4){a[0], a[1], a[2], a[3]}; *(f32x4*)(o + 4) = (f32x4){a[4], a[5], a[6], a[7]};
            }
            __syncthreads();
        }
    }
    if (bidx == 0 && tid == 0) {
        const float* lv = inp(p.ws, I_DLAM) + l * 128; float s01 = 0.f, s23 = 0.f;
        for (int i = 0; i < 32; ++i) { s01 += lv[i] * lv[32 + i]; s23 += lv[64 + i] * lv[96 + i]; }
        float c08; asm volatile("v_mov_b32 %0, 0x3f4ccccd" : "=v"(c08));
        const float lam_init = c08 - 0.6f * __expf(-0.3f * (float)l);
        ((float*)(ws + WS_LAM))[l] = __expf(s01) - __expf(s23) + lam_init; ((float*)(ws + WS_LAM))[4 + l] = lam_init;
    }
}

__device__ __forceinline__ void prep_mod(const Ctx& p, LAS unsigned char* lds) {
    const int tid = opaque_tid(), lane = tid & 63, wave = tid >> 6;
    const int G = gridDim.x;
    LAS float* SC = (LAS float*)lds;
    LAS float* PART = (LAS float*)(lds + 40960);
    for (int i = tid; i < 9 * 1024; i += 512) { const float v = (i < 1024) ? inp(p.ws, I_CCTX)[i] : inp(p.ws, I_C)[i - 1024]; SC[i] = v * sigmoidf_(v); }
    __syncthreads();
    float* mod = (float*)(p.ws + WS_MOD);
    for (int it = blockIdx.x; it < 4 * 36; it += G) {
        const int cb = it % 36, l = it / 36;
        const int col = cb * 256 + lane * 4, k0 = wave * 128;
        const float* W = inp(p.ws, I_WADA) + ((size_t)l * DM + k0) * 9216 + col;
        f32x4 a[9];
#pragma unroll
        for (int c = 0; c < 9; ++c) a[c] = (f32x4){0.f, 0.f, 0.f, 0.f};
#pragma unroll 16
        for (int k = 0; k < 128; ++k) { const f32x4 w = *(const f32x4*)(W + (size_t)k * 9216);
#pragma unroll
            for (int c = 0; c < 9; ++c) a[c] += w * SC[c * 1024 + k0 + k]; }
#pragma unroll
        for (int c = 0; c < 9; ++c) *(LAS f32x4*)(PART + (wave * 9 + c) * 256 + lane * 4) = a[c];
        __syncthreads();
        for (int o = tid; o < 9 * 256; o += 512) { const int c = o >> 8, cc = o & 255;
            float v = inp(p.ws, I_BADA)[(size_t)l * 9216 + cb * 256 + cc];
#pragma unroll
            for (int w = 0; w < 8; ++w) v += PART[(w * 9 + c) * 256 + cc];
            mod[((size_t)(c * 4 + l)) * 9216 + cb * 256 + cc] = v; }
        __syncthreads();
    }
}

__device__ __forceinline__ void norm_phase(const Ctx& p, int l, int which  ) {
    const int tid_ = opaque_tid(), lane = tid_ & 63, wave = tid_ >> 6, gw = blockIdx.x * 8 + wave, NGW = gridDim.x * 8;
    float* X = (float*)(p.ws + WS_X); bf16_t* ACT = (bf16_t*)(p.ws + WS_ACT);
    const float* gsrc = inp(p.ws, which == 0 ? I_NF1 : (which == 1 ? I_NMIX : I_NF2)) + l * DM;
    const bool from_in = (l == 0 && which == 0);
    f32x4 gv[4];
#pragma unroll
    for (int j = 0; j < 4; ++j) gv[j] = *(const f32x4*)(gsrc + j * 256 + lane * 4);
    constexpr int NR = 4;
    for (int row0 = gw * NR; row0 < M_TOT; row0 += NGW * NR) {
        f32x4 v[NR][4]; float s[NR];
#pragma unroll
        for (int r = 0; r < NR; ++r) {
            const int row = row0 + r;
            const float* xr = from_in ? (row < M_CTX ? inp(p.ws, I_XP) + (size_t)row * DM : inp(p.ws, I_XS) + (size_t)(row - M_CTX) * DM) : X + (size_t)row * DM;
#pragma unroll
            for (int j = 0; j < 4; ++j) v[r][j] = *(const f32x4*)(xr + j * 256 + lane * 4);
        }
        const int cond = cond_of_row(row0);
        const float* sh = mod_ptr(p.ws, cond, l, which * 3 + 0); const float* sc = mod_ptr(p.ws, cond, l, which * 3 + 1);
        f32x4 s4[4], h4[4];
#pragma unroll
        for (int j = 0; j < 4; ++j) { s4[j] = *(const f32x4*)(sc + j * 256 + lane * 4) + 1.f; h4[j] = *(const f32x4*)(sh + j * 256 + lane * 4); }
#pragma unroll
        for (int r = 0; r < NR; ++r) { float a = 0.f;
#pragma unroll
            for (int j = 0; j < 4; ++j) a += (v[r][j][0] * v[r][j][0] + v[r][j][1] * v[r][j][1]) + (v[r][j][2] * v[r][j][2] + v[r][j][3] * v[r][j][3]);
            s[r] = a; }
        if (from_in) {
#pragma unroll
            for (int r = 0; r < NR; ++r)
#pragma unroll
                for (int j = 0; j < 4; ++j) *(f32x4*)(X + (size_t)(row0 + r) * DM + j * 256 + lane * 4) = v[r][j];
        }
#pragma unroll
        for (int o = 1; o < 64; o <<= 1) {
#pragma unroll
            for (int r = 0; r < NR; ++r) s[r] += __shfl_xor(s[r], o);
        }
#pragma unroll
        for (int r = 0; r < NR; ++r) {
            const float rstd = rsqrtf(s[r] * (1.f / DM) + EPSF);
#pragma unroll
            for (int j = 0; j < 4; ++j) {
                const f32x4 o = (v[r][j] * rstd) * gv[j] * s4[j] + h4[j];
                u32x2 w; w.x = cvt_pk_bf16(o[0], o[1]); w.y = cvt_pk_bf16(o[2], o[3]);
                *(u32x2*)(ACT + (size_t)(row0 + r) * DM + j * 256 + lane * 4) = w;
            }
        }
    }
}
__device__ __forceinline__ void final_norm_phase(const Ctx& p) {
    const int tid_ = opaque_tid(), lane = tid_ & 63, wave = tid_ >> 6, gw = blockIdx.x * 8 + wave, NGW = gridDim.x * 8;
    const float* X = (const float*)(p.ws + WS_X); const float* gsrc = inp(p.ws, I_FNORM);
    f32x4 gv[4];
#pragma unroll
    for (int j = 0; j < 4; ++j) gv[j] = *(const f32x4*)(gsrc + j * 256 + lane * 4);
    constexpr int NR = 4;
    for (int row0 = gw * NR; row0 < M_TOT; row0 += NGW * NR) {
        f32x4 v[NR][4]; float s[NR];
#pragma unroll
        for (int r = 0; r < NR; ++r) { const float* xr = X + (size_t)(row0 + r) * DM;
#pragma unroll
            for (int j = 0; j < 4; ++j) v[r][j] = *(const f32x4*)(xr + j * 256 + lane * 4); }
#pragma unroll
        for (int r = 0; r < NR; ++r) { float a = 0.f;
#pragma unroll
            for (int j = 0; j < 4; ++j) a += (v[r][j][0] * v[r][j][0] + v[r][j][1] * v[r][j][1]) + (v[r][j][2] * v[r][j][2] + v[r][j][3] * v[r][j][3]);
            s[r] = a; }
#pragma unroll
        for (int o = 1; o < 64; o <<= 1) {
#pragma unroll
            for (int r = 0; r < NR; ++r) s[r] += __shfl_xor(s[r], o);
        }
#pragma unroll
        for (int r = 0; r < NR; ++r) { const float rstd = rsqrtf(s[r] * (1.f / DM) + EPSF);
#pragma unroll
            for (int j = 0; j < 4; ++j) *(f32x4*)(p.out + O_Y + (size_t)(row0 + r) * DM + j * 256 + lane * 4) = (v[r][j] * rstd) * gv[j]; }
    }
}

__device__ __forceinline__ void mixprep_phase(const Ctx& p, LAS unsigned char* lds, int l) {
    const int tid = opaque_tid(), G = gridDim.x;
    bf16_t* PROJ = (bf16_t*)(p.ws + WS_PROJ); bf16_t* TR = (bf16_t*)(p.ws + WS_TR);
    {
        const int lane = tid & 63, wave = tid >> 6, gw = blockIdx.x * 8 + wave, NGW = G * 8;
        LAS float* T = (LAS float*)(lds + wave * 17168);
        const float* sw = inp(p.ws, I_HSW) + (size_t)l * 3 * 768; const float* sb = inp(p.ws, I_HSB) + (size_t)l * 768;
        const int lr = lane >> 3, lc = lane & 7;
        for (int it = gw; it < 320 * 22; it += NGW) {
            const int cb = it % 22, rb = it / 22, row0 = rb * 64, tcol0 = cb * 64;
            int src; bool hy = false;
            if (tcol0 < 256) src = 512 + tcol0; else if (tcol0 < 384) src = 1152 + (tcol0 - 256); else if (tcol0 < 640) src = 2560 + (tcol0 - 384); else { src = 1280 + (tcol0 - 640); hy = true; }
            const bool seq_start = row0 < M_CTX ? ((row0 & 255) == 0) : (((row0 - M_CTX) & 2047) == 0);
            const int rend = row0 + 64; const bool seq_end = rend <= M_CTX ? ((rend & 255) == 0) : (((rend - M_CTX) & 2047) == 0);
            const bf16_t* sp = PROJ + (size_t)row0 * PROJW + src + lc * 8;
            u32x4 w[8], wh = (u32x4){0u, 0u, 0u, 0u};
#pragma unroll
            for (int i = 0; i < 8; ++i) w[i] = *(const u32x4*)(sp + (size_t)(i * 8 + lr) * PROJW);
            if (hy && lane < 16) { const bool top = lane < 8; const bool ok = top ? !seq_start : !seq_end;
                if (ok) wh = *(const u32x4*)(sp + (top ? -(ptrdiff_t)PROJW : (ptrdiff_t)64 * PROJW)); }
#pragma unroll
            for (int i = 0; i < 8; ++i) { LAS float* d = T + (1 + i * 8 + lr) * 65 + lc * 8;
                d[0] = bflo(w[i].x); d[1] = bfhi(w[i].x); d[2] = bflo(w[i].y); d[3] = bfhi(w[i].y); d[4] = bflo(w[i].z); d[5] = bfhi(w[i].z); d[6] = bflo(w[i].w); d[7] = bfhi(w[i].w); }
            if (hy && lane < 16) { LAS float* d = T + (lane < 8 ? 0 : 65) * 65 + lc * 8;
                d[0] = bflo(wh.x); d[1] = bfhi(wh.x); d[2] = bflo(wh.y); d[3] = bfhi(wh.y); d[4] = bflo(wh.z); d[5] = bfhi(wh.z); d[6] = bflo(wh.w); d[7] = bfhi(wh.w); }
            asm volatile("s_waitcnt lgkmcnt(0)" ::: "memory");
            const int rg = lane & 7, csub = lane >> 3;
#pragma unroll 2
            for (int j = 0; j < 8; ++j) {
                const int col = j * 8 + csub; float o[8];
                const LAS float* tp = T + (rg * 8) * 65 + col;
                if (hy) { const int ch = tcol0 - 640 + col; const float w0 = sw[ch], w1 = sw[768 + ch], w2 = sw[1536 + ch], bb = sb[ch];
                    float x[10];
#pragma unroll
                    for (int k = 0; k < 10; ++k) x[k] = tp[k * 65];
#pragma unroll
                    for (int k = 0; k < 8; ++k) o[k] = x[k] * w0 + x[k + 1] * w1 + x[k + 2] * w2 + bb;
                } else {
#pragma unroll
                    for (int k = 0; k < 8; ++k) o[k] = tp[(k + 1) * 65];
                }
                u32x4 ww; ww.x = cvt_pk_bf16(o[0], o[1]); ww.y = cvt_pk_bf16(o[2], o[3]); ww.z = cvt_pk_bf16(o[4], o[5]); ww.w = cvt_pk_bf16(o[6], o[7]);
                *(u32x4*)(TR + (size_t)(tcol0 + col) * M_TOT + row0 + rg * 8) = ww;
            }
            asm volatile("s_waitcnt lgkmcnt(0)" ::: "memory");
        }
    }
    const int gt = blockIdx.x * 512 + tid, NT = G * 512;
    for (int it = gt; it < M_CTX * 160; it += NT) {
        const int row = it / 160, ch = it - row * 160; int pc, H; size_t ob; int c8;
        if (ch < 32) { pc = 256; H = 4; ob = O_NAK; c8 = ch * 8; }
        else if (ch < 64) { pc = 512; H = 4; ob = O_NAV; c8 = (ch - 32) * 8; }
        else if (ch < 80) { pc = 1024; H = 2; ob = O_SWK; c8 = (ch - 64) * 8; }
        else if (ch < 96) { pc = 1152; H = 2; ob = O_SWV; c8 = (ch - 80) * 8; }
        else if (ch < 128) { pc = 2304; H = 4; ob = O_DFK; c8 = (ch - 96) * 8; }
        else { pc = 2560; H = 4; ob = O_DFV; c8 = (ch - 128) * 8; }
        const u32x4 w = *(const u32x4*)(PROJ + (size_t)row * PROJW + pc + c8);
        const int b = row >> 8, t = row & 255, h = c8 >> 6, d = c8 & 63;
        float* o = p.out + ob + ((((size_t)(b * 4 + l) * H + h) * 256 + t) * 64 + d);
        *(f32x4*)o = (f32x4){bflo(w.x), bfhi(w.x), bflo(w.y), bfhi(w.y)}; *(f32x4*)(o + 4) = (f32x4){bflo(w.z), bfhi(w.z), bflo(w.w), bfhi(w.w)};
    }
    for (int it = gt; it < M_DEC * 56; it += NT) {
        const int rowd = it / 56, q = it - rowd * 56, t = rowd & 2047, gr = t >> 6, gc = t & 63;
        int a, bofs, i0; float pos, fstep;
        if (q < 24) {
            const int base = q < 16 ? 768 : 1024, qq = q < 16 ? q : q - 16, h = qq >> 2, half = (qq >> 1) & 1, grp = qq & 1;
            a = base + h * 64 + half * 32 + grp * 8; bofs = 16; i0 = grp * 8; pos = half ? (float)gc : (float)gr; fstep = 13.287712379549449f / 16.f;
        } else {
            const int base = q < 40 ? 2048 : 2304, qq = q < 40 ? q - 24 : q - 40, mp32 = qq >> 1, half = qq & 1;
            a = base + mp32 * 32 + half * 16; bofs = 8; i0 = 0; pos = half ? (float)gc : (float)gr; fstep = 13.287712379549449f / 8.f;
        }
        bf16_t* pa = PROJ + (size_t)(M_CTX + rowd) * PROJW + a;
        const u32x4 wa = *(const u32x4*)pa, wb = *(const u32x4*)(pa + bofs);
        float xa[8], xb[8];
        xa[0] = bflo(wa.x); xa[1] = bfhi(wa.x); xa[2] = bflo(wa.y); xa[3] = bfhi(wa.y); xa[4] = bflo(wa.z); xa[5] = bfhi(wa.z); xa[6] = bflo(wa.w); xa[7] = bfhi(wa.w);
        xb[0] = bflo(wb.x); xb[1] = bfhi(wb.x); xb[2] = bflo(wb.y); xb[3] = bfhi(wb.y); xb[4] = bflo(wb.z); xb[5] = bfhi(wb.z); xb[6] = bflo(wb.w); xb[7] = bfhi(wb.w);
        float oa[8], ob[8];
#pragma unroll
        for (int j = 0; j < 8; ++j) { const float ang = pos * fast_exp2(-(float)(i0 + j) * fstep); const float cs = __cosf(ang), sn = __sinf(ang);
            oa[j] = xa[j] * cs - xb[j] * sn; ob[j] = xb[j] * cs + xa[j] * sn; }
        u32x4 ra, rb;
        ra.x = cvt_pk_bf16(oa[0], oa[1]); ra.y = cvt_pk_bf16(oa[2], oa[3]); ra.z = cvt_pk_bf16(oa[4], oa[5]); ra.w = cvt_pk_bf16(oa[6], oa[7]);
        rb.x = cvt_pk_bf16(ob[0], ob[1]); rb.y = cvt_pk_bf16(ob[2], ob[3]); rb.z = cvt_pk_bf16(ob[4], ob[5]); rb.w = cvt_pk_bf16(ob[6], ob[7]);
        *(u32x4*)pa = ra; *(u32x4*)(pa + bofs) = rb;
    }
}

struct AttnState { float m, l; f32x4 o[4]; };
__device__ __forceinline__ f32x4 mfma16(bf16x8 a, bf16x8 b, f32x4 c) { return __builtin_amdgcn_mfma_f32_16x16x32_bf16(a, b, c, 0, 0, 0); }

__device__ __forceinline__ float xmax16(float x) { const u32x2 r = __builtin_amdgcn_permlane16_swap(__float_as_uint(x), __float_as_uint(x), false, false); return fmaxf(__uint_as_float(r.x), __uint_as_float(r.y)); }
__device__ __forceinline__ float xmax32(float x) { const u32x2 r = __builtin_amdgcn_permlane32_swap(__float_as_uint(x), __float_as_uint(x), false, false); return fmaxf(__uint_as_float(r.x), __uint_as_float(r.y)); }
__device__ __forceinline__ float xadd16(float x) { const u32x2 r = __builtin_amdgcn_permlane16_swap(__float_as_uint(x), __float_as_uint(x), false, false); return __uint_as_float(r.x) + __uint_as_float(r.y); }
__device__ __forceinline__ float xadd32(float x) { const u32x2 r = __builtin_amdgcn_permlane32_swap(__float_as_uint(x), __float_as_uint(x), false, false); return __uint_as_float(r.x) + __uint_as_float(r.y); }
__device__ __forceinline__ void softmax_d16(AttnState& st, float (&s)[16], bool first, float& alpha, bool& resc, bf16x8& p0, bf16x8& p1) {
    float mx = fmaxf(fmaxf(fmaxf(s[0], s[1]), fmaxf(s[2], s[3])), fmaxf(fmaxf(s[4], s[5]), fmaxf(s[6], s[7])));
    mx = fmaxf(mx, fmaxf(fmaxf(fmaxf(s[8], s[9]), fmaxf(s[10], s[11])), fmaxf(fmaxf(s[12], s[13]), fmaxf(s[14], s[15]))));
    resc = first || (__builtin_amdgcn_ballot_w64(mx > 8.f) != 0ull);
    alpha = 1.f;
    if (resc) {
        mx = xmax16(mx); mx = xmax32(mx);
        const float d = first ? mx : fmaxf(mx, 0.f);
        alpha = first ? 0.f : fast_exp2(-d);
        st.m = first ? mx : st.m + d;
#pragma unroll
        for (int j = 0; j < 16; ++j) s[j] -= d;
    }
    float pr[16];
#pragma unroll
    for (int j = 0; j < 16; ++j) pr[j] = fast_exp2(s[j]);
    float sum = (((pr[0] + pr[1]) + (pr[2] + pr[3])) + ((pr[4] + pr[5]) + (pr[6] + pr[7]))) + (((pr[8] + pr[9]) + (pr[10] + pr[11])) + ((pr[12] + pr[13]) + (pr[14] + pr[15])));
    sum = xadd16(sum); sum = xadd32(sum);
    st.l = st.l * alpha + sum;
    u32x4 w0, w1;
    w0.x = cvt_pk_bf16(pr[0], pr[1]); w0.y = cvt_pk_bf16(pr[2], pr[3]); w0.z = cvt_pk_bf16(pr[4], pr[5]); w0.w = cvt_pk_bf16(pr[6], pr[7]);
    w1.x = cvt_pk_bf16(pr[8], pr[9]); w1.y = cvt_pk_bf16(pr[10], pr[11]); w1.z = cvt_pk_bf16(pr[12], pr[13]); w1.w = cvt_pk_bf16(pr[14], pr[15]);
    p0 = __builtin_bit_cast(bf16x8, w0); p1 = __builtin_bit_cast(bf16x8, w1);
}
__device__ __forceinline__ bf16x8 softmax_p(AttnState& st, const float (&s2)[8], unsigned vm, float& alpha) {
    float mx = -1e30f;
#pragma unroll
    for (int j = 0; j < 8; ++j) mx = fmaxf(mx, ((vm >> j) & 1u) ? s2[j] : -1e30f);
    mx = xmax16(mx); mx = xmax32(mx);
    const float mn = fmaxf(st.m, mx); alpha = fast_exp2(st.m - mn);
    float pr[8]; float sum = 0.f;
#pragma unroll
    for (int j = 0; j < 8; ++j) { pr[j] = ((vm >> j) & 1u) ? fast_exp2(s2[j] - mn) : 0.f; sum += pr[j]; }
    sum += __shfl_xor(sum, 16); sum += __shfl_xor(sum, 32);
    st.l = st.l * alpha + sum; st.m = mn;
    u32x4 pw; pw.x = cvt_pk_bf16(pr[0], pr[1]); pw.y = cvt_pk_bf16(pr[2], pr[3]); pw.z = cvt_pk_bf16(pr[4], pr[5]); pw.w = cvt_pk_bf16(pr[6], pr[7]);
    return __builtin_bit_cast(bf16x8, pw);
}
__device__ __forceinline__ bf16x8 softmax_d(AttnState& st, const float (&s2)[8], float& alpha, bool& resc) {
    float mx = fmaxf(fmaxf(fmaxf(s2[0], s2[1]), fmaxf(s2[2], s2[3])), fmaxf(fmaxf(s2[4], s2[5]), fmaxf(s2[6], s2[7])));
    mx = fmaxf(mx, __shfl_xor(mx, 16)); mx = fmaxf(mx, __shfl_xor(mx, 32));
    const float mn = fmaxf(st.m, mx);
    resc = __builtin_amdgcn_ballot_w64(mn > st.m) != 0ull;
    alpha = fast_exp2(st.m - mn);
    float pr[8];
#pragma unroll
    for (int j = 0; j < 8; ++j) pr[j] = fast_exp2(s2[j] - mn);
    float sum = ((pr[0] + pr[1]) + (pr[2] + pr[3])) + ((pr[4] + pr[5]) + (pr[6] + pr[7]));
    sum = xadd16(sum); sum = xadd32(sum);
    st.l = st.l * alpha + sum; st.m = mn;
    u32x4 pw; pw.x = cvt_pk_bf16(pr[0], pr[1]); pw.y = cvt_pk_bf16(pr[2], pr[3]); pw.z = cvt_pk_bf16(pr[4], pr[5]); pw.w = cvt_pk_bf16(pr[6], pr[7]);
    return __builtin_bit_cast(bf16x8, pw);
}
__device__ __forceinline__ void st_init(AttnState& st, float m0, float l0) { st.m = m0; st.l = l0;
#pragma unroll
    for (int i = 0; i < 4; ++i) st.o[i] = (f32x4){0.f, 0.f, 0.f, 0.f}; }

constexpr int AT_ROWB = 144;
constexpr int AT_TILEB = 64 * AT_ROWB;
struct ATC { int l15, quad, kr0, lat0, nlat, rs_w, r_w; int cg4[2], qc[2], c0[2], qt[2], q0[2]; bool dec; const float* rpb; };

template <int TYPE>
__device__ __forceinline__ void attn_tile(AttnState (&sa)[2], AttnState (&sb)[2], const bf16x8 (&qf)[2][2], const ATC& c, const LAS unsigned char* kt, const LAS unsigned char* vt, int i) {
    const bool masked = c.dec && (i < c.nlat) && (TYPE != 2);
    if (TYPE == 0 && masked) { const int krow = c.lat0 + i; if (!((krow >= c.rs_w) && (krow < c.rs_w + 8))) return; }
    const f32x4 z4 = (f32x4){0.f, 0.f, 0.f, 0.f};
    if (!masked) {
        bf16x8 pA[2][2], pB[2][2]; float alA[2], alB[2]; bool rA[2], rB[2];
        const bool first = (TYPE != 1) && (i == 0);
        if (TYPE == 2) {
#pragma unroll
            for (int qi = 0; qi < 2; ++qi)
#pragma unroll
                for (int mp = 0; mp < 2; ++mp) {
                    float s2[16];
#pragma unroll
                    for (int ss = 0; ss < 2; ++ss)
#pragma unroll
                        for (int t = 0; t < 2; ++t) { const int kr = ss * 32 + c.kr0 + 4 * t, sw = ((kr >> 4) & 1) << 2;
                            const bf16x8 kf = *(const LAS bf16x8*)(kt + kr * AT_ROWB + (((mp * 4 + c.quad) ^ sw) << 4));
                            const float nm = first ? 0.f : -(mp == 0 ? sa[qi].m : sb[qi].m);
                            const f32x4 a = mfma16(kf, qf[qi][mp], (f32x4){nm, nm, nm, nm});
#pragma unroll
                            for (int e = 0; e < 4; ++e) s2[ss * 8 + t * 4 + e] = a[e]; }
                    if (mp == 0) softmax_d16(sa[qi], s2, first, alA[qi], rA[qi], pA[qi][0], pA[qi][1]); else softmax_d16(sb[qi], s2, first, alB[qi], rB[qi], pB[qi][0], pB[qi][1]);
                    asm volatile("" ::: "memory");
                }
        } else {
            bf16x8 kf[2][2][2];
#pragma unroll
            for (int ss = 0; ss < 2; ++ss)
#pragma unroll
                for (int t = 0; t < 2; ++t) { const int kr = ss * 32 + c.kr0 + 4 * t, sw = ((kr >> 4) & 1) << 2;
#pragma unroll
                    for (int cc = 0; cc < 2; ++cc) kf[ss][t][cc] = *(const LAS bf16x8*)(kt + kr * AT_ROWB + (((cc * 4 + c.quad) ^ sw) << 4)); }
#pragma unroll
            for (int qi = 0; qi < 2; ++qi) {
                float s2[16];
#pragma unroll
                for (int ss = 0; ss < 2; ++ss)
#pragma unroll
                    for (int t = 0; t < 2; ++t) { const float nm = first ? 0.f : -sa[qi].m; f32x4 a = mfma16(kf[ss][t][0], qf[qi][0], (f32x4){nm, nm, nm, nm}); a = mfma16(kf[ss][t][1], qf[qi][1], a);
#pragma unroll
                        for (int e = 0; e < 4; ++e) s2[ss * 8 + t * 4 + e] = a[e]; }
                softmax_d16(sa[qi], s2, first, alA[qi], rA[qi], pA[qi][0], pA[qi][1]);
            }
        }
#pragma unroll
        for (int qi = 0; qi < 2; ++qi) {
            if (rA[qi]) {
#pragma unroll
                for (int nt = 0; nt < 4; ++nt) sa[qi].o[nt] = sa[qi].o[nt] * alA[qi]; }
            if (TYPE == 2) { if (rB[qi]) {
#pragma unroll
                for (int nt = 0; nt < 4; ++nt) sb[qi].o[nt] = sb[qi].o[nt] * alB[qi]; } }
        }
#pragma unroll
        for (int ss = 0; ss < 2; ++ss) {
            bf16x8 vf[4];
#pragma unroll
            for (int nt = 0; nt < 4; ++nt) vf[nt] = *(const LAS bf16x8*)(vt + (nt * 16 + c.l15) * AT_ROWB + ss * 64 + (c.quad << 4));
#pragma unroll
            for (int qi = 0; qi < 2; ++qi)
#pragma unroll
                for (int nt = 0; nt < 4; ++nt) { sa[qi].o[nt] = mfma16(vf[nt], pA[qi][ss], sa[qi].o[nt]); if (TYPE == 2) sb[qi].o[nt] = mfma16(vf[nt], pB[qi][ss], sb[qi].o[nt]); }
        }
        return;
    }
#pragma unroll 1
    for (int ss = 0; ss < 2; ++ss) {
        bool on[2];
#pragma unroll
        for (int qi = 0; qi < 2; ++qi) {
            on[qi] = true;
            if (TYPE == 0) on[qi] = !((c.cg4[qi] == 0 && ss == 1) || (c.cg4[qi] == 3 && ss == 0));
            if (TYPE == 1) { const int k0 = (c.lat0 + i) * 64 + ss * 32; on[qi] = (k0 + 31 >= c.q0[qi] - 128) && (k0 <= c.q0[qi] + 15 + 128); }
        }
        if (on[0] || on[1]) {
            const int krA = ss * 32 + c.kr0, krB = krA + 4;
            const int swA = ((krA >> 4) & 1) << 2, swB = ((krB >> 4) & 1) << 2;
            bf16x8 kf[2][2];
#pragma unroll
            for (int cc = 0; cc < 2; ++cc) { kf[0][cc] = *(const LAS bf16x8*)(kt + krA * AT_ROWB + (((cc * 4 + c.quad) ^ swA) << 4)); kf[1][cc] = *(const LAS bf16x8*)(kt + krB * AT_ROWB + (((cc * 4 + c.quad) ^ swB) << 4)); }
            bf16x8 vf[4];
#pragma unroll
            for (int nt = 0; nt < 4; ++nt) vf[nt] = *(const LAS bf16x8*)(vt + (nt * 16 + c.l15) * AT_ROWB + ss * 64 + (c.quad << 4));
#pragma unroll
            for (int qi = 0; qi < 2; ++qi) {
                if (on[qi]) {
                    f32x4 a0 = mfma16(kf[0][0], qf[qi][0], z4), a1 = mfma16(kf[1][0], qf[qi][0], z4); a0 = mfma16(kf[0][1], qf[qi][1], a0); a1 = mfma16(kf[1][1], qf[qi][1], a1);
                    float s2[8]; unsigned vm = 0u;
#pragma unroll
                    for (int e = 0; e < 4; ++e) { s2[e] = a0[e]; s2[4 + e] = a1[e]; }
                    if (TYPE == 0) {
                        const float* rp = c.rpb + (c.lat0 + i - c.r_w + 7) * 31;
#pragma unroll
                        for (int j = 0; j < 8; ++j) { const int kc = ss * 32 + c.quad * 8 + j; const bool ok = (kc >= c.c0[qi]) && (kc < c.c0[qi] + 16);
                            const int dc = min(max(kc - c.qc[qi] + 15, 0), 30); s2[j] = s2[j] + rp[dc] * LOG2E; vm |= ok ? (1u << j) : 0u; }
                    } else {
#pragma unroll
                        for (int j = 0; j < 8; ++j) { const int dd = (c.lat0 + i) * 64 + ss * 32 + c.quad * 8 + j - c.qt[qi]; const bool ok = (dd <= 128) && (dd >= -128); vm |= ok ? (1u << j) : 0u; }
                    }
                    float al; const bf16x8 pA = softmax_p(sa[qi], s2, vm, al);
#pragma unroll
                    for (int nt = 0; nt < 4; ++nt) sa[qi].o[nt] = mfma16(vf[nt], pA, sa[qi].o[nt] * al);
                }
            }
        }
    }
}

template <int TYPE>
__device__ __forceinline__ void attn_block(const Ctx& p, LAS unsigned char* lds, int l, bool dec, int b, int h, int qblk) {
    const int tid = opaque_tid(), lane = tid & 63, wave = __builtin_amdgcn_readfirstlane(tid >> 6);
    ATC c; c.l15 = lane & 15; c.quad = lane >> 4; c.dec = dec;
    const bf16_t* PROJ = (const bf16_t*)(p.ws + WS_PROJ); const bf16_t* TR = (const bf16_t*)(p.ws + WS_TR);
    const bf16_t* CK = (const bf16_t*)(p.ws + WS_CK); const bf16_t* CV = CK + CK_HALF;
    bf16_t* BR = (bf16_t*)(p.ws + WS_BR);
    const int L = dec ? 2048 : 256, rowbase = dec ? M_CTX + b * 2048 : b * 256, q0 = qblk * 256 + wave * 32;
    const bf16_t* Pb = PROJ + (size_t)rowbase * PROJW;
    LAS unsigned char* KL = lds; LAS unsigned char* VL = lds + 2 * AT_TILEB;
    int qcol, kcol, vcol, hk, Hc; size_t ckoff;
    if (TYPE == 0) { qcol = h * 64; kcol = 256 + h * 64; vcol = h * 64; hk = h; Hc = 4; ckoff = CK_NA; }
    else if (TYPE == 1) { qcol = 768 + h * 64; kcol = 1024 + (h >> 1) * 64; vcol = 256 + (h >> 1) * 64; hk = h >> 1; Hc = 2; ckoff = CK_SW; }
    else { qcol = 2048 + h * 64; kcol = 2304 + h * 64; vcol = 384 + h * 64; hk = h; Hc = 4; ckoff = CK_DF; }
    const int ncache = dec ? 8 : 0;
    c.rs_w = 0; c.r_w = 0;
    int cgb = 0;
    if (!dec) { c.lat0 = 0; c.nlat = 4; }
    else if (TYPE == 0) { const int r0 = qblk * 4; const int rsA = min(max(r0 - 4, 0), 24), rsB = min(max(r0 - 1, 0), 24); c.lat0 = rsA; c.nlat = rsB + 8 - rsA;
        c.r_w = r0 + (wave >> 1); c.rs_w = min(max(c.r_w - 4, 0), 24); cgb = (wave & 1) * 2; }
    else if (TYPE == 1) { const int q0b = qblk * 256; c.lat0 = max(q0b - 128, 0) >> 6; c.nlat = (min(q0b + 384, L) >> 6) - c.lat0; }
    else { c.lat0 = 0; c.nlat = 32; }
#pragma unroll
    for (int qi = 0; qi < 2; ++qi) { c.cg4[qi] = cgb + qi; c.q0[qi] = q0 + 16 * qi; c.qt[qi] = q0 + 16 * qi + c.l15; c.qc[qi] = c.cg4[qi] * 16 + c.l15; c.c0[qi] = min(max(c.qc[qi] - 8, 0), 48); }
    const int ntile = c.nlat + ncache;
    const int srow = tid >> 3, sch = tid & 7;
    const int kst_off = srow * AT_ROWB + ((sch ^ (((srow >> 4) & 1) << 2)) << 4), vst_off = srow * AT_ROWB + (sch << 4);
    const bf16_t* klat = Pb + kcol + (size_t)(c.lat0 * 64 + srow) * PROJW + sch * 8;
    const bf16_t* vlat = TR + (size_t)(vcol + srow) * M_TOT + rowbase + c.lat0 * 64 + sch * 8;
    const bf16_t* kcac = CK + ckoff + ((size_t)(b * Hc + hk) * 512 + srow) * 64 + sch * 8;
    const bf16_t* vcac = CV + ckoff + ((size_t)(b * Hc + hk) * 64 + srow) * 512 + sch * 8;
    c.kr0 = (c.l15 >> 2) * 8 + (c.l15 & 3);
    bf16x8 qf[2][2];
    AttnState sa[2], sb[2];
    float sc2, m0, l0;
    if (TYPE == 1) { m0 = inp(p.ws, I_SINK)[l * 4 + h] * LOG2E; l0 = 1.f; sc2 = 0.125f * LOG2E; }
    else if (TYPE == 0) { m0 = -1e30f; l0 = 0.f; sc2 = 0.125f * LOG2E; }
    else { m0 = -1e30f; l0 = 0.f; sc2 = 0.17677669529663687f * LOG2E; }
#pragma unroll
    for (int qi = 0; qi < 2; ++qi) {
        st_init(sa[qi], m0, l0); st_init(sb[qi], -1e30f, 0.f);
        const size_t qrow = (size_t)(q0 + 16 * qi + c.l15) * PROJW;
        const u32x4 q0w = *(const u32x4*)(Pb + qrow + qcol + c.quad * 8), q1w = *(const u32x4*)(Pb + qrow + qcol + 32 + c.quad * 8);
        u32x4 a, bq;
        a.x = cvt_pk_bf16(bflo(q0w.x) * sc2, bfhi(q0w.x) * sc2); a.y = cvt_pk_bf16(bflo(q0w.y) * sc2, bfhi(q0w.y) * sc2); a.z = cvt_pk_bf16(bflo(q0w.z) * sc2, bfhi(q0w.z) * sc2); a.w = cvt_pk_bf16(bflo(q0w.w) * sc2, bfhi(q0w.w) * sc2);
        bq.x = cvt_pk_bf16(bflo(q1w.x) * sc2, bfhi(q1w.x) * sc2); bq.y = cvt_pk_bf16(bflo(q1w.y) * sc2, bfhi(q1w.y) * sc2); bq.z = cvt_pk_bf16(bflo(q1w.z) * sc2, bfhi(q1w.z) * sc2); bq.w = cvt_pk_bf16(bflo(q1w.w) * sc2, bfhi(q1w.w) * sc2);
        qf[qi][0] = __builtin_bit_cast(bf16x8, a); qf[qi][1] = __builtin_bit_cast(bf16x8, bq);
    }
    c.rpb = inp(p.ws, I_RPB) + ((size_t)(l * 4 + h)) * 15 * 31;
#define AT_KSRC(n) (((n) < c.nlat) ? klat + (size_t)(n) * 64 * PROJW : kcac + (size_t)((n) - c.nlat) * 4096)
#define AT_VSRC(n) (((n) < c.nlat) ? vlat + (n) * 64 : vcac + ((n) - c.nlat) * 64)
    u32x4 kA, vA, kB, vB;
    kA = *(const u32x4*)AT_KSRC(0); vA = *(const u32x4*)AT_VSRC(0);
    { const int n1 = min(1, ntile - 1); kB = *(const u32x4*)AT_KSRC(n1); vB = *(const u32x4*)AT_VSRC(n1); }
    *(LAS u32x4*)(KL + kst_off) = kA; *(LAS u32x4*)(VL + vst_off) = vA;
    __syncthreads();
#pragma unroll 1
    for (int i = 0; i < ntile; i += 2) {
        { const int n2 = min(i + 2, ntile - 1); kA = *(const u32x4*)AT_KSRC(n2); vA = *(const u32x4*)AT_VSRC(n2); }
        attn_tile<TYPE>(sa, sb, qf, c, KL, VL, i);
        *(LAS u32x4*)(KL + AT_TILEB + kst_off) = kB; *(LAS u32x4*)(VL + AT_TILEB + vst_off) = vB;
        __syncthreads();
        if (i + 1 >= ntile) break;
        { const int n3 = min(i + 3, ntile - 1); kB = *(const u32x4*)AT_KSRC(n3); vB = *(const u32x4*)AT_VSRC(n3); }
        attn_tile<TYPE>(sa, sb, qf, c, KL + AT_TILEB, VL + AT_TILEB, i + 1);
        *(LAS u32x4*)(KL + kst_off) = kA; *(LAS u32x4*)(VL + vst_off) = vA;
        __syncthreads();
    }
#undef AT_KSRC
#undef AT_VSRC
#pragma unroll
    for (int qi = 0; qi < 2; ++qi) {
        const size_t orow = (size_t)(rowbase + q0 + 16 * qi + c.l15) * 256 + h * 64 + c.quad * 4;
        if (TYPE != 2) {
            const float il = fast_rcp(sa[qi].l);
            bf16_t* o = BR + (TYPE == 1 ? (size_t)M_TOT * 256 : 0) + orow;
#pragma unroll
            for (int nt = 0; nt < 4; ++nt) { u32x2 w; w.x = cvt_pk_bf16(sa[qi].o[nt][0] * il, sa[qi].o[nt][1] * il); w.y = cvt_pk_bf16(sa[qi].o[nt][2] * il, sa[qi].o[nt][3] * il); *(u32x2*)(o + nt * 16) = w; }
        } else {
            const float lam = ((const float*)(p.ws + WS_LAM))[l], lam_init = ((const float*)(p.ws + WS_LAM))[4 + l];
            const float i0 = fast_rcp(sa[qi].l), i1 = lam * fast_rcp(sb[qi].l);
            f32x4 d[4]; float ss = 0.f;
#pragma unroll
            for (int i = 0; i < 4; ++i) { d[i] = sa[qi].o[i] * i0 - sb[qi].o[i] * i1; ss += (d[i][0] * d[i][0] + d[i][1] * d[i][1]) + (d[i][2] * d[i][2] + d[i][3] * d[i][3]); }
            ss = xadd16(ss); ss = xadd32(ss);
            const float rs = rsqrtf(ss * (1.f / 64.f) + EPSF) * (1.f - lam_init);
            const float* sg = inp(p.ws, I_DSUB) + l * 64 + c.quad * 4;
            bf16_t* o = BR + (size_t)3 * M_TOT * 256 + orow;
#pragma unroll
            for (int nt = 0; nt < 4; ++nt) { const f32x4 g4 = *(const f32x4*)(sg + nt * 16); const f32x4 v = d[nt] * rs * g4;
                u32x2 w; w.x = cvt_pk_bf16(v[0], v[1]); w.y = cvt_pk_bf16(v[2], v[3]); *(u32x2*)(o + nt * 16) = w; }
        }
    }
}

__device__ __forceinline__ void hyena_unit(const Ctx& p, LAS unsigned char* lds, int l, int c, bool dec) {
    const int tid = opaque_tid(), lane = tid & 63, wave = __builtin_amdgcn_readfirstlane(tid >> 6), l15 = lane & 15, quad = lane >> 4;
    const int L = dec ? 2048 : 256, B = dec ? 8 : 16, LP = L + 8, rowbase = dec ? M_CTX : 0, L2 = 2 * L, CS = L2 + 16;
    LAS bf16_t* COP = (LAS bf16_t*)lds;
    LAS bf16_t* YA = (LAS bf16_t*)(lds + 66048);
    LAS bf16_t* YB = (LAS bf16_t*)(lds + 66048 + 33024);
    LAS float* RED = (LAS float*)(lds + 66048 + 2 * 33024);
    const bf16_t* TR = (const bf16_t*)(p.ws + WS_TR);
    bf16_t* BR2 = (bf16_t*)(p.ws + WS_BR) + (size_t)2 * M_TOT * 256;
    const float* HF = (const float*)(p.ws + WS_HFIL) + (dec ? 262144 : 0);
    { const bf16_t* src = TR + (size_t)(640 + c) * M_TOT + rowbase;
      for (int i = tid; i < B * L / 8; i += 512) { const int e = i * 8, b = e / L, t = e - b * L; *(LAS u32x4*)(YA + b * LP + t) = *(const u32x4*)(src + e); } }
#pragma unroll 1
    for (int o = 0; o < 2; ++o) {
        LAS float* RF = (LAS float*)(o == 0 ? YB : YA);
        __syncthreads();
        const float* raw0 = HF + ((size_t)((o * 2 + 0) * 256 + c)) * L; const float* raw1 = HF + ((size_t)((o * 2 + 1) * 256 + c)) * L;
        float part = 0.f;
        for (int u = tid; u < L2; u += 512) { const int lag = L - 1 - u; float v = 0.f; if (lag >= 0) v = raw0[lag]; else if (lag > -L) v = raw1[-lag]; RF[u] = v; part += fabsf(v); }
        part = wave_sum(part);
        if (lane == 0) RED[wave] = part;
        __syncthreads();
        float tot = 0.f;
#pragma unroll
        for (int w = 0; w < 8; ++w) tot += RED[w];
        const float inv = 1.f / (tot + EPSF);
        const int ng = L2 / 8;
        for (int idx = tid; idx < 8 * ng; idx += 512) { const int m = idx / ng, x = (idx - m * ng) * 8; float v[8];
#pragma unroll
            for (int j = 0; j < 8; ++j) { const int u = x + m + j; v[j] = (u < L2) ? RF[u] * inv : 0.f; }
            u32x4 w; w.x = cvt_pk_bf16(v[0], v[1]); w.y = cvt_pk_bf16(v[2], v[3]); w.z = cvt_pk_bf16(v[4], v[5]); w.w = cvt_pk_bf16(v[6], v[7]);
            *(LAS u32x4*)(COP + m * CS + x) = w; }
        __syncthreads();
        const LAS bf16_t* Y = (o == 0) ? YA : YB;
        const LAS bf16_t* cpb = COP + (7 - (l15 & 7)) * CS + (L - 8 - 8 * (l15 >> 3) + quad * 8);
        const float skip = inp(p.ws, I_HSKIP)[(l * 2 + o) * 256 + c];
        const bf16_t* gate = TR + (size_t)((o == 0 ? 896 : 1152) + c) * M_TOT + rowbase;
        const int ngroups = L / 64;
        const bf16x8 zero8 = (bf16x8){0, 0, 0, 0, 0, 0, 0, 0};
        for (int g = wave; g < ngroups; g += 8) {
            const int t0 = (g >> 1) * 128 + (g & 1) * 16;
            f32x4 a0 = (f32x4){0.f, 0.f, 0.f, 0.f}, a1 = a0, a2 = a0, a3 = a0;
#define HY_D(s) (*(const LAS bf16x8*)(cpb + (32 * (s) - t0)))
#define HY_Y(s) ((l15 < B) ? *(const LAS bf16x8*)(Y + l15 * LP + 32 * (s) + quad * 8) : zero8)
            bf16x8 d0, d1 = HY_D(-1), d2 = HY_D(-2), d3 = HY_D(-3), y;
            for (int s = 0; s < L / 32; s += 4) {
                d0 = HY_D(s);     y = HY_Y(s);     a0 = mfma16(d0, y, a0); a1 = mfma16(d1, y, a1); a2 = mfma16(d2, y, a2); a3 = mfma16(d3, y, a3);
                d3 = HY_D(s + 1); y = HY_Y(s + 1); a0 = mfma16(d3, y, a0); a1 = mfma16(d0, y, a1); a2 = mfma16(d1, y, a2); a3 = mfma16(d2, y, a3);
                d2 = HY_D(s + 2); y = HY_Y(s + 2); a0 = mfma16(d2, y, a0); a1 = mfma16(d3, y, a1); a2 = mfma16(d0, y, a2); a3 = mfma16(d1, y, a3);
                d1 = HY_D(s + 3); y = HY_Y(s + 3); a0 = mfma16(d1, y, a0); a1 = mfma16(d2, y, a1); a2 = mfma16(d3, y, a2); a3 = mfma16(d0, y, a3);
            }
#undef HY_D
#undef HY_Y
            if (l15 < B) {
#pragma unroll
                for (int a = 0; a < 4; ++a) {
                    const f32x4 cv = a == 0 ? a0 : (a == 1 ? a1 : (a == 2 ? a2 : a3));
                    const int t = t0 + 32 * a + quad * 4;
                    const u32x2 gw = *(const u32x2*)(gate + (size_t)l15 * L + t);
                    const u32x2 yw = *(const LAS u32x2*)(Y + l15 * LP + t);
                    f32x4 r;
                    r[0] = bflo(gw.x) * (cv[0] + skip * bflo(yw.x)); r[1] = bfhi(gw.x) * (cv[1] + skip * bfhi(yw.x));
                    r[2] = bflo(gw.y) * (cv[2] + skip * bflo(yw.y)); r[3] = bfhi(gw.y) * (cv[3] + skip * bfhi(yw.y));
                    if (o == 0) { u32x2 w; w.x = cvt_pk_bf16(r[0], r[1]); w.y = cvt_pk_bf16(r[2], r[3]); *(LAS u32x2*)(YB + l15 * LP + t) = w; }
                    else { bf16_t* op = BR2 + (size_t)(rowbase + l15 * L + t) * 256 + c;
                        op[0] = f2bf1(r[0]); op[256] = f2bf1(r[1]); op[512] = f2bf1(r[2]); op[768] = f2bf1(r[3]); }
                }
            }
        }
    }
    __syncthreads();
}

__device__ __forceinline__ void mix_phase(const Ctx& p, LAS unsigned char* lds, int l) {
    const int G = gridDim.x;
    for (int u = blockIdx.x; u < 512; u += G) hyena_unit(p, lds, l, u & 255, u < 256);
#ifdef PROBE_HY2
    for (int u = blockIdx.x; u < 512; u += G) hyena_unit(p, lds, l, u & 255, u < 256);
#endif
    const int vcu = (G % 8 == 0) ? ((int)blockIdx.x % 8) * (G / 8) + (int)blockIdx.x / 8 : (int)blockIdx.x;
#pragma unroll 1
    for (int it = vcu; it < 960; it += G) {
        if (it < 768) { const int k = it >> 8, r = it & 255, qblk = r & 7, bh = r >> 3;
            if (k == 0) attn_block<2>(p, lds, l, true, bh >> 2, bh & 3, qblk); else if (k == 1) attn_block<1>(p, lds, l, true, bh >> 2, bh & 3, qblk); else attn_block<0>(p, lds, l, true, bh >> 2, bh & 3, qblk); }
        else { const int q = it - 768, k = q >> 6, bh = q & 63;
            if (k == 0) attn_block<2>(p, lds, l, false, bh >> 2, bh & 3, 0); else if (k == 1) attn_block<1>(p, lds, l, false, bh >> 2, bh & 3, 0); else attn_block<0>(p, lds, l, false, bh >> 2, bh & 3, 0); }
    }
}

#define XB_TMO      128
#define XB_XCNT(j)  (256  + 64 * (j))
#define XB_XSUB(j)  (1280 + 64 * (j))
#define XB_XGEN(j)  (2304 + 64 * (j))
#define XB_TOP      3328
#define XB_TOPGEN   3392
#define XB_SPIN_CAP (1u << 22)
__device__ __forceinline__ unsigned xb_ld(unsigned* p)              { return __hip_atomic_load(p, __ATOMIC_RELAXED, __HIP_MEMORY_SCOPE_AGENT); }
__device__ __forceinline__ unsigned xb_add(unsigned* p, unsigned v) { return __hip_atomic_fetch_add(p, v, __ATOMIC_RELAXED, __HIP_MEMORY_SCOPE_AGENT); }
__device__ __forceinline__ unsigned xb_xcc_id() { return (unsigned)__builtin_amdgcn_s_getreg((3 << 11) | 20) & 0xFu; }
#define XB_SPIN(cond, bar) do { unsigned _sp = 0; while (cond) { __builtin_amdgcn_s_sleep(1); \
    if ((++_sp & 255u) == 0u) { if (xb_ld(&(bar)[XB_TMO])) break; if (_sp > XB_SPIN_CAP) { atomicAdd(&(bar)[XB_TMO], 1u); break; } } } } while (0)
struct XcdBarrier { unsigned* bar; unsigned x; volatile LAS unsigned* st; };
__device__ __forceinline__ XcdBarrier xcd_barrier_post(unsigned* bar, volatile LAS unsigned* st) {
    XcdBarrier b; b.bar = bar; b.x = xb_xcc_id(); b.st = st;
    if (threadIdx.x == 0) (void)xb_add(&bar[XB_XCNT(b.x)], 1u);
    return b;
}
__device__ __forceinline__ void xcd_barrier_complete(unsigned* bar, unsigned x, unsigned& nloc, unsigned& nx) {
    const unsigned G = gridDim.x * gridDim.y * gridDim.z;
    unsigned sum, cnt, mine, sp = 0u;
    for (;;) {
        sum = 0u; cnt = 0u; mine = 0u;
#pragma unroll
        for (unsigned j = 0; j < 16; ++j) { const unsigned c = xb_ld(&bar[XB_XCNT(j)]); sum += c; cnt += (c > 0u) ? 1u : 0u; mine = (j == x) ? c : mine; }
        if (sum == G) break;
        __builtin_amdgcn_s_sleep(1);
        if ((++sp & 255u) == 0u) { if (xb_ld(&bar[XB_TMO])) break; if (sp > XB_SPIN_CAP) { atomicAdd(&bar[XB_TMO], 1u); break; } }
    }
    nloc = mine > 0u ? mine : 1u; nx = cnt > 0u ? cnt : 1u;
}
__device__ __forceinline__ void xcd_barrier(const XcdBarrier& b) {
    asm volatile("s_waitcnt vmcnt(0)" ::: "memory");
    __syncthreads();
    if (threadIdx.x == 0) {
        unsigned* bar = b.bar;
        __builtin_amdgcn_s_waitcnt(0);
        unsigned nloc = b.st[0], nx = b.st[1];
        if (nloc == 0u) { xcd_barrier_complete(bar, b.x, nloc, nx); b.st[0] = nloc; b.st[1] = nx; }
        const unsigned old = xb_add(&bar[XB_XSUB(b.x)], 1u);
        const unsigned gen = old / nloc;
        if (old + 1u == (gen + 1u) * nloc) {
            __builtin_amdgcn_fence(__ATOMIC_RELEASE, "agent");
            asm volatile("s_waitcnt vmcnt(0)" ::: "memory");
            const unsigned og = xb_add(&bar[XB_TOP], 1u);
            const unsigned tg = og / nx;
            if (og + 1u == (tg + 1u) * nx) xb_add(&bar[XB_TOPGEN], 1u);
            else XB_SPIN(xb_ld(&bar[XB_TOPGEN]) == tg, bar);
            __builtin_amdgcn_fence(__ATOMIC_ACQUIRE, "agent");
            xb_add(&bar[XB_XGEN(b.x)], 1u);
            asm volatile("s_waitcnt vmcnt(0)" ::: "memory");
        } else {
            XB_SPIN(xb_ld(&bar[XB_XGEN(b.x)]) == gen, bar);
            __builtin_amdgcn_fence(__ATOMIC_ACQUIRE, "agent");
            asm volatile("s_waitcnt vmcnt(0)" ::: "memory");
        }
    }
    __syncthreads();
}

__global__ void __launch_bounds__(512, 2) mega(Params P) {
    extern __shared__ __attribute__((aligned(16))) unsigned char lds_raw[];
    LAS unsigned char* lds = (LAS unsigned char*)lds_raw;
    cg::grid_group grid = cg::this_grid();
    volatile LAS unsigned* MISC = (volatile LAS unsigned*)(lds + LDS_BYTES - 64);
    if (threadIdx.x < 16) MISC[threadIdx.x] = 0u;
    __syncthreads();
    (void)xcd_barrier_post((unsigned*)(P.ws + WS_CTL) + 1024, MISC);
#pragma unroll 1
    for (int ph = P.ph_lo; ph < P.ph_hi; ++ph) {
        GAS unsigned char* ws_g = (GAS unsigned char*)P.ws; GAS float* out_g = (GAS float*)P.out; asm volatile("" : "+s"(ws_g), "+s"(out_g));
        Ctx p; p.ws = (unsigned char*)ws_g; p.out = (float*)out_g;
        unsigned char* ws = p.ws;
        int prep_part = 0, prep_l = 0, prep_b = blockIdx.x, prep_G = gridDim.x;
        if (ph == 0) {
            { const int t0_ = opaque_tid(); if (t0_ < N_IN) { ((unsigned long long*)(ws + WS_TAB))[t0_] = (unsigned long long)P.in[t0_]; } }
            asm volatile("s_waitcnt vmcnt(0)" ::: "memory"); __syncthreads();
#ifndef NO_PREP
            prep_mod(p, lds); __syncthreads(); prep_part = 1;
#endif
        }
        else if (ph == NPH - 1) final_norm_phase(p);
        else {
#ifdef PROBE_S
            const int l = (ph - 1) / 13, sv_ = (ph - 1) % 13, s = sv_ <= PROBE_S ? sv_ : sv_ - 1;
#else
            const int l = (ph - 1) / 12, s = (ph - 1) % 12;
#endif
            const bool is_gemm = (s == 1 || s == 2 || s == 4 || s == 7 || s == 8 || s == 10 || s == 11);
            if (is_gemm) {
                pg8::Gemm g; pg8::Sched S; pg8::Epi E; bool perm;
                S.G = gridDim.x; S.c = blockIdx.x; S.mode = 0; S.nM = M_TOT / 256; S.wgm = (s == 2 || s == 8 || s == 11) ? RESID_WGM : (s == 4 ? 2 : pg8::WGM);
                E.o16 = nullptr; E.o16b = nullptr; E.of = nullptr; E.g = nullptr; E.gates = nullptr; E.scale = 1.f;
                bf16_t* ACT = (bf16_t*)(ws + WS_ACT); bf16_t* BIG = (bf16_t*)(ws + WS_BIG); float* X = (float*)(ws + WS_X);
                if (s == 1 || s == 10) { g.A = ACT; g.Bt = (const bf16_t*)(ws + wbase(l) + (s == 1 ? W_F1UP : W_F2UP)); g.K = DM; S.nN = 22; E.kind = pg8::EK_SWIGLU; E.o16 = BIG; perm = true; }
                else if (s == 2 || s == 11) { g.A = BIG; g.Bt = (const bf16_t*)(ws + wbase(l) + (s == 2 ? W_F1DN : W_F2DN)); g.K = DFF; S.nN = 4; E.kind = pg8::EK_RESID; E.of = X;
                    E.g = mod_ptr(ws, 0, l, s == 2 ? 2 : 8); E.scale = 0.5f; perm = false; }
                else if (s == 4) { g.A = ACT; g.Bt = (const bf16_t*)(ws + wbase(l) + W_IN); g.K = DM; S.nN = 27; E.kind = pg8::EK_PROJ; E.o16 = (bf16_t*)(ws + WS_PROJ); E.o16b = BIG; perm = true; }
                else if (s == 7) { g.A = (const bf16_t*)(ws + WS_BR); g.Bt = (const bf16_t*)(ws + wbase(l) + W_BR); g.K = 256; S.mode = 1; S.nN = 8; E.kind = pg8::EK_BRANCH;
                    E.o16 = ACT; E.gates = BIG; perm = false; }
                else { g.A = ACT; g.Bt = (const bf16_t*)(ws + wbase(l) + W_OUT); g.K = DM; S.nN = 4; E.kind = pg8::EK_RESID; E.of = X; E.g = mod_ptr(ws, 0, l, 5); E.scale = 1.f; perm = false; }
                S.nwg = S.nM * S.nN;
                #ifndef NO_GEMM
                if (s == 7) pg8::gemm_phase<true>(lds, g, S, E, perm); else pg8::gemm_phase<false>(lds, g, S, E, perm);
                if (blockIdx.x >= 64) {
                    if (s == 2) { prep_part = 2; prep_l = l; } else if (s == 8) { prep_part = 4; prep_l = l; } else if (s == 11 && l < 3) { prep_part = 1; prep_l = l + 1; }
                    prep_b = blockIdx.x - 64; prep_G = gridDim.x - 64;
                }
#endif
            } else if (s == 0 || s == 3 || s == 9) {
                norm_phase(p, l, s == 0 ? 0 : (s == 3 ? 1 : 2));

            } else if (s == 5) {
#ifndef NO_MIXPREP
                mixprep_phase(p, lds, l);
#endif
            } else {
#ifndef NO_MIX
                mix_phase(p, lds, l);
#ifdef PROBE_MIX2
                __syncthreads(); mix_phase(p, lds, l);
#endif
#endif
            }
        }
#ifndef NO_PREP
        if (prep_part) prep_layer(p, lds, prep_l, prep_b, prep_G, prep_part);
#endif
        if (ph + 1 < P.ph_hi) { if (P.ph_hi > 100000) grid.sync();   { XcdBarrier bar; bar.bar = (unsigned*)(p.ws + WS_CTL) + 1024; bar.x = xb_xcc_id(); bar.st = (volatile LAS unsigned*)(lds + LDS_BYTES - 64); xcd_barrier(bar); } }
    }
}

extern "C" void kernel_launch(void* const* d_in, const int* in_sizes, int n_in, void* d_out, int out_size, void* d_ws, size_t ws_size, hipStream_t stream) {
    static int grid = 0;
    if (grid == 0) {
        if (n_in != N_IN || ws_size < WS_END) { fprintf(stderr, "kernel_launch: unexpected n_in %d / ws_size %zu (need %zu)\n", n_in, ws_size, (size_t)WS_END); grid = -1; return; }
        int dev = 0, cus = 0, per_cu = 0;
        hipGetDevice(&dev); hipDeviceGetAttribute(&cus, hipDeviceAttributeMultiprocessorCount, dev);
        if (hipFuncSetAttribute((const void*)mega, hipFuncAttributeMaxDynamicSharedMemorySize, LDS_BYTES) != hipSuccess) { fprintf(stderr, "kernel_launch: hipFuncSetAttribute failed\n"); grid = -1; return; }
        if (hipOccupancyMaxActiveBlocksPerMultiprocessor(&per_cu, (const void*)mega, 512, LDS_BYTES) != hipSuccess || per_cu < 1) per_cu = 1;
        (void)hipGetLastError();
        grid = cus * 1;
        fprintf(stderr, "kernel_launch: grid %d (per_cu %d), ws %zu\n", grid, per_cu, ws_size);
    }
    if (grid < 0) return;
    hipMemsetAsync(d_ws, 0, WS_ZERO_BYTES, stream);
    Params p{};
    for (int i = 0; i < N_IN; ++i) p.in[i] = (const float*)d_in[i];
    p.out = (float*)d_out; p.ws = (unsigned char*)d_ws; p.ph_lo = 0; p.ph_hi = NPH;
    void* args[] = {&p};
    hipError_t e = hipLaunchCooperativeKernel((const void*)mega, dim3(grid), dim3(512), args, LDS_BYTES, stream);
    if (e != hipSuccess) fprintf(stderr, "cooperative launch failed: %s (grid %d)\n", hipGetErrorString(e), grid);
}
```

```cpp
#ifndef RESID_WGM
#define RESID_WGM 1
#endif
#include <hip/hip_runtime.h>
#include <hip/hip_cooperative_groups.h>
#include <cstdio>
#include <cstdint>
namespace cg = cooperative_groups;

#define LAS __attribute__((address_space(3)))
#define GAS __attribute__((address_space(1)))
typedef unsigned short bf16_t;
typedef short bf16x8 __attribute__((ext_vector_type(8)));
typedef float f32x4 __attribute__((ext_vector_type(4)));
typedef float f32x2 __attribute__((ext_vector_type(2)));
typedef unsigned u32x4 __attribute__((ext_vector_type(4)));
typedef unsigned u32x2 __attribute__((ext_vector_type(2)));

constexpr int DM = 1024, DFF = 2816, INW = 6912, PROJW = 2816, GATEW = 4096;
constexpr int M_CTX = 4096, M_DEC = 16384, M_TOT = 20480;
constexpr int NLAYER = 4;
constexpr float EPSF = 1e-6f;
constexpr float LOG2E = 1.4426950408889634f;
constexpr size_t O_Y = 0, O_NAK = 20971520, O_NAV = 25165824, O_SWK = 29360128, O_SWV = 31457280, O_DFK = 33554432, O_DFV = 37748736;
enum { I_XP = 0, I_XS, I_CNAK, I_CNAV, I_CSWK, I_CSWV, I_CDFK, I_CDFV, I_C, I_CCTX, I_WADA, I_BADA, I_NF1, I_NMIX, I_NF2, I_FNORM,
       I_F1W1, I_F1W3, I_F1W2, I_F2W1, I_F2W3, I_F2W2, I_WIN, I_WBR, I_WOUT, I_RPB, I_SINK, I_HSW, I_HSB, I_HW1, I_HB1, I_HW2, I_HB2, I_HW3,
       I_HSF, I_HLD, I_HSKIP, I_DLAM, I_DSUB, N_IN };

constexpr size_t MiB = 1u << 20;
constexpr size_t WS_CTL = 0;
constexpr size_t WS_MOD = 1 * MiB;
constexpr size_t WS_ZERO_BYTES = 65536;
constexpr size_t WS_LAM = 3 * MiB;
constexpr size_t WS_W = 4 * MiB;
constexpr size_t W_F1UP = 0, W_F1DN = W_F1UP + (size_t)5632 * 1024 * 2, W_F2UP = W_F1DN + (size_t)1024 * 2816 * 2, W_F2DN = W_F2UP + (size_t)5632 * 1024 * 2,
                 W_IN = W_F2DN + (size_t)1024 * 2816 * 2, W_BR = W_IN + (size_t)6912 * 1024 * 2, W_OUT = W_BR + (size_t)4 * 1024 * 256 * 2, W_END = W_OUT + (size_t)1024 * 1024 * 2;
static_assert(W_END <= 52 * MiB, "weights");
constexpr size_t WS_X = 56 * MiB;
constexpr size_t WS_ACT = 136 * MiB;
constexpr size_t WS_BR = 176 * MiB;
constexpr size_t WS_BIG = 216 * MiB;
constexpr size_t WS_PROJ = 376 * MiB;
constexpr size_t WS_TR = 486 * MiB;
constexpr size_t WS_CK = 541 * MiB;
constexpr size_t WS_HFIL = 551 * MiB;
constexpr size_t WS_W2 = 560 * MiB;
constexpr size_t WS_END = 612 * MiB;
constexpr int TRW = 1408;
constexpr size_t CK_NA = 0, CK_SW = 1048576, CK_DF = 1572864, CK_HALF = 2621440;
constexpr int LDS_BYTES = 147456;

#ifdef PROBE_S
constexpr int NPH = 54;
#else
constexpr int NPH = 50;
#endif
struct Params { const float* in[N_IN]; float* out; unsigned char* ws; int ph_lo, ph_hi; };
struct Ctx { float* out; unsigned char* ws; };
__device__ __forceinline__ size_t wbase(int l) { return (l & 1) ? WS_W2 : WS_W; }
constexpr size_t WS_TAB = 3 * MiB + 65536;
__device__ __forceinline__ const float* inp(const unsigned char* ws, int i) {
    const unsigned long long v = __hip_atomic_load((const unsigned long long*)(ws + WS_TAB) + i, __ATOMIC_RELAXED, __HIP_MEMORY_SCOPE_AGENT);
    const unsigned lo = __builtin_amdgcn_readfirstlane((unsigned)v), hi = __builtin_amdgcn_readfirstlane((unsigned)(v >> 32));
    return (const float*)(const GAS float*)(((unsigned long long)hi << 32) | lo);
}


__device__ __forceinline__ unsigned cvt_pk_bf16(float lo, float hi) { unsigned r; asm volatile("v_cvt_pk_bf16_f32 %0, %1, %2" : "=v"(r) : "v"(lo), "v"(hi)); return r; }
__device__ __forceinline__ float bf2f(unsigned short v) { return __uint_as_float(((unsigned)v) << 16); }
__device__ __forceinline__ float bflo(unsigned v) { return __uint_as_float(v << 16); }
__device__ __forceinline__ float bfhi(unsigned v) { return __uint_as_float(v & 0xffff0000u); }
__device__ __forceinline__ bf16_t f2bf1(float f) { return (bf16_t)(cvt_pk_bf16(f, 0.f) & 0xffffu); }
__device__ __forceinline__ float fast_exp2(float x) { return __builtin_amdgcn_exp2f(x); }
__device__ __forceinline__ float fast_rcp(float x) { return __builtin_amdgcn_rcpf(x); }
__device__ __forceinline__ float sigmoidf_(float x) { return fast_rcp(1.f + fast_exp2(-x * LOG2E)); }
__device__ __forceinline__ float wave_sum(float v) {
#pragma unroll
    for (int o = 1; o < 64; o <<= 1) v += __shfl_xor(v, o);
    return v;
}
__device__ __forceinline__ int cond_of_row(int row) { return row < M_CTX ? 0 : 1 + ((row - M_CTX) >> 11); }
__device__ __forceinline__ const float* mod_ptr(const unsigned char* ws, int cond, int l, int chunk) { return (const float*)(ws + WS_MOD) + ((size_t)(cond * 4 + l) * 9 + chunk) * 1024; }

__device__ __forceinline__ int opaque_tid() { int t; asm volatile("v_mov_b32 %0, %1" : "=v"(t) : "v"((int)threadIdx.x)); return t; }
namespace pg8 {
constexpr int BM = 256, BK = 64, HALF = 128, HTB = HALF * BK * 2, STAGE_BYTES = 8 * HTB, NXCD = 8, WGM = 4;
__device__ __forceinline__ int lds_byte(int r, int c) { const int st = (r >> 4) * 2 + (c >> 5), rr = r & 15, cc = c & 31, ob = rr * 64 + cc * 2; return st * 1024 + (ob ^ (((ob >> 9) & 1) << 5)); }
__device__ __forceinline__ void stage_rc(int b, int& R, int& C) { const int st = b / 1024, sb = b % 1024, swz = sb ^ (((sb >> 9) & 1) << 5); R = (st >> 1) * 16 + swz / 64; C = (st & 1) * 32 + (swz % 64) / 2; }
__device__ __forceinline__ int perm32(int rho) { const int n = rho >> 4, i = rho & 15; return 8 * (i >> 2) + 4 * n + (i & 3); }
struct Unit { int pm, pn; };
struct Sched { int mode, nM, nN, nwg, G, c, wgm; };
__device__ __forceinline__ bool sched_next(const Sched& S, int i, Unit& u) {
    const int j = (S.mode == 1) ? (i >> 2) : i;
    const long L = (long)j * S.G + S.c; if (L >= S.nwg) return false;
    int wgid = (int)L; { const int q = S.nwg / NXCD, r = S.nwg % NXCD, xcd = wgid % NXCD, off = wgid / NXCD; wgid = (xcd < r ? xcd * (q + 1) : r * (q + 1) + (xcd - r) * q) + off; }
    const int nig = S.wgm * S.nN, gid = wgid / nig, fm = gid * S.wgm, gsz = (S.nM - fm) < S.wgm ? (S.nM - fm) : S.wgm;
    const int pm = fm + ((wgid % nig) % gsz), pn = (wgid % nig) / gsz;
    if (S.mode == 1) { const int b = i & 3; u.pm = b * S.nM + pm; u.pn = b * S.nN + pn; } else { u.pm = pm; u.pn = pn; }
    return true;
}
enum { EK_SWIGLU = 0, EK_RESID = 1, EK_PROJ = 2, EK_BRANCH = 3 };
struct Epi { int kind; bf16_t* o16; bf16_t* o16b; float* of; const float* g; const bf16_t* gates; float scale; };
struct Gemm { const bf16_t* A; const bf16_t* Bt; int K; };

template <bool BR>
__device__ __forceinline__ void epilogue(const Epi& E, f32x4 (&acc)[2][2][4][2], const Unit& u, int wr, int wc, int fr, int fq) {
    if (BR) {
        const int bi = u.pm / 80, pm = u.pm - bi * 80, pn = u.pn & 7;
        const int row0 = pm * BM + wr * 64 + fr, col0 = pn * HALF + wc * 32 + 4 * fq;
        u32x2 gw[2][2][4];
#pragma unroll
        for (int n = 0; n < 2; ++n)
#pragma unroll
            for (int ai = 0; ai < 2; ++ai)
#pragma unroll
                for (int m = 0; m < 4; ++m) gw[n][ai][m] = *(const u32x2*)(E.gates + (size_t)(row0 + ai * HALF + m * 16) * GATEW + bi * 1024 + col0 + n * 16);
#pragma unroll
        for (int n = 0; n < 2; ++n)
#pragma unroll
            for (int ai = 0; ai < 2; ++ai)
#pragma unroll
                for (int m = 0; m < 4; ++m) {
                    const u32x2 g2 = gw[n][ai][m];
                    f32x4 gt; gt[0] = bflo(g2.x); gt[1] = bfhi(g2.x); gt[2] = bflo(g2.y); gt[3] = bfhi(g2.y);
                    f32x4 v = gt * acc[ai][0][m][n];
                    if (bi > 0) v = v + acc[ai][1][m][n];
                    acc[ai][1][m][n] = v;
                    if (bi == 3) { u32x2 w; w.x = cvt_pk_bf16(v[0], v[1]); w.y = cvt_pk_bf16(v[2], v[3]); *(u32x2*)(E.o16 + (size_t)(row0 + ai * HALF + m * 16) * DM + col0 + n * 16) = w; }
                }
    } else if (E.kind == EK_SWIGLU) {
        const int row0 = u.pm * BM + wr * 64 + fr, col0 = u.pn * 128 + wc * 32 + 8 * fq;
#pragma unroll
        for (int ai = 0; ai < 2; ++ai)
#pragma unroll
            for (int m = 0; m < 4; ++m) {
                const f32x4 a0 = acc[ai][0][m][0], a1 = acc[ai][0][m][1], b0 = acc[ai][1][m][0], b1 = acc[ai][1][m][1];
                float r[8];
#pragma unroll
                for (int e = 0; e < 4; ++e) { r[e] = a0[e] * sigmoidf_(a0[e]) * b0[e]; r[4 + e] = a1[e] * sigmoidf_(a1[e]) * b1[e]; }
                u32x4 w; w.x = cvt_pk_bf16(r[0], r[1]); w.y = cvt_pk_bf16(r[2], r[3]); w.z = cvt_pk_bf16(r[4], r[5]); w.w = cvt_pk_bf16(r[6], r[7]);
                *(u32x4*)(E.o16 + (size_t)(row0 + ai * HALF + m * 16) * DFF + col0) = w;
            }
    } else if (E.kind == EK_PROJ) {
        const int row0 = u.pm * BM + wr * 64 + fr;
        const bool isgate = u.pn >= 11;
        bf16_t* base = isgate ? E.o16b : E.o16; const int ld = isgate ? GATEW : PROJW;
        const int col0 = (isgate ? (u.pn - 11) * BM : u.pn * BM) + wc * 32 + 8 * fq;
#pragma unroll
        for (int ai = 0; ai < 2; ++ai)
#pragma unroll
            for (int m = 0; m < 4; ++m)
#pragma unroll
                for (int bj = 0; bj < 2; ++bj) {
                    f32x4 v0 = acc[ai][bj][m][0], v1 = acc[ai][bj][m][1];
                    if (isgate) {
#pragma unroll
                        for (int e = 0; e < 4; ++e) { v0[e] = sigmoidf_(v0[e]); v1[e] = sigmoidf_(v1[e]); }
                    }
                    u32x4 w; w.x = cvt_pk_bf16(v0[0], v0[1]); w.y = cvt_pk_bf16(v0[2], v0[3]); w.z = cvt_pk_bf16(v1[0], v1[1]); w.w = cvt_pk_bf16(v1[2], v1[3]);
                    *(u32x4*)(base + (size_t)(row0 + ai * HALF + m * 16) * ld + col0 + bj * HALF) = w;
                }
    } else if (E.kind == EK_RESID) {
        const int cond = (u.pm < 16) ? 0 : 1 + ((u.pm - 16) >> 3);
        const float* gv = E.g + (size_t)cond * (4 * 9 * 1024);
        const int row0 = u.pm * BM + wr * 64 + fr, col0 = u.pn * BM + wc * 32 + 4 * fq;
        f32x4 g4[2][2];
#pragma unroll
        for (int bj = 0; bj < 2; ++bj)
#pragma unroll
            for (int n = 0; n < 2; ++n) g4[bj][n] = *(const f32x4*)(gv + col0 + bj * HALF + n * 16) * E.scale;
#pragma unroll
        for (int bj = 0; bj < 2; ++bj)
#pragma unroll
            for (int n = 0; n < 2; ++n) {
                const int col = col0 + bj * HALF + n * 16;
                f32x4 xv[2][4];
#pragma unroll
                for (int ai = 0; ai < 2; ++ai)
#pragma unroll
                    for (int m = 0; m < 4; ++m) xv[ai][m] = *(const f32x4*)(E.of + (size_t)(row0 + ai * HALF + m * 16) * DM + col);
#pragma unroll
                for (int ai = 0; ai < 2; ++ai)
#pragma unroll
                    for (int m = 0; m < 4; ++m) *(f32x4*)(E.of + (size_t)(row0 + ai * HALF + m * 16) * DM + col) = xv[ai][m] + g4[bj][n] * acc[ai][bj][m][n];
            }
    }
}

template <bool BR>
__device__ __forceinline__ void gemm_phase(LAS unsigned char* lds, const Gemm g, const Sched& S, const Epi& E, const bool perm) {
    const int tid = opaque_tid(), wid = __builtin_amdgcn_readfirstlane(tid >> 6), lane = tid & 63, wr = wid >> 2, wc = wid & 3, fr = lane & 15, fq = lane >> 4;
    const int K = g.K, nt = K / BK;
    const bool align = !(E.kind == EK_RESID);
    unsigned voffA[2], voffB[2];
#pragma unroll
    for (int i = 0; i < 2; ++i) { int R, C; stage_rc(tid * 16 + i * 8192, R, C); const int Rb = perm ? ((R & ~31) + perm32(R & 31)) : R;
        voffA[i] = (unsigned)(R * K + C) * 2u; voffB[i] = (unsigned)(Rb * K + C) * 2u; }
    const size_t kstep = (size_t)(BK * 2);
    const size_t hstep = (size_t)HALF * K * 2;
    const size_t tstep = 2 * hstep;
    const size_t bstep = BR ? hstep : tstep;
    const unsigned ldsw = (unsigned)wid * 1024u;
    const int aoff = lds_byte(wr * 64 + fr, fq * 8), boff = lds_byte(wc * 32 + fr, fq * 8);
#define PG8_SA(b, h) (((b) * 2 + (h)) * HTB)
#define PG8_SB(b, h) ((4 + (b) * 2 + (h)) * HTB)
#define PG8_STAGE(bufoff, gbase, voff) do { _Pragma("unroll") for (int _i = 0; _i < 2; ++_i) \
        __builtin_amdgcn_global_load_lds((const unsigned*)((const char*)(gbase) + (voff)[_i]), (LAS unsigned*)(lds + (bufoff) + ldsw + _i * 8192), 16, 0, 0); } while (0)
#define PG8_LDA(dst, b, h) do { _Pragma("unroll") for (int m = 0; m < 4; ++m) _Pragma("unroll") for (int k = 0; k < 2; ++k) dst[m][k] = *(const LAS bf16x8*)(lds + PG8_SA(b, h) + aoff + m * 2048 + k * 1024); } while (0)
#define PG8_LDB(dst, b, h) do { _Pragma("unroll") for (int n = 0; n < 2; ++n) _Pragma("unroll") for (int k = 0; k < 2; ++k) dst[n][k] = *(const LAS bf16x8*)(lds + PG8_SB(b, h) + boff + n * 2048 + k * 1024); } while (0)
#define PG8_MMA(ai, bj, At, Bt) do { __builtin_amdgcn_s_setprio(1); _Pragma("unroll") for (int m = 0; m < 4; ++m) _Pragma("unroll") for (int n = 0; n < 2; ++n) _Pragma("unroll") for (int k = 0; k < 2; ++k) \
        acc[ai][bj][m][n] = __builtin_amdgcn_mfma_f32_16x16x32_bf16(Bt[n][k], At[m][k], acc[ai][bj][m][n], 0, 0, 0); __builtin_amdgcn_s_setprio(0); } while (0)
#define PG8_WAIT_V(n) asm volatile("s_waitcnt vmcnt(" #n ")" ::: "memory")
#define PG8_WAIT_L(n) asm volatile("s_waitcnt lgkmcnt(" #n ")" ::: "memory")
#define PG8_BAR __builtin_amdgcn_s_barrier()
#define PG8_SCHED __builtin_amdgcn_sched_barrier(0)
    Unit cur, nxt; int ui = 0;
    if (!sched_next(S, 0, cur)) return;
    f32x4 acc[2][2][4][2];
#pragma unroll
    for (int a = 0; a < 2; ++a)
#pragma unroll
        for (int b = 0; b < 2; ++b)
#pragma unroll
            for (int m = 0; m < 4; ++m)
#pragma unroll
                for (int n = 0; n < 2; ++n) acc[a][b][m][n] = (f32x4){0.f, 0.f, 0.f, 0.f};
    bf16x8 At[4][2], B0[2][2], B1[2][2];
    const char* cA = (const char*)g.A + (size_t)cur.pm * tstep; const char* cB = (const char*)g.Bt + (size_t)cur.pn * bstep;
    PG8_STAGE(PG8_SB(0, 0), cB, voffB); PG8_STAGE(PG8_SB(0, 1), cB + hstep, voffB); PG8_STAGE(PG8_SA(0, 0), cA, voffA); PG8_STAGE(PG8_SA(0, 1), cA + hstep, voffA);
    if (wr == 1) PG8_BAR;
    PG8_WAIT_V(2); PG8_BAR;
    PG8_STAGE(PG8_SB(1, 0), cB + kstep, voffB); PG8_STAGE(PG8_SA(1, 0), cA + kstep, voffA); PG8_STAGE(PG8_SB(1, 1), cB + hstep + kstep, voffB);
    PG8_WAIT_V(6); PG8_BAR;
    for (;;) {
        const bool has_next = sched_next(S, ui + 1, nxt);
        const char* nA = has_next ? (const char*)g.A + (size_t)nxt.pm * tstep : cA; const char* nB = has_next ? (const char*)g.Bt + (size_t)nxt.pn * bstep : cB;
        for (int t = 0; t < nt; t += 2) {
            const bool last = (t == nt - 2);
            const char* a1 = cA + (size_t)(t + 1) * kstep;
            const char* a2 = last ? nA : cA + (size_t)(t + 2) * kstep; const char* b2 = last ? nB : cB + (size_t)(t + 2) * kstep;
            const char* a3 = a2 + kstep; const char* b3 = b2 + kstep;
            PG8_LDB(B0, 0, 0); PG8_LDB(B1, 0, 1); PG8_SCHED; PG8_LDA(At, 0, 0); PG8_STAGE(PG8_SA(1, 1), a1 + hstep, voffA);
            PG8_WAIT_V(8); PG8_WAIT_L(0); PG8_BAR; PG8_MMA(0, 0, At, B0); if (!BR) { PG8_MMA(0, 1, At, B1); } PG8_BAR; PG8_SCHED;
            PG8_LDA(At, 0, 1); PG8_STAGE(PG8_SB(0, 0), b2, voffB); PG8_STAGE(PG8_SB(0, 1), b2 + hstep, voffB); PG8_STAGE(PG8_SA(0, 0), a2, voffA);
            PG8_WAIT_V(8); PG8_WAIT_L(0); PG8_BAR; PG8_MMA(1, 0, At, B0); if (!BR) { PG8_MMA(1, 1, At, B1); } PG8_BAR; PG8_SCHED;
            PG8_LDB(B0, 1, 0); PG8_LDB(B1, 1, 1); PG8_SCHED; PG8_LDA(At, 1, 0); PG8_STAGE(PG8_SA(0, 1), a2 + hstep, voffA);
            PG8_WAIT_V(8); PG8_WAIT_L(0); PG8_BAR; PG8_MMA(0, 0, At, B0); if (!BR) { PG8_MMA(0, 1, At, B1); } PG8_BAR; PG8_SCHED;
            PG8_LDA(At, 1, 1); PG8_STAGE(PG8_SB(1, 0), b3, voffB); PG8_STAGE(PG8_SB(1, 1), b3 + hstep, voffB); PG8_STAGE(PG8_SA(1, 0), a3, voffA);
            PG8_WAIT_V(8); PG8_WAIT_L(0); PG8_BAR; PG8_MMA(1, 0, At, B0); if (!BR) { PG8_MMA(1, 1, At, B1); } PG8_BAR; PG8_SCHED;
        }
        if (align && wr == 0) PG8_BAR;
        epilogue<BR>(E, acc, cur, wr, wc, fr, fq);
        if (!has_next) break;
#pragma unroll
        for (int a = 0; a < 2; ++a)
#pragma unroll
            for (int b = 0; b < (BR ? 1 : 2); ++b)
#pragma unroll
                for (int m = 0; m < 4; ++m)
#pragma unroll
                    for (int n = 0; n < 2; ++n) acc[a][b][m][n] = (f32x4){0.f, 0.f, 0.f, 0.f};
        cur = nxt; cA = nA; cB = nB; ++ui;
        if (align && wr == 1) PG8_BAR;
    }
    PG8_WAIT_V(0);
    if (!align && wr == 0) PG8_BAR;
    PG8_BAR;
#undef PG8_SA
#undef PG8_SB
#undef PG8_STAGE
#undef PG8_LDA
#undef PG8_LDB
#undef PG8_MMA
#undef PG8_WAIT_V
#undef PG8_WAIT_L
#undef PG8_BAR
#undef PG8_SCHED
}
}


__device__ __forceinline__ void transpose_item(const float* W, int K, int N, bf16_t* WT, int dst_row0, LAS float* scr, int k0, int n0, int lane) {
    f32x4 v[16];
    const int rr = lane >> 4, cc = (lane & 15) * 4;
#pragma unroll
    for (int i = 0; i < 16; ++i) v[i] = *(const f32x4*)(W + (size_t)(k0 + 4 * i + rr) * N + n0 + cc);
#pragma unroll
    for (int i = 0; i < 16; ++i) { LAS float* d = scr + (4 * i + rr) * 65 + cc; d[0] = v[i][0]; d[1] = v[i][1]; d[2] = v[i][2]; d[3] = v[i][3]; }
    asm volatile("s_waitcnt lgkmcnt(0)" ::: "memory");
    const int c = lane & 7, r = lane >> 3;
#pragma unroll
    for (int j = 0; j < 8; ++j) { const int n = 8 * j + r; const LAS float* q = scr + (8 * c) * 65 + n;
        u32x4 o; o.x = cvt_pk_bf16(q[0], q[65]); o.y = cvt_pk_bf16(q[2 * 65], q[3 * 65]); o.z = cvt_pk_bf16(q[4 * 65], q[5 * 65]); o.w = cvt_pk_bf16(q[6 * 65], q[7 * 65]);
        *(u32x4*)(WT + (size_t)(dst_row0 + n) * K + k0 + 8 * c) = o; }
    asm volatile("s_waitcnt lgkmcnt(0)" ::: "memory");
}

__device__ __forceinline__ void prep_layer(const Ctx& p, LAS unsigned char* lds, int l, int bidx, int G, int part) {
    const int tid = opaque_tid(), lane = tid & 63, wave = tid >> 6;
    const int gw = bidx * 8 + wave, NGW = G * 8;
    unsigned char* ws = p.ws; unsigned char* wsw = p.ws + wbase(l);
    LAS float* scr = (LAS float*)(lds + wave * 16896);
    {
        constexpr int I_UP = 16 * 44, I_DN = 44 * 16, I_IN = 16 * 108, I_BR = 4 * 16, I_OUT = 16 * 16;
        constexpr int NIT = 4 * I_UP + 2 * I_DN + I_IN + 4 * I_BR + I_OUT;
        for (int it = gw; it < NIT; it += NGW) {
            int r = it;
            { const int cls = (r < 4 * I_UP) ? ((r < 2 * I_UP) ? 1 : 4) : ((r < 4 * I_UP + 2 * I_DN) ? ((r < 4 * I_UP + I_DN) ? 1 : 4) : 2); if (!(part & cls)) continue; }
            if (r < 4 * I_UP) {
                const int which = r / I_UP; r -= which * I_UP; const int kb = r / 44, nb = r % 44, n0 = nb * 64;
                const float* W = inp(p.ws, (which >> 1) ? ((which & 1) ? I_F2W3 : I_F2W1) : ((which & 1) ? I_F1W3 : I_F1W1)) + (size_t)l * DM * DFF;
                bf16_t* WT = (bf16_t*)(wsw + ((which >> 1) ? W_F2UP : W_F1UP));
                const int drow = 256 * (n0 >> 7) + (which & 1) * 128 + (n0 & 127);
                transpose_item(W, DM, DFF, WT, drow, scr, kb * 64, n0, lane); continue;
            }
            r -= 4 * I_UP;
            if (r < 2 * I_DN) {
                const int which = r / I_DN; r -= which * I_DN; const int kb = r / 16, nb = r % 16;
                const float* W = inp(p.ws, which ? I_F2W2 : I_F1W2) + (size_t)l * DFF * DM;
                bf16_t* WT = (bf16_t*)(wsw + (which ? W_F2DN : W_F1DN));
                transpose_item(W, DFF, DM, WT, nb * 64, scr, kb * 64, nb * 64, lane); continue;
            }
            r -= 2 * I_DN;
            if (r < I_IN) { const int kb = r / 108, nb = r % 108;
                transpose_item(inp(p.ws, I_WIN) + (size_t)l * DM * INW, DM, INW, (bf16_t*)(wsw + W_IN), nb * 64, scr, kb * 64, nb * 64, lane); continue; }
            r -= I_IN;
            if (r < 4 * I_BR) { const int bi = r / I_BR; r -= bi * I_BR; const int kb = r / 16, nb = r % 16;
                transpose_item(inp(p.ws, I_WBR) + ((size_t)l * 4 + bi) * 256 * DM, 256, DM, (bf16_t*)(wsw + W_BR) + (size_t)bi * 1024 * 256, nb * 64, scr, kb * 64, nb * 64, lane); continue; }
            r -= 4 * I_BR;
            { const int kb = r / 16, nb = r % 16;
              transpose_item(inp(p.ws, I_WOUT) + (size_t)l * DM * DM, DM, DM, (bf16_t*)(wsw + W_OUT), nb * 64, scr, kb * 64, nb * 64, lane); }
        }
    }
    if (!(part & 2)) return;
    {
        bf16_t* CK = (bf16_t*)(ws + WS_CK);
        const int gt = bidx * 512 + tid, NT = G * 512;
        for (int it = gt; it < 327680; it += NT) {
            int e = it * 8; const float* src; bf16_t* dst; int per_b;
            if (e < 1048576) { src = inp(p.ws, I_CNAK); dst = CK + CK_NA; per_b = 131072; }
            else if (e < 1572864) { e -= 1048576; src = inp(p.ws, I_CSWK); dst = CK + CK_SW; per_b = 65536; }
            else { e -= 1572864; src = inp(p.ws, I_CDFK); dst = CK + CK_DF; per_b = 131072; }
            const int b = e / per_b, r = e - b * per_b;
            const float* s = src + ((size_t)(b * 4 + l)) * per_b + r;
            const f32x4 v0 = *(const f32x4*)s, v1 = *(const f32x4*)(s + 4);
            u32x4 o; o.x = cvt_pk_bf16(v0[0], v0[1]); o.y = cvt_pk_bf16(v0[2], v0[3]); o.z = cvt_pk_bf16(v1[0], v1[1]); o.w = cvt_pk_bf16(v1[2], v1[3]);
            *(u32x4*)(dst + e) = o;
        }
    }
    {
        bf16_t* CV = (bf16_t*)(ws + WS_CK) + CK_HALF;
        for (int it = gw; it < 640; it += NGW) {
            int r = it; const float* src; bf16_t* dst; int H;
            if (r < 256) { src = inp(p.ws, I_CNAV); dst = CV + CK_NA; H = 4; }
            else if (r < 384) { r -= 256; src = inp(p.ws, I_CSWV); dst = CV + CK_SW; H = 2; }
            else { r -= 384; src = inp(p.ws, I_CDFV); dst = CV + CK_DF; H = 4; }
            const int kb = r & 7, bh = r >> 3, b = bh / H, h = bh - b * H;
            transpose_item(src + ((size_t)(b * 4 + l) * H + h) * 512 * 64, 512, 64, dst + (size_t)bh * 64 * 512, 0, scr, kb * 64, 0, lane);
        }
    }
    __syncthreads();
    {
        LAS float* Z = (LAS float*)lds;
        LAS float* G1 = Z + 8 * 33;
        LAS float* G2 = G1 + 8 * 64;
        float* HF = (float*)(ws + WS_HFIL);
        const float* w1 = inp(p.ws, I_HW1) + (size_t)l * 33 * 64; const float* b1 = inp(p.ws, I_HB1) + l * 64;
        const float* w2 = inp(p.ws, I_HW2) + (size_t)l * 64 * 64; const float* b2 = inp(p.ws, I_HB2) + l * 64;
        const float* w3 = inp(p.ws, I_HW3) + (size_t)l * 64 * 1024; const float* sf = inp(p.ws, I_HSF) + l * 64; const float* ld = inp(p.ws, I_HLD) + l * 1024;
        for (int it = bidx; it < 288; it += G) {
            const int Lsel = it >= 32, L = Lsel ? 2048 : 256, n0 = (Lsel ? it - 32 : it) * 8;
            const float invL = 1.f / (float)L;
            if (tid < 8 * 33) { const int nn = tid / 33, i = tid - nn * 33; const float tn = (float)(n0 + nn) * invL; float v;
                if (i == 0) v = tn; else if (i <= 16) v = __cosf(6.283185307179586f * tn * (float)i); else v = __sinf(6.283185307179586f * tn * (float)(i - 16));
                Z[nn * 33 + i] = v; }
            __syncthreads();
            { const int nn = tid >> 6, j = tid & 63; float a = b1[j];
#pragma unroll 11
              for (int i = 0; i < 33; ++i) a += Z[nn * 33 + i] * w1[i * 64 + j];
              G1[nn * 64 + j] = __sinf(sf[j] * a); }
            __syncthreads();
            { const int nn = tid >> 6, j = tid & 63; float a = b2[j];
#pragma unroll 16
              for (int i = 0; i < 64; ++i) a += G1[nn * 64 + i] * w2[i * 64 + j];
              G2[nn * 64 + j] = __sinf(sf[j] * a); }
            __syncthreads();
#pragma unroll 1
            for (int cc = 0; cc < 2; ++cc) {
                const int col = cc * 512 + tid;
                float a[8];
#pragma unroll
                for (int nn = 0; nn < 8; ++nn) a[nn] = 0.f;
#pragma unroll 16
                for (int i = 0; i < 64; ++i) { const float w = w3[i * 1024 + col];
#pragma unroll
                    for (int nn = 0; nn < 8; ++nn) a[nn] += G2[nn * 64 + i] * w; }
                const float rate = __expf(ld[col]);
#pragma unroll
                for (int nn = 0; nn < 8; ++nn) a[nn] *= __expf(-rate * (float)(n0 + nn) * invL);
                float* o = HF + (Lsel ? 262144 : 0) + (size_t)col * L + n0;
                *(f32x4*)o = (f32x4){a[0], a[1], a[2], a[3]}; *(f32x4*)(o + 4) = (f32x4){a[4], a[5], a[6], a[7]};
            }
            __syncthreads();
        }
    }
    if (bidx == 0 && tid == 0) {
        const float* lv = inp(p.ws, I_DLAM) + l * 128; float s01 = 0.f, s23 = 0.f;
        for (int i = 0; i < 32; ++i) { s01 += lv[i] * lv[32 + i]; s23 += lv[64 + i] * lv[96 + i]; }
        float c08; asm volatile("v_mov_b32 %0, 0x3f4ccccd" : "=v"(c08));
        const float lam_init = c08 - 0.6f * __expf(-0.3f * (float)l);
        ((float*)(ws + WS_LAM))[l] = __expf(s01) - __expf(s23) + lam_init; ((float*)(ws + WS_LAM))[4 + l] = lam_init;
    }
}

__device__ __forceinline__ void prep_mod(const Ctx& p, LAS unsigned char* lds) {
    const int tid = opaque_tid(), lane = tid & 63, wave = tid >> 6;
    const int G = gridDim.x;
    LAS float* SC = (LAS float*)lds;
    LAS float* PART = (LAS float*)(lds + 40960);
    for (int i = tid; i < 9 * 1024; i += 512) { const float v = (i < 1024) ? inp(p.ws, I_CCTX)[i] : inp(p.ws, I_C)[i - 1024]; SC[i] = v * sigmoidf_(v); }
    __syncthreads();
    float* mod = (float*)(p.ws + WS_MOD);
    for (int it = blockIdx.x; it < 4 * 36; it += G) {
        const int cb = it % 36, l = it / 36;
        const int col = cb * 256 + lane * 4, k0 = wave * 128;
        const float* W = inp(p.ws, I_WADA) + ((size_t)l * DM + k0) * 9216 + col;
        f32x4 a[9];
#pragma unroll
        for (int c = 0; c < 9; ++c) a[c] = (f32x4){0.f, 0.f, 0.f, 0.f};
#pragma unroll 16
        for (int k = 0; k < 128; ++k) { const f32x4 w = *(const f32x4*)(W + (size_t)k * 9216);
#pragma unroll
            for (int c = 0; c < 9; ++c) a[c] += w * SC[c * 1024 + k0 + k]; }
#pragma unroll
        for (int c = 0; c < 9; ++c) *(LAS f32x4*)(PART + (wave * 9 + c) * 256 + lane * 4) = a[c];
        __syncthreads();
        for (int o = tid; o < 9 * 256; o += 512) { const int c = o >> 8, cc = o & 255;
            float v = inp(p.ws, I_BADA)[(size_t)l * 9216 + cb * 256 + cc];
#pragma unroll
            for (int w = 0; w < 8; ++w) v += PART[(w * 9 + c) * 256 + cc];
            mod[((size_t)(c * 4 + l)) * 9216 + cb * 256 + cc] = v; }
        __syncthreads();
    }
}

__device__ __forceinline__ void norm_phase(const Ctx& p, int l, int which  ) {
    const int tid_ = opaque_tid(), lane = tid_ & 63, wave = tid_ >> 6, gw = blockIdx.x * 8 + wave, NGW = gridDim.x * 8;
    float* X = (float*)(p.ws + WS_X); bf16_t* ACT = (bf16_t*)(p.ws + WS_ACT);
    const float* gsrc = inp(p.ws, which == 0 ? I_NF1 : (which == 1 ? I_NMIX : I_NF2)) + l * DM;
    const bool from_in = (l == 0 && which == 0);
    f32x4 gv[4];
#pragma unroll
    for (int j = 0; j < 4; ++j) gv[j] = *(const f32x4*)(gsrc + j * 256 + lane * 4);
    constexpr int NR = 4;
    for (int row0 = gw * NR; row0 < M_TOT; row0 += NGW * NR) {
        f32x4 v[NR][4]; float s[NR];
#pragma unroll
        for (int r = 0; r < NR; ++r) {
            const int row = row0 + r;
            const float* xr = from_in ? (row < M_CTX ? inp(p.ws, I_XP) + (size_t)row * DM : inp(p.ws, I_XS) + (size_t)(row - M_CTX) * DM) : X + (size_t)row * DM;
#pragma unroll
            for (int j = 0; j < 4; ++j) v[r][j] = *(const f32x4*)(xr + j * 256 + lane * 4);
        }
        const int cond = cond_of_row(row0);
        const float* sh = mod_ptr(p.ws, cond, l, which * 3 + 0); const float* sc = mod_ptr(p.ws, cond, l, which * 3 + 1);
        f32x4 s4[4], h4[4];
#pragma unroll
        for (int j = 0; j < 4; ++j) { s4[j] = *(const f32x4*)(sc + j * 256 + lane * 4) + 1.f; h4[j] = *(const f32x4*)(sh + j * 256 + lane * 4); }
#pragma unroll
        for (int r = 0; r < NR; ++r) { float a = 0.f;
#pragma unroll
            for (int j = 0; j < 4; ++j) a += (v[r][j][0] * v[r][j][0] + v[r][j][1] * v[r][j][1]) + (v[r][j][2] * v[r][j][2] + v[r][j][3] * v[r][j][3]);
            s[r] = a; }
        if (from_in) {
#pragma unroll
            for (int r = 0; r < NR; ++r)
#pragma unroll
                for (int j = 0; j < 4; ++j) *(f32x4*)(X + (size_t)(row0 + r) * DM + j * 256 + lane * 4) = v[r][j];
        }
#pragma unroll
        for (int o = 1; o < 64; o <<= 1) {
#pragma unroll
            for (int r = 0; r < NR; ++r) s[r] += __shfl_xor(s[r], o);
        }
#pragma unroll
        for (int r = 0; r < NR; ++r) {
            const float rstd = rsqrtf(s[r] * (1.f / DM) + EPSF);
#pragma unroll
            for (int j = 0; j < 4; ++j) {
                const f32x4 o = (v[r][j] * rstd) * gv[j] * s4[j] + h4[j];
                u32x2 w; w.x = cvt_pk_bf16(o[0], o[1]); w.y = cvt_pk_bf16(o[2], o[3]);
                *(u32x2*)(ACT + (size_t)(row0 + r) * DM + j * 256 + lane * 4) = w;
            }
        }
    }
}
__device__ __forceinline__ void final_norm_phase(const Ctx& p) {
    const int tid_ = opaque_tid(), lane = tid_ & 63, wave = tid_ >> 6, gw = blockIdx.x * 8 + wave, NGW = gridDim.x * 8;
    const float* X = (const float*)(p.ws + WS_X); const float* gsrc = inp(p.ws, I_FNORM);
    f32x4 gv[4];
#pragma unroll
    for (int j = 0; j < 4; ++j) gv[j] = *(const f32x4*)(gsrc + j * 256 + lane * 4);
    constexpr int NR = 4;
    for (int row0 = gw * NR; row0 < M_TOT; row0 += NGW * NR) {
        f32x4 v[NR][4]; float s[NR];
#pragma unroll
        for (int r = 0; r < NR; ++r) { const float* xr = X + (size_t)(row0 + r) * DM;
#pragma unroll
            for (int j = 0; j < 4; ++j) v[r][j] = *(const f32x4*)(xr + j * 256 + lane * 4); }
#pragma unroll
        for (int r = 0; r < NR; ++r) { float a = 0.f;
#pragma unroll
            for (int j = 0; j < 4; ++j) a += (v[r][j][0] * v[r][j][0] + v[r][j][1] * v[r][j][1]) + (v[r][j][2] * v[r][j][2] + v[r][j][3] * v[r][j][3]);
            s[r] = a; }
#pragma unroll
        for (int o = 1; o < 64; o <<= 1) {
#pragma unroll
            for (int r = 0; r < NR; ++r) s[r] += __shfl_xor(s[r], o);
        }
#pragma unroll
        for (int r = 0; r < NR; ++r) { const float rstd = rsqrtf(s[r] * (1.f / DM) + EPSF);
#pragma unroll
            for (int j = 0; j < 4; ++j) *(f32x4*)(p.out + O_Y + (size_t)(row0 + r) * DM + j * 256 + lane * 4) = (v[r][j] * rstd) * gv[j]; }
    }
}

__device__ __forceinline__ void mixprep_phase(const Ctx& p, LAS unsigned char* lds, int l) {
    const int tid = opaque_tid(), G = gridDim.x;
    bf16_t* PROJ = (bf16_t*)(p.ws + WS_PROJ); bf16_t* TR = (bf16_t*)(p.ws + WS_TR);
    {
        const int lane = tid & 63, wave = tid >> 6, gw = blockIdx.x * 8 + wave, NGW = G * 8;
        LAS float* T = (LAS float*)(lds + wave * 17168);
        const float* sw = inp(p.ws, I_HSW) + (size_t)l * 3 * 768; const float* sb = inp(p.ws, I_HSB) + (size_t)l * 768;
        const int lr = lane >> 3, lc = lane & 7;
        for (int it = gw; it < 320 * 22; it += NGW) {
            const int cb = it % 22, rb = it / 22, row0 = rb * 64, tcol0 = cb * 64;
            int src; bool hy = false;
            if (tcol0 < 256) src = 512 + tcol0; else if (tcol0 < 384) src = 1152 + (tcol0 - 256); else if (tcol0 < 640) src = 2560 + (tcol0 - 384); else { src = 1280 + (tcol0 - 640); hy = true; }
            const bool seq_start = row0 < M_CTX ? ((row0 & 255) == 0) : (((row0 - M_CTX) & 2047) == 0);
            const int rend = row0 + 64; const bool seq_end = rend <= M_CTX ? ((rend & 255) == 0) : (((rend - M_CTX) & 2047) == 0);
            const bf16_t* sp = PROJ + (size_t)row0 * PROJW + src + lc * 8;
            u32x4 w[8], wh = (u32x4){0u, 0u, 0u, 0u};
#pragma unroll
            for (int i = 0; i < 8; ++i) w[i] = *(const u32x4*)(sp + (size_t)(i * 8 + lr) * PROJW);
            if (hy && lane < 16) { const bool top = lane < 8; const bool ok = top ? !seq_start : !seq_end;
                if (ok) wh = *(const u32x4*)(sp + (top ? -(ptrdiff_t)PROJW : (ptrdiff_t)64 * PROJW)); }
#pragma unroll
            for (int i = 0; i < 8; ++i) { LAS float* d = T + (1 + i * 8 + lr) * 65 + lc * 8;
                d[0] = bflo(w[i].x); d[1] = bfhi(w[i].x); d[2] = bflo(w[i].y); d[3] = bfhi(w[i].y); d[4] = bflo(w[i].z); d[5] = bfhi(w[i].z); d[6] = bflo(w[i].w); d[7] = bfhi(w[i].w); }
            if (hy && lane < 16) { LAS float* d = T + (lane < 8 ? 0 : 65) * 65 + lc * 8;
                d[0] = bflo(wh.x); d[1] = bfhi(wh.x); d[2] = bflo(wh.y); d[3] = bfhi(wh.y); d[4] = bflo(wh.z); d[5] = bfhi(wh.z); d[6] = bflo(wh.w); d[7] = bfhi(wh.w); }
            asm volatile("s_waitcnt lgkmcnt(0)" ::: "memory");
            const int rg = lane & 7, csub = lane >> 3;
#pragma unroll 2
            for (int j = 0; j < 8; ++j) {
                const int col = j * 8 + csub; float o[8];
                const LAS float* tp = T + (rg * 8) * 65 + col;
                if (hy) { const int ch = tcol0 - 640 + col; const float w0 = sw[ch], w1 = sw[768 + ch], w2 = sw[1536 + ch], bb = sb[ch];
                    float x[10];
#pragma unroll
                    for (int k = 0; k < 10; ++k) x[k] = tp[k * 65];
#pragma unroll
                    for (int k = 0; k < 8; ++k) o[k] = x[k] * w0 + x[k + 1] * w1 + x[k + 2] * w2 + bb;
                } else {
#pragma unroll
                    for (int k = 0; k < 8; ++k) o[k] = tp[(k + 1) * 65];
                }
                u32x4 ww; ww.x = cvt_pk_bf16(o[0], o[1]); ww.y = cvt_pk_bf16(o[2], o[3]); ww.z = cvt_pk_bf16(o[4], o[5]); ww.w = cvt_pk_bf16(o[6], o[7]);
                *(u32x4*)(TR + (size_t)(tcol0 + col) * M_TOT + row0 + rg * 8) = ww;
            }
            asm volatile("s_waitcnt lgkmcnt(0)" ::: "memory");
        }
    }
    const int gt = blockIdx.x * 512 + tid, NT = G * 512;
    for (int it = gt; it < M_CTX * 160; it += NT) {
        const int row = it / 160, ch = it - row * 160; int pc, H; size_t ob; int c8;
        if (ch < 32) { pc = 256; H = 4; ob = O_NAK; c8 = ch * 8; }
        else if (ch < 64) { pc = 512; H = 4; ob = O_NAV; c8 = (ch - 32) * 8; }
        else if (ch < 80) { pc = 1024; H = 2; ob = O_SWK; c8 = (ch - 64) * 8; }
        else if (ch < 96) { pc = 1152; H = 2; ob = O_SWV; c8 = (ch - 80) * 8; }
        else if (ch < 128) { pc = 2304; H = 4; ob = O_DFK; c8 = (ch - 96) * 8; }
        else { pc = 2560; H = 4; ob = O_DFV; c8 = (ch - 128) * 8; }
        const u32x4 w = *(const u32x4*)(PROJ + (size_t)row * PROJW + pc + c8);
        const int b = row >> 8, t = row & 255, h = c8 >> 6, d = c8 & 63;
        float* o = p.out + ob + ((((size_t)(b * 4 + l) * H + h) * 256 + t) * 64 + d);
        *(f32x4*)o = (f32x4){bflo(w.x), bfhi(w.x), bflo(w.y), bfhi(w.y)}; *(f32x4*)(o + 4) = (f32x4){bflo(w.z), bfhi(w.z), bflo(w.w), bfhi(w.w)};
    }
    for (int it = gt; it < M_DEC * 56; it += NT) {
        const int rowd = it / 56, q = it - rowd * 56, t = rowd & 2047, gr = t >> 6, gc = t & 63;
        int a, bofs, i0; float pos, fstep;
        if (q < 24) {
            const int base = q < 16 ? 768 : 1024, qq = q < 16 ? q : q - 16, h = qq >> 2, half = (qq >> 1) & 1, grp = qq & 1;
            a = base + h * 64 + half * 32 + grp * 8; bofs = 16; i0 = grp * 8; pos = half ? (float)gc : (float)gr; fstep = 13.287712379549449f / 16.f;
        } else {
            const int base = q < 40 ? 2048 : 2304, qq = q < 40 ? q - 24 : q - 40, mp32 = qq >> 1, half = qq & 1;
            a = base + mp32 * 32 + half * 16; bofs = 8; i0 = 0; pos = half ? (float)gc : (float)gr; fstep = 13.287712379549449f / 8.f;
        }
        bf16_t* pa = PROJ + (size_t)(M_CTX + rowd) * PROJW + a;
        const u32x4 wa = *(const u32x4*)pa, wb = *(const u32x4*)(pa + bofs);
        float xa[8], xb[8];
        xa[0] = bflo(wa.x); xa[1] = bfhi(wa.x); xa[2] = bflo(wa.y); xa[3] = bfhi(wa.y); xa[4] = bflo(wa.z); xa[5] = bfhi(wa.z); xa[6] = bflo(wa.w); xa[7] = bfhi(wa.w);
        xb[0] = bflo(wb.x); xb[1] = bfhi(wb.x); xb[2] = bflo(wb.y); xb[3] = bfhi(wb.y); xb[4] = bflo(wb.z); xb[5] = bfhi(wb.z); xb[6] = bflo(wb.w); xb[7] = bfhi(wb.w);
        float oa[8], ob[8];
#pragma unroll
        for (int j = 0; j < 8; ++j) { const float ang = pos * fast_exp2(-(float)(i0 + j) * fstep); const float cs = __cosf(ang), sn = __sinf(ang);
            oa[j] = xa[j] * cs - xb[j] * sn; ob[j] = xb[j] * cs + xa[j] * sn; }
        u32x4 ra, rb;
        ra.x = cvt_pk_bf16(oa[0], oa[1]); ra.y = cvt_pk_bf16(oa[2], oa[3]); ra.z = cvt_pk_bf16(oa[4], oa[5]); ra.w = cvt_pk_bf16(oa[6], oa[7]);
        rb.x = cvt_pk_bf16(ob[0], ob[1]); rb.y = cvt_pk_bf16(ob[2], ob[3]); rb.z = cvt_pk_bf16(ob[4], ob[5]); rb.w = cvt_pk_bf16(ob[6], ob[7]);
        *(u32x4*)pa = ra; *(u32x4*)(pa + bofs) = rb;
    }
}

struct AttnState { float m, l; f32x4 o[4]; };
__device__ __forceinline__ f32x4 mfma16(bf16x8 a, bf16x8 b, f32x4 c) { return __builtin_amdgcn_mfma_f32_16x16x32_bf16(a, b, c, 0, 0, 0); }

__device__ __forceinline__ float xmax16(float x) { const u32x2 r = __builtin_amdgcn_permlane16_swap(__float_as_uint(x), __float_as_uint(x), false, false); return fmaxf(__uint_as_float(r.x), __uint_as_float(r.y)); }
__device__ __forceinline__ float xmax32(float x) { const u32x2 r = __builtin_amdgcn_permlane32_swap(__float_as_uint(x), __float_as_uint(x), false, false); return fmaxf(__uint_as_float(r.x), __uint_as_float(r.y)); }
__device__ __forceinline__ float xadd16(float x) { const u32x2 r = __builtin_amdgcn_permlane16_swap(__float_as_uint(x), __float_as_uint(x), false, false); return __uint_as_float(r.x) + __uint_as_float(r.y); }
__device__ __forceinline__ float xadd32(float x) { const u32x2 r = __builtin_amdgcn_permlane32_swap(__float_as_uint(x), __float_as_uint(x), false, false); return __uint_as_float(r.x) + __uint_as_float(r.y); }
__device__ __forceinline__ void softmax_d16(AttnState& st, float (&s)[16], bool first, float& alpha, bool& resc, bf16x8& p0, bf16x8& p1) {
    float mx = fmaxf(fmaxf(fmaxf(s[0], s[1]), fmaxf(s[2], s[3])), fmaxf(fmaxf(s[4], s[5]), fmaxf(s[6], s[7])));
    mx = fmaxf(mx, fmaxf(fmaxf(fmaxf(s[8], s[9]), fmaxf(s[10], s[11])), fmaxf(fmaxf(s[12], s[13]), fmaxf(s[14], s[15]))));
    resc = first || (__builtin_amdgcn_ballot_w64(mx > 8.f) != 0ull);
    alpha = 1.f;
    if (resc) {
        mx = xmax16(mx); mx = xmax32(mx);
        const float d = first ? mx : fmaxf(mx, 0.f);
        alpha = first ? 0.f : fast_exp2(-d);
        st.m = first ? mx : st.m + d;
#pragma unroll
        for (int j = 0; j < 16; ++j) s[j] -= d;
    }
    float pr[16];
#pragma unroll
    for (int j = 0; j < 16; ++j) pr[j] = fast_exp2(s[j]);
    float sum = (((pr[0] + pr[1]) + (pr[2] + pr[3])) + ((pr[4] + pr[5]) + (pr[6] + pr[7]))) + (((pr[8] + pr[9]) + (pr[10] + pr[11])) + ((pr[12] + pr[13]) + (pr[14] + pr[15])));
    sum = xadd16(sum); sum = xadd32(sum);
    st.l = st.l * alpha + sum;
    u32x4 w0, w1;
    w0.x = cvt_pk_bf16(pr[0], pr[1]); w0.y = cvt_pk_bf16(pr[2], pr[3]); w0.z = cvt_pk_bf16(pr[4], pr[5]); w0.w = cvt_pk_bf16(pr[6], pr[7]);
    w1.x = cvt_pk_bf16(pr[8], pr[9]); w1.y = cvt_pk_bf16(pr[10], pr[11]); w1.z = cvt_pk_bf16(pr[12], pr[13]); w1.w = cvt_pk_bf16(pr[14], pr[15]);
    p0 = __builtin_bit_cast(bf16x8, w0); p1 = __builtin_bit_cast(bf16x8, w1);
}
__device__ __forceinline__ bf16x8 softmax_p(AttnState& st, const float (&s2)[8], unsigned vm, float& alpha) {
    float mx = -1e30f;
#pragma unroll
    for (int j = 0; j < 8; ++j) mx = fmaxf(mx, ((vm >> j) & 1u) ? s2[j] : -1e30f);
    mx = xmax16(mx); mx = xmax32(mx);
    const float mn = fmaxf(st.m, mx); alpha = fast_exp2(st.m - mn);
    float pr[8]; float sum = 0.f;
#pragma unroll
    for (int j = 0; j < 8; ++j) { pr[j] = ((vm >> j) & 1u) ? fast_exp2(s2[j] - mn) : 0.f; sum += pr[j]; }
    sum += __shfl_xor(sum, 16); sum += __shfl_xor(sum, 32);
    st.l = st.l * alpha + sum; st.m = mn;
    u32x4 pw; pw.x = cvt_pk_bf16(pr[0], pr[1]); pw.y = cvt_pk_bf16(pr[2], pr[3]); pw.z = cvt_pk_bf16(pr[4], pr[5]); pw.w = cvt_pk_bf16(pr[6], pr[7]);
    return __builtin_bit_cast(bf16x8, pw);
}
__device__ __forceinline__ bf16x8 softmax_d(AttnState& st, const float (&s2)[8], float& alpha, bool& resc) {
    float mx = fmaxf(fmaxf(fmaxf(s2[0], s2[1]), fmaxf(s2[2], s2[3])), fmaxf(fmaxf(s2[4], s2[5]), fmaxf(s2[6], s2[7])));
    mx = fmaxf(mx, __shfl_xor(mx, 16)); mx = fmaxf(mx, __shfl_xor(mx, 32));
    const float mn = fmaxf(st.m, mx);
    resc = __builtin_amdgcn_ballot_w64(mn > st.m) != 0ull;
    alpha = fast_exp2(st.m - mn);
    float pr[8];
#pragma unroll
    for (int j = 0; j < 8; ++j) pr[j] = fast_exp2(s2[j] - mn);
    float sum = ((pr[0] + pr[1]) + (pr[2] + pr[3])) + ((pr[4] + pr[5]) + (pr[6] + pr[7]));
    sum = xadd16(sum); sum = xadd32(sum);
    st.l = st.l * alpha + sum; st.m = mn;
    u32x4 pw; pw.x = cvt_pk_bf16(pr[0], pr[1]); pw.y = cvt_pk_bf16(pr[2], pr[3]); pw.z = cvt_pk_bf16(pr[4], pr[5]); pw.w = cvt_pk_bf16(pr[6], pr[7]);
    return __builtin_bit_cast(bf16x8, pw);
}
__device__ __forceinline__ void st_init(AttnState& st, float m0, float l0) { st.m = m0; st.l = l0;
#pragma unroll
    for (int i = 0; i < 4; ++i) st.o[i] = (f32x4){0.f, 0.f, 0.f, 0.f}; }

constexpr int AT_ROWB = 144;
constexpr int AT_TILEB = 64 * AT_ROWB;
struct ATC { int l15, quad, kr0, lat0, nlat, rs_w, r_w; int cg4[2], qc[2], c0[2], qt[2], q0[2]; bool dec; const float* rpb; };

template <int TYPE>
__device__ __forceinline__ void attn_tile(AttnState (&sa)[2], AttnState (&sb)[2], const bf16x8 (&qf)[2][2], const ATC& c, const LAS unsigned char* kt, const LAS unsigned char* vt, int i) {
    const bool masked = c.dec && (i < c.nlat) && (TYPE != 2);
    if (TYPE == 0 && masked) { const int krow = c.lat0 + i; if (!((krow >= c.rs_w) && (krow < c.rs_w + 8))) return; }
    const f32x4 z4 = (f32x4){0.f, 0.f, 0.f, 0.f};
    if (!masked) {
        bf16x8 pA[2][2], pB[2][2]; float alA[2], alB[2]; bool rA[2], rB[2];
        const bool first = (TYPE != 1) && (i == 0);
        if (TYPE == 2) {
#pragma unroll
            for (int qi = 0; qi < 2; ++qi)
#pragma unroll
                for (int mp = 0; mp < 2; ++mp) {
                    float s2[16];
#pragma unroll
                    for (int ss = 0; ss < 2; ++ss)
#pragma unroll
                        for (int t = 0; t < 2; ++t) { const int kr = ss * 32 + c.kr0 + 4 * t, sw = ((kr >> 4) & 1) << 2;
                            const bf16x8 kf = *(const LAS bf16x8*)(kt + kr * AT_ROWB + (((mp * 4 + c.quad) ^ sw) << 4));
                            const float nm = first ? 0.f : -(mp == 0 ? sa[qi].m : sb[qi].m);
                            const f32x4 a = mfma16(kf, qf[qi][mp], (f32x4){nm, nm, nm, nm});
#pragma unroll
                            for (int e = 0; e < 4; ++e) s2[ss * 8 + t * 4 + e] = a[e]; }
                    if (mp == 0) softmax_d16(sa[qi], s2, first, alA[qi], rA[qi], pA[qi][0], pA[qi][1]); else softmax_d16(sb[qi], s2, first, alB[qi], rB[qi], pB[qi][0], pB[qi][1]);
                    asm volatile("" ::: "memory");
                }
        } else {
            bf16x8 kf[2][2][2];
#pragma unroll
            for (int ss = 0; ss < 2; ++ss)
#pragma unroll
                for (int t = 0; t < 2; ++t) { const int kr = ss * 32 + c.kr0 + 4 * t, sw = ((kr >> 4) & 1) << 2;
#pragma unroll
                    for (int cc = 0; cc < 2; ++cc) kf[ss][t][cc] = *(const LAS bf16x8*)(kt + kr * AT_ROWB + (((cc * 4 + c.quad) ^ sw) << 4)); }
#pragma unroll
            for (int qi = 0; qi < 2; ++qi) {
                float s2[16];
#pragma unroll
                for (int ss = 0; ss < 2; ++ss)
#pragma unroll
                    for (int t = 0; t < 2; ++t) { const float nm = first ? 0.f : -sa[qi].m; f32x4 a = mfma16(kf[ss][t][0], qf[qi][0], (f32x4){nm, nm, nm, nm}); a = mfma16(kf[ss][t][1], qf[qi][1], a);
#pragma unroll
                        for (int e = 0; e < 4; ++e) s2[ss * 8 + t * 4 + e] = a[e]; }
                softmax_d16(sa[qi], s2, first, alA[qi], rA[qi], pA[qi][0], pA[qi][1]);
            }
        }
#pragma unroll
        for (int qi = 0; qi < 2; ++qi) {
            if (rA[qi]) {
#pragma unroll
                for (int nt = 0; nt < 4; ++nt) sa[qi].o[nt] = sa[qi].o[nt] * alA[qi]; }
            if (TYPE == 2) { if (rB[qi]) {
#pragma unroll
                for (int nt = 0; nt < 4; ++nt) sb[qi].o[nt] = sb[qi].o[nt] * alB[qi]; } }
        }
#pragma unroll
        for (int ss = 0; ss < 2; ++ss) {
            bf16x8 vf[4];
#pragma unroll
            for (int nt = 0; nt < 4; ++nt) vf[nt] = *(const LAS bf16x8*)(vt + (nt * 16 + c.l15) * AT_ROWB + ss * 64 + (c.quad << 4));
#pragma unroll
            for (int qi = 0; qi < 2; ++qi)
#pragma unroll
                for (int nt = 0; nt < 4; ++nt) { sa[qi].o[nt] = mfma16(vf[nt], pA[qi][ss], sa[qi].o[nt]); if (TYPE == 2) sb[qi].o[nt] = mfma16(vf[nt], pB[qi][ss], sb[qi].o[nt]); }
        }
        return;
    }
#pragma unroll 1
    for (int ss = 0; ss < 2; ++ss) {
        bool on[2];
#pragma unroll
        for (int qi = 0; qi < 2; ++qi) {
            on[qi] = true;
            if (TYPE == 0) on[qi] = !((c.cg4[qi] == 0 && ss == 1) || (c.cg4[qi] == 3 && ss == 0));
            if (TYPE == 1) { const int k0 = (c.lat0 + i) * 64 + ss * 32; on[qi] = (k0 + 31 >= c.q0[qi] - 128) && (k0 <= c.q0[qi] + 15 + 128); }
        }
        if (on[0] || on[1]) {
            const int krA = ss * 32 + c.kr0, krB = krA + 4;
            const int swA = ((krA >> 4) & 1) << 2, swB = ((krB >> 4) & 1) << 2;
            bf16x8 kf[2][2];
#pragma unroll
            for (int cc = 0; cc < 2; ++cc) { kf[0][cc] = *(const LAS bf16x8*)(kt + krA * AT_ROWB + (((cc * 4 + c.quad) ^ swA) << 4)); kf[1][cc] = *(const LAS bf16x8*)(kt + krB * AT_ROWB + (((cc * 4 + c.quad) ^ swB) << 4)); }
            bf16x8 vf[4];
#pragma unroll
            for (int nt = 0; nt < 4; ++nt) vf[nt] = *(const LAS bf16x8*)(vt + (nt * 16 + c.l15) * AT_ROWB + ss * 64 + (c.quad << 4));
#pragma unroll
            for (int qi = 0; qi < 2; ++qi) {
                if (on[qi]) {
                    f32x4 a0 = mfma16(kf[0][0], qf[qi][0], z4), a1 = mfma16(kf[1][0], qf[qi][0], z4); a0 = mfma16(kf[0][1], qf[qi][1], a0); a1 = mfma16(kf[1][1], qf[qi][1], a1);
                    float s2[8]; unsigned vm = 0u;
#pragma unroll
                    for (int e = 0; e < 4; ++e) { s2[e] = a0[e]; s2[4 + e] = a1[e]; }
                    if (TYPE == 0) {
                        const float* rp = c.rpb + (c.lat0 + i - c.r_w + 7) * 31;
#pragma unroll
                        for (int j = 0; j < 8; ++j) { const int kc = ss * 32 + c.quad * 8 + j; const bool ok = (kc >= c.c0[qi]) && (kc < c.c0[qi] + 16);
                            const int dc = min(max(kc - c.qc[qi] + 15, 0), 30); s2[j] = s2[j] + rp[dc] * LOG2E; vm |= ok ? (1u << j) : 0u; }
                    } else {
#pragma unroll
                        for (int j = 0; j < 8; ++j) { const int dd = (c.lat0 + i) * 64 + ss * 32 + c.quad * 8 + j - c.qt[qi]; const bool ok = (dd <= 128) && (dd >= -128); vm |= ok ? (1u << j) : 0u; }
                    }
                    float al; const bf16x8 pA = softmax_p(sa[qi], s2, vm, al);
#pragma unroll
                    for (int nt = 0; nt < 4; ++nt) sa[qi].o[nt] = mfma16(vf[nt], pA, sa[qi].o[nt] * al);
                }
            }
        }
    }
}

template <int TYPE>
__device__ __forceinline__ void attn_block(const Ctx& p, LAS unsigned char* lds, int l, bool dec, int b, int h, int qblk) {
    const int tid = opaque_tid(), lane = tid & 63, wave = __builtin_amdgcn_readfirstlane(tid >> 6);
    ATC c; c.l15 = lane & 15; c.quad = lane >> 4; c.dec = dec;
    const bf16_t* PROJ = (const bf16_t*)(p.ws + WS_PROJ); const bf16_t* TR = (const bf16_t*)(p.ws + WS_TR);
    const bf16_t* CK = (const bf16_t*)(p.ws + WS_CK); const bf16_t* CV = CK + CK_HALF;
    bf16_t* BR = (bf16_t*)(p.ws + WS_BR);
    const int L = dec ? 2048 : 256, rowbase = dec ? M_CTX + b * 2048 : b * 256, q0 = qblk * 256 + wave * 32;
    const bf16_t* Pb = PROJ + (size_t)rowbase * PROJW;
    LAS unsigned char* KL = lds; LAS unsigned char* VL = lds + 2 * AT_TILEB;
    int qcol, kcol, vcol, hk, Hc; size_t ckoff;
    if (TYPE == 0) { qcol = h * 64; kcol = 256 + h * 64; vcol = h * 64; hk = h; Hc = 4; ckoff = CK_NA; }
    else if (TYPE == 1) { qcol = 768 + h * 64; kcol = 1024 + (h >> 1) * 64; vcol = 256 + (h >> 1) * 64; hk = h >> 1; Hc = 2; ckoff = CK_SW; }
    else { qcol = 2048 + h * 64; kcol = 2304 + h * 64; vcol = 384 + h * 64; hk = h; Hc = 4; ckoff = CK_DF; }
    const int ncache = dec ? 8 : 0;
    c.rs_w = 0; c.r_w = 0;
    int cgb = 0;
    if (!dec) { c.lat0 = 0; c.nlat = 4; }
    else if (TYPE == 0) { const int r0 = qblk * 4; const int rsA = min(max(r0 - 4, 0), 24), rsB = min(max(r0 - 1, 0), 24); c.lat0 = rsA; c.nlat = rsB + 8 - rsA;
        c.r_w = r0 + (wave >> 1); c.rs_w = min(max(c.r_w - 4, 0), 24); cgb = (wave & 1) * 2; }
    else if (TYPE == 1) { const int q0b = qblk * 256; c.lat0 = max(q0b - 128, 0) >> 6; c.nlat = (min(q0b + 384, L) >> 6) - c.lat0; }
    else { c.lat0 = 0; c.nlat = 32; }
#pragma unroll
    for (int qi = 0; qi < 2; ++qi) { c.cg4[qi] = cgb + qi; c.q0[qi] = q0 + 16 * qi; c.qt[qi] = q0 + 16 * qi + c.l15; c.qc[qi] = c.cg4[qi] * 16 + c.l15; c.c0[qi] = min(max(c.qc[qi] - 8, 0), 48); }
    const int ntile = c.nlat + ncache;
    const int srow = tid >> 3, sch = tid & 7;
    const int kst_off = srow * AT_ROWB + ((sch ^ (((srow >> 4) & 1) << 2)) << 4), vst_off = srow * AT_ROWB + (sch << 4);
    const bf16_t* klat = Pb + kcol + (size_t)(c.lat0 * 64 + srow) * PROJW + sch * 8;
    const bf16_t* vlat = TR + (size_t)(vcol + srow) * M_TOT + rowbase + c.lat0 * 64 + sch * 8;
    const bf16_t* kcac = CK + ckoff + ((size_t)(b * Hc + hk) * 512 + srow) * 64 + sch * 8;
    const bf16_t* vcac = CV + ckoff + ((size_t)(b * Hc + hk) * 64 + srow) * 512 + sch * 8;
    c.kr0 = (c.l15 >> 2) * 8 + (c.l15 & 3);
    bf16x8 qf[2][2];
    AttnState sa[2], sb[2];
    float sc2, m0, l0;
    if (TYPE == 1) { m0 = inp(p.ws, I_SINK)[l * 4 + h] * LOG2E; l0 = 1.f; sc2 = 0.125f * LOG2E; }
    else if (TYPE == 0) { m0 = -1e30f; l0 = 0.f; sc2 = 0.125f * LOG2E; }
    else { m0 = -1e30f; l0 = 0.f; sc2 = 0.17677669529663687f * LOG2E; }
#pragma unroll
    for (int qi = 0; qi < 2; ++qi) {
        st_init(sa[qi], m0, l0); st_init(sb[qi], -1e30f, 0.f);
        const size_t qrow = (size_t)(q0 + 16 * qi + c.l15) * PROJW;
        const u32x4 q0w = *(const u32x4*)(Pb + qrow + qcol + c.quad * 8), q1w = *(const u32x4*)(Pb + qrow + qcol + 32 + c.quad * 8);
        u32x4 a, bq;
        a.x = cvt_pk_bf16(bflo(q0w.x) * sc2, bfhi(q0w.x) * sc2); a.y = cvt_pk_bf16(bflo(q0w.y) * sc2, bfhi(q0w.y) * sc2); a.z = cvt_pk_bf16(bflo(q0w.z) * sc2, bfhi(q0w.z) * sc2); a.w = cvt_pk_bf16(bflo(q0w.w) * sc2, bfhi(q0w.w) * sc2);
        bq.x = cvt_pk_bf16(bflo(q1w.x) * sc2, bfhi(q1w.x) * sc2); bq.y = cvt_pk_bf16(bflo(q1w.y) * sc2, bfhi(q1w.y) * sc2); bq.z = cvt_pk_bf16(bflo(q1w.z) * sc2, bfhi(q1w.z) * sc2); bq.w = cvt_pk_bf16(bflo(q1w.w) * sc2, bfhi(q1w.w) * sc2);
        qf[qi][0] = __builtin_bit_cast(bf16x8, a); qf[qi][1] = __builtin_bit_cast(bf16x8, bq);
    }
    c.rpb = inp(p.ws, I_RPB) + ((size_t)(l * 4 + h)) * 15 * 31;
#define AT_KSRC(n) (((n) < c.nlat) ? klat + (size_t)(n) * 64 * PROJW : kcac + (size_t)((n) - c.nlat) * 4096)
#define AT_VSRC(n) (((n) < c.nlat) ? vlat + (n) * 64 : vcac + ((n) - c.nlat) * 64)
    u32x4 kA, vA, kB, vB;
    kA = *(const u32x4*)AT_KSRC(0); vA = *(const u32x4*)AT_VSRC(0);
    { const int n1 = min(1, ntile - 1); kB = *(const u32x4*)AT_KSRC(n1); vB = *(const u32x4*)AT_VSRC(n1); }
    *(LAS u32x4*)(KL + kst_off) = kA; *(LAS u32x4*)(VL + vst_off) = vA;
    __syncthreads();
#pragma unroll 1
    for (int i = 0; i < ntile; i += 2) {
        { const int n2 = min(i + 2, ntile - 1); kA = *(const u32x4*)AT_KSRC(n2); vA = *(const u32x4*)AT_VSRC(n2); }
        attn_tile<TYPE>(sa, sb, qf, c, KL, VL, i);
        *(LAS u32x4*)(KL + AT_TILEB + kst_off) = kB; *(LAS u32x4*)(VL + AT_TILEB + vst_off) = vB;
        __syncthreads();
        if (i + 1 >= ntile) break;
        { const int n3 = min(i + 3, ntile - 1); kB = *(const u32x4*)AT_KSRC(n3); vB = *(const u32x4*)AT_VSRC(n3); }
        attn_tile<TYPE>(sa, sb, qf, c, KL + AT_TILEB, VL + AT_TILEB, i + 1);
        *(LAS u32x4*)(KL + kst_off) = kA; *(LAS u32x4*)(VL + vst_off) = vA;
        __syncthreads();
    }
#undef AT_KSRC
#undef AT_VSRC
#pragma unroll
    for (int qi = 0; qi < 2; ++qi) {
        const size_t orow = (size_t)(rowbase + q0 + 16 * qi + c.l15) * 256 + h * 64 + c.quad * 4;
        if (TYPE != 2) {
            const float il = fast_rcp(sa[qi].l);
            bf16_t* o = BR + (TYPE == 1 ? (size_t)M_TOT * 256 : 0) + orow;
#pragma unroll
            for (int nt = 0; nt < 4; ++nt) { u32x2 w; w.x = cvt_pk_bf16(sa[qi].o[nt][0] * il, sa[qi].o[nt][1] * il); w.y = cvt_pk_bf16(sa[qi].o[nt][2] * il, sa[qi].o[nt][3] * il); *(u32x2*)(o + nt * 16) = w; }
        } else {
            const float lam = ((const float*)(p.ws + WS_LAM))[l], lam_init = ((const float*)(p.ws + WS_LAM))[4 + l];
            const float i0 = fast_rcp(sa[qi].l), i1 = lam * fast_rcp(sb[qi].l);
            f32x4 d[4]; float ss = 0.f;
#pragma unroll
            for (int i = 0; i < 4; ++i) { d[i] = sa[qi].o[i] * i0 - sb[qi].o[i] * i1; ss += (d[i][0] * d[i][0] + d[i][1] * d[i][1]) + (d[i][2] * d[i][2] + d[i][3] * d[i][3]); }
            ss = xadd16(ss); ss = xadd32(ss);
            const float rs = rsqrtf(ss * (1.f / 64.f) + EPSF) * (1.f - lam_init);
            const float* sg = inp(p.ws, I_DSUB) + l * 64 + c.quad * 4;
            bf16_t* o = BR + (size_t)3 * M_TOT * 256 + orow;
#pragma unroll
            for (int nt = 0; nt < 4; ++nt) { const f32x4 g4 = *(const f32x4*)(sg + nt * 16); const f32x4 v = d[nt] * rs * g4;
                u32x2 w; w.x = cvt_pk_bf16(v[0], v[1]); w.y = cvt_pk_bf16(v[2], v[3]); *(u32x2*)(o + nt * 16) = w; }
        }
    }
}

__device__ __forceinline__ void hyena_unit(const Ctx& p, LAS unsigned char* lds, int l, int c, bool dec) {
    const int tid = opaque_tid(), lane = tid & 63, wave = __builtin_amdgcn_readfirstlane(tid >> 6), l15 = lane & 15, quad = lane >> 4;
    const int L = dec ? 2048 : 256, B = dec ? 8 : 16, LP = L + 8, rowbase = dec ? M_CTX : 0, L2 = 2 * L, CS = L2 + 16;
    LAS bf16_t* COP = (LAS bf16_t*)lds;
    LAS bf16_t* YA = (LAS bf16_t*)(lds + 66048);
    LAS bf16_t* YB = (LAS bf16_t*)(lds + 66048 + 33024);
    LAS float* RED = (LAS float*)(lds + 66048 + 2 * 33024);
    const bf16_t* TR = (const bf16_t*)(p.ws + WS_TR);
    bf16_t* BR2 = (bf16_t*)(p.ws + WS_BR) + (size_t)2 * M_TOT * 256;
    const float* HF = (const float*)(p.ws + WS_HFIL) + (dec ? 262144 : 0);
    { const bf16_t* src = TR + (size_t)(640 + c) * M_TOT + rowbase;
      for (int i = tid; i < B * L / 8; i += 512) { const int e = i * 8, b = e / L, t = e - b * L; *(LAS u32x4*)(YA + b * LP + t) = *(const u32x4*)(src + e); } }
#pragma unroll 1
    for (int o = 0; o < 2; ++o) {
        LAS float* RF = (LAS float*)(o == 0 ? YB : YA);
        __syncthreads();
        const float* raw0 = HF + ((size_t)((o * 2 + 0) * 256 + c)) * L; const float* raw1 = HF + ((size_t)((o * 2 + 1) * 256 + c)) * L;
        float part = 0.f;
        for (int u = tid; u < L2; u += 512) { const int lag = L - 1 - u; float v = 0.f; if (lag >= 0) v = raw0[lag]; else if (lag > -L) v = raw1[-lag]; RF[u] = v; part += fabsf(v); }
        part = wave_sum(part);
        if (lane == 0) RED[wave] = part;
        __syncthreads();
        float tot = 0.f;
#pragma unroll
        for (int w = 0; w < 8; ++w) tot += RED[w];
        const float inv = 1.f / (tot + EPSF);
        const int ng = L2 / 8;
        for (int idx = tid; idx < 8 * ng; idx += 512) { const int m = idx / ng, x = (idx - m * ng) * 8; float v[8];
#pragma unroll
            for (int j = 0; j < 8; ++j) { const int u = x + m + j; v[j] = (u < L2) ? RF[u] * inv : 0.f; }
            u32x4 w; w.x = cvt_pk_bf16(v[0], v[1]); w.y = cvt_pk_bf16(v[2], v[3]); w.z = cvt_pk_bf16(v[4], v[5]); w.w = cvt_pk_bf16(v[6], v[7]);
            *(LAS u32x4*)(COP + m * CS + x) = w; }
        __syncthreads();
        const LAS bf16_t* Y = (o == 0) ? YA : YB;
        const LAS bf16_t* cpb = COP + (7 - (l15 & 7)) * CS + (L - 8 - 8 * (l15 >> 3) + quad * 8);
        const float skip = inp(p.ws, I_HSKIP)[(l * 2 + o) * 256 + c];
        const bf16_t* gate = TR + (size_t)((o == 0 ? 896 : 1152) + c) * M_TOT + rowbase;
        const int ngroups = L / 64;
        const bf16x8 zero8 = (bf16x8){0, 0, 0, 0, 0, 0, 0, 0};
        for (int g = wave; g < ngroups; g += 8) {
            const int t0 = (g >> 1) * 128 + (g & 1) * 16;
            f32x4 a0 = (f32x4){0.f, 0.f, 0.f, 0.f}, a1 = a0, a2 = a0, a3 = a0;
#define HY_D(s) (*(const LAS bf16x8*)(cpb + (32 * (s) - t0)))
#define HY_Y(s) ((l15 < B) ? *(const LAS bf16x8*)(Y + l15 * LP + 32 * (s) + quad * 8) : zero8)
            bf16x8 d0, d1 = HY_D(-1), d2 = HY_D(-2), d3 = HY_D(-3), y;
            for (int s = 0; s < L / 32; s += 4) {
                d0 = HY_D(s);     y = HY_Y(s);     a0 = mfma16(d0, y, a0); a1 = mfma16(d1, y, a1); a2 = mfma16(d2, y, a2); a3 = mfma16(d3, y, a3);
                d3 = HY_D(s + 1); y = HY_Y(s + 1); a0 = mfma16(d3, y, a0); a1 = mfma16(d0, y, a1); a2 = mfma16(d1, y, a2); a3 = mfma16(d2, y, a3);
                d2 = HY_D(s + 2); y = HY_Y(s + 2); a0 = mfma16(d2, y, a0); a1 = mfma16(d3, y, a1); a2 = mfma16(d0, y, a2); a3 = mfma16(d1, y, a3);
                d1 = HY_D(s + 3); y = HY_Y(s + 3); a0 = mfma16(d1, y, a0); a1 = mfma16(d2, y, a1); a2 = mfma16(d3, y, a2); a3 = mfma16(d0, y, a3);
            }
#undef HY_D
#undef HY_Y
            if (l15 < B) {
#pragma unroll
                for (int a = 0; a < 4; ++a) {
                    const f32x4 cv = a == 0 ? a0 : (a == 1 ? a1 : (a == 2 ? a2 : a3));
                    const int t = t0 + 32 * a + quad * 4;
                    const u32x2 gw = *(const u32x2*)(gate + (size_t)l15 * L + t);
                    const u32x2 yw = *(const LAS u32x2*)(Y + l15 * LP + t);
                    f32x4 r;
                    r[0] = bflo(gw.x) * (cv[0] + skip * bflo(yw.x)); r[1] = bfhi(gw.x) * (cv[1] + skip * bfhi(yw.x));
                    r[2] = bflo(gw.y) * (cv[2] + skip * bflo(yw.y)); r[3] = bfhi(gw.y) * (cv[3] + skip * bfhi(yw.y));
                    if (o == 0) { u32x2 w; w.x = cvt_pk_bf16(r[0], r[1]); w.y = cvt_pk_bf16(r[2], r[3]); *(LAS u32x2*)(YB + l15 * LP + t) = w; }
                    else { bf16_t* op = BR2 + (size_t)(rowbase + l15 * L + t) * 256 + c;
                        op[0] = f2bf1(r[0]); op[256] = f2bf1(r[1]); op[512] = f2bf1(r[2]); op[768] = f2bf1(r[3]); }
                }
            }
        }
    }
    __syncthreads();
}

__device__ __forceinline__ void mix_phase(const Ctx& p, LAS unsigned char* lds, int l) {
    const int G = gridDim.x;
    for (int u = blockIdx.x; u < 512; u += G) hyena_unit(p, lds, l, u & 255, u < 256);
#ifdef PROBE_HY2
    for (int u = blockIdx.x; u < 512; u += G) hyena_unit(p, lds, l, u & 255, u < 256);
#endif
    const int vcu = (G % 8 == 0) ? ((int)blockIdx.x % 8) * (G / 8) + (int)blockIdx.x / 8 : (int)blockIdx.x;
#pragma unroll 1
    for (int it = vcu; it < 960; it += G) {
        if (it < 768) { const int k = it >> 8, r = it & 255, qblk = r & 7, bh = r >> 3;
            if (k == 0) attn_block<2>(p, lds, l, true, bh >> 2, bh & 3, qblk); else if (k == 1) attn_block<1>(p, lds, l, true, bh >> 2, bh & 3, qblk); else attn_block<0>(p, lds, l, true, bh >> 2, bh & 3, qblk); }
        else { const int q = it - 768, k = q >> 6, bh = q & 63;
            if (k == 0) attn_block<2>(p, lds, l, false, bh >> 2, bh & 3, 0); else if (k == 1) attn_block<1>(p, lds, l, false, bh >> 2, bh & 3, 0); else attn_block<0>(p, lds, l, false, bh >> 2, bh & 3, 0); }
    }
}

#define XB_TMO      128
#define XB_XCNT(j)  (256  + 64 * (j))
#define XB_XSUB(j)  (1280 + 64 * (j))
#define XB_XGEN(j)  (2304 + 64 * (j))
#define XB_TOP      3328
#define XB_TOPGEN   3392
#define XB_SPIN_CAP (1u << 22)
__device__ __forceinline__ unsigned xb_ld(unsigned* p)              { return __hip_atomic_load(p, __ATOMIC_RELAXED, __HIP_MEMORY_SCOPE_AGENT); }
__device__ __forceinline__ unsigned xb_add(unsigned* p, unsigned v) { return __hip_atomic_fetch_add(p, v, __ATOMIC_RELAXED, __HIP_MEMORY_SCOPE_AGENT); }
__device__ __forceinline__ unsigned xb_xcc_id() { return (unsigned)__builtin_amdgcn_s_getreg((3 << 11) | 20) & 0xFu; }
#define XB_SPIN(cond, bar) do { unsigned _sp = 0; while (cond) { __builtin_amdgcn_s_sleep(1); \
    if ((++_sp & 255u) == 0u) { if (xb_ld(&(bar)[XB_TMO])) break; if (_sp > XB_SPIN_CAP) { atomicAdd(&(bar)[XB_TMO], 1u); break; } } } } while (0)
struct XcdBarrier { unsigned* bar; unsigned x; volatile LAS unsigned* st; };
__device__ __forceinline__ XcdBarrier xcd_barrier_post(unsigned* bar, volatile LAS unsigned* st) {
    XcdBarrier b; b.bar = bar; b.x = xb_xcc_id(); b.st = st;
    if (threadIdx.x == 0) (void)xb_add(&bar[XB_XCNT(b.x)], 1u);
    return b;
}
__device__ __forceinline__ void xcd_barrier_complete(unsigned* bar, unsigned x, unsigned& nloc, unsigned& nx) {
    const unsigned G = gridDim.x * gridDim.y * gridDim.z;
    unsigned sum, cnt, mine, sp = 0u;
    for (;;) {
        sum = 0u; cnt = 0u; mine = 0u;
#pragma unroll
        for (unsigned j = 0; j < 16; ++j) { const unsigned c = xb_ld(&bar[XB_XCNT(j)]); sum += c; cnt += (c > 0u) ? 1u : 0u; mine = (j == x) ? c : mine; }
        if (sum == G) break;
        __builtin_amdgcn_s_sleep(1);
        if ((++sp & 255u) == 0u) { if (xb_ld(&bar[XB_TMO])) break; if (sp > XB_SPIN_CAP) { atomicAdd(&bar[XB_TMO], 1u); break; } }
    }
    nloc = mine > 0u ? mine : 1u; nx = cnt > 0u ? cnt : 1u;
}
__device__ __forceinline__ void xcd_barrier(const XcdBarrier& b) {
    asm volatile("s_waitcnt vmcnt(0)" ::: "memory");
    __syncthreads();
    if (threadIdx.x == 0) {
        unsigned* bar = b.bar;
        __builtin_amdgcn_s_waitcnt(0);
        unsigned nloc = b.st[0], nx = b.st[1];
        if (nloc == 0u) { xcd_barrier_complete(bar, b.x, nloc, nx); b.st[0] = nloc; b.st[1] = nx; }
        const unsigned old = xb_add(&bar[XB_XSUB(b.x)], 1u);
        const unsigned gen = old / nloc;
        if (old + 1u == (gen + 1u) * nloc) {
            __builtin_amdgcn_fence(__ATOMIC_RELEASE, "agent");
            asm volatile("s_waitcnt vmcnt(0)" ::: "memory");
            const unsigned og = xb_add(&bar[XB_TOP], 1u);
            const unsigned tg = og / nx;
            if (og + 1u == (tg + 1u) * nx) xb_add(&bar[XB_TOPGEN], 1u);
            else XB_SPIN(xb_ld(&bar[XB_TOPGEN]) == tg, bar);
            __builtin_amdgcn_fence(__ATOMIC_ACQUIRE, "agent");
            xb_add(&bar[XB_XGEN(b.x)], 1u);
            asm volatile("s_waitcnt vmcnt(0)" ::: "memory");
        } else {
            XB_SPIN(xb_ld(&bar[XB_XGEN(b.x)]) == gen, bar);
            __builtin_amdgcn_fence(__ATOMIC_ACQUIRE, "agent");
            asm volatile("s_waitcnt vmcnt(0)" ::: "memory");
        }
    }
    __syncthreads();
}

__global__ void __launch_bounds__(512, 2) mega(Params P) {
    extern __shared__ __attribute__((aligned(16))) unsigned char lds_raw[];
    LAS unsigned char* lds = (LAS unsigned char*)lds_raw;
    cg::grid_group grid = cg::this_grid();
    volatile LAS unsigned* MISC = (volatile LAS unsigned*)(lds + LDS_BYTES - 64);
    if (threadIdx.x < 16) MISC[threadIdx.x] = 0u;
    __syncthreads();
    (void)xcd_barrier_post((unsigned*)(P.ws + WS_CTL) + 1024, MISC);
#pragma unroll 1
    for (int ph = P.ph_lo; ph < P.ph_hi; ++ph) {
        GAS unsigned char* ws_g = (GAS unsigned char*)P.ws; GAS float* out_g = (GAS float*)P.out; asm volatile("" : "+s"(ws_g), "+s"(out_g));
        Ctx p; p.ws = (unsigned char*)ws_g; p.out = (float*)out_g;
        unsigned char* ws = p.ws;
        int prep_part = 0, prep_l = 0, prep_b = blockIdx.x, prep_G = gridDim.x;
        if (ph == 0) {
            { const int t0_ = opaque_tid(); if (t0_ < N_IN) { ((unsigned long long*)(ws + WS_TAB))[t0_] = (unsigned long long)P.in[t0_]; } }
            asm volatile("s_waitcnt vmcnt(0)" ::: "memory"); __syncthreads();
#ifndef NO_PREP
            prep_mod(p, lds); __syncthreads(); prep_part = 1;
#endif
        }
        else if (ph == NPH - 1) final_norm_phase(p);
        else {
#ifdef PROBE_S
            const int l = (ph - 1) / 13, sv_ = (ph - 1) % 13, s = sv_ <= PROBE_S ? sv_ : sv_ - 1;
#else
            const int l = (ph - 1) / 12, s = (ph - 1) % 12;
#endif
            const bool is_gemm = (s == 1 || s == 2 || s == 4 || s == 7 || s == 8 || s == 10 || s == 11);
            if (is_gemm) {
                pg8::Gemm g; pg8::Sched S; pg8::Epi E; bool perm;
                S.G = gridDim.x; S.c = blockIdx.x; S.mode = 0; S.nM = M_TOT / 256; S.wgm = (s == 2 || s == 8 || s == 11) ? RESID_WGM : ((s == 1 || s == 10) ? 8 : pg8::WGM);
                E.o16 = nullptr; E.o16b = nullptr; E.of = nullptr; E.g = nullptr; E.gates = nullptr; E.scale = 1.f;
                bf16_t* ACT = (bf16_t*)(ws + WS_ACT); bf16_t* BIG = (bf16_t*)(ws + WS_BIG); float* X = (float*)(ws + WS_X);
                if (s == 1 || s == 10) { g.A = ACT; g.Bt = (const bf16_t*)(ws + wbase(l) + (s == 1 ? W_F1UP : W_F2UP)); g.K = DM; S.nN = 22; E.kind = pg8::EK_SWIGLU; E.o16 = BIG; perm = true; }
                else if (s == 2 || s == 11) { g.A = BIG; g.Bt = (const bf16_t*)(ws + wbase(l) + (s == 2 ? W_F1DN : W_F2DN)); g.K = DFF; S.nN = 4; E.kind = pg8::EK_RESID; E.of = X;
                    E.g = mod_ptr(ws, 0, l, s == 2 ? 2 : 8); E.scale = 0.5f; perm = false; }
                else if (s == 4) { g.A = ACT; g.Bt = (const bf16_t*)(ws + wbase(l) + W_IN); g.K = DM; S.nN = 27; E.kind = pg8::EK_PROJ; E.o16 = (bf16_t*)(ws + WS_PROJ); E.o16b = BIG; perm = true; }
                else if (s == 7) { g.A = (const bf16_t*)(ws + WS_BR); g.Bt = (const bf16_t*)(ws + wbase(l) + W_BR); g.K = 256; S.mode = 1; S.nN = 8; E.kind = pg8::EK_BRANCH;
                    E.o16 = ACT; E.gates = BIG; perm = false; }
                else { g.A = ACT; g.Bt = (const bf16_t*)(ws + wbase(l) + W_OUT); g.K = DM; S.nN = 4; E.kind = pg8::EK_RESID; E.of = X; E.g = mod_ptr(ws, 0, l, 5); E.scale = 1.f; perm = false; }
                S.nwg = S.nM * S.nN;
                #ifndef NO_GEMM
                if (s == 7) pg8::gemm_phase<true>(lds, g, S, E, perm); else pg8::gemm_phase<false>(lds, g, S, E, perm);
                if (blockIdx.x >= 64) {
                    if (s == 2) { prep_part = 2; prep_l = l; } else if (s == 8) { prep_part = 4; prep_l = l; } else if (s == 11 && l < 3) { prep_part = 1; prep_l = l + 1; }
                    prep_b = blockIdx.x - 64; prep_G = gridDim.x - 64;
                }
#endif
            } else if (s == 0 || s == 3 || s == 9) {
                norm_phase(p, l, s == 0 ? 0 : (s == 3 ? 1 : 2));

            } else if (s == 5) {
#ifndef NO_MIXPREP
                mixprep_phase(p, lds, l);
#endif
            } else {
#ifndef NO_MIX
                mix_phase(p, lds, l);
#ifdef PROBE_MIX2
                __syncthreads(); mix_phase(p, lds, l);
#endif
#endif
            }
        }
#ifndef NO_PREP
        if (prep_part) prep_layer(p, lds, prep_l, prep_b, prep_G, prep_part);
#endif
        if (ph + 1 < P.ph_hi) { if (P.ph_hi > 100000) grid.sync();   { XcdBarrier bar; bar.bar = (unsigned*)(p.ws + WS_CTL) + 1024; bar.x = xb_xcc_id(); bar.st = (volatile LAS unsigned*)(lds + LDS_BYTES - 64); xcd_barrier(bar); } }
    }
}

extern "C" void kernel_launch(void* const* d_in, const int* in_sizes, int n_in, void* d_out, int out_size, void* d_ws, size_t ws_size, hipStream_t stream) {
    static int grid = 0;
    if (grid == 0) {
        if (n_in != N_IN || ws_size < WS_END) { fprintf(stderr, "kernel_launch: unexpected n_in %d / ws_size %zu (need %zu)\n", n_in, ws_size, (size_t)WS_END); grid = -1; return; }
        int dev = 0, cus = 0, per_cu = 0;
        hipGetDevice(&dev); hipDeviceGetAttribute(&cus, hipDeviceAttributeMultiprocessorCount, dev);
        if (hipFuncSetAttribute((const void*)mega, hipFuncAttributeMaxDynamicSharedMemorySize, LDS_BYTES) != hipSuccess) { fprintf(stderr, "kernel_launch: hipFuncSetAttribute failed\n"); grid = -1; return; }
        if (hipOccupancyMaxActiveBlocksPerMultiprocessor(&per_cu, (const void*)mega, 512, LDS_BYTES) != hipSuccess || per_cu < 1) per_cu = 1;
        (void)hipGetLastError();
        grid = cus * 1;
        fprintf(stderr, "kernel_launch: grid %d (per_cu %d), ws %zu\n", grid, per_cu, ws_size);
    }
    if (grid < 0) return;
    hipMemsetAsync(d_ws, 0, WS_ZERO_BYTES, stream);
    Params p{};
    for (int i = 0; i < N_IN; ++i) p.in[i] = (const float*)d_in[i];
    p.out = (float*)d_out; p.ws = (unsigned char*)d_ws; p.ph_lo = 0; p.ph_hi = NPH;
    void* args[] = {&p};
    hipError_t e = hipLaunchCooperativeKernel((const void*)mega, dim3(grid), dim3(512), args, LDS_BYTES, stream);
    if (e != hipSuccess) fprintf(stderr, "cooperative launch failed: %s (grid %d)\n", hipGetErrorString(e), grid);
}
```

```cpp
#ifndef RESID_WGM
#define RESID_WGM 1
#endif
#include <hip/hip_runtime.h>
#include <hip/hip_cooperative_groups.h>
#include <cstdio>
#include <cstdint>
namespace cg = cooperative_groups;

#define LAS __attribute__((address_space(3)))
#define GAS __attribute__((address_space(1)))
typedef unsigned short bf16_t;
typedef short bf16x8 __attribute__((ext_vector_type(8)));
typedef float f32x4 __attribute__((ext_vector_type(4)));
typedef float f32x2 __attribute__((ext_vector_type(2)));
typedef unsigned u32x4 __attribute__((ext_vector_type(4)));
typedef unsigned u32x2 __attribute__((ext_vector_type(2)));

constexpr int DM = 1024, DFF = 2816, INW = 6912, PROJW = 2816, GATEW = 4096;
constexpr int M_CTX = 4096, M_DEC = 16384, M_TOT = 20480;
constexpr int NLAYER = 4;
constexpr float EPSF = 1e-6f;
constexpr float LOG2E = 1.4426950408889634f;
constexpr size_t O_Y = 0, O_NAK = 20971520, O_NAV = 25165824, O_SWK = 29360128, O_SWV = 31457280, O_DFK = 33554432, O_DFV = 37748736;
enum { I_XP = 0, I_XS, I_CNAK, I_CNAV, I_CSWK, I_CSWV, I_CDFK, I_CDFV, I_C, I_CCTX, I_WADA, I_BADA, I_NF1, I_NMIX, I_NF2, I_FNORM,
       I_F1W1, I_F1W3, I_F1W2, I_F2W1, I_F2W3, I_F2W2, I_WIN, I_WBR, I_WOUT, I_RPB, I_SINK, I_HSW, I_HSB, I_HW1, I_HB1, I_HW2, I_HB2, I_HW3,
       I_HSF, I_HLD, I_HSKIP, I_DLAM, I_DSUB, N_IN };

constexpr size_t MiB = 1u << 20;
constexpr size_t WS_CTL = 0;
constexpr size_t WS_MOD = 1 * MiB;
constexpr size_t WS_ZERO_BYTES = 65536;
constexpr size_t WS_LAM = 3 * MiB;
constexpr size_t WS_W = 4 * MiB;
constexpr size_t W_F1UP = 0, W_F1DN = W_F1UP + (size_t)5632 * 1024 * 2, W_F2UP = W_F1DN + (size_t)1024 * 2816 * 2, W_F2DN = W_F2UP + (size_t)5632 * 1024 * 2,
                 W_IN = W_F2DN + (size_t)1024 * 2816 * 2, W_BR = W_IN + (size_t)6912 * 1024 * 2, W_OUT = W_BR + (size_t)4 * 1024 * 256 * 2, W_END = W_OUT + (size_t)1024 * 1024 * 2;
static_assert(W_END <= 52 * MiB, "weights");
constexpr size_t WS_X = 56 * MiB;
constexpr size_t WS_ACT = 136 * MiB;
constexpr size_t WS_BR = 176 * MiB;
constexpr size_t WS_BIG = 216 * MiB;
constexpr size_t WS_PROJ = 376 * MiB;
constexpr size_t WS_TR = 486 * MiB;
constexpr size_t WS_CK = 541 * MiB;
constexpr size_t WS_HFIL = 551 * MiB;
constexpr size_t WS_W2 = 560 * MiB;
constexpr size_t WS_END = 612 * MiB;
constexpr int TRW = 1408;
constexpr size_t CK_NA = 0, CK_SW = 1048576, CK_DF = 1572864, CK_HALF = 2621440;
constexpr int LDS_BYTES = 147456;

#ifdef PROBE_S
constexpr int NPH = 54;
#else
constexpr int NPH = 50;
#endif
struct Params { const float* in[N_IN]; float* out; unsigned char* ws; int ph_lo, ph_hi; };
struct Ctx { float* out; unsigned char* ws; };
__device__ __forceinline__ size_t wbase(int l) { return (l & 1) ? WS_W2 : WS_W; }
constexpr size_t WS_TAB = 3 * MiB + 65536;
__device__ __forceinline__ const float* inp(const unsigned char* ws, int i) {
    const unsigned long long v = __hip_atomic_load((const unsigned long long*)(ws + WS_TAB) + i, __ATOMIC_RELAXED, __HIP_MEMORY_SCOPE_AGENT);
    const unsigned lo = __builtin_amdgcn_readfirstlane((unsigned)v), hi = __builtin_amdgcn_readfirstlane((unsigned)(v >> 32));
    return (const float*)(const GAS float*)(((unsigned long long)hi << 32) | lo);
}


__device__ __forceinline__ unsigned cvt_pk_bf16(float lo, float hi) { unsigned r; asm volatile("v_cvt_pk_bf16_f32 %0, %1, %2" : "=v"(r) : "v"(lo), "v"(hi)); return r; }
__device__ __forceinline__ float bf2f(unsigned short v) { return __uint_as_float(((unsigned)v) << 16); }
__device__ __forceinline__ float bflo(unsigned v) { return __uint_as_float(v << 16); }
__device__ __forceinline__ float bfhi(unsigned v) { return __uint_as_float(v & 0xffff0000u); }
__device__ __forceinline__ bf16_t f2bf1(float f) { return (bf16_t)(cvt_pk_bf16(f, 0.f) & 0xffffu); }
__device__ __forceinline__ float fast_exp2(float x) { return __builtin_amdgcn_exp2f(x); }
__device__ __forceinline__ float fast_rcp(float x) { return __builtin_amdgcn_rcpf(x); }
__device__ __forceinline__ float sigmoidf_(float x) { return fast_rcp(1.f + fast_exp2(-x * LOG2E)); }
__device__ __forceinline__ float wave_sum(float v) {
#pragma unroll
    for (int o = 1; o < 64; o <<= 1) v += __shfl_xor(v, o);
    return v;
}
__device__ __forceinline__ int cond_of_row(int row) { return row < M_CTX ? 0 : 1 + ((row - M_CTX) >> 11); }
__device__ __forceinline__ const float* mod_ptr(const unsigned char* ws, int cond, int l, int chunk) { return (const float*)(ws + WS_MOD) + ((size_t)(cond * 4 + l) * 9 + chunk) * 1024; }

__device__ __forceinline__ int opaque_tid() { int t; asm volatile("v_mov_b32 %0, %1" : "=v"(t) : "v"((int)threadIdx.x)); return t; }
namespace pg8 {
constexpr int BM = 256, BK = 64, HALF = 128, HTB = HALF * BK * 2, STAGE_BYTES = 8 * HTB, NXCD = 8, WGM = 4;
__device__ __forceinline__ int lds_byte(int r, int c) { const int st = (r >> 4) * 2 + (c >> 5), rr = r & 15, cc = c & 31, ob = rr * 64 + cc * 2; return st * 1024 + (ob ^ (((ob >> 9) & 1) << 5)); }
__device__ __forceinline__ void stage_rc(int b, int& R, int& C) { const int st = b / 1024, sb = b % 1024, swz = sb ^ (((sb >> 9) & 1) << 5); R = (st >> 1) * 16 + swz / 64; C = (st & 1) * 32 + (swz % 64) / 2; }
__device__ __forceinline__ int perm32(int rho) { const int n = rho >> 4, i = rho & 15; return 8 * (i >> 2) + 4 * n + (i & 3); }
struct Unit { int pm, pn; };
struct Sched { int mode, nM, nN, nwg, G, c, wgm; };
__device__ __forceinline__ bool sched_next(const Sched& S, int i, Unit& u) {
    const int j = (S.mode == 1) ? (i >> 2) : i;
    const long L = (long)j * S.G + S.c; if (L >= S.nwg) return false;
    int wgid = (int)L; { const int q = S.nwg / NXCD, r = S.nwg % NXCD, xcd = wgid % NXCD, off = wgid / NXCD; wgid = (xcd < r ? xcd * (q + 1) : r * (q + 1) + (xcd - r) * q) + off; }
    const int nig = S.wgm * S.nN, gid = wgid / nig, fm = gid * S.wgm, gsz = (S.nM - fm) < S.wgm ? (S.nM - fm) : S.wgm;
    const int pm = fm + ((wgid % nig) % gsz), pn = (wgid % nig) / gsz;
    if (S.mode == 1) { const int b = i & 3; u.pm = b * S.nM + pm; u.pn = b * S.nN + pn; } else { u.pm = pm; u.pn = pn; }
    return true;
}
enum { EK_SWIGLU = 0, EK_RESID = 1, EK_PROJ = 2, EK_BRANCH = 3 };
struct Epi { int kind; bf16_t* o16; bf16_t* o16b; float* of; const float* g; const bf16_t* gates; float scale; };
struct Gemm { const bf16_t* A; const bf16_t* Bt; int K; };

template <bool BR>
__device__ __forceinline__ void epilogue(const Epi& E, f32x4 (&acc)[2][2][4][2], const Unit& u, int wr, int wc, int fr, int fq) {
    if (BR) {
        const int bi = u.pm / 80, pm = u.pm - bi * 80, pn = u.pn & 7;
        const int row0 = pm * BM + wr * 64 + fr, col0 = pn * HALF + wc * 32 + 4 * fq;
        u32x2 gw[2][2][4];
#pragma unroll
        for (int n = 0; n < 2; ++n)
#pragma unroll
            for (int ai = 0; ai < 2; ++ai)
#pragma unroll
                for (int m = 0; m < 4; ++m) gw[n][ai][m] = *(const u32x2*)(E.gates + (size_t)(row0 + ai * HALF + m * 16) * GATEW + bi * 1024 + col0 + n * 16);
#pragma unroll
        for (int n = 0; n < 2; ++n)
#pragma unroll
            for (int ai = 0; ai < 2; ++ai)
#pragma unroll
                for (int m = 0; m < 4; ++m) {
                    const u32x2 g2 = gw[n][ai][m];
                    f32x4 gt; gt[0] = bflo(g2.x); gt[1] = bfhi(g2.x); gt[2] = bflo(g2.y); gt[3] = bfhi(g2.y);
                    f32x4 v = gt * acc[ai][0][m][n];
                    if (bi > 0) v = v + acc[ai][1][m][n];
                    acc[ai][1][m][n] = v;
                    if (bi == 3) { u32x2 w; w.x = cvt_pk_bf16(v[0], v[1]); w.y = cvt_pk_bf16(v[2], v[3]); *(u32x2*)(E.o16 + (size_t)(row0 + ai * HALF + m * 16) * DM + col0 + n * 16) = w; }
                }
    } else if (E.kind == EK_SWIGLU) {
        const int row0 = u.pm * BM + wr * 64 + fr, col0 = u.pn * 128 + wc * 32 + 8 * fq;
#pragma unroll
        for (int ai = 0; ai < 2; ++ai)
#pragma unroll
            for (int m = 0; m < 4; ++m) {
                const f32x4 a0 = acc[ai][0][m][0], a1 = acc[ai][0][m][1], b0 = acc[ai][1][m][0], b1 = acc[ai][1][m][1];
                float r[8];
#pragma unroll
                for (int e = 0; e < 4; ++e) { r[e] = a0[e] * sigmoidf_(a0[e]) * b0[e]; r[4 + e] = a1[e] * sigmoidf_(a1[e]) * b1[e]; }
                u32x4 w; w.x = cvt_pk_bf16(r[0], r[1]); w.y = cvt_pk_bf16(r[2], r[3]); w.z = cvt_pk_bf16(r[4], r[5]); w.w = cvt_pk_bf16(r[6], r[7]);
                *(u32x4*)(E.o16 + (size_t)(row0 + ai * HALF + m * 16) * DFF + col0) = w;
            }
    } else if (E.kind == EK_PROJ) {
        const int row0 = u.pm * BM + wr * 64 + fr;
        const bool isgate = u.pn >= 11;
        bf16_t* base = isgate ? E.o16b : E.o16; const int ld = isgate ? GATEW : PROJW;
        const int col0 = (isgate ? (u.pn - 11) * BM : u.pn * BM) + wc * 32 + 8 * fq;
#pragma unroll
        for (int ai = 0; ai < 2; ++ai)
#pragma unroll
            for (int m = 0; m < 4; ++m)
#pragma unroll
                for (int bj = 0; bj < 2; ++bj) {
                    f32x4 v0 = acc[ai][bj][m][0], v1 = acc[ai][bj][m][1];
                    if (isgate) {
#pragma unroll
                        for (int e = 0; e < 4; ++e) { v0[e] = sigmoidf_(v0[e]); v1[e] = sigmoidf_(v1[e]); }
                    }
                    u32x4 w; w.x = cvt_pk_bf16(v0[0], v0[1]); w.y = cvt_pk_bf16(v0[2], v0[3]); w.z = cvt_pk_bf16(v1[0], v1[1]); w.w = cvt_pk_bf16(v1[2], v1[3]);
                    *(u32x4*)(base + (size_t)(row0 + ai * HALF + m * 16) * ld + col0 + bj * HALF) = w;
                }
    } else if (E.kind == EK_RESID) {
        const int cond = (u.pm < 16) ? 0 : 1 + ((u.pm - 16) >> 3);
        const float* gv = E.g + (size_t)cond * (4 * 9 * 1024);
        const int row0 = u.pm * BM + wr * 64 + fr, col0 = u.pn * BM + wc * 32 + 4 * fq;
        f32x4 g4[2][2];
#pragma unroll
        for (int bj = 0; bj < 2; ++bj)
#pragma unroll
            for (int n = 0; n < 2; ++n) g4[bj][n] = *(const f32x4*)(gv + col0 + bj * HALF + n * 16) * E.scale;
#pragma unroll
        for (int bj = 0; bj < 2; ++bj)
#pragma unroll
            for (int n = 0; n < 2; ++n) {
                const int col = col0 + bj * HALF + n * 16;
                f32x4 xv[2][4];
#pragma unroll
                for (int ai = 0; ai < 2; ++ai)
#pragma unroll
                    for (int m = 0; m < 4; ++m) xv[ai][m] = *(const f32x4*)(E.of + (size_t)(row0 + ai * HALF + m * 16) * DM + col);
#pragma unroll
                for (int ai = 0; ai < 2; ++ai)
#pragma unroll
                    for (int m = 0; m < 4; ++m) *(f32x4*)(E.of + (size_t)(row0 + ai * HALF + m * 16) * DM + col) = xv[ai][m] + g4[bj][n] * acc[ai][bj][m][n];
            }
    }
}

template <bool BR>
__device__ __forceinline__ void gemm_phase(LAS unsigned char* lds, const Gemm g, const Sched& S, const Epi& E, const bool perm) {
    const int tid = opaque_tid(), wid = __builtin_amdgcn_readfirstlane(tid >> 6), lane = tid & 63, wr = wid >> 2, wc = wid & 3, fr = lane & 15, fq = lane >> 4;
    const int K = g.K, nt = K / BK;
    const bool align = !(E.kind == EK_RESID);
    unsigned voffA[2], voffB[2];
#pragma unroll
    for (int i = 0; i < 2; ++i) { int R, C; stage_rc(tid * 16 + i * 8192, R, C); const int Rb = perm ? ((R & ~31) + perm32(R & 31)) : R;
        voffA[i] = (unsigned)(R * K + C) * 2u; voffB[i] = (unsigned)(Rb * K + C) * 2u; }
    const size_t kstep = (size_t)(BK * 2);
    const size_t hstep = (size_t)HALF * K * 2;
    const size_t tstep = 2 * hstep;
    const size_t bstep = BR ? hstep : tstep;
    const unsigned ldsw = (unsigned)wid * 1024u;
    const int aoff = lds_byte(wr * 64 + fr, fq * 8), boff = lds_byte(wc * 32 + fr, fq * 8);
#define PG8_SA(b, h) (((b) * 2 + (h)) * HTB)
#define PG8_SB(b, h) ((4 + (b) * 2 + (h)) * HTB)
#define PG8_STAGE(bufoff, gbase, voff) do { _Pragma("unroll") for (int _i = 0; _i < 2; ++_i) \
        __builtin_amdgcn_global_load_lds((const unsigned*)((const char*)(gbase) + (voff)[_i]), (LAS unsigned*)(lds + (bufoff) + ldsw + _i * 8192), 16, 0, 0); } while (0)
#define PG8_LDA(dst, b, h) do { _Pragma("unroll") for (int m = 0; m < 4; ++m) _Pragma("unroll") for (int k = 0; k < 2; ++k) dst[m][k] = *(const LAS bf16x8*)(lds + PG8_SA(b, h) + aoff + m * 2048 + k * 1024); } while (0)
#define PG8_LDB(dst, b, h) do { _Pragma("unroll") for (int n = 0; n < 2; ++n) _Pragma("unroll") for (int k = 0; k < 2; ++k) dst[n][k] = *(const LAS bf16x8*)(lds + PG8_SB(b, h) + boff + n * 2048 + k * 1024); } while (0)
#define PG8_MMA(ai, bj, At, Bt) do { __builtin_amdgcn_s_setprio(1); _Pragma("unroll") for (int m = 0; m < 4; ++m) _Pragma("unroll") for (int n = 0; n < 2; ++n) _Pragma("unroll") for (int k = 0; k < 2; ++k) \
        acc[ai][bj][m][n] = __builtin_amdgcn_mfma_f32_16x16x32_bf16(Bt[n][k], At[m][k], acc[ai][bj][m][n], 0, 0, 0); __builtin_amdgcn_s_setprio(0); } while (0)
#define PG8_WAIT_V(n) asm volatile("s_waitcnt vmcnt(" #n ")" ::: "memory")
#define PG8_WAIT_L(n) asm volatile("s_waitcnt lgkmcnt(" #n ")" ::: "memory")
#define PG8_BAR __builtin_amdgcn_s_barrier()
#define PG8_SCHED __builtin_amdgcn_sched_barrier(0)
    Unit cur, nxt; int ui = 0;
    if (!sched_next(S, 0, cur)) return;
    f32x4 acc[2][2][4][2];
#pragma unroll
    for (int a = 0; a < 2; ++a)
#pragma unroll
        for (int b = 0; b < 2; ++b)
#pragma unroll
            for (int m = 0; m < 4; ++m)
#pragma unroll
                for (int n = 0; n < 2; ++n) acc[a][b][m][n] = (f32x4){0.f, 0.f, 0.f, 0.f};
    bf16x8 At[4][2], B0[2][2], B1[2][2];
    const char* cA = (const char*)g.A + (size_t)cur.pm * tstep; const char* cB = (const char*)g.Bt + (size_t)cur.pn * bstep;
    PG8_STAGE(PG8_SB(0, 0), cB, voffB); PG8_STAGE(PG8_SB(0, 1), cB + hstep, voffB); PG8_STAGE(PG8_SA(0, 0), cA, voffA); PG8_STAGE(PG8_SA(0, 1), cA + hstep, voffA);
    if (wr == 1) PG8_BAR;
    PG8_WAIT_V(2); PG8_BAR;
    PG8_STAGE(PG8_SB(1, 0), cB + kstep, voffB); PG8_STAGE(PG8_SA(1, 0), cA + kstep, voffA); PG8_STAGE(PG8_SB(1, 1), cB + hstep + kstep, voffB);
    PG8_WAIT_V(6); PG8_BAR;
    for (;;) {
        const bool has_next = sched_next(S, ui + 1, nxt);
        const char* nA = has_next ? (const char*)g.A + (size_t)nxt.pm * tstep : cA; const char* nB = has_next ? (const char*)g.Bt + (size_t)nxt.pn * bstep : cB;
        for (int t = 0; t < nt; t += 2) {
            const bool last = (t == nt - 2);
            const char* a1 = cA + (size_t)(t + 1) * kstep;
            const char* a2 = last ? nA : cA + (size_t)(t + 2) * kstep; const char* b2 = last ? nB : cB + (size_t)(t + 2) * kstep;
            const char* a3 = a2 + kstep; const char* b3 = b2 + kstep;
            PG8_LDB(B0, 0, 0); PG8_LDB(B1, 0, 1); PG8_SCHED; PG8_LDA(At, 0, 0); PG8_STAGE(PG8_SA(1, 1), a1 + hstep, voffA);
            PG8_WAIT_V(8); PG8_WAIT_L(0); PG8_BAR; PG8_MMA(0, 0, At, B0); if (!BR) { PG8_MMA(0, 1, At, B1); } PG8_BAR; PG8_SCHED;
            PG8_LDA(At, 0, 1); PG8_STAGE(PG8_SB(0, 0), b2, voffB); PG8_STAGE(PG8_SB(0, 1), b2 + hstep, voffB); PG8_STAGE(PG8_SA(0, 0), a2, voffA);
            PG8_WAIT_V(8); PG8_WAIT_L(0); PG8_BAR; PG8_MMA(1, 0, At, B0); if (!BR) { PG8_MMA(1, 1, At, B1); } PG8_BAR; PG8_SCHED;
            PG8_LDB(B0, 1, 0); PG8_LDB(B1, 1, 1); PG8_SCHED; PG8_LDA(At, 1, 0); PG8_STAGE(PG8_SA(0, 1), a2 + hstep, voffA);
            PG8_WAIT_V(8); PG8_WAIT_L(0); PG8_BAR; PG8_MMA(0, 0, At, B0); if (!BR) { PG8_MMA(0, 1, At, B1); } PG8_BAR; PG8_SCHED;
            PG8_LDA(At, 1, 1); PG8_STAGE(PG8_SB(1, 0), b3, voffB); PG8_STAGE(PG8_SB(1, 1), b3 + hstep, voffB); PG8_STAGE(PG8_SA(1, 0), a3, voffA);
            PG8_WAIT_V(8); PG8_WAIT_L(0); PG8_BAR; PG8_MMA(1, 0, At, B0); if (!BR) { PG8_MMA(1, 1, At, B1); } PG8_BAR; PG8_SCHED;
        }
        if (align && wr == 0) PG8_BAR;
        epilogue<BR>(E, acc, cur, wr, wc, fr, fq);
        if (!has_next) break;
#pragma unroll
        for (int a = 0; a < 2; ++a)
#pragma unroll
            for (int b = 0; b < (BR ? 1 : 2); ++b)
#pragma unroll
                for (int m = 0; m < 4; ++m)
#pragma unroll
                    for (int n = 0; n < 2; ++n) acc[a][b][m][n] = (f32x4){0.f, 0.f, 0.f, 0.f};
        cur = nxt; cA = nA; cB = nB; ++ui;
        if (align && wr == 1) PG8_BAR;
    }
    PG8_WAIT_V(0);
    if (!align && wr == 0) PG8_BAR;
    PG8_BAR;
#undef PG8_SA
#undef PG8_SB
#undef PG8_STAGE
#undef PG8_LDA
#undef PG8_LDB
#undef PG8_MMA
#undef PG8_WAIT_V
#undef PG8_WAIT_L
#undef PG8_BAR
#undef PG8_SCHED
}
}


__device__ __forceinline__ void transpose_item(const float* W, int K, int N, bf16_t* WT, int dst_row0, LAS float* scr, int k0, int n0, int lane) {
    f32x4 v[16];
    const int rr = lane >> 4, cc = (lane & 15) * 4;
#pragma unroll
    for (int i = 0; i < 16; ++i) v[i] = *(const f32x4*)(W + (size_t)(k0 + 4 * i + rr) * N + n0 + cc);
#pragma unroll
    for (int i = 0; i < 16; ++i) { LAS float* d = scr + (4 * i + rr) * 65 + cc; d[0] = v[i][0]; d[1] = v[i][1]; d[2] = v[i][2]; d[3] = v[i][3]; }
    asm volatile("s_waitcnt lgkmcnt(0)" ::: "memory");
    const int c = lane & 7, r = lane >> 3;
#pragma unroll
    for (int j = 0; j < 8; ++j) { const int n = 8 * j + r; const LAS float* q = scr + (8 * c) * 65 + n;
        u32x4 o; o.x = cvt_pk_bf16(q[0], q[65]); o.y = cvt_pk_bf16(q[2 * 65], q[3 * 65]); o.z = cvt_pk_bf16(q[4 * 65], q[5 * 65]); o.w = cvt_pk_bf16(q[6 * 65], q[7 * 65]);
        *(u32x4*)(WT + (size_t)(dst_row0 + n) * K + k0 + 8 * c) = o; }
    asm volatile("s_waitcnt lgkmcnt(0)" ::: "memory");
}

__device__ __forceinline__ void prep_layer(const Ctx& p, LAS unsigned char* lds, int l, int bidx, int G, int part) {
    const int tid = opaque_tid(), lane = tid & 63, wave = tid >> 6;
    const int gw = bidx * 8 + wave, NGW = G * 8;
    unsigned char* ws = p.ws; unsigned char* wsw = p.ws + wbase(l);
    LAS float* scr = (LAS float*)(lds + wave * 16896);
    {
        constexpr int I_UP = 16 * 44, I_DN = 44 * 16, I_IN = 16 * 108, I_BR = 4 * 16, I_OUT = 16 * 16;
        constexpr int NIT = 4 * I_UP + 2 * I_DN + I_IN + 4 * I_BR + I_OUT;
        for (int it = gw; it < NIT; it += NGW) {
            int r = it;
            { const int cls = (r < 4 * I_UP) ? ((r < 2 * I_UP) ? 1 : 4) : ((r < 4 * I_UP + 2 * I_DN) ? ((r < 4 * I_UP + I_DN) ? 1 : 4) : 2); if (!(part & cls)) continue; }
            if (r < 4 * I_UP) {
                const int which = r / I_UP; r -= which * I_UP; const int kb = r / 44, nb = r % 44, n0 = nb * 64;
                const float* W = inp(p.ws, (which >> 1) ? ((which & 1) ? I_F2W3 : I_F2W1) : ((which & 1) ? I_F1W3 : I_F1W1)) + (size_t)l * DM * DFF;
                bf16_t* WT = (bf16_t*)(wsw + ((which >> 1) ? W_F2UP : W_F1UP));
                const int drow = 256 * (n0 >> 7) + (which & 1) * 128 + (n0 & 127);
                transpose_item(W, DM, DFF, WT, drow, scr, kb * 64, n0, lane); continue;
            }
            r -= 4 * I_UP;
            if (r < 2 * I_DN) {
                const int which = r / I_DN; r -= which * I_DN; const int kb = r / 16, nb = r % 16;
                const float* W = inp(p.ws, which ? I_F2W2 : I_F1W2) + (size_t)l * DFF * DM;
                bf16_t* WT = (bf16_t*)(wsw + (which ? W_F2DN : W_F1DN));
                transpose_item(W, DFF, DM, WT, nb * 64, scr, kb * 64, nb * 64, lane); continue;
            }
            r -= 2 * I_DN;
            if (r < I_IN) { const int kb = r / 108, nb = r % 108;
                transpose_item(inp(p.ws, I_WIN) + (size_t)l * DM * INW, DM, INW, (bf16_t*)(wsw + W_IN), nb * 64, scr, kb * 64, nb * 64, lane); continue; }
            r -= I_IN;
            if (r < 4 * I_BR) { const int bi = r / I_BR; r -= bi * I_BR; const int kb = r / 16, nb = r % 16;
                transpose_item(inp(p.ws, I_WBR) + ((size_t)l * 4 + bi) * 256 * DM, 256, DM, (bf16_t*)(wsw + W_BR) + (size_t)bi * 1024 * 256, nb * 64, scr, kb * 64, nb * 64, lane); continue; }
            r -= 4 * I_BR;
            { const int kb = r / 16, nb = r % 16;
              transpose_item(inp(p.ws, I_WOUT) + (size_t)l * DM * DM, DM, DM, (bf16_t*)(wsw + W_OUT), nb * 64, scr, kb * 64, nb * 64, lane); }
        }
    }
    if (!(part & 2)) return;
    {
        bf16_t* CK = (bf16_t*)(ws + WS_CK);
        const int gt = bidx * 512 + tid, NT = G * 512;
        for (int it = gt; it < 327680; it += NT) {
            int e = it * 8; const float* src; bf16_t* dst; int per_b;
            if (e < 1048576) { src = inp(p.ws, I_CNAK); dst = CK + CK_NA; per_b = 131072; }
            else if (e < 1572864) { e -= 1048576; src = inp(p.ws, I_CSWK); dst = CK + CK_SW; per_b = 65536; }
            else { e -= 1572864; src = inp(p.ws, I_CDFK); dst = CK + CK_DF; per_b = 131072; }
            const int b = e / per_b, r = e - b * per_b;
            const float* s = src + ((size_t)(b * 4 + l)) * per_b + r;
            const f32x4 v0 = *(const f32x4*)s, v1 = *(const f32x4*)(s + 4);
            u32x4 o; o.x = cvt_pk_bf16(v0[0], v0[1]); o.y = cvt_pk_bf16(v0[2], v0[3]); o.z = cvt_pk_bf16(v1[0], v1[1]); o.w = cvt_pk_bf16(v1[2], v1[3]);
            *(u32x4*)(dst + e) = o;
        }
    }
    {
        bf16_t* CV = (bf16_t*)(ws + WS_CK) + CK_HALF;
        for (int it = gw; it < 640; it += NGW) {
            int r = it; const float* src; bf16_t* dst; int H;
            if (r < 256) { src = inp(p.ws, I_CNAV); dst = CV + CK_NA; H = 4; }
            else if (r < 384) { r -= 256; src = inp(p.ws, I_CSWV); dst = CV + CK_SW; H = 2; }
            else { r -= 384; src = inp(p.ws, I_CDFV); dst = CV + CK_DF; H = 4; }
            const int kb = r & 7, bh = r >> 3, b = bh / H, h = bh - b * H;
            transpose_item(src + ((size_t)(b * 4 + l) * H + h) * 512 * 64, 512, 64, dst + (size_t)bh * 64 * 512, 0, scr, kb * 64, 0, lane);
        }
    }
    __syncthreads();
    {
        LAS float* Z = (LAS float*)lds;
        LAS float* G1 = Z + 8 * 33;
        LAS float* G2 = G1 + 8 * 64;
        float* HF = (float*)(ws + WS_HFIL);
        const float* w1 = inp(p.ws, I_HW1) + (size_t)l * 33 * 64; const float* b1 = inp(p.ws, I_HB1) + l * 64;
        const float* w2 = inp(p.ws, I_HW2) + (size_t)l * 64 * 64; const float* b2 = inp(p.ws, I_HB2) + l * 64;
        const float* w3 = inp(p.ws, I_HW3) + (size_t)l * 64 * 1024; const float* sf = inp(p.ws, I_HSF) + l * 64; const float* ld = inp(p.ws, I_HLD) + l * 1024;
        for (int it = bidx; it < 288; it += G) {
            const int Lsel = it >= 32, L = Lsel ? 2048 : 256, n0 = (Lsel ? it - 32 : it) * 8;
            const float invL = 1.f / (float)L;
            if (tid < 8 * 33) { const int nn = tid / 33, i = tid - nn * 33; const float tn = (float)(n0 + nn) * invL; float v;
                if (i == 0) v = tn; else if (i <= 16) v = __cosf(6.283185307179586f * tn * (float)i); else v = __sinf(6.283185307179586f * tn * (float)(i - 16));
                Z[nn * 33 + i] = v; }
            __syncthreads();
            { const int nn = tid >> 6, j = tid & 63; float a = b1[j];
#pragma unroll 11
              for (int i = 0; i < 33; ++i) a += Z[nn * 33 + i] * w1[i * 64 + j];
              G1[nn * 64 + j] = __sinf(sf[j] * a); }
            __syncthreads();
            { const int nn = tid >> 6, j = tid & 63; float a = b2[j];
#pragma unroll 16
              for (int i = 0; i < 64; ++i) a += G1[nn * 64 + i] * w2[i * 64 + j];
              G2[nn * 64 + j] = __sinf(sf[j] * a); }
            __syncthreads();
#pragma unroll 1
            for (int cc = 0; cc < 2; ++cc) {
                const int col = cc * 512 + tid;
                float a[8];
#pragma unroll
                for (int nn = 0; nn < 8; ++nn) a[nn] = 0.f;
#pragma unroll 16
                for (int i = 0; i < 64; ++i) { const float w = w3[i * 1024 + col];
#pragma unroll
                    for (int nn = 0; nn < 8; ++nn) a[nn] += G2[nn * 64 + i] * w; }
                const float rate = __expf(ld[col]);
#pragma unroll
                for (int nn = 0; nn < 8; ++nn) a[nn] *= __expf(-rate * (float)(n0 + nn) * invL);
                float* o = HF + (Lsel ? 262144 : 0) + (size_t)col * L + n0;
                *(f32x4*)o = (f32x4){a[0], a[1], a[2], a[3]}; *(f32x4*)(o + 4) = (f32x4){a[4], a[5], a[6], a[7]};
            }
            __syncthreads();
        }
    }
    if (bidx == 0 && tid == 0) {
        const float* lv = inp(p.ws, I_DLAM) + l * 128; float s01 = 0.f, s23 = 0.f;
        for (int i = 0; i < 32; ++i) { s01 += lv[i] * lv[32 + i]; s23 += lv[64 + i] * lv[96 + i]; }
        float c08; asm volatile("v_mov_b32 %0, 0x3f4ccccd" : "=v"(c08));
        const float lam_init = c08 - 0.6f * __expf(-0.3f * (float)l);
        ((float*)(ws + WS_LAM))[l] = __expf(s01) - __expf(s23) + lam_init; ((float*)(ws + WS_LAM))[4 + l] = lam_init;
    }
}

__device__ __forceinline__ void prep_mod(const Ctx& p, LAS unsigned char* lds) {
    const int tid = opaque_tid(), lane = tid & 63, wave = tid >> 6;
    const int G = gridDim.x;
    LAS float* SC = (LAS float*)lds;
    LAS float* PART = (LAS float*)(lds + 40960);
    for (int i = tid; i < 9 * 1024; i += 512) { const float v = (i < 1024) ? inp(p.ws, I_CCTX)[i] : inp(p.ws, I_C)[i - 1024]; SC[i] = v * sigmoidf_(v); }
    __syncthreads();
    float* mod = (float*)(p.ws + WS_MOD);
    for (int it = blockIdx.x; it < 4 * 36; it += G) {
        const int cb = it % 36, l = it / 36;
        const int col = cb * 256 + lane * 4, k0 = wave * 128;
        const float* W = inp(p.ws, I_WADA) + ((size_t)l * DM + k0) * 9216 + col;
        f32x4 a[9];
#pragma unroll
        for (int c = 0; c < 9; ++c) a[c] = (f32x4){0.f, 0.f, 0.f, 0.f};
#pragma unroll 16
        for (int k = 0; k < 128; ++k) { const f32x4 w = *(const f32x4*)(W + (size_t)k * 9216);
#pragma unroll
            for (int c = 0; c < 9; ++c) a[c] += w * SC[c * 1024 + k0 + k]; }
#pragma unroll
        for (int c = 0; c < 9; ++c) *(LAS f32x4*)(PART + (wave * 9 + c) * 256 + lane * 4) = a[c];
        __syncthreads();
        for (int o = tid; o < 9 * 256; o += 512) { const int c = o >> 8, cc = o & 255;
            float v = inp(p.ws, I_BADA)[(size_t)l * 9216 + cb * 256 + cc];
#pragma unroll
            for (int w = 0; w < 8; ++w) v += PART[(w * 9 + c) * 256 + cc];
            mod[((size_t)(c * 4 + l)) * 9216 + cb * 256 + cc] = v; }
        __syncthreads();
    }
}

template <int NR>
__device__ __forceinline__ void norm_batch(const Ctx& p, int l, int which, bool from_in, int row0, int lane, const f32x4 (&gv)[4]) {
    float* X = (float*)(p.ws + WS_X); bf16_t* ACT = (bf16_t*)(p.ws + WS_ACT);
    f32x4 v[NR][4]; float s[NR];
#pragma unroll
    for (int r = 0; r < NR; ++r) {
        const int row = row0 + r;
        const float* xr = from_in ? (row < M_CTX ? inp(p.ws, I_XP) + (size_t)row * DM : inp(p.ws, I_XS) + (size_t)(row - M_CTX) * DM) : X + (size_t)row * DM;
#pragma unroll
        for (int j = 0; j < 4; ++j) v[r][j] = *(const f32x4*)(xr + j * 256 + lane * 4);
    }
    const int cond = cond_of_row(row0);
    const float* sh = mod_ptr(p.ws, cond, l, which * 3 + 0); const float* sc = mod_ptr(p.ws, cond, l, which * 3 + 1);
    f32x4 s4[4], h4[4];
#pragma unroll
    for (int j = 0; j < 4; ++j) { s4[j] = *(const f32x4*)(sc + j * 256 + lane * 4) + 1.f; h4[j] = *(const f32x4*)(sh + j * 256 + lane * 4); }
#pragma unroll
    for (int r = 0; r < NR; ++r) { float a = 0.f;
#pragma unroll
        for (int j = 0; j < 4; ++j) a += (v[r][j][0] * v[r][j][0] + v[r][j][1] * v[r][j][1]) + (v[r][j][2] * v[r][j][2] + v[r][j][3] * v[r][j][3]);
        s[r] = a; }
    if (from_in) {
#pragma unroll
        for (int r = 0; r < NR; ++r)
#pragma unroll
            for (int j = 0; j < 4; ++j) *(f32x4*)(X + (size_t)(row0 + r) * DM + j * 256 + lane * 4) = v[r][j];
    }
#pragma unroll
    for (int o = 1; o < 64; o <<= 1) {
#pragma unroll
        for (int r = 0; r < NR; ++r) s[r] += __shfl_xor(s[r], o);
    }
#pragma unroll
    for (int r = 0; r < NR; ++r) {
        const float rstd = rsqrtf(s[r] * (1.f / DM) + EPSF);
#pragma unroll
        for (int j = 0; j < 4; ++j) {
            const f32x4 o = (v[r][j] * rstd) * gv[j] * s4[j] + h4[j];
            u32x2 w; w.x = cvt_pk_bf16(o[0], o[1]); w.y = cvt_pk_bf16(o[2], o[3]);
            *(u32x2*)(ACT + (size_t)(row0 + r) * DM + j * 256 + lane * 4) = w;
        }
    }
}
__device__ __forceinline__ void norm_phase(const Ctx& p, int l, int which  ) {
    const int tid_ = opaque_tid(), lane = tid_ & 63, wave = tid_ >> 6, gw = blockIdx.x * 8 + wave, NGW = gridDim.x * 8;
    const float* gsrc = inp(p.ws, which == 0 ? I_NF1 : (which == 1 ? I_NMIX : I_NF2)) + l * DM;
    const bool from_in = (l == 0 && which == 0);
    f32x4 gv[4];
#pragma unroll
    for (int j = 0; j < 4; ++j) gv[j] = *(const f32x4*)(gsrc + j * 256 + lane * 4);
    const int R4 = (M_TOT / (NGW * 4)) * (NGW * 4);
    for (int row0 = gw * 4; row0 < R4; row0 += NGW * 4) norm_batch<4>(p, l, which, from_in, row0, lane, gv);
    for (int row0 = R4 + gw * 2; row0 < M_TOT; row0 += NGW * 2) norm_batch<2>(p, l, which, from_in, row0, lane, gv);
}
__device__ __forceinline__ void final_norm_phase(const Ctx& p) {
    const int tid_ = opaque_tid(), lane = tid_ & 63, wave = tid_ >> 6, gw = blockIdx.x * 8 + wave, NGW = gridDim.x * 8;
    const float* X = (const float*)(p.ws + WS_X); const float* gsrc = inp(p.ws, I_FNORM);
    f32x4 gv[4];
#pragma unroll
    for (int j = 0; j < 4; ++j) gv[j] = *(const f32x4*)(gsrc + j * 256 + lane * 4);
    constexpr int NR = 4;
    for (int row0 = gw * NR; row0 < M_TOT; row0 += NGW * NR) {
        f32x4 v[NR][4]; float s[NR];
#pragma unroll
        for (int r = 0; r < NR; ++r) { const float* xr = X + (size_t)(row0 + r) * DM;
#pragma unroll
            for (int j = 0; j < 4; ++j) v[r][j] = *(const f32x4*)(xr + j * 256 + lane * 4); }
#pragma unroll
        for (int r = 0; r < NR; ++r) { float a = 0.f;
#pragma unroll
            for (int j = 0; j < 4; ++j) a += (v[r][j][0] * v[r][j][0] + v[r][j][1] * v[r][j][1]) + (v[r][j][2] * v[r][j][2] + v[r][j][3] * v[r][j][3]);
            s[r] = a; }
#pragma unroll
        for (int o = 1; o < 64; o <<= 1) {
#pragma unroll
            for (int r = 0; r < NR; ++r) s[r] += __shfl_xor(s[r], o);
        }
#pragma unroll
        for (int r = 0; r < NR; ++r) { const float rstd = rsqrtf(s[r] * (1.f / DM) + EPSF);
#pragma unroll
            for (int j = 0; j < 4; ++j) *(f32x4*)(p.out + O_Y + (size_t)(row0 + r) * DM + j * 256 + lane * 4) = (v[r][j] * rstd) * gv[j]; }
    }
}

__device__ __forceinline__ void mixprep_phase(const Ctx& p, LAS unsigned char* lds, int l) {
    const int tid = opaque_tid(), G = gridDim.x;
    bf16_t* PROJ = (bf16_t*)(p.ws + WS_PROJ); bf16_t* TR = (bf16_t*)(p.ws + WS_TR);
    {
        const int lane = tid & 63, wave = tid >> 6, gw = blockIdx.x * 8 + wave, NGW = G * 8;
        LAS float* T = (LAS float*)(lds + wave * 17168);
        const float* sw = inp(p.ws, I_HSW) + (size_t)l * 3 * 768; const float* sb = inp(p.ws, I_HSB) + (size_t)l * 768;
        const int lr = lane >> 3, lc = lane & 7;
        for (int it = gw; it < 320 * 22; it += NGW) {
            const int cb = it % 22, rb = it / 22, row0 = rb * 64, tcol0 = cb * 64;
            int src; bool hy = false;
            if (tcol0 < 256) src = 512 + tcol0; else if (tcol0 < 384) src = 1152 + (tcol0 - 256); else if (tcol0 < 640) src = 2560 + (tcol0 - 384); else { src = 1280 + (tcol0 - 640); hy = true; }
            const bool seq_start = row0 < M_CTX ? ((row0 & 255) == 0) : (((row0 - M_CTX) & 2047) == 0);
            const int rend = row0 + 64; const bool seq_end = rend <= M_CTX ? ((rend & 255) == 0) : (((rend - M_CTX) & 2047) == 0);
            const bf16_t* sp = PROJ + (size_t)row0 * PROJW + src + lc * 8;
            u32x4 w[8], wh = (u32x4){0u, 0u, 0u, 0u};
#pragma unroll
            for (int i = 0; i < 8; ++i) w[i] = *(const u32x4*)(sp + (size_t)(i * 8 + lr) * PROJW);
            if (hy && lane < 16) { const bool top = lane < 8; const bool ok = top ? !seq_start : !seq_end;
                if (ok) wh = *(const u32x4*)(sp + (top ? -(ptrdiff_t)PROJW : (ptrdiff_t)64 * PROJW)); }
#pragma unroll
            for (int i = 0; i < 8; ++i) { LAS float* d = T + (1 + i * 8 + lr) * 65 + lc * 8;
                d[0] = bflo(w[i].x); d[1] = bfhi(w[i].x); d[2] = bflo(w[i].y); d[3] = bfhi(w[i].y); d[4] = bflo(w[i].z); d[5] = bfhi(w[i].z); d[6] = bflo(w[i].w); d[7] = bfhi(w[i].w); }
            if (hy && lane < 16) { LAS float* d = T + (lane < 8 ? 0 : 65) * 65 + lc * 8;
                d[0] = bflo(wh.x); d[1] = bfhi(wh.x); d[2] = bflo(wh.y); d[3] = bfhi(wh.y); d[4] = bflo(wh.z); d[5] = bfhi(wh.z); d[6] = bflo(wh.w); d[7] = bfhi(wh.w); }
            asm volatile("s_waitcnt lgkmcnt(0)" ::: "memory");
            const int rg = lane & 7, csub = lane >> 3;
#pragma unroll 2
            for (int j = 0; j < 8; ++j) {
                const int col = j * 8 + csub; float o[8];
                const LAS float* tp = T + (rg * 8) * 65 + col;
                if (hy) { const int ch = tcol0 - 640 + col; const float w0 = sw[ch], w1 = sw[768 + ch], w2 = sw[1536 + ch], bb = sb[ch];
                    float x[10];
#pragma unroll
                    for (int k = 0; k < 10; ++k) x[k] = tp[k * 65];
#pragma unroll
                    for (int k = 0; k < 8; ++k) o[k] = x[k] * w0 + x[k + 1] * w1 + x[k + 2] * w2 + bb;
                } else {
#pragma unroll
                    for (int k = 0; k < 8; ++k) o[k] = tp[(k + 1) * 65];
                }
                u32x4 ww; ww.x = cvt_pk_bf16(o[0], o[1]); ww.y = cvt_pk_bf16(o[2], o[3]); ww.z = cvt_pk_bf16(o[4], o[5]); ww.w = cvt_pk_bf16(o[6], o[7]);
                *(u32x4*)(TR + (size_t)(tcol0 + col) * M_TOT + row0 + rg * 8) = ww;
            }
            asm volatile("s_waitcnt lgkmcnt(0)" ::: "memory");
        }
    }
    const int gt = blockIdx.x * 512 + tid, NT = G * 512;
    for (int it = gt; it < M_CTX * 160; it += NT) {
        const int row = it / 160, ch = it - row * 160; int pc, H; size_t ob; int c8;
        if (ch < 32) { pc = 256; H = 4; ob = O_NAK; c8 = ch * 8; }
        else if (ch < 64) { pc = 512; H = 4; ob = O_NAV; c8 = (ch - 32) * 8; }
        else if (ch < 80) { pc = 1024; H = 2; ob = O_SWK; c8 = (ch - 64) * 8; }
        else if (ch < 96) { pc = 1152; H = 2; ob = O_SWV; c8 = (ch - 80) * 8; }
        else if (ch < 128) { pc = 2304; H = 4; ob = O_DFK; c8 = (ch - 96) * 8; }
        else { pc = 2560; H = 4; ob = O_DFV; c8 = (ch - 128) * 8; }
        const u32x4 w = *(const u32x4*)(PROJ + (size_t)row * PROJW + pc + c8);
        const int b = row >> 8, t = row & 255, h = c8 >> 6, d = c8 & 63;
        float* o = p.out + ob + ((((size_t)(b * 4 + l) * H + h) * 256 + t) * 64 + d);
        *(f32x4*)o = (f32x4){bflo(w.x), bfhi(w.x), bflo(w.y), bfhi(w.y)}; *(f32x4*)(o + 4) = (f32x4){bflo(w.z), bfhi(w.z), bflo(w.w), bfhi(w.w)};
    }
    for (int it = gt; it < M_DEC * 56; it += NT) {
        const int rowd = it / 56, q = it - rowd * 56, t = rowd & 2047, gr = t >> 6, gc = t & 63;
        int a, bofs, i0; float pos, fstep;
        if (q < 24) {
            const int base = q < 16 ? 768 : 1024, qq = q < 16 ? q : q - 16, h = qq >> 2, half = (qq >> 1) & 1, grp = qq & 1;
            a = base + h * 64 + half * 32 + grp * 8; bofs = 16; i0 = grp * 8; pos = half ? (float)gc : (float)gr; fstep = 13.287712379549449f / 16.f;
        } else {
            const int base = q < 40 ? 2048 : 2304, qq = q < 40 ? q - 24 : q - 40, mp32 = qq >> 1, half = qq & 1;
            a = base + mp32 * 32 + half * 16; bofs = 8; i0 = 0; pos = half ? (float)gc : (float)gr; fstep = 13.287712379549449f / 8.f;
        }
        bf16_t* pa = PROJ + (size_t)(M_CTX + rowd) * PROJW + a;
        const u32x4 wa = *(const u32x4*)pa, wb = *(const u32x4*)(pa + bofs);
        float xa[8], xb[8];
        xa[0] = bflo(wa.x); xa[1] = bfhi(wa.x); xa[2] = bflo(wa.y); xa[3] = bfhi(wa.y); xa[4] = bflo(wa.z); xa[5] = bfhi(wa.z); xa[6] = bflo(wa.w); xa[7] = bfhi(wa.w);
        xb[0] = bflo(wb.x); xb[1] = bfhi(wb.x); xb[2] = bflo(wb.y); xb[3] = bfhi(wb.y); xb[4] = bflo(wb.z); xb[5] = bfhi(wb.z); xb[6] = bflo(wb.w); xb[7] = bfhi(wb.w);
        float oa[8], ob[8];
#pragma unroll
        for (int j = 0; j < 8; ++j) { const float ang = pos * fast_exp2(-(float)(i0 + j) * fstep); const float cs = __cosf(ang), sn = __sinf(ang);
            oa[j] = xa[j] * cs - xb[j] * sn; ob[j] = xb[j] * cs + xa[j] * sn; }
        u32x4 ra, rb;
        ra.x = cvt_pk_bf16(oa[0], oa[1]); ra.y = cvt_pk_bf16(oa[2], oa[3]); ra.z = cvt_pk_bf16(oa[4], oa[5]); ra.w = cvt_pk_bf16(oa[6], oa[7]);
        rb.x = cvt_pk_bf16(ob[0], ob[1]); rb.y = cvt_pk_bf16(ob[2], ob[3]); rb.z = cvt_pk_bf16(ob[4], ob[5]); rb.w = cvt_pk_bf16(ob[6], ob[7]);
        *(u32x4*)pa = ra; *(u32x4*)(pa + bofs) = rb;
    }
}

struct AttnState { float m, l; f32x4 o[4]; };
__device__ __forceinline__ f32x4 mfma16(bf16x8 a, bf16x8 b, f32x4 c) { return __builtin_amdgcn_mfma_f32_16x16x32_bf16(a, b, c, 0, 0, 0); }

__device__ __forceinline__ float xmax16(float x) { const u32x2 r = __builtin_amdgcn_permlane16_swap(__float_as_uint(x), __float_as_uint(x), false, false); return fmaxf(__uint_as_float(r.x), __uint_as_float(r.y)); }
__device__ __forceinline__ float xmax32(float x) { const u32x2 r = __builtin_amdgcn_permlane32_swap(__float_as_uint(x), __float_as_uint(x), false, false); return fmaxf(__uint_as_float(r.x), __uint_as_float(r.y)); }
__device__ __forceinline__ float xadd16(float x) { const u32x2 r = __builtin_amdgcn_permlane16_swap(__float_as_uint(x), __float_as_uint(x), false, false); return __uint_as_float(r.x) + __uint_as_float(r.y); }
__device__ __forceinline__ float xadd32(float x) { const u32x2 r = __builtin_amdgcn_permlane32_swap(__float_as_uint(x), __float_as_uint(x), false, false); return __uint_as_float(r.x) + __uint_as_float(r.y); }
__device__ __forceinline__ void softmax_d16(AttnState& st, float (&s)[16], bool first, float& alpha, bool& resc, bf16x8& p0, bf16x8& p1) {
    float mx = fmaxf(fmaxf(fmaxf(s[0], s[1]), fmaxf(s[2], s[3])), fmaxf(fmaxf(s[4], s[5]), fmaxf(s[6], s[7])));
    mx = fmaxf(mx, fmaxf(fmaxf(fmaxf(s[8], s[9]), fmaxf(s[10], s[11])), fmaxf(fmaxf(s[12], s[13]), fmaxf(s[14], s[15]))));
    resc = first || (__builtin_amdgcn_ballot_w64(mx > 8.f) != 0ull);
    alpha = 1.f;
    if (resc) {
        mx = xmax16(mx); mx = xmax32(mx);
        const float d = first ? mx : fmaxf(mx, 0.f);
        alpha = first ? 0.f : fast_exp2(-d);
        st.m = first ? mx : st.m + d;
#pragma unroll
        for (int j = 0; j < 16; ++j) s[j] -= d;
    }
    float pr[16];
#pragma unroll
    for (int j = 0; j < 16; ++j) pr[j] = fast_exp2(s[j]);
    float sum = (((pr[0] + pr[1]) + (pr[2] + pr[3])) + ((pr[4] + pr[5]) + (pr[6] + pr[7]))) + (((pr[8] + pr[9]) + (pr[10] + pr[11])) + ((pr[12] + pr[13]) + (pr[14] + pr[15])));
    sum = xadd16(sum); sum = xadd32(sum);
    st.l = st.l * alpha + sum;
    u32x4 w0, w1;
    w0.x = cvt_pk_bf16(pr[0], pr[1]); w0.y = cvt_pk_bf16(pr[2], pr[3]); w0.z = cvt_pk_bf16(pr[4], pr[5]); w0.w = cvt_pk_bf16(pr[6], pr[7]);
    w1.x = cvt_pk_bf16(pr[8], pr[9]); w1.y = cvt_pk_bf16(pr[10], pr[11]); w1.z = cvt_pk_bf16(pr[12], pr[13]); w1.w = cvt_pk_bf16(pr[14], pr[15]);
    p0 = __builtin_bit_cast(bf16x8, w0); p1 = __builtin_bit_cast(bf16x8, w1);
}
__device__ __forceinline__ bf16x8 softmax_p(AttnState& st, const float (&s2)[8], unsigned vm, float& alpha) {
    float mx = -1e30f;
#pragma unroll
    for (int j = 0; j < 8; ++j) mx = fmaxf(mx, ((vm >> j) & 1u) ? s2[j] : -1e30f);
    mx = xmax16(mx); mx = xmax32(mx);
    const float mn = fmaxf(st.m, mx); alpha = fast_exp2(st.m - mn);
    float pr[8]; float sum = 0.f;
#pragma unroll
    for (int j = 0; j < 8; ++j) { pr[j] = ((vm >> j) & 1u) ? fast_exp2(s2[j] - mn) : 0.f; sum += pr[j]; }
    sum += __shfl_xor(sum, 16); sum += __shfl_xor(sum, 32);
    st.l = st.l * alpha + sum; st.m = mn;
    u32x4 pw; pw.x = cvt_pk_bf16(pr[0], pr[1]); pw.y = cvt_pk_bf16(pr[2], pr[3]); pw.z = cvt_pk_bf16(pr[4], pr[5]); pw.w = cvt_pk_bf16(pr[6], pr[7]);
    return __builtin_bit_cast(bf16x8, pw);
}
__device__ __forceinline__ bf16x8 softmax_d(AttnState& st, const float (&s2)[8], float& alpha, bool& resc) {
    float mx = fmaxf(fmaxf(fmaxf(s2[0], s2[1]), fmaxf(s2[2], s2[3])), fmaxf(fmaxf(s2[4], s2[5]), fmaxf(s2[6], s2[7])));
    mx = fmaxf(mx, __shfl_xor(mx, 16)); mx = fmaxf(mx, __shfl_xor(mx, 32));
    const float mn = fmaxf(st.m, mx);
    resc = __builtin_amdgcn_ballot_w64(mn > st.m) != 0ull;
    alpha = fast_exp2(st.m - mn);
    float pr[8];
#pragma unroll
    for (int j = 0; j < 8; ++j) pr[j] = fast_exp2(s2[j] - mn);
    float sum = ((pr[0] + pr[1]) + (pr[2] + pr[3])) + ((pr[4] + pr[5]) + (pr[6] + pr[7]));
    sum = xadd16(sum); sum = xadd32(sum);
    st.l = st.l * alpha + sum; st.m = mn;
    u32x4 pw; pw.x = cvt_pk_bf16(pr[0], pr[1]); pw.y = cvt_pk_bf16(pr[2], pr[3]); pw.z = cvt_pk_bf16(pr[4], pr[5]); pw.w = cvt_pk_bf16(pr[6], pr[7]);
    return __builtin_bit_cast(bf16x8, pw);
}
__device__ __forceinline__ void st_init(AttnState& st, float m0, float l0) { st.m = m0; st.l = l0;
#pragma unroll
    for (int i = 0; i < 4; ++i) st.o[i] = (f32x4){0.f, 0.f, 0.f, 0.f}; }

constexpr int AT_ROWB = 144;
constexpr int AT_TILEB = 64 * AT_ROWB;
struct ATC { int l15, quad, kr0, lat0, nlat, rs_w, r_w; int cg4[2], qc[2], c0[2], qt[2], q0[2]; bool dec; const float* rpb; };

template <int TYPE>
__device__ __forceinline__ void attn_tile(AttnState (&sa)[2], AttnState (&sb)[2], const bf16x8 (&qf)[2][2], const ATC& c, const LAS unsigned char* kt, const LAS unsigned char* vt, int i) {
    const bool masked = c.dec && (i < c.nlat) && (TYPE != 2);
    if (TYPE == 0 && masked) { const int krow = c.lat0 + i; if (!((krow >= c.rs_w) && (krow < c.rs_w + 8))) return; }
    const f32x4 z4 = (f32x4){0.f, 0.f, 0.f, 0.f};
    if (!masked) {
        bf16x8 pA[2][2], pB[2][2]; float alA[2], alB[2]; bool rA[2], rB[2];
        const bool first = (TYPE != 1) && (i == 0);
        if (TYPE == 2) {
#pragma unroll
            for (int qi = 0; qi < 2; ++qi)
#pragma unroll
                for (int mp = 0; mp < 2; ++mp) {
                    float s2[16];
#pragma unroll
                    for (int ss = 0; ss < 2; ++ss)
#pragma unroll
                        for (int t = 0; t < 2; ++t) { const int kr = ss * 32 + c.kr0 + 4 * t, sw = ((kr >> 4) & 1) << 2;
                            const bf16x8 kf = *(const LAS bf16x8*)(kt + kr * AT_ROWB + (((mp * 4 + c.quad) ^ sw) << 4));
                            const float nm = first ? 0.f : -(mp == 0 ? sa[qi].m : sb[qi].m);
                            const f32x4 a = mfma16(kf, qf[qi][mp], (f32x4){nm, nm, nm, nm});
#pragma unroll
                            for (int e = 0; e < 4; ++e) s2[ss * 8 + t * 4 + e] = a[e]; }
                    if (mp == 0) softmax_d16(sa[qi], s2, first, alA[qi], rA[qi], pA[qi][0], pA[qi][1]); else softmax_d16(sb[qi], s2, first, alB[qi], rB[qi], pB[qi][0], pB[qi][1]);
                    asm volatile("" ::: "memory");
                }
        } else {
            bf16x8 kf[2][2][2];
#pragma unroll
            for (int ss = 0; ss < 2; ++ss)
#pragma unroll
                for (int t = 0; t < 2; ++t) { const int kr = ss * 32 + c.kr0 + 4 * t, sw = ((kr >> 4) & 1) << 2;
#pragma unroll
                    for (int cc = 0; cc < 2; ++cc) kf[ss][t][cc] = *(const LAS bf16x8*)(kt + kr * AT_ROWB + (((cc * 4 + c.quad) ^ sw) << 4)); }
#pragma unroll
            for (int qi = 0; qi < 2; ++qi) {
                float s2[16];
#pragma unroll
                for (int ss = 0; ss < 2; ++ss)
#pragma unroll
                    for (int t = 0; t < 2; ++t) { const float nm = first ? 0.f : -sa[qi].m; f32x4 a = mfma16(kf[ss][t][0], qf[qi][0], (f32x4){nm, nm, nm, nm}); a = mfma16(kf[ss][t][1], qf[qi][1], a);
#pragma unroll
                        for (int e = 0; e < 4; ++e) s2[ss * 8 + t * 4 + e] = a[e]; }
                softmax_d16(sa[qi], s2, first, alA[qi], rA[qi], pA[qi][0], pA[qi][1]);
            }
        }
#pragma unroll
        for (int qi = 0; qi < 2; ++qi) {
            if (rA[qi]) {
#pragma unroll
                for (int nt = 0; nt < 4; ++nt) sa[qi].o[nt] = sa[qi].o[nt] * alA[qi]; }
            if (TYPE == 2) { if (rB[qi]) {
#pragma unroll
                for (int nt = 0; nt < 4; ++nt) sb[qi].o[nt] = sb[qi].o[nt] * alB[qi]; } }
        }
#pragma unroll
        for (int ss = 0; ss < 2; ++ss) {
            bf16x8 vf[4];
#pragma unroll
            for (int nt = 0; nt < 4; ++nt) vf[nt] = *(const LAS bf16x8*)(vt + (nt * 16 + c.l15) * AT_ROWB + ss * 64 + (c.quad << 4));
#pragma unroll
            for (int qi = 0; qi < 2; ++qi)
#pragma unroll
                for (int nt = 0; nt < 4; ++nt) { sa[qi].o[nt] = mfma16(vf[nt], pA[qi][ss], sa[qi].o[nt]); if (TYPE == 2) sb[qi].o[nt] = mfma16(vf[nt], pB[qi][ss], sb[qi].o[nt]); }
        }
        return;
    }
#pragma unroll 1
    for (int ss = 0; ss < 2; ++ss) {
        bool on[2];
#pragma unroll
        for (int qi = 0; qi < 2; ++qi) {
            on[qi] = true;
            if (TYPE == 0) on[qi] = !((c.cg4[qi] == 0 && ss == 1) || (c.cg4[qi] == 3 && ss == 0));
            if (TYPE == 1) { const int k0 = (c.lat0 + i) * 64 + ss * 32; on[qi] = (k0 + 31 >= c.q0[qi] - 128) && (k0 <= c.q0[qi] + 15 + 128); }
        }
        if (on[0] || on[1]) {
            const int krA = ss * 32 + c.kr0, krB = krA + 4;
            const int swA = ((krA >> 4) & 1) << 2, swB = ((krB >> 4) & 1) << 2;
            bf16x8 kf[2][2];
#pragma unroll
            for (int cc = 0; cc < 2; ++cc) { kf[0][cc] = *(const LAS bf16x8*)(kt + krA * AT_ROWB + (((cc * 4 + c.quad) ^ swA) << 4)); kf[1][cc] = *(const LAS bf16x8*)(kt + krB * AT_ROWB + (((cc * 4 + c.quad) ^ swB) << 4)); }
            bf16x8 vf[4];
#pragma unroll
            for (int nt = 0; nt < 4; ++nt) vf[nt] = *(const LAS bf16x8*)(vt + (nt * 16 + c.l15) * AT_ROWB + ss * 64 + (c.quad << 4));
#pragma unroll
            for (int qi = 0; qi < 2; ++qi) {
                if (on[qi]) {
                    f32x4 a0 = mfma16(kf[0][0], qf[qi][0], z4), a1 = mfma16(kf[1][0], qf[qi][0], z4); a0 = mfma16(kf[0][1], qf[qi][1], a0); a1 = mfma16(kf[1][1], qf[qi][1], a1);
                    float s2[8]; unsigned vm = 0u;
#pragma unroll
                    for (int e = 0; e < 4; ++e) { s2[e] = a0[e]; s2[4 + e] = a1[e]; }
                    if (TYPE == 0) {
                        const float* rp = c.rpb + (c.lat0 + i - c.r_w + 7) * 31;
#pragma unroll
                        for (int j = 0; j < 8; ++j) { const int kc = ss * 32 + c.quad * 8 + j; const bool ok = (kc >= c.c0[qi]) && (kc < c.c0[qi] + 16);
                            const int dc = min(max(kc - c.qc[qi] + 15, 0), 30); s2[j] = s2[j] + rp[dc] * LOG2E; vm |= ok ? (1u << j) : 0u; }
                    } else {
#pragma unroll
                        for (int j = 0; j < 8; ++j) { const int dd = (c.lat0 + i) * 64 + ss * 32 + c.quad * 8 + j - c.qt[qi]; const bool ok = (dd <= 128) && (dd >= -128); vm |= ok ? (1u << j) : 0u; }
                    }
                    float al; const bf16x8 pA = softmax_p(sa[qi], s2, vm, al);
#pragma unroll
                    for (int nt = 0; nt < 4; ++nt) sa[qi].o[nt] = mfma16(vf[nt], pA, sa[qi].o[nt] * al);
                }
            }
        }
    }
}

template <int TYPE>
__device__ __forceinline__ void attn_block(const Ctx& p, LAS unsigned char* lds, int l, bool dec, int b, int h, int qblk) {
    const int tid = opaque_tid(), lane = tid & 63, wave = __builtin_amdgcn_readfirstlane(tid >> 6);
    ATC c; c.l15 = lane & 15; c.quad = lane >> 4; c.dec = dec;
    const bf16_t* PROJ = (const bf16_t*)(p.ws + WS_PROJ); const bf16_t* TR = (const bf16_t*)(p.ws + WS_TR);
    const bf16_t* CK = (const bf16_t*)(p.ws + WS_CK); const bf16_t* CV = CK + CK_HALF;
    bf16_t* BR = (bf16_t*)(p.ws + WS_BR);
    const int L = dec ? 2048 : 256, rowbase = dec ? M_CTX + b * 2048 : b * 256, q0 = qblk * 256 + wave * 32;
    const bf16_t* Pb = PROJ + (size_t)rowbase * PROJW;
    LAS unsigned char* KL = lds; LAS unsigned char* VL = lds + 2 * AT_TILEB;
    int qcol, kcol, vcol, hk, Hc; size_t ckoff;
    if (TYPE == 0) { qcol = h * 64; kcol = 256 + h * 64; vcol = h * 64; hk = h; Hc = 4; ckoff = CK_NA; }
    else if (TYPE == 1) { qcol = 768 + h * 64; kcol = 1024 + (h >> 1) * 64; vcol = 256 + (h >> 1) * 64; hk = h >> 1; Hc = 2; ckoff = CK_SW; }
    else { qcol = 2048 + h * 64; kcol = 2304 + h * 64; vcol = 384 + h * 64; hk = h; Hc = 4; ckoff = CK_DF; }
    const int ncache = dec ? 8 : 0;
    c.rs_w = 0; c.r_w = 0;
    int cgb = 0;
    if (!dec) { c.lat0 = 0; c.nlat = 4; }
    else if (TYPE == 0) { const int r0 = qblk * 4; const int rsA = min(max(r0 - 4, 0), 24), rsB = min(max(r0 - 1, 0), 24); c.lat0 = rsA; c.nlat = rsB + 8 - rsA;
        c.r_w = r0 + (wave >> 1); c.rs_w = min(max(c.r_w - 4, 0), 24); cgb = (wave & 1) * 2; }
    else if (TYPE == 1) { const int q0b = qblk * 256; c.lat0 = max(q0b - 128, 0) >> 6; c.nlat = (min(q0b + 384, L) >> 6) - c.lat0; }
    else { c.lat0 = 0; c.nlat = 32; }
#pragma unroll
    for (int qi = 0; qi < 2; ++qi) { c.cg4[qi] = cgb + qi; c.q0[qi] = q0 + 16 * qi; c.qt[qi] = q0 + 16 * qi + c.l15; c.qc[qi] = c.cg4[qi] * 16 + c.l15; c.c0[qi] = min(max(c.qc[qi] - 8, 0), 48); }
    const int ntile = c.nlat + ncache;
    const int srow = tid >> 3, sch = tid & 7;
    const int kst_off = srow * AT_ROWB + ((sch ^ (((srow >> 4) & 1) << 2)) << 4), vst_off = srow * AT_ROWB + (sch << 4);
    const bf16_t* klat = Pb + kcol + (size_t)(c.lat0 * 64 + srow) * PROJW + sch * 8;
    const bf16_t* vlat = TR + (size_t)(vcol + srow) * M_TOT + rowbase + c.lat0 * 64 + sch * 8;
    const bf16_t* kcac = CK + ckoff + ((size_t)(b * Hc + hk) * 512 + srow) * 64 + sch * 8;
    const bf16_t* vcac = CV + ckoff + ((size_t)(b * Hc + hk) * 64 + srow) * 512 + sch * 8;
    c.kr0 = (c.l15 >> 2) * 8 + (c.l15 & 3);
    bf16x8 qf[2][2];
    AttnState sa[2], sb[2];
    float sc2, m0, l0;
    if (TYPE == 1) { m0 = inp(p.ws, I_SINK)[l * 4 + h] * LOG2E; l0 = 1.f; sc2 = 0.125f * LOG2E; }
    else if (TYPE == 0) { m0 = -1e30f; l0 = 0.f; sc2 = 0.125f * LOG2E; }
    else { m0 = -1e30f; l0 = 0.f; sc2 = 0.17677669529663687f * LOG2E; }
#pragma unroll
    for (int qi = 0; qi < 2; ++qi) {
        st_init(sa[qi], m0, l0); st_init(sb[qi], -1e30f, 0.f);
        const size_t qrow = (size_t)(q0 + 16 * qi + c.l15) * PROJW;
        const u32x4 q0w = *(const u32x4*)(Pb + qrow + qcol + c.quad * 8), q1w = *(const u32x4*)(Pb + qrow + qcol + 32 + c.quad * 8);
        u32x4 a, bq;
        a.x = cvt_pk_bf16(bflo(q0w.x) * sc2, bfhi(q0w.x) * sc2); a.y = cvt_pk_bf16(bflo(q0w.y) * sc2, bfhi(q0w.y) * sc2); a.z = cvt_pk_bf16(bflo(q0w.z) * sc2, bfhi(q0w.z) * sc2); a.w = cvt_pk_bf16(bflo(q0w.w) * sc2, bfhi(q0w.w) * sc2);
        bq.x = cvt_pk_bf16(bflo(q1w.x) * sc2, bfhi(q1w.x) * sc2); bq.y = cvt_pk_bf16(bflo(q1w.y) * sc2, bfhi(q1w.y) * sc2); bq.z = cvt_pk_bf16(bflo(q1w.z) * sc2, bfhi(q1w.z) * sc2); bq.w = cvt_pk_bf16(bflo(q1w.w) * sc2, bfhi(q1w.w) * sc2);
        qf[qi][0] = __builtin_bit_cast(bf16x8, a); qf[qi][1] = __builtin_bit_cast(bf16x8, bq);
    }
    c.rpb = inp(p.ws, I_RPB) + ((size_t)(l * 4 + h)) * 15 * 31;
#define AT_KSRC(n) (((n) < c.nlat) ? klat + (size_t)(n) * 64 * PROJW : kcac + (size_t)((n) - c.nlat) * 4096)
#define AT_VSRC(n) (((n) < c.nlat) ? vlat + (n) * 64 : vcac + ((n) - c.nlat) * 64)
    u32x4 kA, vA, kB, vB;
    kA = *(const u32x4*)AT_KSRC(0); vA = *(const u32x4*)AT_VSRC(0);
    { const int n1 = min(1, ntile - 1); kB = *(const u32x4*)AT_KSRC(n1); vB = *(const u32x4*)AT_VSRC(n1); }
    *(LAS u32x4*)(KL + kst_off) = kA; *(LAS u32x4*)(VL + vst_off) = vA;
    __syncthreads();
#pragma unroll 1
    for (int i = 0; i < ntile; i += 2) {
        { const int n2 = min(i + 2, ntile - 1); kA = *(const u32x4*)AT_KSRC(n2); vA = *(const u32x4*)AT_VSRC(n2); }
        attn_tile<TYPE>(sa, sb, qf, c, KL, VL, i);
        *(LAS u32x4*)(KL + AT_TILEB + kst_off) = kB; *(LAS u32x4*)(VL + AT_TILEB + vst_off) = vB;
        __syncthreads();
        if (i + 1 >= ntile) break;
        { const int n3 = min(i + 3, ntile - 1); kB = *(const u32x4*)AT_KSRC(n3); vB = *(const u32x4*)AT_VSRC(n3); }
        attn_tile<TYPE>(sa, sb, qf, c, KL + AT_TILEB, VL + AT_TILEB, i + 1);
        *(LAS u32x4*)(KL + kst_off) = kA; *(LAS u32x4*)(VL + vst_off) = vA;
        __syncthreads();
    }
#undef AT_KSRC
#undef AT_VSRC
#pragma unroll
    for (int qi = 0; qi < 2; ++qi) {
        const size_t orow = (size_t)(rowbase + q0 + 16 * qi + c.l15) * 256 + h * 64 + c.quad * 4;
        if (TYPE != 2) {
            const float il = fast_rcp(sa[qi].l);
            bf16_t* o = BR + (TYPE == 1 ? (size_t)M_TOT * 256 : 0) + orow;
#pragma unroll
            for (int nt = 0; nt < 4; ++nt) { u32x2 w; w.x = cvt_pk_bf16(sa[qi].o[nt][0] * il, sa[qi].o[nt][1] * il); w.y = cvt_pk_bf16(sa[qi].o[nt][2] * il, sa[qi].o[nt][3] * il); *(u32x2*)(o + nt * 16) = w; }
        } else {
            const float lam = ((const float*)(p.ws + WS_LAM))[l], lam_init = ((const float*)(p.ws + WS_LAM))[4 + l];
            const float i0 = fast_rcp(sa[qi].l), i1 = lam * fast_rcp(sb[qi].l);
            f32x4 d[4]; float ss = 0.f;
#pragma unroll
            for (int i = 0; i < 4; ++i) { d[i] = sa[qi].o[i] * i0 - sb[qi].o[i] * i1; ss += (d[i][0] * d[i][0] + d[i][1] * d[i][1]) + (d[i][2] * d[i][2] + d[i][3] * d[i][3]); }
            ss = xadd16(ss); ss = xadd32(ss);
            const float rs = rsqrtf(ss * (1.f / 64.f) + EPSF) * (1.f - lam_init);
            const float* sg = inp(p.ws, I_DSUB) + l * 64 + c.quad * 4;
            bf16_t* o = BR + (size_t)3 * M_TOT * 256 + orow;
#pragma unroll
            for (int nt = 0; nt < 4; ++nt) { const f32x4 g4 = *(const f32x4*)(sg + nt * 16); const f32x4 v = d[nt] * rs * g4;
                u32x2 w; w.x = cvt_pk_bf16(v[0], v[1]); w.y = cvt_pk_bf16(v[2], v[3]); *(u32x2*)(o + nt * 16) = w; }
        }
    }
}

__device__ __forceinline__ void hyena_unit(const Ctx& p, LAS unsigned char* lds, int l, int c, bool dec) {
    const int tid = opaque_tid(), lane = tid & 63, wave = __builtin_amdgcn_readfirstlane(tid >> 6), l15 = lane & 15, quad = lane >> 4;
    const int L = dec ? 2048 : 256, B = dec ? 8 : 16, LP = L + 8, rowbase = dec ? M_CTX : 0, L2 = 2 * L, CS = L2 + 16;
    LAS bf16_t* COP = (LAS bf16_t*)lds;
    LAS bf16_t* YA = (LAS bf16_t*)(lds + 66048);
    LAS bf16_t* YB = (LAS bf16_t*)(lds + 66048 + 33024);
    LAS float* RED = (LAS float*)(lds + 66048 + 2 * 33024);
    const bf16_t* TR = (const bf16_t*)(p.ws + WS_TR);
    bf16_t* BR2 = (bf16_t*)(p.ws + WS_BR) + (size_t)2 * M_TOT * 256;
    const float* HF = (const float*)(p.ws + WS_HFIL) + (dec ? 262144 : 0);
    { const bf16_t* src = TR + (size_t)(640 + c) * M_TOT + rowbase;
      for (int i = tid; i < B * L / 8; i += 512) { const int e = i * 8, b = e / L, t = e - b * L; *(LAS u32x4*)(YA + b * LP + t) = *(const u32x4*)(src + e); } }
#pragma unroll 1
    for (int o = 0; o < 2; ++o) {
        LAS float* RF = (LAS float*)(o == 0 ? YB : YA);
        __syncthreads();
        const float* raw0 = HF + ((size_t)((o * 2 + 0) * 256 + c)) * L; const float* raw1 = HF + ((size_t)((o * 2 + 1) * 256 + c)) * L;
        float part = 0.f;
        for (int u = tid; u < L2; u += 512) { const int lag = L - 1 - u; float v = 0.f; if (lag >= 0) v = raw0[lag]; else if (lag > -L) v = raw1[-lag]; RF[u] = v; part += fabsf(v); }
        part = wave_sum(part);
        if (lane == 0) RED[wave] = part;
        __syncthreads();
        float tot = 0.f;
#pragma unroll
        for (int w = 0; w < 8; ++w) tot += RED[w];
        const float inv = 1.f / (tot + EPSF);
        const int ng = L2 / 8;
        for (int idx = tid; idx < 8 * ng; idx += 512) { const int m = idx / ng, x = (idx - m * ng) * 8; float v[8];
#pragma unroll
            for (int j = 0; j < 8; ++j) { const int u = x + m + j; v[j] = (u < L2) ? RF[u] * inv : 0.f; }
            u32x4 w; w.x = cvt_pk_bf16(v[0], v[1]); w.y = cvt_pk_bf16(v[2], v[3]); w.z = cvt_pk_bf16(v[4], v[5]); w.w = cvt_pk_bf16(v[6], v[7]);
            *(LAS u32x4*)(COP + m * CS + x) = w; }
        __syncthreads();
        const LAS bf16_t* Y = (o == 0) ? YA : YB;
        const LAS bf16_t* cpb = COP + (7 - (l15 & 7)) * CS + (L - 8 - 8 * (l15 >> 3) + quad * 8);
        const float skip = inp(p.ws, I_HSKIP)[(l * 2 + o) * 256 + c];
        const bf16_t* gate = TR + (size_t)((o == 0 ? 896 : 1152) + c) * M_TOT + rowbase;
        const int ngroups = L / 64;
        const bf16x8 zero8 = (bf16x8){0, 0, 0, 0, 0, 0, 0, 0};
        for (int g = wave; g < ngroups; g += 8) {
            const int t0 = (g >> 1) * 128 + (g & 1) * 16;
            f32x4 a0 = (f32x4){0.f, 0.f, 0.f, 0.f}, a1 = a0, a2 = a0, a3 = a0;
#define HY_D(s) (*(const LAS bf16x8*)(cpb + (32 * (s) - t0)))
#define HY_Y(s) ((l15 < B) ? *(const LAS bf16x8*)(Y + l15 * LP + 32 * (s) + quad * 8) : zero8)
            bf16x8 d0, d1 = HY_D(-1), d2 = HY_D(-2), d3 = HY_D(-3), y;
            for (int s = 0; s < L / 32; s += 4) {
                d0 = HY_D(s);     y = HY_Y(s);     a0 = mfma16(d0, y, a0); a1 = mfma16(d1, y, a1); a2 = mfma16(d2, y, a2); a3 = mfma16(d3, y, a3);
                d3 = HY_D(s + 1); y = HY_Y(s + 1); a0 = mfma16(d3, y, a0); a1 = mfma16(d0, y, a1); a2 = mfma16(d1, y, a2); a3 = mfma16(d2, y, a3);
                d2 = HY_D(s + 2); y = HY_Y(s + 2); a0 = mfma16(d2, y, a0); a1 = mfma16(d3, y, a1); a2 = mfma16(d0, y, a2); a3 = mfma16(d1, y, a3);
                d1 = HY_D(s + 3); y = HY_Y(s + 3); a0 = mfma16(d1, y, a0); a1 = mfma16(d2, y, a1); a2 = mfma16(d3, y, a2); a3 = mfma16(d0, y, a3);
            }
#undef HY_D
#undef HY_Y
            if (l15 < B) {
#pragma unroll
                for (int a = 0; a < 4; ++a) {
                    const f32x4 cv = a == 0 ? a0 : (a == 1 ? a1 : (a == 2 ? a2 : a3));
                    const int t = t0 + 32 * a + quad * 4;
                    const u32x2 gw = *(const u32x2*)(gate + (size_t)l15 * L + t);
                    const u32x2 yw = *(const LAS u32x2*)(Y + l15 * LP + t);
                    f32x4 r;
                    r[0] = bflo(gw.x) * (cv[0] + skip * bflo(yw.x)); r[1] = bfhi(gw.x) * (cv[1] + skip * bfhi(yw.x));
                    r[2] = bflo(gw.y) * (cv[2] + skip * bflo(yw.y)); r[3] = bfhi(gw.y) * (cv[3] + skip * bfhi(yw.y));
                    if (o == 0) { u32x2 w; w.x = cvt_pk_bf16(r[0], r[1]); w.y = cvt_pk_bf16(r[2], r[3]); *(LAS u32x2*)(YB + l15 * LP + t) = w; }
                    else { bf16_t* op = BR2 + (size_t)(rowbase + l15 * L + t) * 256 + c;
                        op[0] = f2bf1(r[0]); op[256] = f2bf1(r[1]); op[512] = f2bf1(r[2]); op[768] = f2bf1(r[3]); }
                }
            }
        }
    }
    __syncthreads();
}

__device__ __forceinline__ void mix_phase(const Ctx& p, LAS unsigned char* lds, int l) {
    const int G = gridDim.x;
    for (int u = blockIdx.x; u < 512; u += G) hyena_unit(p, lds, l, u & 255, u < 256);
#ifdef PROBE_HY2
    for (int u = blockIdx.x; u < 512; u += G) hyena_unit(p, lds, l, u & 255, u < 256);
#endif
    const int vcu = (G % 8 == 0) ? ((int)blockIdx.x % 8) * (G / 8) + (int)blockIdx.x / 8 : (int)blockIdx.x;
#pragma unroll 1
    for (int it = vcu; it < 960; it += G) {
        if (it < 768) { const int k = it >> 8, r = it & 255, qblk = r & 7, bh = r >> 3;
            if (k == 0) attn_block<2>(p, lds, l, true, bh >> 2, bh & 3, qblk); else if (k == 1) attn_block<1>(p, lds, l, true, bh >> 2, bh & 3, qblk); else attn_block<0>(p, lds, l, true, bh >> 2, bh & 3, qblk); }
        else { const int q = it - 768, k = q >> 6, bh = q & 63;
            if (k == 0) attn_block<2>(p, lds, l, false, bh >> 2, bh & 3, 0); else if (k == 1) attn_block<1>(p, lds, l, false, bh >> 2, bh & 3, 0); else attn_block<0>(p, lds, l, false, bh >> 2, bh & 3, 0); }
    }
}

#define XB_TMO      128
#define XB_XCNT(j)  (256  + 64 * (j))
#define XB_XSUB(j)  (1280 + 64 * (j))
#define XB_XGEN(j)  (2304 + 64 * (j))
#define XB_TOP      3328
#define XB_TOPGEN   3392
#define XB_SPIN_CAP (1u << 22)
__device__ __forceinline__ unsigned xb_ld(unsigned* p)              { return __hip_atomic_load(p, __ATOMIC_RELAXED, __HIP_MEMORY_SCOPE_AGENT); }
__device__ __forceinline__ unsigned xb_add(unsigned* p, unsigned v) { return __hip_atomic_fetch_add(p, v, __ATOMIC_RELAXED, __HIP_MEMORY_SCOPE_AGENT); }
__device__ __forceinline__ unsigned xb_xcc_id() { return (unsigned)__builtin_amdgcn_s_getreg((3 << 11) | 20) & 0xFu; }
#define XB_SPIN(cond, bar) do { unsigned _sp = 0; while (cond) { __builtin_amdgcn_s_sleep(1); \
    if ((++_sp & 255u) == 0u) { if (xb_ld(&(bar)[XB_TMO])) break; if (_sp > XB_SPIN_CAP) { atomicAdd(&(bar)[XB_TMO], 1u); break; } } } } while (0)
struct XcdBarrier { unsigned* bar; unsigned x; volatile LAS unsigned* st; };
__device__ __forceinline__ XcdBarrier xcd_barrier_post(unsigned* bar, volatile LAS unsigned* st) {
    XcdBarrier b; b.bar = bar; b.x = xb_xcc_id(); b.st = st;
    if (threadIdx.x == 0) (void)xb_add(&bar[XB_XCNT(b.x)], 1u);
    return b;
}
__device__ __forceinline__ void xcd_barrier_complete(unsigned* bar, unsigned x, unsigned& nloc, unsigned& nx) {
    const unsigned G = gridDim.x * gridDim.y * gridDim.z;
    unsigned sum, cnt, mine, sp = 0u;
    for (;;) {
        sum = 0u; cnt = 0u; mine = 0u;
#pragma unroll
        for (unsigned j = 0; j < 16; ++j) { const unsigned c = xb_ld(&bar[XB_XCNT(j)]); sum += c; cnt += (c > 0u) ? 1u : 0u; mine = (j == x) ? c : mine; }
        if (sum == G) break;
        __builtin_amdgcn_s_sleep(1);
        if ((++sp & 255u) == 0u) { if (xb_ld(&bar[XB_TMO])) break; if (sp > XB_SPIN_CAP) { atomicAdd(&bar[XB_TMO], 1u); break; } }
    }
    nloc = mine > 0u ? mine : 1u; nx = cnt > 0u ? cnt : 1u;
}
__device__ __forceinline__ void xcd_barrier(const XcdBarrier& b) {
    asm volatile("s_waitcnt vmcnt(0)" ::: "memory");
    __syncthreads();
    if (threadIdx.x == 0) {
        unsigned* bar = b.bar;
        __builtin_amdgcn_s_waitcnt(0);
        unsigned nloc = b.st[0], nx = b.st[1];
        if (nloc == 0u) { xcd_barrier_complete(bar, b.x, nloc, nx); b.st[0] = nloc; b.st[1] = nx; }
        const unsigned old = xb_add(&bar[XB_XSUB(b.x)], 1u);
        const unsigned gen = old / nloc;
        if (old + 1u == (gen + 1u) * nloc) {
            __builtin_amdgcn_fence(__ATOMIC_RELEASE, "agent");
            asm volatile("s_waitcnt vmcnt(0)" ::: "memory");
            const unsigned og = xb_add(&bar[XB_TOP], 1u);
            const unsigned tg = og / nx;
            if (og + 1u == (tg + 1u) * nx) xb_add(&bar[XB_TOPGEN], 1u);
            else XB_SPIN(xb_ld(&bar[XB_TOPGEN]) == tg, bar);
            __builtin_amdgcn_fence(__ATOMIC_ACQUIRE, "agent");
            xb_add(&bar[XB_XGEN(b.x)], 1u);
            asm volatile("s_waitcnt vmcnt(0)" ::: "memory");
        } else {
            XB_SPIN(xb_ld(&bar[XB_XGEN(b.x)]) == gen, bar);
            __builtin_amdgcn_fence(__ATOMIC_ACQUIRE, "agent");
            asm volatile("s_waitcnt vmcnt(0)" ::: "memory");
        }
    }
    __syncthreads();
}

__global__ void __launch_bounds__(512, 2) mega(Params P) {
    extern __shared__ __attribute__((aligned(16))) unsigned char lds_raw[];
    LAS unsigned char* lds = (LAS unsigned char*)lds_raw;
    cg::grid_group grid = cg::this_grid();
    volatile LAS unsigned* MISC = (volatile LAS unsigned*)(lds + LDS_BYTES - 64);
    if (threadIdx.x < 16) MISC[threadIdx.x] = 0u;
    __syncthreads();
    (void)xcd_barrier_post((unsigned*)(P.ws + WS_CTL) + 1024, MISC);
#pragma unroll 1
    for (int ph = P.ph_lo; ph < P.ph_hi; ++ph) {
        GAS unsigned char* ws_g = (GAS unsigned char*)P.ws; GAS float* out_g = (GAS float*)P.out; asm volatile("" : "+s"(ws_g), "+s"(out_g));
        Ctx p; p.ws = (unsigned char*)ws_g; p.out = (float*)out_g;
        unsigned char* ws = p.ws;
        int prep_part = 0, prep_l = 0, prep_b = blockIdx.x, prep_G = gridDim.x;
        if (ph == 0) {
            { const int t0_ = opaque_tid(); if (t0_ < N_IN) { ((unsigned long long*)(ws + WS_TAB))[t0_] = (unsigned long long)P.in[t0_]; } }
            asm volatile("s_waitcnt vmcnt(0)" ::: "memory"); __syncthreads();
#ifndef NO_PREP
            prep_mod(p, lds); __syncthreads(); prep_part = 1;
#endif
        }
        else if (ph == NPH - 1) final_norm_phase(p);
        else {
#ifdef PROBE_S
            const int l = (ph - 1) / 13, sv_ = (ph - 1) % 13, s = sv_ <= PROBE_S ? sv_ : sv_ - 1;
#else
            const int l = (ph - 1) / 12, s = (ph - 1) % 12;
#endif
            const bool is_gemm = (s == 1 || s == 2 || s == 4 || s == 7 || s == 8 || s == 10 || s == 11);
            if (is_gemm) {
                pg8::Gemm g; pg8::Sched S; pg8::Epi E; bool perm;
                S.G = gridDim.x; S.c = blockIdx.x; S.mode = 0; S.nM = M_TOT / 256; S.wgm = (s == 2 || s == 8 || s == 11) ? RESID_WGM : pg8::WGM;
                E.o16 = nullptr; E.o16b = nullptr; E.of = nullptr; E.g = nullptr; E.gates = nullptr; E.scale = 1.f;
                bf16_t* ACT = (bf16_t*)(ws + WS_ACT); bf16_t* BIG = (bf16_t*)(ws + WS_BIG); float* X = (float*)(ws + WS_X);
                if (s == 1 || s == 10) { g.A = ACT; g.Bt = (const bf16_t*)(ws + wbase(l) + (s == 1 ? W_F1UP : W_F2UP)); g.K = DM; S.nN = 22; E.kind = pg8::EK_SWIGLU; E.o16 = BIG; perm = true; }
                else if (s == 2 || s == 11) { g.A = BIG; g.Bt = (const bf16_t*)(ws + wbase(l) + (s == 2 ? W_F1DN : W_F2DN)); g.K = DFF; S.nN = 4; E.kind = pg8::EK_RESID; E.of = X;
                    E.g = mod_ptr(ws, 0, l, s == 2 ? 2 : 8); E.scale = 0.5f; perm = false; }
                else if (s == 4) { g.A = ACT; g.Bt = (const bf16_t*)(ws + wbase(l) + W_IN); g.K = DM; S.nN = 27; E.kind = pg8::EK_PROJ; E.o16 = (bf16_t*)(ws + WS_PROJ); E.o16b = BIG; perm = true; }
                else if (s == 7) { g.A = (const bf16_t*)(ws + WS_BR); g.Bt = (const bf16_t*)(ws + wbase(l) + W_BR); g.K = 256; S.mode = 1; S.nN = 8; E.kind = pg8::EK_BRANCH;
                    E.o16 = ACT; E.gates = BIG; perm = false; }
                else { g.A = ACT; g.Bt = (const bf16_t*)(ws + wbase(l) + W_OUT); g.K = DM; S.nN = 4; E.kind = pg8::EK_RESID; E.of = X; E.g = mod_ptr(ws, 0, l, 5); E.scale = 1.f; perm = false; }
                S.nwg = S.nM * S.nN;
                #ifndef NO_GEMM
                if (s == 7) pg8::gemm_phase<true>(lds, g, S, E, perm); else pg8::gemm_phase<false>(lds, g, S, E, perm);
                if (blockIdx.x >= 64) {
                    if (s == 2) { prep_part = 2; prep_l = l; } else if (s == 8) { prep_part = 4; prep_l = l; } else if (s == 11 && l < 3) { prep_part = 1; prep_l = l + 1; }
                    prep_b = blockIdx.x - 64; prep_G = gridDim.x - 64;
                }
#endif
            } else if (s == 0 || s == 3 || s == 9) {
                norm_phase(p, l, s == 0 ? 0 : (s == 3 ? 1 : 2));

            } else if (s == 5) {
#ifndef NO_MIXPREP
                mixprep_phase(p, lds, l);
#endif
            } else {
#ifndef NO_MIX
                mix_phase(p, lds, l);
#ifdef PROBE_MIX2
                __syncthreads(); mix_phase(p, lds, l);
#endif
#endif
            }
        }
#ifndef NO_PREP
        if (prep_part) prep_layer(p, lds, prep_l, prep_b, prep_G, prep_part);
#endif
        if (ph + 1 < P.ph_hi) { if (P.ph_hi > 100000) grid.sync();   { XcdBarrier bar; bar.bar = (unsigned*)(p.ws + WS_CTL) + 1024; bar.x = xb_xcc_id(); bar.st = (volatile LAS unsigned*)(lds + LDS_BYTES - 64); xcd_barrier(bar); } }
    }
}

extern "C" void kernel_launch(void* const* d_in, const int* in_sizes, int n_in, void* d_out, int out_size, void* d_ws, size_t ws_size, hipStream_t stream) {
    static int grid = 0;
    if (grid == 0) {
        if (n_in != N_IN || ws_size < WS_END) { fprintf(stderr, "kernel_launch: unexpected n_in %d / ws_size %zu (need %zu)\n", n_in, ws_size, (size_t)WS_END); grid = -1; return; }
        int dev = 0, cus = 0, per_cu = 0;
        hipGetDevice(&dev); hipDeviceGetAttribute(&cus, hipDeviceAttributeMultiprocessorCount, dev);
        if (hipFuncSetAttribute((const void*)mega, hipFuncAttributeMaxDynamicSharedMemorySize, LDS_BYTES) != hipSuccess) { fprintf(stderr, "kernel_launch: hipFuncSetAttribute failed\n"); grid = -1; return; }
        if (hipOccupancyMaxActiveBlocksPerMultiprocessor(&per_cu, (const void*)mega, 512, LDS_BYTES) != hipSuccess || per_cu < 1) per_cu = 1;
        (void)hipGetLastError();
        grid = cus * 1;
        fprintf(stderr, "kernel_launch: grid %d (per_cu %d), ws %zu\n", grid, per_cu, ws_size);
    }
    if (grid < 0) return;
    hipMemsetAsync(d_ws, 0, WS_ZERO_BYTES, stream);
    Params p{};
    for (int i = 0; i < N_IN; ++i) p.in[i] = (const float*)d_in[i];
    p.out = (float*)d_out; p.ws = (unsigned char*)d_ws; p.ph_lo = 0; p.ph_hi = NPH;
    void* args[] = {&p};
    hipError_t e = hipLaunchCooperativeKernel((const void*)mega, dim3(grid), dim3(512), args, LDS_BYTES, stream);
    if (e != hipSuccess) fprintf(stderr, "cooperative launch failed: %s (grid %d)\n", hipGetErrorString(e), grid);
}
```

```cpp
#ifndef RESID_WGM
#define RESID_WGM 1
#endif
#include <hip/hip_runtime.h>
#include <hip/hip_cooperative_groups.h>
#include <cstdio>
#include <cstdint>
namespace cg = cooperative_groups;

#define LAS __attribute__((address_space(3)))
#define GAS __attribute__((address_space(1)))
typedef unsigned short bf16_t;
typedef short bf16x8 __attribute__((ext_vector_type(8)));
typedef float f32x4 __attribute__((ext_vector_type(4)));
typedef float f32x2 __attribute__((ext_vector_type(2)));
typedef unsigned u32x4 __attribute__((ext_vector_type(4)));
typedef unsigned u32x2 __attribute__((ext_vector_type(2)));

constexpr int DM = 1024, DFF = 2816, INW = 6912, PROJW = 2816, GATEW = 4096;
constexpr int M_CTX = 4096, M_DEC = 16384, M_TOT = 20480;
constexpr int NLAYER = 4;
constexpr float EPSF = 1e-6f;
constexpr float LOG2E = 1.4426950408889634f;
constexpr size_t O_Y = 0, O_NAK = 20971520, O_NAV = 25165824, O_SWK = 29360128, O_SWV = 31457280, O_DFK = 33554432, O_DFV = 37748736;
enum { I_XP = 0, I_XS, I_CNAK, I_CNAV, I_CSWK, I_CSWV, I_CDFK, I_CDFV, I_C, I_CCTX, I_WADA, I_BADA, I_NF1, I_NMIX, I_NF2, I_FNORM,
       I_F1W1, I_F1W3, I_F1W2, I_F2W1, I_F2W3, I_F2W2, I_WIN, I_WBR, I_WOUT, I_RPB, I_SINK, I_HSW, I_HSB, I_HW1, I_HB1, I_HW2, I_HB2, I_HW3,
       I_HSF, I_HLD, I_HSKIP, I_DLAM, I_DSUB, N_IN };

constexpr size_t MiB = 1u << 20;
constexpr size_t WS_CTL = 0;
constexpr size_t WS_MOD = 1 * MiB;
constexpr size_t WS_ZERO_BYTES = 65536;
constexpr size_t WS_LAM = 3 * MiB;
constexpr size_t WS_W = 4 * MiB;
constexpr size_t W_F1UP = 0, W_F1DN = W_F1UP + (size_t)5632 * 1024 * 2, W_F2UP = W_F1DN + (size_t)1024 * 2816 * 2, W_F2DN = W_F2UP + (size_t)5632 * 1024 * 2,
                 W_IN = W_F2DN + (size_t)1024 * 2816 * 2, W_BR = W_IN + (size_t)6912 * 1024 * 2, W_OUT = W_BR + (size_t)4 * 1024 * 256 * 2, W_END = W_OUT + (size_t)1024 * 1024 * 2;
static_assert(W_END <= 52 * MiB, "weights");
constexpr size_t WS_X = 56 * MiB;
constexpr size_t WS_ACT = 136 * MiB;
constexpr size_t WS_BR = 176 * MiB;
constexpr size_t WS_BIG = 216 * MiB;
constexpr size_t WS_PROJ = 376 * MiB;
constexpr size_t WS_TR = 486 * MiB;
constexpr size_t WS_CK = 541 * MiB;
constexpr size_t WS_HFIL = 551 * MiB;
constexpr size_t WS_W2 = 560 * MiB;
constexpr size_t WS_END = 612 * MiB;
constexpr int TRW = 1408;
constexpr size_t CK_NA = 0, CK_SW = 1048576, CK_DF = 1572864, CK_HALF = 2621440;
constexpr int LDS_BYTES = 147456;

#ifdef PROBE_S
constexpr int NPH = 54;
#else
constexpr int NPH = 50;
#endif
struct Params { const float* in[N_IN]; float* out; unsigned char* ws; int ph_lo, ph_hi; };
struct Ctx { float* out; unsigned char* ws; };
__device__ __forceinline__ size_t wbase(int l) { return (l & 1) ? WS_W2 : WS_W; }
constexpr size_t WS_TAB = 3 * MiB + 65536;
__device__ __forceinline__ const float* inp(const unsigned char* ws, int i) {
    const unsigned long long v = __hip_atomic_load((const unsigned long long*)(ws + WS_TAB) + i, __ATOMIC_RELAXED, __HIP_MEMORY_SCOPE_AGENT);
    const unsigned lo = __builtin_amdgcn_readfirstlane((unsigned)v), hi = __builtin_amdgcn_readfirstlane((unsigned)(v >> 32));
    return (const float*)(const GAS float*)(((unsigned long long)hi << 32) | lo);
}


__device__ __forceinline__ unsigned cvt_pk_bf16(float lo, float hi) { unsigned r; asm volatile("v_cvt_pk_bf16_f32 %0, %1, %2" : "=v"(r) : "v"(lo), "v"(hi)); return r; }
__device__ __forceinline__ float bf2f(unsigned short v) { return __uint_as_float(((unsigned)v) << 16); }
__device__ __forceinline__ float bflo(unsigned v) { return __uint_as_float(v << 16); }
__device__ __forceinline__ float bfhi(unsigned v) { return __uint_as_float(v & 0xffff0000u); }
__device__ __forceinline__ bf16_t f2bf1(float f) { return (bf16_t)(cvt_pk_bf16(f, 0.f) & 0xffffu); }
__device__ __forceinline__ float fast_exp2(float x) { return __builtin_amdgcn_exp2f(x); }
__device__ __forceinline__ float fast_rcp(float x) { return __builtin_amdgcn_rcpf(x); }
__device__ __forceinline__ float sigmoidf_(float x) { return fast_rcp(1.f + fast_exp2(-x * LOG2E)); }
__device__ __forceinline__ float wave_sum(float v) {
#pragma unroll
    for (int o = 1; o < 64; o <<= 1) v += __shfl_xor(v, o);
    return v;
}
__device__ __forceinline__ int cond_of_row(int row) { return row < M_CTX ? 0 : 1 + ((row - M_CTX) >> 11); }
__device__ __forceinline__ const float* mod_ptr(const unsigned char* ws, int cond, int l, int chunk) { return (const float*)(ws + WS_MOD) + ((size_t)(cond * 4 + l) * 9 + chunk) * 1024; }

__device__ __forceinline__ int opaque_tid() { int t; asm volatile("v_mov_b32 %0, %1" : "=v"(t) : "v"((int)threadIdx.x)); return t; }
namespace pg8 {
constexpr int BM = 256, BK = 64, HALF = 128, HTB = HALF * BK * 2, STAGE_BYTES = 8 * HTB, NXCD = 8, WGM = 4;
__device__ __forceinline__ int lds_byte(int r, int c) { const int st = (r >> 4) * 2 + (c >> 5), rr = r & 15, cc = c & 31, ob = rr * 64 + cc * 2; return st * 1024 + (ob ^ (((ob >> 9) & 1) << 5)); }
__device__ __forceinline__ void stage_rc(int b, int& R, int& C) { const int st = b / 1024, sb = b % 1024, swz = sb ^ (((sb >> 9) & 1) << 5); R = (st >> 1) * 16 + swz / 64; C = (st & 1) * 32 + (swz % 64) / 2; }
__device__ __forceinline__ int perm32(int rho) { const int n = rho >> 4, i = rho & 15; return 8 * (i >> 2) + 4 * n + (i & 3); }
struct Unit { int pm, pn; };
struct Sched { int mode, nM, nN, nwg, G, c, wgm; };
__device__ __forceinline__ bool sched_next(const Sched& S, int i, Unit& u) {
    const int j = (S.mode == 1) ? (i >> 2) : i;
    const long L = (long)j * S.G + S.c; if (L >= S.nwg) return false;
    int wgid = (int)L; { const int q = S.nwg / NXCD, r = S.nwg % NXCD, xcd = wgid % NXCD, off = wgid / NXCD; wgid = (xcd < r ? xcd * (q + 1) : r * (q + 1) + (xcd - r) * q) + off; }
    const int nig = S.wgm * S.nN, gid = wgid / nig, fm = gid * S.wgm, gsz = (S.nM - fm) < S.wgm ? (S.nM - fm) : S.wgm;
    const int pm = fm + ((wgid % nig) % gsz), pn = (wgid % nig) / gsz;
    if (S.mode == 1) { const int b = i & 3; u.pm = b * S.nM + pm; u.pn = b * S.nN + pn; } else { u.pm = pm; u.pn = pn; }
    return true;
}
enum { EK_SWIGLU = 0, EK_RESID = 1, EK_PROJ = 2, EK_BRANCH = 3 };
struct Epi { int kind; bf16_t* o16; bf16_t* o16b; float* of; const float* g; const bf16_t* gates; float scale; };
struct Gemm { const bf16_t* A; const bf16_t* Bt; int K; };

template <bool BR>
__device__ __forceinline__ void epilogue(const Epi& E, f32x4 (&acc)[2][2][4][2], const Unit& u, int wr, int wc, int fr, int fq) {
    if (BR) {
        const int bi = u.pm / 80, pm = u.pm - bi * 80, pn = u.pn & 7;
        const int row0 = pm * BM + wr * 64 + fr, col0 = pn * HALF + wc * 32 + 4 * fq;
        u32x2 gw[2][2][4];
#pragma unroll
        for (int n = 0; n < 2; ++n)
#pragma unroll
            for (int ai = 0; ai < 2; ++ai)
#pragma unroll
                for (int m = 0; m < 4; ++m) gw[n][ai][m] = *(const u32x2*)(E.gates + (size_t)(row0 + ai * HALF + m * 16) * GATEW + bi * 1024 + col0 + n * 16);
#pragma unroll
        for (int n = 0; n < 2; ++n)
#pragma unroll
            for (int ai = 0; ai < 2; ++ai)
#pragma unroll
                for (int m = 0; m < 4; ++m) {
                    const u32x2 g2 = gw[n][ai][m];
                    f32x4 gt; gt[0] = bflo(g2.x); gt[1] = bfhi(g2.x); gt[2] = bflo(g2.y); gt[3] = bfhi(g2.y);
                    f32x4 v = gt * acc[ai][0][m][n];
                    if (bi > 0) v = v + acc[ai][1][m][n];
                    acc[ai][1][m][n] = v;
                    if (bi == 3) { u32x2 w; w.x = cvt_pk_bf16(v[0], v[1]); w.y = cvt_pk_bf16(v[2], v[3]); *(u32x2*)(E.o16 + (size_t)(row0 + ai * HALF + m * 16) * DM + col0 + n * 16) = w; }
                }
    } else if (E.kind == EK_SWIGLU) {
        const int row0 = u.pm * BM + wr * 64 + fr, col0 = u.pn * 128 + wc * 32 + 8 * fq;
#pragma unroll
        for (int ai = 0; ai < 2; ++ai)
#pragma unroll
            for (int m = 0; m < 4; ++m) {
                const f32x4 a0 = acc[ai][0][m][0], a1 = acc[ai][0][m][1], b0 = acc[ai][1][m][0], b1 = acc[ai][1][m][1];
                float r[8];
#pragma unroll
                for (int e = 0; e < 4; ++e) { r[e] = a0[e] * sigmoidf_(a0[e]) * b0[e]; r[4 + e] = a1[e] * sigmoidf_(a1[e]) * b1[e]; }
                u32x4 w; w.x = cvt_pk_bf16(r[0], r[1]); w.y = cvt_pk_bf16(r[2], r[3]); w.z = cvt_pk_bf16(r[4], r[5]); w.w = cvt_pk_bf16(r[6], r[7]);
                *(u32x4*)(E.o16 + (size_t)(row0 + ai * HALF + m * 16) * DFF + col0) = w;
            }
    } else if (E.kind == EK_PROJ) {
        const int row0 = u.pm * BM + wr * 64 + fr;
        const bool isgate = u.pn >= 11;
        bf16_t* base = isgate ? E.o16b : E.o16; const int ld = isgate ? GATEW : PROJW;
        const int col0 = (isgate ? (u.pn - 11) * BM : u.pn * BM) + wc * 32 + 8 * fq;
#pragma unroll
        for (int ai = 0; ai < 2; ++ai)
#pragma unroll
            for (int m = 0; m < 4; ++m)
#pragma unroll
                for (int bj = 0; bj < 2; ++bj) {
                    f32x4 v0 = acc[ai][bj][m][0], v1 = acc[ai][bj][m][1];
                    if (isgate) {
#pragma unroll
                        for (int e = 0; e < 4; ++e) { v0[e] = sigmoidf_(v0[e]); v1[e] = sigmoidf_(v1[e]); }
                    }
                    u32x4 w; w.x = cvt_pk_bf16(v0[0], v0[1]); w.y = cvt_pk_bf16(v0[2], v0[3]); w.z = cvt_pk_bf16(v1[0], v1[1]); w.w = cvt_pk_bf16(v1[2], v1[3]);
                    *(u32x4*)(base + (size_t)(row0 + ai * HALF + m * 16) * ld + col0 + bj * HALF) = w;
                }
    } else if (E.kind == EK_RESID) {
        const int cond = (u.pm < 16) ? 0 : 1 + ((u.pm - 16) >> 3);
        const float* gv = E.g + (size_t)cond * (4 * 9 * 1024);
        const int row0 = u.pm * BM + wr * 64 + fr, col0 = u.pn * BM + wc * 32 + 4 * fq;
        f32x4 g4[2][2];
#pragma unroll
        for (int bj = 0; bj < 2; ++bj)
#pragma unroll
            for (int n = 0; n < 2; ++n) g4[bj][n] = *(const f32x4*)(gv + col0 + bj * HALF + n * 16) * E.scale;
#pragma unroll
        for (int bj = 0; bj < 2; ++bj)
#pragma unroll
            for (int n = 0; n < 2; ++n) {
                const int col = col0 + bj * HALF + n * 16;
                f32x4 xv[2][4];
#pragma unroll
                for (int ai = 0; ai < 2; ++ai)
#pragma unroll
                    for (int m = 0; m < 4; ++m) xv[ai][m] = *(const f32x4*)(E.of + (size_t)(row0 + ai * HALF + m * 16) * DM + col);
#pragma unroll
                for (int ai = 0; ai < 2; ++ai)
#pragma unroll
                    for (int m = 0; m < 4; ++m) *(f32x4*)(E.of + (size_t)(row0 + ai * HALF + m * 16) * DM + col) = xv[ai][m] + g4[bj][n] * acc[ai][bj][m][n];
            }
    }
}

template <bool BR>
__device__ __forceinline__ void gemm_phase(LAS unsigned char* lds, const Gemm g, const Sched& S, const Epi& E, const bool perm) {
    const int tid = opaque_tid(), wid = __builtin_amdgcn_readfirstlane(tid >> 6), lane = tid & 63, wr = wid >> 2, wc = wid & 3, fr = lane & 15, fq = lane >> 4;
    const int K = g.K, nt = K / BK;
    const bool align = !(E.kind == EK_RESID);
    unsigned voffA[2], voffB[2];
#pragma unroll
    for (int i = 0; i < 2; ++i) { int R, C; stage_rc(tid * 16 + i * 8192, R, C); const int Rb = perm ? ((R & ~31) + perm32(R & 31)) : R;
        voffA[i] = (unsigned)(R * K + C) * 2u; voffB[i] = (unsigned)(Rb * K + C) * 2u; }
    const size_t kstep = (size_t)(BK * 2);
    const size_t hstep = (size_t)HALF * K * 2;
    const size_t tstep = 2 * hstep;
    const size_t bstep = BR ? hstep : tstep;
    const unsigned ldsw = (unsigned)wid * 1024u;
    const int aoff = lds_byte(wr * 64 + fr, fq * 8), boff = lds_byte(wc * 32 + fr, fq * 8);
#define PG8_SA(b, h) (((b) * 2 + (h)) * HTB)
#define PG8_SB(b, h) ((4 + (b) * 2 + (h)) * HTB)
#define PG8_STAGE(bufoff, gbase, voff) do { _Pragma("unroll") for (int _i = 0; _i < 2; ++_i) \
        __builtin_amdgcn_global_load_lds((const unsigned*)((const char*)(gbase) + (voff)[_i]), (LAS unsigned*)(lds + (bufoff) + ldsw + _i * 8192), 16, 0, 0); } while (0)
#define PG8_LDA(dst, b, h) do { _Pragma("unroll") for (int m = 0; m < 4; ++m) _Pragma("unroll") for (int k = 0; k < 2; ++k) dst[m][k] = *(const LAS bf16x8*)(lds + PG8_SA(b, h) + aoff + m * 2048 + k * 1024); } while (0)
#define PG8_LDB(dst, b, h) do { _Pragma("unroll") for (int n = 0; n < 2; ++n) _Pragma("unroll") for (int k = 0; k < 2; ++k) dst[n][k] = *(const LAS bf16x8*)(lds + PG8_SB(b, h) + boff + n * 2048 + k * 1024); } while (0)
#define PG8_MMA(ai, bj, At, Bt) do { __builtin_amdgcn_s_setprio(1); _Pragma("unroll") for (int m = 0; m < 4; ++m) _Pragma("unroll") for (int n = 0; n < 2; ++n) _Pragma("unroll") for (int k = 0; k < 2; ++k) \
        acc[ai][bj][m][n] = __builtin_amdgcn_mfma_f32_16x16x32_bf16(Bt[n][k], At[m][k], acc[ai][bj][m][n], 0, 0, 0); __builtin_amdgcn_s_setprio(0); } while (0)
#define PG8_WAIT_V(n) asm volatile("s_waitcnt vmcnt(" #n ")" ::: "memory")
#define PG8_WAIT_L(n) asm volatile("s_waitcnt lgkmcnt(" #n ")" ::: "memory")
#define PG8_BAR __builtin_amdgcn_s_barrier()
#define PG8_SCHED __builtin_amdgcn_sched_barrier(0)
    Unit cur, nxt; int ui = 0;
    if (!sched_next(S, 0, cur)) return;
    f32x4 acc[2][2][4][2];
#pragma unroll
    for (int a = 0; a < 2; ++a)
#pragma unroll
        for (int b = 0; b < 2; ++b)
#pragma unroll
            for (int m = 0; m < 4; ++m)
#pragma unroll
                for (int n = 0; n < 2; ++n) acc[a][b][m][n] = (f32x4){0.f, 0.f, 0.f, 0.f};
    bf16x8 At[4][2], B0[2][2], B1[2][2];
    const char* cA = (const char*)g.A + (size_t)cur.pm * tstep; const char* cB = (const char*)g.Bt + (size_t)cur.pn * bstep;
    PG8_STAGE(PG8_SB(0, 0), cB, voffB); PG8_STAGE(PG8_SB(0, 1), cB + hstep, voffB); PG8_STAGE(PG8_SA(0, 0), cA, voffA); PG8_STAGE(PG8_SA(0, 1), cA + hstep, voffA);
    if (wr == 1) PG8_BAR;
    PG8_WAIT_V(2); PG8_BAR;
    PG8_STAGE(PG8_SB(1, 0), cB + kstep, voffB); PG8_STAGE(PG8_SA(1, 0), cA + kstep, voffA); PG8_STAGE(PG8_SB(1, 1), cB + hstep + kstep, voffB);
    PG8_WAIT_V(6); PG8_BAR;
    for (;;) {
        const bool has_next = sched_next(S, ui + 1, nxt);
        const char* nA = has_next ? (const char*)g.A + (size_t)nxt.pm * tstep : cA; const char* nB = has_next ? (const char*)g.Bt + (size_t)nxt.pn * bstep : cB;
        for (int t = 0; t < nt; t += 2) {
            const bool last = (t == nt - 2);
            const char* a1 = cA + (size_t)(t + 1) * kstep;
            const char* a2 = last ? nA : cA + (size_t)(t + 2) * kstep; const char* b2 = last ? nB : cB + (size_t)(t + 2) * kstep;
            const char* a3 = a2 + kstep; const char* b3 = b2 + kstep;
            PG8_LDB(B0, 0, 0); PG8_LDB(B1, 0, 1); PG8_SCHED; PG8_LDA(At, 0, 0); PG8_STAGE(PG8_SA(1, 1), a1 + hstep, voffA);
            PG8_WAIT_V(8); PG8_WAIT_L(0); PG8_BAR; PG8_MMA(0, 0, At, B0); if (!BR) { PG8_MMA(0, 1, At, B1); } PG8_BAR; PG8_SCHED;
            PG8_LDA(At, 0, 1); PG8_STAGE(PG8_SB(0, 0), b2, voffB); PG8_STAGE(PG8_SB(0, 1), b2 + hstep, voffB); PG8_STAGE(PG8_SA(0, 0), a2, voffA);
            PG8_WAIT_V(8); PG8_WAIT_L(0); PG8_BAR; PG8_MMA(1, 0, At, B0); if (!BR) { PG8_MMA(1, 1, At, B1); } PG8_BAR; PG8_SCHED;
            PG8_LDB(B0, 1, 0); PG8_LDB(B1, 1, 1); PG8_SCHED; PG8_LDA(At, 1, 0); PG8_STAGE(PG8_SA(0, 1), a2 + hstep, voffA);
            PG8_WAIT_V(8); PG8_WAIT_L(0); PG8_BAR; PG8_MMA(0, 0, At, B0); if (!BR) { PG8_MMA(0, 1, At, B1); } PG8_BAR; PG8_SCHED;
            PG8_LDA(At, 1, 1); PG8_STAGE(PG8_SB(1, 0), b3, voffB); PG8_STAGE(PG8_SB(1, 1), b3 + hstep, voffB); PG8_STAGE(PG8_SA(1, 0), a3, voffA);
            PG8_WAIT_V(8); PG8_WAIT_L(0); PG8_BAR; PG8_MMA(1, 0, At, B0); if (!BR) { PG8_MMA(1, 1, At, B1); } PG8_BAR; PG8_SCHED;
        }
        if (align && wr == 0) PG8_BAR;
        epilogue<BR>(E, acc, cur, wr, wc, fr, fq);
        if (!has_next) break;
#pragma unroll
        for (int a = 0; a < 2; ++a)
#pragma unroll
            for (int b = 0; b < (BR ? 1 : 2); ++b)
#pragma unroll
                for (int m = 0; m < 4; ++m)
#pragma unroll
                    for (int n = 0; n < 2; ++n) acc[a][b][m][n] = (f32x4){0.f, 0.f, 0.f, 0.f};
        cur = nxt; cA = nA; cB = nB; ++ui;
        if (align && wr == 1) PG8_BAR;
    }
    PG8_WAIT_V(0);
    if (!align && wr == 0) PG8_BAR;
    PG8_BAR;
#undef PG8_SA
#undef PG8_SB
#undef PG8_STAGE
#undef PG8_LDA
#undef PG8_LDB
#undef PG8_MMA
#undef PG8_WAIT_V
#undef PG8_WAIT_L
#undef PG8_BAR
#undef PG8_SCHED
}
}


__device__ __forceinline__ void transpose_item(const float* W, int K, int N, bf16_t* WT, int dst_row0, LAS float* scr, int k0, int n0, int lane) {
    f32x4 v[16];
    const int rr = lane >> 4, cc = (lane & 15) * 4;
#pragma unroll
    for (int i = 0; i < 16; ++i) v[i] = *(const f32x4*)(W + (size_t)(k0 + 4 * i + rr) * N + n0 + cc);
#pragma unroll
    for (int i = 0; i < 16; ++i) { LAS float* d = scr + (4 * i + rr) * 65 + cc; d[0] = v[i][0]; d[1] = v[i][1]; d[2] = v[i][2]; d[3] = v[i][3]; }
    asm volatile("s_waitcnt lgkmcnt(0)" ::: "memory");
    const int c = lane & 7, r = lane >> 3;
#pragma unroll
    for (int j = 0; j < 8; ++j) { const int n = 8 * j + r; const LAS float* q = scr + (8 * c) * 65 + n;
        u32x4 o; o.x = cvt_pk_bf16(q[0], q[65]); o.y = cvt_pk_bf16(q[2 * 65], q[3 * 65]); o.z = cvt_pk_bf16(q[4 * 65], q[5 * 65]); o.w = cvt_pk_bf16(q[6 * 65], q[7 * 65]);
        *(u32x4*)(WT + (size_t)(dst_row0 + n) * K + k0 + 8 * c) = o; }
    asm volatile("s_waitcnt lgkmcnt(0)" ::: "memory");
}

__device__ __forceinline__ void prep_layer(const Ctx& p, LAS unsigned char* lds, int l, int bidx, int G, int part) {
    const int tid = opaque_tid(), lane = tid & 63, wave = tid >> 6;
    const int gw = bidx * 8 + wave, NGW = G * 8;
    unsigned char* ws = p.ws; unsigned char* wsw = p.ws + wbase(l);
    LAS float* scr = (LAS float*)(lds + wave * 16896);
    {
        constexpr int I_UP = 16 * 44, I_DN = 44 * 16, I_IN = 16 * 108, I_BR = 4 * 16, I_OUT = 16 * 16;
        constexpr int NIT = 4 * I_UP + 2 * I_DN + I_IN + 4 * I_BR + I_OUT;
        for (int it = gw; it < NIT; it += NGW) {
            int r = it;
            { const int cls = (r < 4 * I_UP) ? ((r < 2 * I_UP) ? 1 : 4) : ((r < 4 * I_UP + 2 * I_DN) ? ((r < 4 * I_UP + I_DN) ? 1 : 4) : 2); if (!(part & cls)) continue; }
            if (r < 4 * I_UP) {
                const int which = r / I_UP; r -= which * I_UP; const int kb = r / 44, nb = r % 44, n0 = nb * 64;
                const float* W = inp(p.ws, (which >> 1) ? ((which & 1) ? I_F2W3 : I_F2W1) : ((which & 1) ? I_F1W3 : I_F1W1)) + (size_t)l * DM * DFF;
                bf16_t* WT = (bf16_t*)(wsw + ((which >> 1) ? W_F2UP : W_F1UP));
                const int drow = 256 * (n0 >> 7) + (which & 1) * 128 + (n0 & 127);
                transpose_item(W, DM, DFF, WT, drow, scr, kb * 64, n0, lane); continue;
            }
            r -= 4 * I_UP;
            if (r < 2 * I_DN) {
                const int which = r / I_DN; r -= which * I_DN; const int kb = r / 16, nb = r % 16;
                const float* W = inp(p.ws, which ? I_F2W2 : I_F1W2) + (size_t)l * DFF * DM;
                bf16_t* WT = (bf16_t*)(wsw + (which ? W_F2DN : W_F1DN));
                transpose_item(W, DFF, DM, WT, nb * 64, scr, kb * 64, nb * 64, lane); continue;
            }
            r -= 2 * I_DN;
            if (r < I_IN) { const int kb = r / 108, nb = r % 108;
                transpose_item(inp(p.ws, I_WIN) + (size_t)l * DM * INW, DM, INW, (bf16_t*)(wsw + W_IN), nb * 64, scr, kb * 64, nb * 64, lane); continue; }
            r -= I_IN;
            if (r < 4 * I_BR) { const int bi = r / I_BR; r -= bi * I_BR; const int kb = r / 16, nb = r % 16;
                transpose_item(inp(p.ws, I_WBR) + ((size_t)l * 4 + bi) * 256 * DM, 256, DM, (bf16_t*)(wsw + W_BR) + (size_t)bi * 1024 * 256, nb * 64, scr, kb * 64, nb * 64, lane); continue; }
            r -= 4 * I_BR;
            { const int kb = r / 16, nb = r % 16;
              transpose_item(inp(p.ws, I_WOUT) + (size_t)l * DM * DM, DM, DM, (bf16_t*)(wsw + W_OUT), nb * 64, scr, kb * 64, nb * 64, lane); }
        }
    }
    if (!(part & 2)) return;
    {
        bf16_t* CK = (bf16_t*)(ws + WS_CK);
        const int gt = bidx * 512 + tid, NT = G * 512;
        for (int it = gt; it < 327680; it += NT) {
            int e = it * 8; const float* src; bf16_t* dst; int per_b;
            if (e < 1048576) { src = inp(p.ws, I_CNAK); dst = CK + CK_NA; per_b = 131072; }
            else if (e < 1572864) { e -= 1048576; src = inp(p.ws, I_CSWK); dst = CK + CK_SW; per_b = 65536; }
            else { e -= 1572864; src = inp(p.ws, I_CDFK); dst = CK + CK_DF; per_b = 131072; }
            const int b = e / per_b, r = e - b * per_b;
            const float* s = src + ((size_t)(b * 4 + l)) * per_b + r;
            const f32x4 v0 = *(const f32x4*)s, v1 = *(const f32x4*)(s + 4);
            u32x4 o; o.x = cvt_pk_bf16(v0[0], v0[1]); o.y = cvt_pk_bf16(v0[2], v0[3]); o.z = cvt_pk_bf16(v1[0], v1[1]); o.w = cvt_pk_bf16(v1[2], v1[3]);
            *(u32x4*)(dst + e) = o;
        }
    }
    {
        bf16_t* CV = (bf16_t*)(ws + WS_CK) + CK_HALF;
        for (int it = gw; it < 640; it += NGW) {
            int r = it; const float* src; bf16_t* dst; int H;
            if (r < 256) { src = inp(p.ws, I_CNAV); dst = CV + CK_NA; H = 4; }
            else if (r < 384) { r -= 256; src = inp(p.ws, I_CSWV); dst = CV + CK_SW; H = 2; }
            else { r -= 384; src = inp(p.ws, I_CDFV); dst = CV + CK_DF; H = 4; }
            const int kb = r & 7, bh = r >> 3, b = bh / H, h = bh - b * H;
            transpose_item(src + ((size_t)(b * 4 + l) * H + h) * 512 * 64, 512, 64, dst + (size_t)bh * 64 * 512, 0, scr, kb * 64, 0, lane);
        }
    }
    __syncthreads();
    {
        LAS float* Z = (LAS float*)lds;
        LAS float* G1 = Z + 8 * 33;
        LAS float* G2 = G1 + 8 * 64;
        float* HF = (float*)(ws + WS_HFIL);
        const float* w1 = inp(p.ws, I_HW1) + (size_t)l * 33 * 64; const float* b1 = inp(p.ws, I_HB1) + l * 64;
        const float* w2 = inp(p.ws, I_HW2) + (size_t)l * 64 * 64; const float* b2 = inp(p.ws, I_HB2) + l * 64;
        const float* w3 = inp(p.ws, I_HW3) + (size_t)l * 64 * 1024; const float* sf = inp(p.ws, I_HSF) + l * 64; const float* ld = inp(p.ws, I_HLD) + l * 1024;
        for (int it = bidx; it < 288; it += G) {
            const int Lsel = it >= 32, L = Lsel ? 2048 : 256, n0 = (Lsel ? it - 32 : it) * 8;
            const float invL = 1.f / (float)L;
            if (tid < 8 * 33) { const int nn = tid / 33, i = tid - nn * 33; const float tn = (float)(n0 + nn) * invL; float v;
                if (i == 0) v = tn; else if (i <= 16) v = __cosf(6.283185307179586f * tn * (float)i); else v = __sinf(6.283185307179586f * tn * (float)(i - 16));
                Z[nn * 33 + i] = v; }
            __syncthreads();
            { const int nn = tid >> 6, j = tid & 63; float a = b1[j];
#pragma unroll 11
              for (int i = 0; i < 33; ++i) a += Z[nn * 33 + i] * w1[i * 64 + j];
              G1[nn * 64 + j] = __sinf(sf[j] * a); }
            __syncthreads();
            { const int nn = tid >> 6, j = tid & 63; float a = b2[j];
#pragma unroll 16
              for (int i = 0; i < 64; ++i) a += G1[nn * 64 + i] * w2[i * 64 + j];
              G2[nn * 64 + j] = __sinf(sf[j] * a); }
            __syncthreads();
#pragma unroll 1
            for (int cc = 0; cc < 2; ++cc) {
                const int col = cc * 512 + tid;
                float a[8];
#pragma unroll
                for (int nn = 0; nn < 8; ++nn) a[nn] = 0.f;
#pragma unroll 16
                for (int i = 0; i < 64; ++i) { const float w = w3[i * 1024 + col];
#pragma unroll
                    for (int nn = 0; nn < 8; ++nn) a[nn] += G2[nn * 64 + i] * w; }
                const float rate = __expf(ld[col]);
#pragma unroll
                for (int nn = 0; nn < 8; ++nn) a[nn] *= __expf(-rate * (float)(n0 + nn) * invL);
                float* o = HF + (Lsel ? 262144 : 0) + (size_t)col * L + n0;
                *(f32x4*)o = (f32x4){a[0], a[1], a[2], a[3]}; *(f32x4*)(o + 4) = (f32x4){a[4], a[5], a[6], a[7]};
            }
            __syncthreads();
        }
    }
    if (bidx == 0 && tid == 0) {
        const float* lv = inp(p.ws, I_DLAM) + l * 128; float s01 = 0.f, s23 = 0.f;
        for (int i = 0; i < 32; ++i) { s01 += lv[i] * lv[32 + i]; s23 += lv[64 + i] * lv[96 + i]; }
        float c08; asm volatile("v_mov_b32 %0, 0x3f4ccccd" : "=v"(c08));
        const float lam_init = c08 - 0.6f * __expf(-0.3f * (float)l);
        ((float*)(ws + WS_LAM))[l] = __expf(s01) - __expf(s23) + lam_init; ((float*)(ws + WS_LAM))[4 + l] = lam_init;
    }
}

__device__ __forceinline__ void prep_mod(const Ctx& p, LAS unsigned char* lds) {
    const int tid = opaque_tid(), lane = tid & 63, wave = tid >> 6;
    const int G = gridDim.x;
    LAS float* SC = (LAS float*)lds;
    LAS float* PART = (LAS float*)(lds + 40960);
    for (int i = tid; i < 9 * 1024; i += 512) { const float v = (i < 1024) ? inp(p.ws, I_CCTX)[i] : inp(p.ws, I_C)[i - 1024]; SC[i] = v * sigmoidf_(v); }
    __syncthreads();
    float* mod = (float*)(p.ws + WS_MOD);
    for (int it = blockIdx.x; it < 4 * 36; it += G) {
        const int cb = it % 36, l = it / 36;
        const int col = cb * 256 + lane * 4, k0 = wave * 128;
        const float* W = inp(p.ws, I_WADA) + ((size_t)l * DM + k0) * 9216 + col;
        f32x4 a[9];
#pragma unroll
        for (int c = 0; c < 9; ++c) a[c] = (f32x4){0.f, 0.f, 0.f, 0.f};
#pragma unroll 16
        for (int k = 0; k < 128; ++k) { const f32x4 w = *(const f32x4*)(W + (size_t)k * 9216);
#pragma unroll
            for (int c = 0; c < 9; ++c) a[c] += w * SC[c * 1024 + k0 + k]; }
#pragma unroll
        for (int c = 0; c < 9; ++c) *(LAS f32x4*)(PART + (wave * 9 + c) * 256 + lane * 4) = a[c];
        __syncthreads();
        for (int o = tid; o < 9 * 256; o += 512) { const int c = o >> 8, cc = o & 255;
            float v = inp(p.ws, I_BADA)[(size_t)l * 9216 + cb * 256 + cc];
#pragma unroll
            for (int w = 0; w < 8; ++w) v += PART[(w * 9 + c) * 256 + cc];
            mod[((size_t)(c * 4 + l)) * 9216 + cb * 256 + cc] = v; }
        __syncthreads();
    }
}

__device__ __forceinline__ void norm_phase(const Ctx& p, int l, int which  ) {
    const int tid_ = opaque_tid(), lane = tid_ & 63, wave = tid_ >> 6, gw = blockIdx.x * 8 + wave, NGW = gridDim.x * 8;
    float* X = (float*)(p.ws + WS_X); bf16_t* ACT = (bf16_t*)(p.ws + WS_ACT);
    const float* gsrc = inp(p.ws, which == 0 ? I_NF1 : (which == 1 ? I_NMIX : I_NF2)) + l * DM;
    const bool from_in = (l == 0 && which == 0);
    f32x4 gv[4];
#pragma unroll
    for (int j = 0; j < 4; ++j) gv[j] = *(const f32x4*)(gsrc + j * 256 + lane * 4);
    constexpr int NR = 4;
    for (int row0 = gw * NR; row0 < M_TOT; row0 += NGW * NR) {
        f32x4 v[NR][4]; float s[NR];
#pragma unroll
        for (int r = 0; r < NR; ++r) {
            const int row = row0 + r;
            const float* xr = from_in ? (row < M_CTX ? inp(p.ws, I_XP) + (size_t)row * DM : inp(p.ws, I_XS) + (size_t)(row - M_CTX) * DM) : X + (size_t)row * DM;
#pragma unroll
            for (int j = 0; j < 4; ++j) v[r][j] = *(const f32x4*)(xr + j * 256 + lane * 4);
        }
        const int cond = cond_of_row(row0);
        const float* sh = mod_ptr(p.ws, cond, l, which * 3 + 0); const float* sc = mod_ptr(p.ws, cond, l, which * 3 + 1);
        f32x4 s4[4], h4[4];
#pragma unroll
        for (int j = 0; j < 4; ++j) { s4[j] = *(const f32x4*)(sc + j * 256 + lane * 4) + 1.f; h4[j] = *(const f32x4*)(sh + j * 256 + lane * 4); }
#pragma unroll
        for (int r = 0; r < NR; ++r) { float a = 0.f;
#pragma unroll
            for (int j = 0; j < 4; ++j) a += (v[r][j][0] * v[r][j][0] + v[r][j][1] * v[r][j][1]) + (v[r][j][2] * v[r][j][2] + v[r][j][3] * v[r][j][3]);
            s[r] = a; }
        if (from_in) {
#pragma unroll
            for (int r = 0; r < NR; ++r)
#pragma unroll
                for (int j = 0; j < 4; ++j) *(f32x4*)(X + (size_t)(row0 + r) * DM + j * 256 + lane * 4) = v[r][j];
        }
#pragma unroll
        for (int o = 1; o < 64; o <<= 1) {
#pragma unroll
            for (int r = 0; r < NR; ++r) s[r] += __shfl_xor(s[r], o);
        }
#pragma unroll
        for (int r = 0; r < NR; ++r) {
            const float rstd = rsqrtf(s[r] * (1.f / DM) + EPSF);
#pragma unroll
            for (int j = 0; j < 4; ++j) {
                const f32x4 o = (v[r][j] * rstd) * gv[j] * s4[j] + h4[j];
                u32x2 w; w.x = cvt_pk_bf16(o[0], o[1]); w.y = cvt_pk_bf16(o[2], o[3]);
                *(u32x2*)(ACT + (size_t)(row0 + r) * DM + j * 256 + lane * 4) = w;
            }
        }
    }
}
__device__ __forceinline__ void final_norm_phase(const Ctx& p) {
    const int tid_ = opaque_tid(), lane = tid_ & 63, wave = tid_ >> 6, gw = blockIdx.x * 8 + wave, NGW = gridDim.x * 8;
    const float* X = (const float*)(p.ws + WS_X); const float* gsrc = inp(p.ws, I_FNORM);
    f32x4 gv[4];
#pragma unroll
    for (int j = 0; j < 4; ++j) gv[j] = *(const f32x4*)(gsrc + j * 256 + lane * 4);
    constexpr int NR = 4;
    for (int row0 = gw * NR; row0 < M_TOT; row0 += NGW * NR) {
        f32x4 v[NR][4]; float s[NR];
#pragma unroll
        for (int r = 0; r < NR; ++r) { const float* xr = X + (size_t)(row0 + r) * DM;
#pragma unroll
            for (int j = 0; j < 4; ++j) v[r][j] = *(const f32x4*)(xr + j * 256 + lane * 4); }
#pragma unroll
        for (int r = 0; r < NR; ++r) { float a = 0.f;
#pragma unroll
            for (int j = 0; j < 4; ++j) a += (v[r][j][0] * v[r][j][0] + v[r][j][1] * v[r][j][1]) + (v[r][j][2] * v[r][j][2] + v[r][j][3] * v[r][j][3]);
            s[r] = a; }
#pragma unroll
        for (int o = 1; o < 64; o <<= 1) {
#pragma unroll
            for (int r = 0; r < NR; ++r) s[r] += __shfl_xor(s[r], o);
        }
#pragma unroll
        for (int r = 0; r < NR; ++r) { const float rstd = rsqrtf(s[r] * (1.f / DM) + EPSF);
#pragma unroll
            for (int j = 0; j < 4; ++j) __builtin_nontemporal_store((v[r][j] * rstd) * gv[j], (f32x4*)(p.out + O_Y + (size_t)(row0 + r) * DM + j * 256 + lane * 4)); }
    }
}

__device__ __forceinline__ void mixprep_phase(const Ctx& p, LAS unsigned char* lds, int l) {
    const int tid = opaque_tid(), G = gridDim.x;
    bf16_t* PROJ = (bf16_t*)(p.ws + WS_PROJ); bf16_t* TR = (bf16_t*)(p.ws + WS_TR);
    {
        const int lane = tid & 63, wave = tid >> 6, gw = blockIdx.x * 8 + wave, NGW = G * 8;
        LAS float* T = (LAS float*)(lds + wave * 17168);
        const float* sw = inp(p.ws, I_HSW) + (size_t)l * 3 * 768; const float* sb = inp(p.ws, I_HSB) + (size_t)l * 768;
        const int lr = lane >> 3, lc = lane & 7;
        for (int it = gw; it < 320 * 22; it += NGW) {
            const int cb = it % 22, rb = it / 22, row0 = rb * 64, tcol0 = cb * 64;
            int src; bool hy = false;
            if (tcol0 < 256) src = 512 + tcol0; else if (tcol0 < 384) src = 1152 + (tcol0 - 256); else if (tcol0 < 640) src = 2560 + (tcol0 - 384); else { src = 1280 + (tcol0 - 640); hy = true; }
            const bool seq_start = row0 < M_CTX ? ((row0 & 255) == 0) : (((row0 - M_CTX) & 2047) == 0);
            const int rend = row0 + 64; const bool seq_end = rend <= M_CTX ? ((rend & 255) == 0) : (((rend - M_CTX) & 2047) == 0);
            const bf16_t* sp = PROJ + (size_t)row0 * PROJW + src + lc * 8;
            u32x4 w[8], wh = (u32x4){0u, 0u, 0u, 0u};
#pragma unroll
            for (int i = 0; i < 8; ++i) w[i] = *(const u32x4*)(sp + (size_t)(i * 8 + lr) * PROJW);
            if (hy && lane < 16) { const bool top = lane < 8; const bool ok = top ? !seq_start : !seq_end;
                if (ok) wh = *(const u32x4*)(sp + (top ? -(ptrdiff_t)PROJW : (ptrdiff_t)64 * PROJW)); }
#pragma unroll
            for (int i = 0; i < 8; ++i) { LAS float* d = T + (1 + i * 8 + lr) * 65 + lc * 8;
                d[0] = bflo(w[i].x); d[1] = bfhi(w[i].x); d[2] = bflo(w[i].y); d[3] = bfhi(w[i].y); d[4] = bflo(w[i].z); d[5] = bfhi(w[i].z); d[6] = bflo(w[i].w); d[7] = bfhi(w[i].w); }
            if (hy && lane < 16) { LAS float* d = T + (lane < 8 ? 0 : 65) * 65 + lc * 8;
                d[0] = bflo(wh.x); d[1] = bfhi(wh.x); d[2] = bflo(wh.y); d[3] = bfhi(wh.y); d[4] = bflo(wh.z); d[5] = bfhi(wh.z); d[6] = bflo(wh.w); d[7] = bfhi(wh.w); }
            asm volatile("s_waitcnt lgkmcnt(0)" ::: "memory");
            const int rg = lane & 7, csub = lane >> 3;
#pragma unroll 2
            for (int j = 0; j < 8; ++j) {
                const int col = j * 8 + csub; float o[8];
                const LAS float* tp = T + (rg * 8) * 65 + col;
                if (hy) { const int ch = tcol0 - 640 + col; const float w0 = sw[ch], w1 = sw[768 + ch], w2 = sw[1536 + ch], bb = sb[ch];
                    float x[10];
#pragma unroll
                    for (int k = 0; k < 10; ++k) x[k] = tp[k * 65];
#pragma unroll
                    for (int k = 0; k < 8; ++k) o[k] = x[k] * w0 + x[k + 1] * w1 + x[k + 2] * w2 + bb;
                } else {
#pragma unroll
                    for (int k = 0; k < 8; ++k) o[k] = tp[(k + 1) * 65];
                }
                u32x4 ww; ww.x = cvt_pk_bf16(o[0], o[1]); ww.y = cvt_pk_bf16(o[2], o[3]); ww.z = cvt_pk_bf16(o[4], o[5]); ww.w = cvt_pk_bf16(o[6], o[7]);
                *(u32x4*)(TR + (size_t)(tcol0 + col) * M_TOT + row0 + rg * 8) = ww;
            }
            asm volatile("s_waitcnt lgkmcnt(0)" ::: "memory");
        }
    }
    const int gt = blockIdx.x * 512 + tid, NT = G * 512;
    for (int it = gt; it < M_CTX * 160; it += NT) {
        const int row = it / 160, ch = it - row * 160; int pc, H; size_t ob; int c8;
        if (ch < 32) { pc = 256; H = 4; ob = O_NAK; c8 = ch * 8; }
        else if (ch < 64) { pc = 512; H = 4; ob = O_NAV; c8 = (ch - 32) * 8; }
        else if (ch < 80) { pc = 1024; H = 2; ob = O_SWK; c8 = (ch - 64) * 8; }
        else if (ch < 96) { pc = 1152; H = 2; ob = O_SWV; c8 = (ch - 80) * 8; }
        else if (ch < 128) { pc = 2304; H = 4; ob = O_DFK; c8 = (ch - 96) * 8; }
        else { pc = 2560; H = 4; ob = O_DFV; c8 = (ch - 128) * 8; }
        const u32x4 w = *(const u32x4*)(PROJ + (size_t)row * PROJW + pc + c8);
        const int b = row >> 8, t = row & 255, h = c8 >> 6, d = c8 & 63;
        float* o = p.out + ob + ((((size_t)(b * 4 + l) * H + h) * 256 + t) * 64 + d);
        __builtin_nontemporal_store((f32x4){bflo(w.x), bfhi(w.x), bflo(w.y), bfhi(w.y)}, (f32x4*)o); __builtin_nontemporal_store((f32x4){bflo(w.z), bfhi(w.z), bflo(w.w), bfhi(w.w)}, (f32x4*)(o + 4));
    }
    for (int it = gt; it < M_DEC * 56; it += NT) {
        const int rowd = it / 56, q = it - rowd * 56, t = rowd & 2047, gr = t >> 6, gc = t & 63;
        int a, bofs, i0; float pos, fstep;
        if (q < 24) {
            const int base = q < 16 ? 768 : 1024, qq = q < 16 ? q : q - 16, h = qq >> 2, half = (qq >> 1) & 1, grp = qq & 1;
            a = base + h * 64 + half * 32 + grp * 8; bofs = 16; i0 = grp * 8; pos = half ? (float)gc : (float)gr; fstep = 13.287712379549449f / 16.f;
        } else {
            const int base = q < 40 ? 2048 : 2304, qq = q < 40 ? q - 24 : q - 40, mp32 = qq >> 1, half = qq & 1;
            a = base + mp32 * 32 + half * 16; bofs = 8; i0 = 0; pos = half ? (float)gc : (float)gr; fstep = 13.287712379549449f / 8.f;
        }
        bf16_t* pa = PROJ + (size_t)(M_CTX + rowd) * PROJW + a;
        const u32x4 wa = *(const u32x4*)pa, wb = *(const u32x4*)(pa + bofs);
        float xa[8], xb[8];
        xa[0] = bflo(wa.x); xa[1] = bfhi(wa.x); xa[2] = bflo(wa.y); xa[3] = bfhi(wa.y); xa[4] = bflo(wa.z); xa[5] = bfhi(wa.z); xa[6] = bflo(wa.w); xa[7] = bfhi(wa.w);
        xb[0] = bflo(wb.x); xb[1] = bfhi(wb.x); xb[2] = bflo(wb.y); xb[3] = bfhi(wb.y); xb[4] = bflo(wb.z); xb[5] = bfhi(wb.z); xb[6] = bflo(wb.w); xb[7] = bfhi(wb.w);
        float oa[8], ob[8];
#pragma unroll
        for (int j = 0; j < 8; ++j) { const float ang = pos * fast_exp2(-(float)(i0 + j) * fstep); const float cs = __cosf(ang), sn = __sinf(ang);
            oa[j] = xa[j] * cs - xb[j] * sn; ob[j] = xb[j] * cs + xa[j] * sn; }
        u32x4 ra, rb;
        ra.x = cvt_pk_bf16(oa[0], oa[1]); ra.y = cvt_pk_bf16(oa[2], oa[3]); ra.z = cvt_pk_bf16(oa[4], oa[5]); ra.w = cvt_pk_bf16(oa[6], oa[7]);
        rb.x = cvt_pk_bf16(ob[0], ob[1]); rb.y = cvt_pk_bf16(ob[2], ob[3]); rb.z = cvt_pk_bf16(ob[4], ob[5]); rb.w = cvt_pk_bf16(ob[6], ob[7]);
        *(u32x4*)pa = ra; *(u32x4*)(pa + bofs) = rb;
    }
}

struct AttnState { float m, l; f32x4 o[4]; };
__device__ __forceinline__ f32x4 mfma16(bf16x8 a, bf16x8 b, f32x4 c) { return __builtin_amdgcn_mfma_f32_16x16x32_bf16(a, b, c, 0, 0, 0); }

__device__ __forceinline__ float xmax16(float x) { const u32x2 r = __builtin_amdgcn_permlane16_swap(__float_as_uint(x), __float_as_uint(x), false, false); return fmaxf(__uint_as_float(r.x), __uint_as_float(r.y)); }
__device__ __forceinline__ float xmax32(float x) { const u32x2 r = __builtin_amdgcn_permlane32_swap(__float_as_uint(x), __float_as_uint(x), false, false); return fmaxf(__uint_as_float(r.x), __uint_as_float(r.y)); }
__device__ __forceinline__ float xadd16(float x) { const u32x2 r = __builtin_amdgcn_permlane16_swap(__float_as_uint(x), __float_as_uint(x), false, false); return __uint_as_float(r.x) + __uint_as_float(r.y); }
__device__ __forceinline__ float xadd32(float x) { const u32x2 r = __builtin_amdgcn_permlane32_swap(__float_as_uint(x), __float_as_uint(x), false, false); return __uint_as_float(r.x) + __uint_as_float(r.y); }
__device__ __forceinline__ void softmax_d16(AttnState& st, float (&s)[16], bool first, float& alpha, bool& resc, bf16x8& p0, bf16x8& p1) {
    float mx = fmaxf(fmaxf(fmaxf(s[0], s[1]), fmaxf(s[2], s[3])), fmaxf(fmaxf(s[4], s[5]), fmaxf(s[6], s[7])));
    mx = fmaxf(mx, fmaxf(fmaxf(fmaxf(s[8], s[9]), fmaxf(s[10], s[11])), fmaxf(fmaxf(s[12], s[13]), fmaxf(s[14], s[15]))));
    resc = first || (__builtin_amdgcn_ballot_w64(mx > 8.f) != 0ull);
    alpha = 1.f;
    if (resc) {
        mx = xmax16(mx); mx = xmax32(mx);
        const float d = first ? mx : fmaxf(mx, 0.f);
        alpha = first ? 0.f : fast_exp2(-d);
        st.m = first ? mx : st.m + d;
#pragma unroll
        for (int j = 0; j < 16; ++j) s[j] -= d;
    }
    float pr[16];
#pragma unroll
    for (int j = 0; j < 16; ++j) pr[j] = fast_exp2(s[j]);
    float sum = (((pr[0] + pr[1]) + (pr[2] + pr[3])) + ((pr[4] + pr[5]) + (pr[6] + pr[7]))) + (((pr[8] + pr[9]) + (pr[10] + pr[11])) + ((pr[12] + pr[13]) + (pr[14] + pr[15])));
    sum = xadd16(sum); sum = xadd32(sum);
    st.l = st.l * alpha + sum;
    u32x4 w0, w1;
    w0.x = cvt_pk_bf16(pr[0], pr[1]); w0.y = cvt_pk_bf16(pr[2], pr[3]); w0.z = cvt_pk_bf16(pr[4], pr[5]); w0.w = cvt_pk_bf16(pr[6], pr[7]);
    w1.x = cvt_pk_bf16(pr[8], pr[9]); w1.y = cvt_pk_bf16(pr[10], pr[11]); w1.z = cvt_pk_bf16(pr[12], pr[13]); w1.w = cvt_pk_bf16(pr[14], pr[15]);
    p0 = __builtin_bit_cast(bf16x8, w0); p1 = __builtin_bit_cast(bf16x8, w1);
}
__device__ __forceinline__ bf16x8 softmax_p(AttnState& st, const float (&s2)[8], unsigned vm, float& alpha) {
    float mx = -1e30f;
#pragma unroll
    for (int j = 0; j < 8; ++j) mx = fmaxf(mx, ((vm >> j) & 1u) ? s2[j] : -1e30f);
    mx = xmax16(mx); mx = xmax32(mx);
    const float mn = fmaxf(st.m, mx); alpha = fast_exp2(st.m - mn);
    float pr[8]; float sum = 0.f;
#pragma unroll
    for (int j = 0; j < 8; ++j) { pr[j] = ((vm >> j) & 1u) ? fast_exp2(s2[j] - mn) : 0.f; sum += pr[j]; }
    sum += __shfl_xor(sum, 16); sum += __shfl_xor(sum, 32);
    st.l = st.l * alpha + sum; st.m = mn;
    u32x4 pw; pw.x = cvt_pk_bf16(pr[0], pr[1]); pw.y = cvt_pk_bf16(pr[2], pr[3]); pw.z = cvt_pk_bf16(pr[4], pr[5]); pw.w = cvt_pk_bf16(pr[6], pr[7]);
    return __builtin_bit_cast(bf16x8, pw);
}
__device__ __forceinline__ bf16x8 softmax_d(AttnState& st, const float (&s2)[8], float& alpha, bool& resc) {
    float mx = fmaxf(fmaxf(fmaxf(s2[0], s2[1]), fmaxf(s2[2], s2[3])), fmaxf(fmaxf(s2[4], s2[5]), fmaxf(s2[6], s2[7])));
    mx = fmaxf(mx, __shfl_xor(mx, 16)); mx = fmaxf(mx, __shfl_xor(mx, 32));
    const float mn = fmaxf(st.m, mx);
    resc = __builtin_amdgcn_ballot_w64(mn > st.m) != 0ull;
    alpha = fast_exp2(st.m - mn);
    float pr[8];
#pragma unroll
    for (int j = 0; j < 8; ++j) pr[j] = fast_exp2(s2[j] - mn);
    float sum = ((pr[0] + pr[1]) + (pr[2] + pr[3])) + ((pr[4] + pr[5]) + (pr[6] + pr[7]));
    sum = xadd16(sum); sum = xadd32(sum);
    st.l = st.l * alpha + sum; st.m = mn;
    u32x4 pw; pw.x = cvt_pk_bf16(pr[0], pr[1]); pw.y = cvt_pk_bf16(pr[2], pr[3]); pw.z = cvt_pk_bf16(pr[4], pr[5]); pw.w = cvt_pk_bf16(pr[6], pr[7]);
    return __builtin_bit_cast(bf16x8, pw);
}
__device__ __forceinline__ void st_init(AttnState& st, float m0, float l0) { st.m = m0; st.l = l0;
#pragma unroll
    for (int i = 0; i < 4; ++i) st.o[i] = (f32x4){0.f, 0.f, 0.f, 0.f}; }

constexpr int AT_ROWB = 144;
constexpr int AT_TILEB = 64 * AT_ROWB;
struct ATC { int l15, quad, kr0, lat0, nlat, rs_w, r_w; int cg4[2], qc[2], c0[2], qt[2], q0[2]; bool dec; const float* rpb; };

template <int TYPE>
__device__ __forceinline__ void attn_tile(AttnState (&sa)[2], AttnState (&sb)[2], const bf16x8 (&qf)[2][2], const ATC& c, const LAS unsigned char* kt, const LAS unsigned char* vt, int i) {
    const bool masked = c.dec && (i < c.nlat) && (TYPE != 2);
    if (TYPE == 0 && masked) { const int krow = c.lat0 + i; if (!((krow >= c.rs_w) && (krow < c.rs_w + 8))) return; }
    const f32x4 z4 = (f32x4){0.f, 0.f, 0.f, 0.f};
    if (!masked) {
        bf16x8 pA[2][2], pB[2][2]; float alA[2], alB[2]; bool rA[2], rB[2];
        const bool first = (TYPE != 1) && (i == 0);
        if (TYPE == 2) {
#pragma unroll
            for (int qi = 0; qi < 2; ++qi)
#pragma unroll
                for (int mp = 0; mp < 2; ++mp) {
                    float s2[16];
#pragma unroll
                    for (int ss = 0; ss < 2; ++ss)
#pragma unroll
                        for (int t = 0; t < 2; ++t) { const int kr = ss * 32 + c.kr0 + 4 * t, sw = ((kr >> 4) & 1) << 2;
                            const bf16x8 kf = *(const LAS bf16x8*)(kt + kr * AT_ROWB + (((mp * 4 + c.quad) ^ sw) << 4));
                            const float nm = first ? 0.f : -(mp == 0 ? sa[qi].m : sb[qi].m);
                            const f32x4 a = mfma16(kf, qf[qi][mp], (f32x4){nm, nm, nm, nm});
#pragma unroll
                            for (int e = 0; e < 4; ++e) s2[ss * 8 + t * 4 + e] = a[e]; }
                    if (mp == 0) softmax_d16(sa[qi], s2, first, alA[qi], rA[qi], pA[qi][0], pA[qi][1]); else softmax_d16(sb[qi], s2, first, alB[qi], rB[qi], pB[qi][0], pB[qi][1]);
                    asm volatile("" ::: "memory");
                }
        } else {
            bf16x8 kf[2][2][2];
#pragma unroll
            for (int ss = 0; ss < 2; ++ss)
#pragma unroll
                for (int t = 0; t < 2; ++t) { const int kr = ss * 32 + c.kr0 + 4 * t, sw = ((kr >> 4) & 1) << 2;
#pragma unroll
                    for (int cc = 0; cc < 2; ++cc) kf[ss][t][cc] = *(const LAS bf16x8*)(kt + kr * AT_ROWB + (((cc * 4 + c.quad) ^ sw) << 4)); }
#pragma unroll
            for (int qi = 0; qi < 2; ++qi) {
                float s2[16];
#pragma unroll
                for (int ss = 0; ss < 2; ++ss)
#pragma unroll
                    for (int t = 0; t < 2; ++t) { const float nm = first ? 0.f : -sa[qi].m; f32x4 a = mfma16(kf[ss][t][0], qf[qi][0], (f32x4){nm, nm, nm, nm}); a = mfma16(kf[ss][t][1], qf[qi][1], a);
#pragma unroll
                        for (int e = 0; e < 4; ++e) s2[ss * 8 + t * 4 + e] = a[e]; }
                softmax_d16(sa[qi], s2, first, alA[qi], rA[qi], pA[qi][0], pA[qi][1]);
            }
        }
#pragma unroll
        for (int qi = 0; qi < 2; ++qi) {
            if (rA[qi]) {
#pragma unroll
                for (int nt = 0; nt < 4; ++nt) sa[qi].o[nt] = sa[qi].o[nt] * alA[qi]; }
            if (TYPE == 2) { if (rB[qi]) {
#pragma unroll
                for (int nt = 0; nt < 4; ++nt) sb[qi].o[nt] = sb[qi].o[nt] * alB[qi]; } }
        }
#pragma unroll
        for (int ss = 0; ss < 2; ++ss) {
            bf16x8 vf[4];
#pragma unroll
            for (int nt = 0; nt < 4; ++nt) vf[nt] = *(const LAS bf16x8*)(vt + (nt * 16 + c.l15) * AT_ROWB + ss * 64 + (c.quad << 4));
#pragma unroll
            for (int qi = 0; qi < 2; ++qi)
#pragma unroll
                for (int nt = 0; nt < 4; ++nt) { sa[qi].o[nt] = mfma16(vf[nt], pA[qi][ss], sa[qi].o[nt]); if (TYPE == 2) sb[qi].o[nt] = mfma16(vf[nt], pB[qi][ss], sb[qi].o[nt]); }
        }
        return;
    }
#pragma unroll 1
    for (int ss = 0; ss < 2; ++ss) {
        bool on[2];
#pragma unroll
        for (int qi = 0; qi < 2; ++qi) {
            on[qi] = true;
            if (TYPE == 0) on[qi] = !((c.cg4[qi] == 0 && ss == 1) || (c.cg4[qi] == 3 && ss == 0));
            if (TYPE == 1) { const int k0 = (c.lat0 + i) * 64 + ss * 32; on[qi] = (k0 + 31 >= c.q0[qi] - 128) && (k0 <= c.q0[qi] + 15 + 128); }
        }
        if (on[0] || on[1]) {
            const int krA = ss * 32 + c.kr0, krB = krA + 4;
            const int swA = ((krA >> 4) & 1) << 2, swB = ((krB >> 4) & 1) << 2;
            bf16x8 kf[2][2];
#pragma unroll
            for (int cc = 0; cc < 2; ++cc) { kf[0][cc] = *(const LAS bf16x8*)(kt + krA * AT_ROWB + (((cc * 4 + c.quad) ^ swA) << 4)); kf[1][cc] = *(const LAS bf16x8*)(kt + krB * AT_ROWB + (((cc * 4 + c.quad) ^ swB) << 4)); }
            bf16x8 vf[4];
#pragma unroll
            for (int nt = 0; nt < 4; ++nt) vf[nt] = *(const LAS bf16x8*)(vt + (nt * 16 + c.l15) * AT_ROWB + ss * 64 + (c.quad << 4));
#pragma unroll
            for (int qi = 0; qi < 2; ++qi) {
                if (on[qi]) {
                    f32x4 a0 = mfma16(kf[0][0], qf[qi][0], z4), a1 = mfma16(kf[1][0], qf[qi][0], z4); a0 = mfma16(kf[0][1], qf[qi][1], a0); a1 = mfma16(kf[1][1], qf[qi][1], a1);
                    float s2[8]; unsigned vm = 0u;
#pragma unroll
                    for (int e = 0; e < 4; ++e) { s2[e] = a0[e]; s2[4 + e] = a1[e]; }
                    if (TYPE == 0) {
                        const float* rp = c.rpb + (c.lat0 + i - c.r_w + 7) * 31;
#pragma unroll
                        for (int j = 0; j < 8; ++j) { const int kc = ss * 32 + c.quad * 8 + j; const bool ok = (kc >= c.c0[qi]) && (kc < c.c0[qi] + 16);
                            const int dc = min(max(kc - c.qc[qi] + 15, 0), 30); s2[j] = s2[j] + rp[dc] * LOG2E; vm |= ok ? (1u << j) : 0u; }
                    } else {
#pragma unroll
                        for (int j = 0; j < 8; ++j) { const int dd = (c.lat0 + i) * 64 + ss * 32 + c.quad * 8 + j - c.qt[qi]; const bool ok = (dd <= 128) && (dd >= -128); vm |= ok ? (1u << j) : 0u; }
                    }
                    float al; const bf16x8 pA = softmax_p(sa[qi], s2, vm, al);
#pragma unroll
                    for (int nt = 0; nt < 4; ++nt) sa[qi].o[nt] = mfma16(vf[nt], pA, sa[qi].o[nt] * al);
                }
            }
        }
    }
}

template <int TYPE>
__device__ __forceinline__ void attn_block(const Ctx& p, LAS unsigned char* lds, int l, bool dec, int b, int h, int qblk) {
    const int tid = opaque_tid(), lane = tid & 63, wave = __builtin_amdgcn_readfirstlane(tid >> 6);
    ATC c; c.l15 = lane & 15; c.quad = lane >> 4; c.dec = dec;
    const bf16_t* PROJ = (const bf16_t*)(p.ws + WS_PROJ); const bf16_t* TR = (const bf16_t*)(p.ws + WS_TR);
    const bf16_t* CK = (const bf16_t*)(p.ws + WS_CK); const bf16_t* CV = CK + CK_HALF;
    bf16_t* BR = (bf16_t*)(p.ws + WS_BR);
    const int L = dec ? 2048 : 256, rowbase = dec ? M_CTX + b * 2048 : b * 256, q0 = qblk * 256 + wave * 32;
    const bf16_t* Pb = PROJ + (size_t)rowbase * PROJW;
    LAS unsigned char* KL = lds; LAS unsigned char* VL = lds + 2 * AT_TILEB;
    int qcol, kcol, vcol, hk, Hc; size_t ckoff;
    if (TYPE == 0) { qcol = h * 64; kcol = 256 + h * 64; vcol = h * 64; hk = h; Hc = 4; ckoff = CK_NA; }
    else if (TYPE == 1) { qcol = 768 + h * 64; kcol = 1024 + (h >> 1) * 64; vcol = 256 + (h >> 1) * 64; hk = h >> 1; Hc = 2; ckoff = CK_SW; }
    else { qcol = 2048 + h * 64; kcol = 2304 + h * 64; vcol = 384 + h * 64; hk = h; Hc = 4; ckoff = CK_DF; }
    const int ncache = dec ? 8 : 0;
    c.rs_w = 0; c.r_w = 0;
    int cgb = 0;
    if (!dec) { c.lat0 = 0; c.nlat = 4; }
    else if (TYPE == 0) { const int r0 = qblk * 4; const int rsA = min(max(r0 - 4, 0), 24), rsB = min(max(r0 - 1, 0), 24); c.lat0 = rsA; c.nlat = rsB + 8 - rsA;
        c.r_w = r0 + (wave >> 1); c.rs_w = min(max(c.r_w - 4, 0), 24); cgb = (wave & 1) * 2; }
    else if (TYPE == 1) { const int q0b = qblk * 256; c.lat0 = max(q0b - 128, 0) >> 6; c.nlat = (min(q0b + 384, L) >> 6) - c.lat0; }
    else { c.lat0 = 0; c.nlat = 32; }
#pragma unroll
    for (int qi = 0; qi < 2; ++qi) { c.cg4[qi] = cgb + qi; c.q0[qi] = q0 + 16 * qi; c.qt[qi] = q0 + 16 * qi + c.l15; c.qc[qi] = c.cg4[qi] * 16 + c.l15; c.c0[qi] = min(max(c.qc[qi] - 8, 0), 48); }
    const int ntile = c.nlat + ncache;
    const int srow = tid >> 3, sch = tid & 7;
    const int kst_off = srow * AT_ROWB + ((sch ^ (((srow >> 4) & 1) << 2)) << 4), vst_off = srow * AT_ROWB + (sch << 4);
    const bf16_t* klat = Pb + kcol + (size_t)(c.lat0 * 64 + srow) * PROJW + sch * 8;
    const bf16_t* vlat = TR + (size_t)(vcol + srow) * M_TOT + rowbase + c.lat0 * 64 + sch * 8;
    const bf16_t* kcac = CK + ckoff + ((size_t)(b * Hc + hk) * 512 + srow) * 64 + sch * 8;
    const bf16_t* vcac = CV + ckoff + ((size_t)(b * Hc + hk) * 64 + srow) * 512 + sch * 8;
    c.kr0 = (c.l15 >> 2) * 8 + (c.l15 & 3);
    bf16x8 qf[2][2];
    AttnState sa[2], sb[2];
    float sc2, m0, l0;
    if (TYPE == 1) { m0 = inp(p.ws, I_SINK)[l * 4 + h] * LOG2E; l0 = 1.f; sc2 = 0.125f * LOG2E; }
    else if (TYPE == 0) { m0 = -1e30f; l0 = 0.f; sc2 = 0.125f * LOG2E; }
    else { m0 = -1e30f; l0 = 0.f; sc2 = 0.17677669529663687f * LOG2E; }
#pragma unroll
    for (int qi = 0; qi < 2; ++qi) {
        st_init(sa[qi], m0, l0); st_init(sb[qi], -1e30f, 0.f);
        const size_t qrow = (size_t)(q0 + 16 * qi + c.l15) * PROJW;
        const u32x4 q0w = *(const u32x4*)(Pb + qrow + qcol + c.quad * 8), q1w = *(const u32x4*)(Pb + qrow + qcol + 32 + c.quad * 8);
        u32x4 a, bq;
        a.x = cvt_pk_bf16(bflo(q0w.x) * sc2, bfhi(q0w.x) * sc2); a.y = cvt_pk_bf16(bflo(q0w.y) * sc2, bfhi(q0w.y) * sc2); a.z = cvt_pk_bf16(bflo(q0w.z) * sc2, bfhi(q0w.z) * sc2); a.w = cvt_pk_bf16(bflo(q0w.w) * sc2, bfhi(q0w.w) * sc2);
        bq.x = cvt_pk_bf16(bflo(q1w.x) * sc2, bfhi(q1w.x) * sc2); bq.y = cvt_pk_bf16(bflo(q1w.y) * sc2, bfhi(q1w.y) * sc2); bq.z = cvt_pk_bf16(bflo(q1w.z) * sc2, bfhi(q1w.z) * sc2); bq.w = cvt_pk_bf16(bflo(q1w.w) * sc2, bfhi(q1w.w) * sc2);
        qf[qi][0] = __builtin_bit_cast(bf16x8, a); qf[qi][1] = __builtin_bit_cast(bf16x8, bq);
    }
    c.rpb = inp(p.ws, I_RPB) + ((size_t)(l * 4 + h)) * 15 * 31;
#define AT_KSRC(n) (((n) < c.nlat) ? klat + (size_t)(n) * 64 * PROJW : kcac + (size_t)((n) - c.nlat) * 4096)
#define AT_VSRC(n) (((n) < c.nlat) ? vlat + (n) * 64 : vcac + ((n) - c.nlat) * 64)
    u32x4 kA, vA, kB, vB;
    kA = *(const u32x4*)AT_KSRC(0); vA = *(const u32x4*)AT_VSRC(0);
    { const int n1 = min(1, ntile - 1); kB = *(const u32x4*)AT_KSRC(n1); vB = *(const u32x4*)AT_VSRC(n1); }
    *(LAS u32x4*)(KL + kst_off) = kA; *(LAS u32x4*)(VL + vst_off) = vA;
    __syncthreads();
#pragma unroll 1
    for (int i = 0; i < ntile; i += 2) {
        { const int n2 = min(i + 2, ntile - 1); kA = *(const u32x4*)AT_KSRC(n2); vA = *(const u32x4*)AT_VSRC(n2); }
        attn_tile<TYPE>(sa, sb, qf, c, KL, VL, i);
        *(LAS u32x4*)(KL + AT_TILEB + kst_off) = kB; *(LAS u32x4*)(VL + AT_TILEB + vst_off) = vB;
        __syncthreads();
        if (i + 1 >= ntile) break;
        { const int n3 = min(i + 3, ntile - 1); kB = *(const u32x4*)AT_KSRC(n3); vB = *(const u32x4*)AT_VSRC(n3); }
        attn_tile<TYPE>(sa, sb, qf, c, KL + AT_TILEB, VL + AT_TILEB, i + 1);
        *(LAS u32x4*)(KL + kst_off) = kA; *(LAS u32x4*)(VL + vst_off) = vA;
        __syncthreads();
    }
#undef AT_KSRC
#undef AT_VSRC
#pragma unroll
    for (int qi = 0; qi < 2; ++qi) {
        const size_t orow = (size_t)(rowbase + q0 + 16 * qi + c.l15) * 256 + h * 64 + c.quad * 4;
        if (TYPE != 2) {
            const float il = fast_rcp(sa[qi].l);
            bf16_t* o = BR + (TYPE == 1 ? (size_t)M_TOT * 256 : 0) + orow;
#pragma unroll
            for (int nt = 0; nt < 4; ++nt) { u32x2 w; w.x = cvt_pk_bf16(sa[qi].o[nt][0] * il, sa[qi].o[nt][1] * il); w.y = cvt_pk_bf16(sa[qi].o[nt][2] * il, sa[qi].o[nt][3] * il); *(u32x2*)(o + nt * 16) = w; }
        } else {
            const float lam = ((const float*)(p.ws + WS_LAM))[l], lam_init = ((const float*)(p.ws + WS_LAM))[4 + l];
            const float i0 = fast_rcp(sa[qi].l), i1 = lam * fast_rcp(sb[qi].l);
            f32x4 d[4]; float ss = 0.f;
#pragma unroll
            for (int i = 0; i < 4; ++i) { d[i] = sa[qi].o[i] * i0 - sb[qi].o[i] * i1; ss += (d[i][0] * d[i][0] + d[i][1] * d[i][1]) + (d[i][2] * d[i][2] + d[i][3] * d[i][3]); }
            ss = xadd16(ss); ss = xadd32(ss);
            const float rs = rsqrtf(ss * (1.f / 64.f) + EPSF) * (1.f - lam_init);
            const float* sg = inp(p.ws, I_DSUB) + l * 64 + c.quad * 4;
            bf16_t* o = BR + (size_t)3 * M_TOT * 256 + orow;
#pragma unroll
            for (int nt = 0; nt < 4; ++nt) { const f32x4 g4 = *(const f32x4*)(sg + nt * 16); const f32x4 v = d[nt] * rs * g4;
                u32x2 w; w.x = cvt_pk_bf16(v[0], v[1]); w.y = cvt_pk_bf16(v[2], v[3]); *(u32x2*)(o + nt * 16) = w; }
        }
    }
}

__device__ __forceinline__ void hyena_unit(const Ctx& p, LAS unsigned char* lds, int l, int c, bool dec) {
    const int tid = opaque_tid(), lane = tid & 63, wave = __builtin_amdgcn_readfirstlane(tid >> 6), l15 = lane & 15, quad = lane >> 4;
    const int L = dec ? 2048 : 256, B = dec ? 8 : 16, LP = L + 8, rowbase = dec ? M_CTX : 0, L2 = 2 * L, CS = L2 + 16;
    LAS bf16_t* COP = (LAS bf16_t*)lds;
    LAS bf16_t* YA = (LAS bf16_t*)(lds + 66048);
    LAS bf16_t* YB = (LAS bf16_t*)(lds + 66048 + 33024);
    LAS float* RED = (LAS float*)(lds + 66048 + 2 * 33024);
    const bf16_t* TR = (const bf16_t*)(p.ws + WS_TR);
    bf16_t* BR2 = (bf16_t*)(p.ws + WS_BR) + (size_t)2 * M_TOT * 256;
    const float* HF = (const float*)(p.ws + WS_HFIL) + (dec ? 262144 : 0);
    { const bf16_t* src = TR + (size_t)(640 + c) * M_TOT + rowbase;
      for (int i = tid; i < B * L / 8; i += 512) { const int e = i * 8, b = e / L, t = e - b * L; *(LAS u32x4*)(YA + b * LP + t) = *(const u32x4*)(src + e); } }
#pragma unroll 1
    for (int o = 0; o < 2; ++o) {
        LAS float* RF = (LAS float*)(o == 0 ? YB : YA);
        __syncthreads();
        const float* raw0 = HF + ((size_t)((o * 2 + 0) * 256 + c)) * L; const float* raw1 = HF + ((size_t)((o * 2 + 1) * 256 + c)) * L;
        float part = 0.f;
        for (int u = tid; u < L2; u += 512) { const int lag = L - 1 - u; float v = 0.f; if (lag >= 0) v = raw0[lag]; else if (lag > -L) v = raw1[-lag]; RF[u] = v; part += fabsf(v); }
        part = wave_sum(part);
        if (lane == 0) RED[wave] = part;
        __syncthreads();
        float tot = 0.f;
#pragma unroll
        for (int w = 0; w < 8; ++w) tot += RED[w];
        const float inv = 1.f / (tot + EPSF);
        const int ng = L2 / 8;
        for (int idx = tid; idx < 8 * ng; idx += 512) { const int m = idx / ng, x = (idx - m * ng) * 8; float v[8];
#pragma unroll
            for (int j = 0; j < 8; ++j) { const int u = x + m + j; v[j] = (u < L2) ? RF[u] * inv : 0.f; }
            u32x4 w; w.x = cvt_pk_bf16(v[0], v[1]); w.y = cvt_pk_bf16(v[2], v[3]); w.z = cvt_pk_bf16(v[4], v[5]); w.w = cvt_pk_bf16(v[6], v[7]);
            *(LAS u32x4*)(COP + m * CS + x) = w; }
        __syncthreads();
        const LAS bf16_t* Y = (o == 0) ? YA : YB;
        const LAS bf16_t* cpb = COP + (7 - (l15 & 7)) * CS + (L - 8 - 8 * (l15 >> 3) + quad * 8);
        const float skip = inp(p.ws, I_HSKIP)[(l * 2 + o) * 256 + c];
        const bf16_t* gate = TR + (size_t)((o == 0 ? 896 : 1152) + c) * M_TOT + rowbase;
        const int ngroups = L / 64;
        const bf16x8 zero8 = (bf16x8){0, 0, 0, 0, 0, 0, 0, 0};
        for (int g = wave; g < ngroups; g += 8) {
            const int t0 = (g >> 1) * 128 + (g & 1) * 16;
            f32x4 a0 = (f32x4){0.f, 0.f, 0.f, 0.f}, a1 = a0, a2 = a0, a3 = a0;
#define HY_D(s) (*(const LAS bf16x8*)(cpb + (32 * (s) - t0)))
#define HY_Y(s) ((l15 < B) ? *(const LAS bf16x8*)(Y + l15 * LP + 32 * (s) + quad * 8) : zero8)
            bf16x8 d0, d1 = HY_D(-1), d2 = HY_D(-2), d3 = HY_D(-3), y;
            for (int s = 0; s < L / 32; s += 4) {
                d0 = HY_D(s);     y = HY_Y(s);     a0 = mfma16(d0, y, a0); a1 = mfma16(d1, y, a1); a2 = mfma16(d2, y, a2); a3 = mfma16(d3, y, a3);
                d3 = HY_D(s + 1); y = HY_Y(s + 1); a0 = mfma16(d3, y, a0); a1 = mfma16(d0, y, a1); a2 = mfma16(d1, y, a2); a3 = mfma16(d2, y, a3);
                d2 = HY_D(s + 2); y = HY_Y(s + 2); a0 = mfma16(d2, y, a0); a1 = mfma16(d3, y, a1); a2 = mfma16(d0, y, a2); a3 = mfma16(d1, y, a3);
                d1 = HY_D(s + 3); y = HY_Y(s + 3); a0 = mfma16(d1, y, a0); a1 = mfma16(d2, y, a1); a2 = mfma16(d3, y, a2); a3 = mfma16(d0, y, a3);
            }
#undef HY_D
#undef HY_Y
            if (l15 < B) {
#pragma unroll
                for (int a = 0; a < 4; ++a) {
                    const f32x4 cv = a == 0 ? a0 : (a == 1 ? a1 : (a == 2 ? a2 : a3));
                    const int t = t0 + 32 * a + quad * 4;
                    const u32x2 gw = *(const u32x2*)(gate + (size_t)l15 * L + t);
                    const u32x2 yw = *(const LAS u32x2*)(Y + l15 * LP + t);
                    f32x4 r;
                    r[0] = bflo(gw.x) * (cv[0] + skip * bflo(yw.x)); r[1] = bfhi(gw.x) * (cv[1] + skip * bfhi(yw.x));
                    r[2] = bflo(gw.y) * (cv[2] + skip * bflo(yw.y)); r[3] = bfhi(gw.y) * (cv[3] + skip * bfhi(yw.y));
                    if (o == 0) { u32x2 w; w.x = cvt_pk_bf16(r[0], r[1]); w.y = cvt_pk_bf16(r[2], r[3]); *(LAS u32x2*)(YB + l15 * LP + t) = w; }
                    else { bf16_t* op = BR2 + (size_t)(rowbase + l15 * L + t) * 256 + c;
                        op[0] = f2bf1(r[0]); op[256] = f2bf1(r[1]); op[512] = f2bf1(r[2]); op[768] = f2bf1(r[3]); }
                }
            }
        }
    }
    __syncthreads();
}

__device__ __forceinline__ void mix_phase(const Ctx& p, LAS unsigned char* lds, int l) {
    const int G = gridDim.x;
    for (int u = blockIdx.x; u < 512; u += G) hyena_unit(p, lds, l, u & 255, u < 256);
#ifdef PROBE_HY2
    for (int u = blockIdx.x; u < 512; u += G) hyena_unit(p, lds, l, u & 255, u < 256);
#endif
    const int vcu = (G % 8 == 0) ? ((int)blockIdx.x % 8) * (G / 8) + (int)blockIdx.x / 8 : (int)blockIdx.x;
#pragma unroll 1
    for (int it = vcu; it < 960; it += G) {
        if (it < 768) { const int k = it >> 8, r = it & 255, qblk = r & 7, bh = r >> 3;
            if (k == 0) attn_block<2>(p, lds, l, true, bh >> 2, bh & 3, qblk); else if (k == 1) attn_block<1>(p, lds, l, true, bh >> 2, bh & 3, qblk); else attn_block<0>(p, lds, l, true, bh >> 2, bh & 3, qblk); }
        else { const int q = it - 768, k = q >> 6, bh = q & 63;
            if (k == 0) attn_block<2>(p, lds, l, false, bh >> 2, bh & 3, 0); else if (k == 1) attn_block<1>(p, lds, l, false, bh >> 2, bh & 3, 0); else attn_block<0>(p, lds, l, false, bh >> 2, bh & 3, 0); }
    }
}

#define XB_TMO      128
#define XB_XCNT(j)  (256  + 64 * (j))
#define XB_XSUB(j)  (1280 + 64 * (j))
#define XB_XGEN(j)  (2304 + 64 * (j))
#define XB_TOP      3328
#define XB_TOPGEN   3392
#define XB_SPIN_CAP (1u << 22)
__device__ __forceinline__ unsigned xb_ld(unsigned* p)              { return __hip_atomic_load(p, __ATOMIC_RELAXED, __HIP_MEMORY_SCOPE_AGENT); }
__device__ __forceinline__ unsigned xb_add(unsigned* p, unsigned v) { return __hip_atomic_fetch_add(p, v, __ATOMIC_RELAXED, __HIP_MEMORY_SCOPE_AGENT); }
__device__ __forceinline__ unsigned xb_xcc_id() { return (unsigned)__builtin_amdgcn_s_getreg((3 << 11) | 20) & 0xFu; }
#define XB_SPIN(cond, bar) do { unsigned _sp = 0; while (cond) { __builtin_amdgcn_s_sleep(1); \
    if ((++_sp & 255u) == 0u) { if (xb_ld(&(bar)[XB_TMO])) break; if (_sp > XB_SPIN_CAP) { atomicAdd(&(bar)[XB_TMO], 1u); break; } } } } while (0)
struct XcdBarrier { unsigned* bar; unsigned x; volatile LAS unsigned* st; };
__device__ __forceinline__ XcdBarrier xcd_barrier_post(unsigned* bar, volatile LAS unsigned* st) {
    XcdBarrier b; b.bar = bar; b.x = xb_xcc_id(); b.st = st;
    if (threadIdx.x == 0) (void)xb_add(&bar[XB_XCNT(b.x)], 1u);
    return b;
}
__device__ __forceinline__ void xcd_barrier_complete(unsigned* bar, unsigned x, unsigned& nloc, unsigned& nx) {
    const unsigned G = gridDim.x * gridDim.y * gridDim.z;
    unsigned sum, cnt, mine, sp = 0u;
    for (;;) {
        sum = 0u; cnt = 0u; mine = 0u;
#pragma unroll
        for (unsigned j = 0; j < 16; ++j) { const unsigned c = xb_ld(&bar[XB_XCNT(j)]); sum += c; cnt += (c > 0u) ? 1u : 0u; mine = (j == x) ? c : mine; }
        if (sum == G) break;
        __builtin_amdgcn_s_sleep(1);
        if ((++sp & 255u) == 0u) { if (xb_ld(&bar[XB_TMO])) break; if (sp > XB_SPIN_CAP) { atomicAdd(&bar[XB_TMO], 1u); break; } }
    }
    nloc = mine > 0u ? mine : 1u; nx = cnt > 0u ? cnt : 1u;
}
__device__ __forceinline__ void xcd_barrier(const XcdBarrier& b) {
    asm volatile("s_waitcnt vmcnt(0)" ::: "memory");
    __syncthreads();
    if (threadIdx.x == 0) {
        unsigned* bar = b.bar;
        __builtin_amdgcn_s_waitcnt(0);
        unsigned nloc = b.st[0], nx = b.st[1];
        if (nloc == 0u) { xcd_barrier_complete(bar, b.x, nloc, nx); b.st[0] = nloc; b.st[1] = nx; }
        const unsigned old = xb_add(&bar[XB_XSUB(b.x)], 1u);
        const unsigned gen = old / nloc;
        if (old + 1u == (gen + 1u) * nloc) {
            __builtin_amdgcn_fence(__ATOMIC_RELEASE, "agent");
            asm volatile("s_waitcnt vmcnt(0)" ::: "memory");
            const unsigned og = xb_add(&bar[XB_TOP], 1u);
            const unsigned tg = og / nx;
            if (og + 1u == (tg + 1u) * nx) xb_add(&bar[XB_TOPGEN], 1u);
            else XB_SPIN(xb_ld(&bar[XB_TOPGEN]) == tg, bar);
            __builtin_amdgcn_fence(__ATOMIC_ACQUIRE, "agent");
            xb_add(&bar[XB_XGEN(b.x)], 1u);
            asm volatile("s_waitcnt vmcnt(0)" ::: "memory");
        } else {
            XB_SPIN(xb_ld(&bar[XB_XGEN(b.x)]) == gen, bar);
            __builtin_amdgcn_fence(__ATOMIC_ACQUIRE, "agent");
            asm volatile("s_waitcnt vmcnt(0)" ::: "memory");
        }
    }
    __syncthreads();
}

__global__ void __launch_bounds__(512, 2) mega(Params P) {
    extern __shared__ __attribute__((aligned(16))) unsigned char lds_raw[];
    LAS unsigned char* lds = (LAS unsigned char*)lds_raw;
    cg::grid_group grid = cg::this_grid();
    volatile LAS unsigned* MISC = (volatile LAS unsigned*)(lds + LDS_BYTES - 64);
    if (threadIdx.x < 16) MISC[threadIdx.x] = 0u;
    __syncthreads();
    (void)xcd_barrier_post((unsigned*)(P.ws + WS_CTL) + 1024, MISC);
#pragma unroll 1
    for (int ph = P.ph_lo; ph < P.ph_hi; ++ph) {
        GAS unsigned char* ws_g = (GAS unsigned char*)P.ws; GAS float* out_g = (GAS float*)P.out; asm volatile("" : "+s"(ws_g), "+s"(out_g));
        Ctx p; p.ws = (unsigned char*)ws_g; p.out = (float*)out_g;
        unsigned char* ws = p.ws;
        int prep_part = 0, prep_l = 0, prep_b = blockIdx.x, prep_G = gridDim.x;
        if (ph == 0) {
            { const int t0_ = opaque_tid(); if (t0_ < N_IN) { ((unsigned long long*)(ws + WS_TAB))[t0_] = (unsigned long long)P.in[t0_]; } }
            asm volatile("s_waitcnt vmcnt(0)" ::: "memory"); __syncthreads();
#ifndef NO_PREP
            prep_mod(p, lds); __syncthreads(); prep_part = 1;
#endif
        }
        else if (ph == NPH - 1) final_norm_phase(p);
        else {
#ifdef PROBE_S
            const int l = (ph - 1) / 13, sv_ = (ph - 1) % 13, s = sv_ <= PROBE_S ? sv_ : sv_ - 1;
#else
            const int l = (ph - 1) / 12, s = (ph - 1) % 12;
#endif
            const bool is_gemm = (s == 1 || s == 2 || s == 4 || s == 7 || s == 8 || s == 10 || s == 11);
            if (is_gemm) {
                pg8::Gemm g; pg8::Sched S; pg8::Epi E; bool perm;
                S.G = gridDim.x; S.c = blockIdx.x; S.mode = 0; S.nM = M_TOT / 256; S.wgm = (s == 2 || s == 8 || s == 11) ? RESID_WGM : pg8::WGM;
                E.o16 = nullptr; E.o16b = nullptr; E.of = nullptr; E.g = nullptr; E.gates = nullptr; E.scale = 1.f;
                bf16_t* ACT = (bf16_t*)(ws + WS_ACT); bf16_t* BIG = (bf16_t*)(ws + WS_BIG); float* X = (float*)(ws + WS_X);
                if (s == 1 || s == 10) { g.A = ACT; g.Bt = (const bf16_t*)(ws + wbase(l) + (s == 1 ? W_F1UP : W_F2UP)); g.K = DM; S.nN = 22; E.kind = pg8::EK_SWIGLU; E.o16 = BIG; perm = true; }
                else if (s == 2 || s == 11) { g.A = BIG; g.Bt = (const bf16_t*)(ws + wbase(l) + (s == 2 ? W_F1DN : W_F2DN)); g.K = DFF; S.nN = 4; E.kind = pg8::EK_RESID; E.of = X;
                    E.g = mod_ptr(ws, 0, l, s == 2 ? 2 : 8); E.scale = 0.5f; perm = false; }
                else if (s == 4) { g.A = ACT; g.Bt = (const bf16_t*)(ws + wbase(l) + W_IN); g.K = DM; S.nN = 27; E.kind = pg8::EK_PROJ; E.o16 = (bf16_t*)(ws + WS_PROJ); E.o16b = BIG; perm = true; }
                else if (s == 7) { g.A = (const bf16_t*)(ws + WS_BR); g.Bt = (const bf16_t*)(ws + wbase(l) + W_BR); g.K = 256; S.mode = 1; S.nN = 8; E.kind = pg8::EK_BRANCH;
                    E.o16 = ACT; E.gates = BIG; perm = false; }
                else { g.A = ACT; g.Bt = (const bf16_t*)(ws + wbase(l) + W_OUT); g.K = DM; S.nN = 4; E.kind = pg8::EK_RESID; E.of = X; E.g = mod_ptr(ws, 0, l, 5); E.scale = 1.f; perm = false; }
                S.nwg = S.nM * S.nN;
                #ifndef NO_GEMM
                if (s == 7) pg8::gemm_phase<true>(lds, g, S, E, perm); else pg8::gemm_phase<false>(lds, g, S, E, perm);
                if (blockIdx.x >= 64) {
                    if (s == 2) { prep_part = 2; prep_l = l; } else if (s == 8) { prep_part = 4; prep_l = l; } else if (s == 11 && l < 3) { prep_part = 1; prep_l = l + 1; }
                    prep_b = blockIdx.x - 64; prep_G = gridDim.x - 64;
                }
#endif
            } else if (s == 0 || s == 3 || s == 9) {
                norm_phase(p, l, s == 0 ? 0 : (s == 3 ? 1 : 2));

            } else if (s == 5) {
#ifndef NO_MIXPREP
                mixprep_phase(p, lds, l);
#endif
            } else {
#ifndef NO_MIX
                mix_phase(p, lds, l);
#ifdef PROBE_MIX2
                __syncthreads(); mix_phase(p, lds, l);
#endif
#endif
            }
        }
#ifndef NO_PREP
        if (prep_part) prep_layer(p, lds, prep_l, prep_b, prep_G, prep_part);
#endif
        if (ph + 1 < P.ph_hi) { if (P.ph_hi > 100000) grid.sync();   { XcdBarrier bar; bar.bar = (unsigned*)(p.ws + WS_CTL) + 1024; bar.x = xb_xcc_id(); bar.st = (volatile LAS unsigned*)(lds + LDS_BYTES - 64); xcd_barrier(bar); } }
    }
}

extern "C" void kernel_launch(void* const* d_in, const int* in_sizes, int n_in, void* d_out, int out_size, void* d_ws, size_t ws_size, hipStream_t stream) {
    static int grid = 0;
    if (grid == 0) {
        if (n_in != N_IN || ws_size < WS_END) { fprintf(stderr, "kernel_launch: unexpected n_in %d / ws_size %zu (need %zu)\n", n_in, ws_size, (size_t)WS_END); grid = -1; return; }
        int dev = 0, cus = 0, per_cu = 0;
        hipGetDevice(&dev); hipDeviceGetAttribute(&cus, hipDeviceAttributeMultiprocessorCount, dev);
        if (hipFuncSetAttribute((const void*)mega, hipFuncAttributeMaxDynamicSharedMemorySize, LDS_BYTES) != hipSuccess) { fprintf(stderr, "kernel_launch: hipFuncSetAttribute failed\n"); grid = -1; return; }
        if (hipOccupancyMaxActiveBlocksPerMultiprocessor(&per_cu, (const void*)mega, 512, LDS_BYTES) != hipSuccess || per_cu < 1) per_cu = 1;
        (void)hipGetLastError();
        grid = cus * 1;
        fprintf(stderr, "kernel_launch: grid %d (per_cu %d), ws %zu\n", grid, per_cu, ws_size);
    }
    if (grid < 0) return;
    hipMemsetAsync(d_ws, 0, WS_ZERO_BYTES, stream);
    Params p{};
    for (int i = 0; i < N_IN; ++i) p.in[i] = (const float*)d_in[i];
    p.out = (float*)d_out; p.ws = (unsigned char*)d_ws; p.ph_lo = 0; p.ph_hi = NPH;
    void* args[] = {&p};
    hipError_t e = hipLaunchCooperativeKernel((const void*)mega, dim3(grid), dim3(512), args, LDS_BYTES, stream);
    if (e != hipSuccess) fprintf(stderr, "cooperative launch failed: %s (grid %d)\n", hipGetErrorString(e), grid);
}
```

```cpp
#ifndef RESID_WGM
#define RESID_WGM 1
#endif
#include <hip/hip_runtime.h>
#include <hip/hip_cooperative_groups.h>
#include <cstdio>
#include <cstdint>
namespace cg = cooperative_groups;

#define LAS __attribute__((address_space(3)))
#define GAS __attribute__((address_space(1)))
typedef unsigned short bf16_t;
typedef short bf16x8 __attribute__((ext_vector_type(8)));
typedef float f32x4 __attribute__((ext_vector_type(4)));
typedef float f32x2 __attribute__((ext_vector_type(2)));
typedef unsigned u32x4 __attribute__((ext_vector_type(4)));
typedef unsigned u32x2 __attribute__((ext_vector_type(2)));

constexpr int DM = 1024, DFF = 2816, INW = 6912, PROJW = 2816, GATEW = 4096;
constexpr int M_CTX = 4096, M_DEC = 16384, M_TOT = 20480;
constexpr int NLAYER = 4;
constexpr float EPSF = 1e-6f;
constexpr float LOG2E = 1.4426950408889634f;
constexpr size_t O_Y = 0, O_NAK = 20971520, O_NAV = 25165824, O_SWK = 29360128, O_SWV = 31457280, O_DFK = 33554432, O_DFV = 37748736;
enum { I_XP = 0, I_XS, I_CNAK, I_CNAV, I_CSWK, I_CSWV, I_CDFK, I_CDFV, I_C, I_CCTX, I_WADA, I_BADA, I_NF1, I_NMIX, I_NF2, I_FNORM,
       I_F1W1, I_F1W3, I_F1W2, I_F2W1, I_F2W3, I_F2W2, I_WIN, I_WBR, I_WOUT, I_RPB, I_SINK, I_HSW, I_HSB, I_HW1, I_HB1, I_HW2, I_HB2, I_HW3,
       I_HSF, I_HLD, I_HSKIP, I_DLAM, I_DSUB, N_IN };

constexpr size_t MiB = 1u << 20;
constexpr size_t WS_CTL = 0;
constexpr size_t WS_MOD = 1 * MiB;
constexpr size_t WS_ZERO_BYTES = 65536;
constexpr size_t WS_LAM = 3 * MiB;
constexpr size_t WS_W = 4 * MiB;
constexpr size_t W_F1UP = 0, W_F1DN = W_F1UP + (size_t)5632 * 1024 * 2, W_F2UP = W_F1DN + (size_t)1024 * 2816 * 2, W_F2DN = W_F2UP + (size_t)5632 * 1024 * 2,
                 W_IN = W_F2DN + (size_t)1024 * 2816 * 2, W_BR = W_IN + (size_t)6912 * 1024 * 2, W_OUT = W_BR + (size_t)4 * 1024 * 256 * 2, W_END = W_OUT + (size_t)1024 * 1024 * 2;
static_assert(W_END <= 52 * MiB, "weights");
constexpr size_t WS_X = 56 * MiB;
constexpr size_t WS_ACT = 136 * MiB;
constexpr size_t WS_BR = 176 * MiB;
constexpr size_t WS_BIG = 216 * MiB;
constexpr size_t WS_PROJ = 376 * MiB;
constexpr size_t WS_TR = 486 * MiB;
constexpr size_t WS_CK = 541 * MiB;
constexpr size_t WS_HFIL = 551 * MiB;
constexpr size_t WS_W2 = 560 * MiB;
constexpr size_t WS_END = 612 * MiB;
constexpr int TRW = 1408;
constexpr size_t CK_NA = 0, CK_SW = 1048576, CK_DF = 1572864, CK_HALF = 2621440;
constexpr int LDS_BYTES = 147456;

#ifdef PROBE_S
constexpr int NPH = 54;
#else
constexpr int NPH = 50;
#endif
struct Params { const float* in[N_IN]; float* out; unsigned char* ws; int ph_lo, ph_hi; };
struct Ctx { float* out; unsigned char* ws; };
__device__ __forceinline__ size_t wbase(int l) { return (l & 1) ? WS_W2 : WS_W; }
constexpr size_t WS_TAB = 3 * MiB + 65536;
__device__ __forceinline__ const float* inp(const unsigned char* ws, int i) {
    const unsigned long long v = __hip_atomic_load((const unsigned long long*)(ws + WS_TAB) + i, __ATOMIC_RELAXED, __HIP_MEMORY_SCOPE_AGENT);
    const unsigned lo = __builtin_amdgcn_readfirstlane((unsigned)v), hi = __builtin_amdgcn_readfirstlane((unsigned)(v >> 32));
    return (const float*)(const GAS float*)(((unsigned long long)hi << 32) | lo);
}


__device__ __forceinline__ unsigned cvt_pk_bf16(float lo, float hi) { unsigned r; asm volatile("v_cvt_pk_bf16_f32 %0, %1, %2" : "=v"(r) : "v"(lo), "v"(hi)); return r; }
__device__ __forceinline__ float bf2f(unsigned short v) { return __uint_as_float(((unsigned)v) << 16); }
__device__ __forceinline__ float bflo(unsigned v) { return __uint_as_float(v << 16); }
__device__ __forceinline__ float bfhi(unsigned v) { return __uint_as_float(v & 0xffff0000u); }
__device__ __forceinline__ bf16_t f2bf1(float f) { return (bf16_t)(cvt_pk_bf16(f, 0.f) & 0xffffu); }
__device__ __forceinline__ float fast_exp2(float x) { return __builtin_amdgcn_exp2f(x); }
__device__ __forceinline__ float fast_rcp(float x) { return __builtin_amdgcn_rcpf(x); }
__device__ __forceinline__ float sigmoidf_(float x) { return fast_rcp(1.f + fast_exp2(-x * LOG2E)); }
__device__ __forceinline__ float wave_sum(float v) {
#pragma unroll
    for (int o = 1; o < 64; o <<= 1) v += __shfl_xor(v, o);
    return v;
}
__device__ __forceinline__ int cond_of_row(int row) { return row < M_CTX ? 0 : 1 + ((row - M_CTX) >> 11); }
__device__ __forceinline__ const float* mod_ptr(const unsigned char* ws, int cond, int l, int chunk) { return (const float*)(ws + WS_MOD) + ((size_t)(cond * 4 + l) * 9 + chunk) * 1024; }

__device__ __forceinline__ int opaque_tid() { int t; asm volatile("v_mov_b32 %0, %1" : "=v"(t) : "v"((int)threadIdx.x)); return t; }
namespace pg8 {
constexpr int BM = 256, BK = 64, HALF = 128, HTB = HALF * BK * 2, STAGE_BYTES = 8 * HTB, NXCD = 8, WGM = 4;
__device__ __forceinline__ int lds_byte(int r, int c) { const int st = (r >> 4) * 2 + (c >> 5), rr = r & 15, cc = c & 31, ob = rr * 64 + cc * 2; return st * 1024 + (ob ^ (((ob >> 9) & 1) << 5)); }
__device__ __forceinline__ void stage_rc(int b, int& R, int& C) { const int st = b / 1024, sb = b % 1024, swz = sb ^ (((sb >> 9) & 1) << 5); R = (st >> 1) * 16 + swz / 64; C = (st & 1) * 32 + (swz % 64) / 2; }
__device__ __forceinline__ int perm32(int rho) { const int n = rho >> 4, i = rho & 15; return 8 * (i >> 2) + 4 * n + (i & 3); }
struct Unit { int pm, pn; };
struct Sched { int mode, nM, nN, nwg, G, c, wgm; };
__device__ __forceinline__ bool sched_next(const Sched& S, int i, Unit& u) {
    const int j = (S.mode == 1) ? (i >> 2) : i;
    const long L = (long)j * S.G + S.c; if (L >= S.nwg) return false;
    int wgid = (int)L; { const int q = S.nwg / NXCD, r = S.nwg % NXCD, xcd = wgid % NXCD, off = wgid / NXCD; wgid = (xcd < r ? xcd * (q + 1) : r * (q + 1) + (xcd - r) * q) + off; }
    const int nig = S.wgm * S.nN, gid = wgid / nig, fm = gid * S.wgm, gsz = (S.nM - fm) < S.wgm ? (S.nM - fm) : S.wgm;
    const int pm = fm + ((wgid % nig) % gsz), pn = (wgid % nig) / gsz;
    if (S.mode == 1) { const int b = i & 3; u.pm = b * S.nM + pm; u.pn = b * S.nN + pn; } else { u.pm = pm; u.pn = pn; }
    return true;
}
enum { EK_SWIGLU = 0, EK_RESID = 1, EK_PROJ = 2, EK_BRANCH = 3 };
struct Epi { int kind; bf16_t* o16; bf16_t* o16b; float* of; const float* g; const bf16_t* gates; float scale; };
struct Gemm { const bf16_t* A; const bf16_t* Bt; int K; };

template <bool BR>
__device__ __forceinline__ void epilogue(const Epi& E, f32x4 (&acc)[2][2][4][2], const Unit& u, int wr, int wc, int fr, int fq) {
    if (BR) {
        const int bi = u.pm / 80, pm = u.pm - bi * 80, pn = u.pn & 7;
        const int row0 = pm * BM + wr * 64 + fr, col0 = pn * HALF + wc * 32 + 4 * fq;
        u32x2 gw[2][2][4];
#pragma unroll
        for (int n = 0; n < 2; ++n)
#pragma unroll
            for (int ai = 0; ai < 2; ++ai)
#pragma unroll
                for (int m = 0; m < 4; ++m) gw[n][ai][m] = *(const u32x2*)(E.gates + (size_t)(row0 + ai * HALF + m * 16) * GATEW + bi * 1024 + col0 + n * 16);
#pragma unroll
        for (int n = 0; n < 2; ++n)
#pragma unroll
            for (int ai = 0; ai < 2; ++ai)
#pragma unroll
                for (int m = 0; m < 4; ++m) {
                    const u32x2 g2 = gw[n][ai][m];
                    f32x4 gt; gt[0] = bflo(g2.x); gt[1] = bfhi(g2.x); gt[2] = bflo(g2.y); gt[3] = bfhi(g2.y);
                    f32x4 v = gt * acc[ai][0][m][n];
                    if (bi > 0) v = v + acc[ai][1][m][n];
                    acc[ai][1][m][n] = v;
                    if (bi == 3) { u32x2 w; w.x = cvt_pk_bf16(v[0], v[1]); w.y = cvt_pk_bf16(v[2], v[3]); *(u32x2*)(E.o16 + (size_t)(row0 + ai * HALF + m * 16) * DM + col0 + n * 16) = w; }
                }
    } else if (E.kind == EK_SWIGLU) {
        const int row0 = u.pm * BM + wr * 64 + fr, col0 = u.pn * 128 + wc * 32 + 8 * fq;
#pragma unroll
        for (int ai = 0; ai < 2; ++ai)
#pragma unroll
            for (int m = 0; m < 4; ++m) {
                const f32x4 a0 = acc[ai][0][m][0], a1 = acc[ai][0][m][1], b0 = acc[ai][1][m][0], b1 = acc[ai][1][m][1];
                float r[8];
#pragma unroll
                for (int e = 0; e < 4; ++e) { r[e] = a0[e] * sigmoidf_(a0[e]) * b0[e]; r[4 + e] = a1[e] * sigmoidf_(a1[e]) * b1[e]; }
                u32x4 w; w.x = cvt_pk_bf16(r[0], r[1]); w.y = cvt_pk_bf16(r[2], r[3]); w.z = cvt_pk_bf16(r[4], r[5]); w.w = cvt_pk_bf16(r[6], r[7]);
                *(u32x4*)(E.o16 + (size_t)(row0 + ai * HALF + m * 16) * DFF + col0) = w;
            }
    } else if (E.kind == EK_PROJ) {
        const int row0 = u.pm * BM + wr * 64 + fr;
        const bool isgate = u.pn >= 11;
        bf16_t* base = isgate ? E.o16b : E.o16; const int ld = isgate ? GATEW : PROJW;
        const int col0 = (isgate ? (u.pn - 11) * BM : u.pn * BM) + wc * 32 + 8 * fq;
#pragma unroll
        for (int ai = 0; ai < 2; ++ai)
#pragma unroll
            for (int m = 0; m < 4; ++m)
#pragma unroll
                for (int bj = 0; bj < 2; ++bj) {
                    f32x4 v0 = acc[ai][bj][m][0], v1 = acc[ai][bj][m][1];
                    if (isgate) {
#pragma unroll
                        for (int e = 0; e < 4; ++e) { v0[e] = sigmoidf_(v0[e]); v1[e] = sigmoidf_(v1[e]); }
                    }
                    u32x4 w; w.x = cvt_pk_bf16(v0[0], v0[1]); w.y = cvt_pk_bf16(v0[2], v0[3]); w.z = cvt_pk_bf16(v1[0], v1[1]); w.w = cvt_pk_bf16(v1[2], v1[3]);
                    *(u32x4*)(base + (size_t)(row0 + ai * HALF + m * 16) * ld + col0 + bj * HALF) = w;
                }
    } else if (E.kind == EK_RESID) {
        const int cond = (u.pm < 16) ? 0 : 1 + ((u.pm - 16) >> 3);
        const float* gv = E.g + (size_t)cond * (4 * 9 * 1024);
        const int row0 = u.pm * BM + wr * 64 + fr, col0 = u.pn * BM + wc * 32 + 4 * fq;
        f32x4 g4[2][2];
#pragma unroll
        for (int bj = 0; bj < 2; ++bj)
#pragma unroll
            for (int n = 0; n < 2; ++n) g4[bj][n] = *(const f32x4*)(gv + col0 + bj * HALF + n * 16) * E.scale;
#pragma unroll
        for (int bj = 0; bj < 2; ++bj)
#pragma unroll
            for (int n = 0; n < 2; ++n) {
                const int col = col0 + bj * HALF + n * 16;
                f32x4 xv[2][4];
#pragma unroll
                for (int ai = 0; ai < 2; ++ai)
#pragma unroll
                    for (int m = 0; m < 4; ++m) xv[ai][m] = *(const f32x4*)(E.of + (size_t)(row0 + ai * HALF + m * 16) * DM + col);
#pragma unroll
                for (int ai = 0; ai < 2; ++ai)
#pragma unroll
                    for (int m = 0; m < 4; ++m) *(f32x4*)(E.of + (size_t)(row0 + ai * HALF + m * 16) * DM + col) = xv[ai][m] + g4[bj][n] * acc[ai][bj][m][n];
            }
    }
}

template <bool BR>
__device__ __forceinline__ void gemm_phase(LAS unsigned char* lds, const Gemm g, const Sched& S, const Epi& E, const bool perm) {
    const int tid = opaque_tid(), wid = __builtin_amdgcn_readfirstlane(tid >> 6), lane = tid & 63, wr = wid >> 2, wc = wid & 3, fr = lane & 15, fq = lane >> 4;
    const int K = g.K, nt = K / BK;
    const bool align = !(E.kind == EK_RESID);
    unsigned voffA[2], voffB[2];
#pragma unroll
    for (int i = 0; i < 2; ++i) { int R, C; stage_rc(tid * 16 + i * 8192, R, C); const int Rb = perm ? ((R & ~31) + perm32(R & 31)) : R;
        voffA[i] = (unsigned)(R * K + C) * 2u; voffB[i] = (unsigned)(Rb * K + C) * 2u; }
    const size_t kstep = (size_t)(BK * 2);
    const size_t hstep = (size_t)HALF * K * 2;
    const size_t tstep = 2 * hstep;
    const size_t bstep = BR ? hstep : tstep;
    const unsigned ldsw = (unsigned)wid * 1024u;
    const int aoff = lds_byte(wr * 64 + fr, fq * 8), boff = lds_byte(wc * 32 + fr, fq * 8);
#define PG8_SA(b, h) (((b) * 2 + (h)) * HTB)
#define PG8_SB(b, h) ((4 + (b) * 2 + (h)) * HTB)
#define PG8_STAGE(bufoff, gbase, voff) do { _Pragma("unroll") for (int _i = 0; _i < 2; ++_i) \
        __builtin_amdgcn_global_load_lds((const unsigned*)((const char*)(gbase) + (voff)[_i]), (LAS unsigned*)(lds + (bufoff) + ldsw + _i * 8192), 16, 0, 0); } while (0)
#define PG8_LDA(dst, b, h) do { _Pragma("unroll") for (int m = 0; m < 4; ++m) _Pragma("unroll") for (int k = 0; k < 2; ++k) dst[m][k] = *(const LAS bf16x8*)(lds + PG8_SA(b, h) + aoff + m * 2048 + k * 1024); } while (0)
#define PG8_LDB(dst, b, h) do { _Pragma("unroll") for (int n = 0; n < 2; ++n) _Pragma("unroll") for (int k = 0; k < 2; ++k) dst[n][k] = *(const LAS bf16x8*)(lds + PG8_SB(b, h) + boff + n * 2048 + k * 1024); } while (0)
#define PG8_MMA(ai, bj, At, Bt) do { __builtin_amdgcn_s_setprio(1); _Pragma("unroll") for (int m = 0; m < 4; ++m) _Pragma("unroll") for (int n = 0; n < 2; ++n) _Pragma("unroll") for (int k = 0; k < 2; ++k) \
        acc[ai][bj][m][n] = __builtin_amdgcn_mfma_f32_16x16x32_bf16(Bt[n][k], At[m][k], acc[ai][bj][m][n], 0, 0, 0); __builtin_amdgcn_s_setprio(0); } while (0)
#define PG8_WAIT_V(n) asm volatile("s_waitcnt vmcnt(" #n ")" ::: "memory")
#define PG8_WAIT_L(n) asm volatile("s_waitcnt lgkmcnt(" #n ")" ::: "memory")
#define PG8_BAR __builtin_amdgcn_s_barrier()
#define PG8_SCHED __builtin_amdgcn_sched_barrier(0)
    Unit cur, nxt; int ui = 0;
    if (!sched_next(S, 0, cur)) return;
    f32x4 acc[2][2][4][2];
#pragma unroll
    for (int a = 0; a < 2; ++a)
#pragma unroll
        for (int b = 0; b < 2; ++b)
#pragma unroll
            for (int m = 0; m < 4; ++m)
#pragma unroll
                for (int n = 0; n < 2; ++n) acc[a][b][m][n] = (f32x4){0.f, 0.f, 0.f, 0.f};
    bf16x8 At[4][2], B0[2][2], B1[2][2];
    const char* cA = (const char*)g.A + (size_t)cur.pm * tstep; const char* cB = (const char*)g.Bt + (size_t)cur.pn * bstep;
    PG8_STAGE(PG8_SB(0, 0), cB, voffB); PG8_STAGE(PG8_SB(0, 1), cB + hstep, voffB); PG8_STAGE(PG8_SA(0, 0), cA, voffA); PG8_STAGE(PG8_SA(0, 1), cA + hstep, voffA);
    if (wr == 1) PG8_BAR;
    PG8_WAIT_V(2); PG8_BAR;
    PG8_STAGE(PG8_SB(1, 0), cB + kstep, voffB); PG8_STAGE(PG8_SA(1, 0), cA + kstep, voffA); PG8_STAGE(PG8_SB(1, 1), cB + hstep + kstep, voffB);
    PG8_WAIT_V(6); PG8_BAR;
    for (;;) {
        const bool has_next = sched_next(S, ui + 1, nxt);
        const char* nA = has_next ? (const char*)g.A + (size_t)nxt.pm * tstep : cA; const char* nB = has_next ? (const char*)g.Bt + (size_t)nxt.pn * bstep : cB;
        for (int t = 0; t < nt; t += 2) {
            const bool last = (t == nt - 2);
            const char* a1 = cA + (size_t)(t + 1) * kstep;
            const char* a2 = last ? nA : cA + (size_t)(t + 2) * kstep; const char* b2 = last ? nB : cB + (size_t)(t + 2) * kstep;
            const char* a3 = a2 + kstep; const char* b3 = b2 + kstep;
            PG8_LDB(B0, 0, 0); PG8_LDB(B1, 0, 1); PG8_SCHED; PG8_LDA(At, 0, 0); PG8_STAGE(PG8_SA(1, 1), a1 + hstep, voffA);
            PG8_WAIT_V(8); PG8_WAIT_L(0); PG8_BAR; PG8_MMA(0, 0, At, B0); if (!BR) { PG8_MMA(0, 1, At, B1); } PG8_BAR; PG8_SCHED;
            PG8_LDA(At, 0, 1); PG8_STAGE(PG8_SB(0, 0), b2, voffB); PG8_STAGE(PG8_SB(0, 1), b2 + hstep, voffB); PG8_STAGE(PG8_SA(0, 0), a2, voffA);
            PG8_WAIT_V(8); PG8_WAIT_L(0); PG8_BAR; PG8_MMA(1, 0, At, B0); if (!BR) { PG8_MMA(1, 1, At, B1); } PG8_BAR; PG8_SCHED;
            PG8_LDB(B0, 1, 0); PG8_LDB(B1, 1, 1); PG8_SCHED; PG8_LDA(At, 1, 0); PG8_STAGE(PG8_SA(0, 1), a2 + hstep, voffA);
            PG8_WAIT_V(8); PG8_WAIT_L(0); PG8_BAR; PG8_MMA(0, 0, At, B0); if (!BR) { PG8_MMA(0, 1, At, B1); } PG8_BAR; PG8_SCHED;
            PG8_LDA(At, 1, 1); PG8_STAGE(PG8_SB(1, 0), b3, voffB); PG8_STAGE(PG8_SB(1, 1), b3 + hstep, voffB); PG8_STAGE(PG8_SA(1, 0), a3, voffA);
            PG8_WAIT_V(8); PG8_WAIT_L(0); PG8_BAR; PG8_MMA(1, 0, At, B0); if (!BR) { PG8_MMA(1, 1, At, B1); } PG8_BAR; PG8_SCHED;
        }
        if (align && wr == 0) PG8_BAR;
        epilogue<BR>(E, acc, cur, wr, wc, fr, fq);
        if (!has_next) break;
#pragma unroll
        for (int a = 0; a < 2; ++a)
#pragma unroll
            for (int b = 0; b < (BR ? 1 : 2); ++b)
#pragma unroll
                for (int m = 0; m < 4; ++m)
#pragma unroll
                    for (int n = 0; n < 2; ++n) acc[a][b][m][n] = (f32x4){0.f, 0.f, 0.f, 0.f};
        cur = nxt; cA = nA; cB = nB; ++ui;
        if (align && wr == 1) PG8_BAR;
    }
    PG8_WAIT_V(0);
    if (!align && wr == 0) PG8_BAR;
    PG8_BAR;
#undef PG8_SA
#undef PG8_SB
#undef PG8_STAGE
#undef PG8_LDA
#undef PG8_LDB
#undef PG8_MMA
#undef PG8_WAIT_V
#undef PG8_WAIT_L
#undef PG8_BAR
#undef PG8_SCHED
}
}


__device__ __forceinline__ void transpose_item(const float* W, int K, int N, bf16_t* WT, int dst_row0, LAS float* scr, int k0, int n0, int lane) {
    f32x4 v[16];
    const int rr = lane >> 4, cc = (lane & 15) * 4;
#pragma unroll
    for (int i = 0; i < 16; ++i) v[i] = __builtin_nontemporal_load((const f32x4*)(W + (size_t)(k0 + 4 * i + rr) * N + n0 + cc));
#pragma unroll
    for (int i = 0; i < 16; ++i) { LAS float* d = scr + (4 * i + rr) * 65 + cc; d[0] = v[i][0]; d[1] = v[i][1]; d[2] = v[i][2]; d[3] = v[i][3]; }
    asm volatile("s_waitcnt lgkmcnt(0)" ::: "memory");
    const int c = lane & 7, r = lane >> 3;
#pragma unroll
    for (int j = 0; j < 8; ++j) { const int n = 8 * j + r; const LAS float* q = scr + (8 * c) * 65 + n;
        u32x4 o; o.x = cvt_pk_bf16(q[0], q[65]); o.y = cvt_pk_bf16(q[2 * 65], q[3 * 65]); o.z = cvt_pk_bf16(q[4 * 65], q[5 * 65]); o.w = cvt_pk_bf16(q[6 * 65], q[7 * 65]);
        *(u32x4*)(WT + (size_t)(dst_row0 + n) * K + k0 + 8 * c) = o; }
    asm volatile("s_waitcnt lgkmcnt(0)" ::: "memory");
}

__device__ __forceinline__ void prep_layer(const Ctx& p, LAS unsigned char* lds, int l, int bidx, int G, int part) {
    const int tid = opaque_tid(), lane = tid & 63, wave = tid >> 6;
    const int gw = bidx * 8 + wave, NGW = G * 8;
    unsigned char* ws = p.ws; unsigned char* wsw = p.ws + wbase(l);
    LAS float* scr = (LAS float*)(lds + wave * 16896);
    {
        constexpr int I_UP = 16 * 44, I_DN = 44 * 16, I_IN = 16 * 108, I_BR = 4 * 16, I_OUT = 16 * 16;
        constexpr int NIT = 4 * I_UP + 2 * I_DN + I_IN + 4 * I_BR + I_OUT;
        for (int it = gw; it < NIT; it += NGW) {
            int r = it;
            { const int cls = (r < 4 * I_UP) ? ((r < 2 * I_UP) ? 1 : 4) : ((r < 4 * I_UP + 2 * I_DN) ? ((r < 4 * I_UP + I_DN) ? 1 : 4) : 2); if (!(part & cls)) continue; }
            if (r < 4 * I_UP) {
                const int which = r / I_UP; r -= which * I_UP; const int kb = r / 44, nb = r % 44, n0 = nb * 64;
                const float* W = inp(p.ws, (which >> 1) ? ((which & 1) ? I_F2W3 : I_F2W1) : ((which & 1) ? I_F1W3 : I_F1W1)) + (size_t)l * DM * DFF;
                bf16_t* WT = (bf16_t*)(wsw + ((which >> 1) ? W_F2UP : W_F1UP));
                const int drow = 256 * (n0 >> 7) + (which & 1) * 128 + (n0 & 127);
                transpose_item(W, DM, DFF, WT, drow, scr, kb * 64, n0, lane); continue;
            }
            r -= 4 * I_UP;
            if (r < 2 * I_DN) {
                const int which = r / I_DN; r -= which * I_DN; const int kb = r / 16, nb = r % 16;
                const float* W = inp(p.ws, which ? I_F2W2 : I_F1W2) + (size_t)l * DFF * DM;
                bf16_t* WT = (bf16_t*)(wsw + (which ? W_F2DN : W_F1DN));
                transpose_item(W, DFF, DM, WT, nb * 64, scr, kb * 64, nb * 64, lane); continue;
            }
            r -= 2 * I_DN;
            if (r < I_IN) { const int kb = r / 108, nb = r % 108;
                transpose_item(inp(p.ws, I_WIN) + (size_t)l * DM * INW, DM, INW, (bf16_t*)(wsw + W_IN), nb * 64, scr, kb * 64, nb * 64, lane); continue; }
            r -= I_IN;
            if (r < 4 * I_BR) { const int bi = r / I_BR; r -= bi * I_BR; const int kb = r / 16, nb = r % 16;
                transpose_item(inp(p.ws, I_WBR) + ((size_t)l * 4 + bi) * 256 * DM, 256, DM, (bf16_t*)(wsw + W_BR) + (size_t)bi * 1024 * 256, nb * 64, scr, kb * 64, nb * 64, lane); continue; }
            r -= 4 * I_BR;
            { const int kb = r / 16, nb = r % 16;
              transpose_item(inp(p.ws, I_WOUT) + (size_t)l * DM * DM, DM, DM, (bf16_t*)(wsw + W_OUT), nb * 64, scr, kb * 64, nb * 64, lane); }
        }
    }
    if (!(part & 2)) return;
    {
        bf16_t* CK = (bf16_t*)(ws + WS_CK);
        const int gt = bidx * 512 + tid, NT = G * 512;
        for (int it = gt; it < 327680; it += NT) {
            int e = it * 8; const float* src; bf16_t* dst; int per_b;
            if (e < 1048576) { src = inp(p.ws, I_CNAK); dst = CK + CK_NA; per_b = 131072; }
            else if (e < 1572864) { e -= 1048576; src = inp(p.ws, I_CSWK); dst = CK + CK_SW; per_b = 65536; }
            else { e -= 1572864; src = inp(p.ws, I_CDFK); dst = CK + CK_DF; per_b = 131072; }
            const int b = e / per_b, r = e - b * per_b;
            const float* s = src + ((size_t)(b * 4 + l)) * per_b + r;
            const f32x4 v0 = *(const f32x4*)s, v1 = *(const f32x4*)(s + 4);
            u32x4 o; o.x = cvt_pk_bf16(v0[0], v0[1]); o.y = cvt_pk_bf16(v0[2], v0[3]); o.z = cvt_pk_bf16(v1[0], v1[1]); o.w = cvt_pk_bf16(v1[2], v1[3]);
            *(u32x4*)(dst + e) = o;
        }
    }
    {
        bf16_t* CV = (bf16_t*)(ws + WS_CK) + CK_HALF;
        for (int it = gw; it < 640; it += NGW) {
            int r = it; const float* src; bf16_t* dst; int H;
            if (r < 256) { src = inp(p.ws, I_CNAV); dst = CV + CK_NA; H = 4; }
            else if (r < 384) { r -= 256; src = inp(p.ws, I_CSWV); dst = CV + CK_SW; H = 2; }
            else { r -= 384; src = inp(p.ws, I_CDFV); dst = CV + CK_DF; H = 4; }
            const int kb = r & 7, bh = r >> 3, b = bh / H, h = bh - b * H;
            transpose_item(src + ((size_t)(b * 4 + l) * H + h) * 512 * 64, 512, 64, dst + (size_t)bh * 64 * 512, 0, scr, kb * 64, 0, lane);
        }
    }
    __syncthreads();
    {
        LAS float* Z = (LAS float*)lds;
        LAS float* G1 = Z + 8 * 33;
        LAS float* G2 = G1 + 8 * 64;
        float* HF = (float*)(ws + WS_HFIL);
        const float* w1 = inp(p.ws, I_HW1) + (size_t)l * 33 * 64; const float* b1 = inp(p.ws, I_HB1) + l * 64;
        const float* w2 = inp(p.ws, I_HW2) + (size_t)l * 64 * 64; const float* b2 = inp(p.ws, I_HB2) + l * 64;
        const float* w3 = inp(p.ws, I_HW3) + (size_t)l * 64 * 1024; const float* sf = inp(p.ws, I_HSF) + l * 64; const float* ld = inp(p.ws, I_HLD) + l * 1024;
        for (int it = bidx; it < 288; it += G) {
            const int Lsel = it >= 32, L = Lsel ? 2048 : 256, n0 = (Lsel ? it - 32 : it) * 8;
            const float invL = 1.f / (float)L;
            if (tid < 8 * 33) { const int nn = tid / 33, i = tid - nn * 33; const float tn = (float)(n0 + nn) * invL; float v;
                if (i == 0) v = tn; else if (i <= 16) v = __cosf(6.283185307179586f * tn * (float)i); else v = __sinf(6.283185307179586f * tn * (float)(i - 16));
                Z[nn * 33 + i] = v; }
            __syncthreads();
            { const int nn = tid >> 6, j = tid & 63; float a = b1[j];
#pragma unroll 11
              for (int i = 0; i < 33; ++i) a += Z[nn * 33 + i] * w1[i * 64 + j];
              G1[nn * 64 + j] = __sinf(sf[j] * a); }
            __syncthreads();
            { const int nn = tid >> 6, j = tid & 63; float a = b2[j];
#pragma unroll 16
              for (int i = 0; i < 64; ++i) a += G1[nn * 64 + i] * w2[i * 64 + j];
              G2[nn * 64 + j] = __sinf(sf[j] * a); }
            __syncthreads();
#pragma unroll 1
            for (int cc = 0; cc < 2; ++cc) {
                const int col = cc * 512 + tid;
                float a[8];
#pragma unroll
                for (int nn = 0; nn < 8; ++nn) a[nn] = 0.f;
#pragma unroll 16
                for (int i = 0; i < 64; ++i) { const float w = w3[i * 1024 + col];
#pragma unroll
                    for (int nn = 0; nn < 8; ++nn) a[nn] += G2[nn * 64 + i] * w; }
                const float rate = __expf(ld[col]);
#pragma unroll
                for (int nn = 0; nn < 8; ++nn) a[nn] *= __expf(-rate * (float)(n0 + nn) * invL);
                float* o = HF + (Lsel ? 262144 : 0) + (size_t)col * L + n0;
                *(f32x4*)o = (f32x4){a[0], a[1], a[2], a[3]}; *(f32x4*)(o + 4) = (f32x4){a[4], a[5], a[6], a[7]};
            }
            __syncthreads();
        }
    }
    if (bidx == 0 && tid == 0) {
        const float* lv = inp(p.ws, I_DLAM) + l * 128; float s01 = 0.f, s23 = 0.f;
        for (int i = 0; i < 32; ++i) { s01 += lv[i] * lv[32 + i]; s23 += lv[64 + i] * lv[96 + i]; }
        float c08; asm volatile("v_mov_b32 %0, 0x3f4ccccd" : "=v"(c08));
        const float lam_init = c08 - 0.6f * __expf(-0.3f * (float)l);
        ((float*)(ws + WS_LAM))[l] = __expf(s01) - __expf(s23) + lam_init; ((float*)(ws + WS_LAM))[4 + l] = lam_init;
    }
}

__device__ __forceinline__ void prep_mod(const Ctx& p, LAS unsigned char* lds) {
    const int tid = opaque_tid(), lane = tid & 63, wave = tid >> 6;
    const int G = gridDim.x;
    LAS float* SC = (LAS float*)lds;
    LAS float* PART = (LAS float*)(lds + 40960);
    for (int i = tid; i < 9 * 1024; i += 512) { const float v = (i < 1024) ? inp(p.ws, I_CCTX)[i] : inp(p.ws, I_C)[i - 1024]; SC[i] = v * sigmoidf_(v); }
    __syncthreads();
    float* mod = (float*)(p.ws + WS_MOD);
    for (int it = blockIdx.x; it < 4 * 36; it += G) {
        const int cb = it % 36, l = it / 36;
        const int col = cb * 256 + lane * 4, k0 = wave * 128;
        const float* W = inp(p.ws, I_WADA) + ((size_t)l * DM + k0) * 9216 + col;
        f32x4 a[9];
#pragma unroll
        for (int c = 0; c < 9; ++c) a[c] = (f32x4){0.f, 0.f, 0.f, 0.f};
#pragma unroll 16
        for (int k = 0; k < 128; ++k) { const f32x4 w = __builtin_nontemporal_load((const f32x4*)(W + (size_t)k * 9216));
#pragma unroll
            for (int c = 0; c < 9; ++c) a[c] += w * SC[c * 1024 + k0 + k]; }
#pragma unroll
        for (int c = 0; c < 9; ++c) *(LAS f32x4*)(PART + (wave * 9 + c) * 256 + lane * 4) = a[c];
        __syncthreads();
        for (int o = tid; o < 9 * 256; o += 512) { const int c = o >> 8, cc = o & 255;
            float v = inp(p.ws, I_BADA)[(size_t)l * 9216 + cb * 256 + cc];
#pragma unroll
            for (int w = 0; w < 8; ++w) v += PART[(w * 9 + c) * 256 + cc];
            mod[((size_t)(c * 4 + l)) * 9216 + cb * 256 + cc] = v; }
        __syncthreads();
    }
}

__device__ __forceinline__ void norm_phase(const Ctx& p, int l, int which  ) {
    const int tid_ = opaque_tid(), lane = tid_ & 63, wave = tid_ >> 6, gw = blockIdx.x * 8 + wave, NGW = gridDim.x * 8;
    float* X = (float*)(p.ws + WS_X); bf16_t* ACT = (bf16_t*)(p.ws + WS_ACT);
    const float* gsrc = inp(p.ws, which == 0 ? I_NF1 : (which == 1 ? I_NMIX : I_NF2)) + l * DM;
    const bool from_in = (l == 0 && which == 0);
    f32x4 gv[4];
#pragma unroll
    for (int j = 0; j < 4; ++j) gv[j] = *(const f32x4*)(gsrc + j * 256 + lane * 4);
    constexpr int NR = 4;
    for (int row0 = gw * NR; row0 < M_TOT; row0 += NGW * NR) {
        f32x4 v[NR][4]; float s[NR];
#pragma unroll
        for (int r = 0; r < NR; ++r) {
            const int row = row0 + r;
            const float* xr = from_in ? (row < M_CTX ? inp(p.ws, I_XP) + (size_t)row * DM : inp(p.ws, I_XS) + (size_t)(row - M_CTX) * DM) : X + (size_t)row * DM;
#pragma unroll
            for (int j = 0; j < 4; ++j) v[r][j] = *(const f32x4*)(xr + j * 256 + lane * 4);
        }
        const int cond = cond_of_row(row0);
        const float* sh = mod_ptr(p.ws, cond, l, which * 3 + 0); const float* sc = mod_ptr(p.ws, cond, l, which * 3 + 1);
        f32x4 s4[4], h4[4];
#pragma unroll
        for (int j = 0; j < 4; ++j) { s4[j] = *(const f32x4*)(sc + j * 256 + lane * 4) + 1.f; h4[j] = *(const f32x4*)(sh + j * 256 + lane * 4); }
#pragma unroll
        for (int r = 0; r < NR; ++r) { float a = 0.f;
#pragma unroll
            for (int j = 0; j < 4; ++j) a += (v[r][j][0] * v[r][j][0] + v[r][j][1] * v[r][j][1]) + (v[r][j][2] * v[r][j][2] + v[r][j][3] * v[r][j][3]);
            s[r] = a; }
        if (from_in) {
#pragma unroll
            for (int r = 0; r < NR; ++r)
#pragma unroll
                for (int j = 0; j < 4; ++j) *(f32x4*)(X + (size_t)(row0 + r) * DM + j * 256 + lane * 4) = v[r][j];
        }
#pragma unroll
        for (int o = 1; o < 64; o <<= 1) {
#pragma unroll
            for (int r = 0; r < NR; ++r) s[r] += __shfl_xor(s[r], o);
        }
#pragma unroll
        for (int r = 0; r < NR; ++r) {
            const float rstd = rsqrtf(s[r] * (1.f / DM) + EPSF);
#pragma unroll
            for (int j = 0; j < 4; ++j) {
                const f32x4 o = (v[r][j] * rstd) * gv[j] * s4[j] + h4[j];
                u32x2 w; w.x = cvt_pk_bf16(o[0], o[1]); w.y = cvt_pk_bf16(o[2], o[3]);
                *(u32x2*)(ACT + (size_t)(row0 + r) * DM + j * 256 + lane * 4) = w;
            }
        }
    }
}
__device__ __forceinline__ void final_norm_phase(const Ctx& p) {
    const int tid_ = opaque_tid(), lane = tid_ & 63, wave = tid_ >> 6, gw = blockIdx.x * 8 + wave, NGW = gridDim.x * 8;
    const float* X = (const float*)(p.ws + WS_X); const float* gsrc = inp(p.ws, I_FNORM);
    f32x4 gv[4];
#pragma unroll
    for (int j = 0; j < 4; ++j) gv[j] = *(const f32x4*)(gsrc + j * 256 + lane * 4);
    constexpr int NR = 4;
    for (int row0 = gw * NR; row0 < M_TOT; row0 += NGW * NR) {
        f32x4 v[NR][4]; float s[NR];
#pragma unroll
        for (int r = 0; r < NR; ++r) { const float* xr = X + (size_t)(row0 + r) * DM;
#pragma unroll
            for (int j = 0; j < 4; ++j) v[r][j] = *(const f32x4*)(xr + j * 256 + lane * 4); }
#pragma unroll
        for (int r = 0; r < NR; ++r) { float a = 0.f;
#pragma unroll
            for (int j = 0; j < 4; ++j) a += (v[r][j][0] * v[r][j][0] + v[r][j][1] * v[r][j][1]) + (v[r][j][2] * v[r][j][2] + v[r][j][3] * v[r][j][3]);
            s[r] = a; }
#pragma unroll
        for (int o = 1; o < 64; o <<= 1) {
#pragma unroll
            for (int r = 0; r < NR; ++r) s[r] += __shfl_xor(s[r], o);
        }
#pragma unroll
        for (int r = 0; r < NR; ++r) { const float rstd = rsqrtf(s[r] * (1.f / DM) + EPSF);
#pragma unroll
            for (int j = 0; j < 4; ++j) __builtin_nontemporal_store((v[r][j] * rstd) * gv[j], (f32x4*)(p.out + O_Y + (size_t)(row0 + r) * DM + j * 256 + lane * 4)); }
    }
}

__device__ __forceinline__ void mixprep_phase(const Ctx& p, LAS unsigned char* lds, int l) {
    const int tid = opaque_tid(), G = gridDim.x;
    bf16_t* PROJ = (bf16_t*)(p.ws + WS_PROJ); bf16_t* TR = (bf16_t*)(p.ws + WS_TR);
    {
        const int lane = tid & 63, wave = tid >> 6, gw = blockIdx.x * 8 + wave, NGW = G * 8;
        LAS float* T = (LAS float*)(lds + wave * 17168);
        const float* sw = inp(p.ws, I_HSW) + (size_t)l * 3 * 768; const float* sb = inp(p.ws, I_HSB) + (size_t)l * 768;
        const int lr = lane >> 3, lc = lane & 7;
        for (int it = gw; it < 320 * 22; it += NGW) {
            const int cb = it % 22, rb = it / 22, row0 = rb * 64, tcol0 = cb * 64;
            int src; bool hy = false;
            if (tcol0 < 256) src = 512 + tcol0; else if (tcol0 < 384) src = 1152 + (tcol0 - 256); else if (tcol0 < 640) src = 2560 + (tcol0 - 384); else { src = 1280 + (tcol0 - 640); hy = true; }
            const bool seq_start = row0 < M_CTX ? ((row0 & 255) == 0) : (((row0 - M_CTX) & 2047) == 0);
            const int rend = row0 + 64; const bool seq_end = rend <= M_CTX ? ((rend & 255) == 0) : (((rend - M_CTX) & 2047) == 0);
            const bf16_t* sp = PROJ + (size_t)row0 * PROJW + src + lc * 8;
            u32x4 w[8], wh = (u32x4){0u, 0u, 0u, 0u};
#pragma unroll
            for (int i = 0; i < 8; ++i) w[i] = *(const u32x4*)(sp + (size_t)(i * 8 + lr) * PROJW);
            if (hy && lane < 16) { const bool top = lane < 8; const bool ok = top ? !seq_start : !seq_end;
                if (ok) wh = *(const u32x4*)(sp + (top ? -(ptrdiff_t)PROJW : (ptrdiff_t)64 * PROJW)); }
#pragma unroll
            for (int i = 0; i < 8; ++i) { LAS float* d = T + (1 + i * 8 + lr) * 65 + lc * 8;
                d[0] = bflo(w[i].x); d[1] = bfhi(w[i].x); d[2] = bflo(w[i].y); d[3] = bfhi(w[i].y); d[4] = bflo(w[i].z); d[5] = bfhi(w[i].z); d[6] = bflo(w[i].w); d[7] = bfhi(w[i].w); }
            if (hy && lane < 16) { LAS float* d = T + (lane < 8 ? 0 : 65) * 65 + lc * 8;
                d[0] = bflo(wh.x); d[1] = bfhi(wh.x); d[2] = bflo(wh.y); d[3] = bfhi(wh.y); d[4] = bflo(wh.z); d[5] = bfhi(wh.z); d[6] = bflo(wh.w); d[7] = bfhi(wh.w); }
            asm volatile("s_waitcnt lgkmcnt(0)" ::: "memory");
            const int rg = lane & 7, csub = lane >> 3;
#pragma unroll 2
            for (int j = 0; j < 8; ++j) {
                const int col = j * 8 + csub; float o[8];
                const LAS float* tp = T + (rg * 8) * 65 + col;
                if (hy) { const int ch = tcol0 - 640 + col; const float w0 = sw[ch], w1 = sw[768 + ch], w2 = sw[1536 + ch], bb = sb[ch];
                    float x[10];
#pragma unroll
                    for (int k = 0; k < 10; ++k) x[k] = tp[k * 65];
#pragma unroll
                    for (int k = 0; k < 8; ++k) o[k] = x[k] * w0 + x[k + 1] * w1 + x[k + 2] * w2 + bb;
                } else {
#pragma unroll
                    for (int k = 0; k < 8; ++k) o[k] = tp[(k + 1) * 65];
                }
                u32x4 ww; ww.x = cvt_pk_bf16(o[0], o[1]); ww.y = cvt_pk_bf16(o[2], o[3]); ww.z = cvt_pk_bf16(o[4], o[5]); ww.w = cvt_pk_bf16(o[6], o[7]);
                *(u32x4*)(TR + (size_t)(tcol0 + col) * M_TOT + row0 + rg * 8) = ww;
            }
            asm volatile("s_waitcnt lgkmcnt(0)" ::: "memory");
        }
    }
    const int gt = blockIdx.x * 512 + tid, NT = G * 512;
    for (int it = gt; it < M_CTX * 160; it += NT) {
        const int row = it / 160, ch = it - row * 160; int pc, H; size_t ob; int c8;
        if (ch < 32) { pc = 256; H = 4; ob = O_NAK; c8 = ch * 8; }
        else if (ch < 64) { pc = 512; H = 4; ob = O_NAV; c8 = (ch - 32) * 8; }
        else if (ch < 80) { pc = 1024; H = 2; ob = O_SWK; c8 = (ch - 64) * 8; }
        else if (ch < 96) { pc = 1152; H = 2; ob = O_SWV; c8 = (ch - 80) * 8; }
        else if (ch < 128) { pc = 2304; H = 4; ob = O_DFK; c8 = (ch - 96) * 8; }
        else { pc = 2560; H = 4; ob = O_DFV; c8 = (ch - 128) * 8; }
        const u32x4 w = *(const u32x4*)(PROJ + (size_t)row * PROJW + pc + c8);
        const int b = row >> 8, t = row & 255, h = c8 >> 6, d = c8 & 63;
        float* o = p.out + ob + ((((size_t)(b * 4 + l) * H + h) * 256 + t) * 64 + d);
        __builtin_nontemporal_store((f32x4){bflo(w.x), bfhi(w.x), bflo(w.y), bfhi(w.y)}, (f32x4*)o); __builtin_nontemporal_store((f32x4){bflo(w.z), bfhi(w.z), bflo(w.w), bfhi(w.w)}, (f32x4*)(o + 4));
    }
    for (int it = gt; it < M_DEC * 56; it += NT) {
        const int rowd = it / 56, q = it - rowd * 56, t = rowd & 2047, gr = t >> 6, gc = t & 63;
        int a, bofs, i0; float pos, fstep;
        if (q < 24) {
            const int base = q < 16 ? 768 : 1024, qq = q < 16 ? q : q - 16, h = qq >> 2, half = (qq >> 1) & 1, grp = qq & 1;
            a = base + h * 64 + half * 32 + grp * 8; bofs = 16; i0 = grp * 8; pos = half ? (float)gc : (float)gr; fstep = 13.287712379549449f / 16.f;
        } else {
            const int base = q < 40 ? 2048 : 2304, qq = q < 40 ? q - 24 : q - 40, mp32 = qq >> 1, half = qq & 1;
            a = base + mp32 * 32 + half * 16; bofs = 8; i0 = 0; pos = half ? (float)gc : (float)gr; fstep = 13.287712379549449f / 8.f;
        }
        bf16_t* pa = PROJ + (size_t)(M_CTX + rowd) * PROJW + a;
        const u32x4 wa = *(const u32x4*)pa, wb = *(const u32x4*)(pa + bofs);
        float xa[8], xb[8];
        xa[0] = bflo(wa.x); xa[1] = bfhi(wa.x); xa[2] = bflo(wa.y); xa[3] = bfhi(wa.y); xa[4] = bflo(wa.z); xa[5] = bfhi(wa.z); xa[6] = bflo(wa.w); xa[7] = bfhi(wa.w);
        xb[0] = bflo(wb.x); xb[1] = bfhi(wb.x); xb[2] = bflo(wb.y); xb[3] = bfhi(wb.y); xb[4] = bflo(wb.z); xb[5] = bfhi(wb.z); xb[6] = bflo(wb.w); xb[7] = bfhi(wb.w);
        float oa[8], ob[8];
#pragma unroll
        for (int j = 0; j < 8; ++j) { const float ang = pos * fast_exp2(-(float)(i0 + j) * fstep); const float cs = __cosf(ang), sn = __sinf(ang);
            oa[j] = xa[j] * cs - xb[j] * sn; ob[j] = xb[j] * cs + xa[j] * sn; }
        u32x4 ra, rb;
        ra.x = cvt_pk_bf16(oa[0], oa[1]); ra.y = cvt_pk_bf16(oa[2], oa[3]); ra.z = cvt_pk_bf16(oa[4], oa[5]); ra.w = cvt_pk_bf16(oa[6], oa[7]);
        rb.x = cvt_pk_bf16(ob[0], ob[1]); rb.y = cvt_pk_bf16(ob[2], ob[3]); rb.z = cvt_pk_bf16(ob[4], ob[5]); rb.w = cvt_pk_bf16(ob[6], ob[7]);
        *(u32x4*)pa = ra; *(u32x4*)(pa + bofs) = rb;
    }
}

struct AttnState { float m, l; f32x4 o[4]; };
__device__ __forceinline__ f32x4 mfma16(bf16x8 a, bf16x8 b, f32x4 c) { return __builtin_amdgcn_mfma_f32_16x16x32_bf16(a, b, c, 0, 0, 0); }

__device__ __forceinline__ float xmax16(float x) { const u32x2 r = __builtin_amdgcn_permlane16_swap(__float_as_uint(x), __float_as_uint(x), false, false); return fmaxf(__uint_as_float(r.x), __uint_as_float(r.y)); }
__device__ __forceinline__ float xmax32(float x) { const u32x2 r = __builtin_amdgcn_permlane32_swap(__float_as_uint(x), __float_as_uint(x), false, false); return fmaxf(__uint_as_float(r.x), __uint_as_float(r.y)); }
__device__ __forceinline__ float xadd16(float x) { const u32x2 r = __builtin_amdgcn_permlane16_swap(__float_as_uint(x), __float_as_uint(x), false, false); return __uint_as_float(r.x) + __uint_as_float(r.y); }
__device__ __forceinline__ float xadd32(float x) { const u32x2 r = __builtin_amdgcn_permlane32_swap(__float_as_uint(x), __float_as_uint(x), false, false); return __uint_as_float(r.x) + __uint_as_float(r.y); }
__device__ __forceinline__ void softmax_d16(AttnState& st, float (&s)[16], bool first, float& alpha, bool& resc, bf16x8& p0, bf16x8& p1) {
    float mx = fmaxf(fmaxf(fmaxf(s[0], s[1]), fmaxf(s[2], s[3])), fmaxf(fmaxf(s[4], s[5]), fmaxf(s[6], s[7])));
    mx = fmaxf(mx, fmaxf(fmaxf(fmaxf(s[8], s[9]), fmaxf(s[10], s[11])), fmaxf(fmaxf(s[12], s[13]), fmaxf(s[14], s[15]))));
    resc = first || (__builtin_amdgcn_ballot_w64(mx > 8.f) != 0ull);
    alpha = 1.f;
    if (resc) {
        mx = xmax16(mx); mx = xmax32(mx);
        const float d = first ? mx : fmaxf(mx, 0.f);
        alpha = first ? 0.f : fast_exp2(-d);
        st.m = first ? mx : st.m + d;
#pragma unroll
        for (int j = 0; j < 16; ++j) s[j] -= d;
    }
    float pr[16];
#pragma unroll
    for (int j = 0; j < 16; ++j) pr[j] = fast_exp2(s[j]);
    float sum = (((pr[0] + pr[1]) + (pr[2] + pr[3])) + ((pr[4] + pr[5]) + (pr[6] + pr[7]))) + (((pr[8] + pr[9]) + (pr[10] + pr[11])) + ((pr[12] + pr[13]) + (pr[14] + pr[15])));
    sum = xadd16(sum); sum = xadd32(sum);
    st.l = st.l * alpha + sum;
    u32x4 w0, w1;
    w0.x = cvt_pk_bf16(pr[0], pr[1]); w0.y = cvt_pk_bf16(pr[2], pr[3]); w0.z = cvt_pk_bf16(pr[4], pr[5]); w0.w = cvt_pk_bf16(pr[6], pr[7]);
    w1.x = cvt_pk_bf16(pr[8], pr[9]); w1.y = cvt_pk_bf16(pr[10], pr[11]); w1.z = cvt_pk_bf16(pr[12], pr[13]); w1.w = cvt_pk_bf16(pr[14], pr[15]);
    p0 = __builtin_bit_cast(bf16x8, w0); p1 = __builtin_bit_cast(bf16x8, w1);
}
__device__ __forceinline__ bf16x8 softmax_p(AttnState& st, const float (&s2)[8], unsigned vm, float& alpha) {
    float mx = -1e30f;
#pragma unroll
    for (int j = 0; j < 8; ++j) mx = fmaxf(mx, ((vm >> j) & 1u) ? s2[j] : -1e30f);
    mx = xmax16(mx); mx = xmax32(mx);
    const float mn = fmaxf(st.m, mx); alpha = fast_exp2(st.m - mn);
    float pr[8]; float sum = 0.f;
#pragma unroll
    for (int j = 0; j < 8; ++j) { pr[j] = ((vm >> j) & 1u) ? fast_exp2(s2[j] - mn) : 0.f; sum += pr[j]; }
    sum += __shfl_xor(sum, 16); sum += __shfl_xor(sum, 32);
    st.l = st.l * alpha + sum; st.m = mn;
    u32x4 pw; pw.x = cvt_pk_bf16(pr[0], pr[1]); pw.y = cvt_pk_bf16(pr[2], pr[3]); pw.z = cvt_pk_bf16(pr[4], pr[5]); pw.w = cvt_pk_bf16(pr[6], pr[7]);
    return __builtin_bit_cast(bf16x8, pw);
}
__device__ __forceinline__ bf16x8 softmax_d(AttnState& st, const float (&s2)[8], float& alpha, bool& resc) {
    float mx = fmaxf(fmaxf(fmaxf(s2[0], s2[1]), fmaxf(s2[2], s2[3])), fmaxf(fmaxf(s2[4], s2[5]), fmaxf(s2[6], s2[7])));
    mx = fmaxf(mx, __shfl_xor(mx, 16)); mx = fmaxf(mx, __shfl_xor(mx, 32));
    const float mn = fmaxf(st.m, mx);
    resc = __builtin_amdgcn_ballot_w64(mn > st.m) != 0ull;
    alpha = fast_exp2(st.m - mn);
    float pr[8];
#pragma unroll
    for (int j = 0; j < 8; ++j) pr[j] = fast_exp2(s2[j] - mn);
    float sum = ((pr[0] + pr[1]) + (pr[2] + pr[3])) + ((pr[4] + pr[5]) + (pr[6] + pr[7]));
    sum = xadd16(sum); sum = xadd32(sum);
    st.l = st.l * alpha + sum; st.m = mn;
    u32x4 pw; pw.x = cvt_pk_bf16(pr[0], pr[1]); pw.y = cvt_pk_bf16(pr[2], pr[3]); pw.z = cvt_pk_bf16(pr[4], pr[5]); pw.w = cvt_pk_bf16(pr[6], pr[7]);
    return __builtin_bit_cast(bf16x8, pw);
}
__device__ __forceinline__ void st_init(AttnState& st, float m0, float l0) { st.m = m0; st.l = l0;
#pragma unroll
    for (int i = 0; i < 4; ++i) st.o[i] = (f32x4){0.f, 0.f, 0.f, 0.f}; }

constexpr int AT_ROWB = 144;
constexpr int AT_TILEB = 64 * AT_ROWB;
struct ATC { int l15, quad, kr0, lat0, nlat, rs_w, r_w; int cg4[2], qc[2], c0[2], qt[2], q0[2]; bool dec; const float* rpb; };

template <int TYPE>
__device__ __forceinline__ void attn_tile(AttnState (&sa)[2], AttnState (&sb)[2], const bf16x8 (&qf)[2][2], const ATC& c, const LAS unsigned char* kt, const LAS unsigned char* vt, int i) {
    const bool masked = c.dec && (i < c.nlat) && (TYPE != 2);
    if (TYPE == 0 && masked) { const int krow = c.lat0 + i; if (!((krow >= c.rs_w) && (krow < c.rs_w + 8))) return; }
    const f32x4 z4 = (f32x4){0.f, 0.f, 0.f, 0.f};
    if (!masked) {
        bf16x8 pA[2][2], pB[2][2]; float alA[2], alB[2]; bool rA[2], rB[2];
        const bool first = (TYPE != 1) && (i == 0);
        if (TYPE == 2) {
#pragma unroll
            for (int qi = 0; qi < 2; ++qi)
#pragma unroll
                for (int mp = 0; mp < 2; ++mp) {
                    float s2[16];
#pragma unroll
                    for (int ss = 0; ss < 2; ++ss)
#pragma unroll
                        for (int t = 0; t < 2; ++t) { const int kr = ss * 32 + c.kr0 + 4 * t, sw = ((kr >> 4) & 1) << 2;
                            const bf16x8 kf = *(const LAS bf16x8*)(kt + kr * AT_ROWB + (((mp * 4 + c.quad) ^ sw) << 4));
                            const float nm = first ? 0.f : -(mp == 0 ? sa[qi].m : sb[qi].m);
                            const f32x4 a = mfma16(kf, qf[qi][mp], (f32x4){nm, nm, nm, nm});
#pragma unroll
                            for (int e = 0; e < 4; ++e) s2[ss * 8 + t * 4 + e] = a[e]; }
                    if (mp == 0) softmax_d16(sa[qi], s2, first, alA[qi], rA[qi], pA[qi][0], pA[qi][1]); else softmax_d16(sb[qi], s2, first, alB[qi], rB[qi], pB[qi][0], pB[qi][1]);
                    asm volatile("" ::: "memory");
                }
        } else {
            bf16x8 kf[2][2][2];
#pragma unroll
            for (int ss = 0; ss < 2; ++ss)
#pragma unroll
                for (int t = 0; t < 2; ++t) { const int kr = ss * 32 + c.kr0 + 4 * t, sw = ((kr >> 4) & 1) << 2;
#pragma unroll
                    for (int cc = 0; cc < 2; ++cc) kf[ss][t][cc] = *(const LAS bf16x8*)(kt + kr * AT_ROWB + (((cc * 4 + c.quad) ^ sw) << 4)); }
#pragma unroll
            for (int qi = 0; qi < 2; ++qi) {
                float s2[16];
#pragma unroll
                for (int ss = 0; ss < 2; ++ss)
#pragma unroll
                    for (int t = 0; t < 2; ++t) { const float nm = first ? 0.f : -sa[qi].m; f32x4 a = mfma16(kf[ss][t][0], qf[qi][0], (f32x4){nm, nm, nm, nm}); a = mfma16(kf[ss][t][1], qf[qi][1], a);
#pragma unroll
                        for (int e = 0; e < 4; ++e) s2[ss * 8 + t * 4 + e] = a[e]; }
                softmax_d16(sa[qi], s2, first, alA[qi], rA[qi], pA[qi][0], pA[qi][1]);
            }
        }
#pragma unroll
        for (int qi = 0; qi < 2; ++qi) {
            if (rA[qi]) {
#pragma unroll
                for (int nt = 0; nt < 4; ++nt) sa[qi].o[nt] = sa[qi].o[nt] * alA[qi]; }
            if (TYPE == 2) { if (rB[qi]) {
#pragma unroll
                for (int nt = 0; nt < 4; ++nt) sb[qi].o[nt] = sb[qi].o[nt] * alB[qi]; } }
        }
#pragma unroll
        for (int ss = 0; ss < 2; ++ss) {
            bf16x8 vf[4];
#pragma unroll
            for (int nt = 0; nt < 4; ++nt) vf[nt] = *(const LAS bf16x8*)(vt + (nt * 16 + c.l15) * AT_ROWB + ss * 64 + (c.quad << 4));
#pragma unroll
            for (int qi = 0; qi < 2; ++qi)
#pragma unroll
                for (int nt = 0; nt < 4; ++nt) { sa[qi].o[nt] = mfma16(vf[nt], pA[qi][ss], sa[qi].o[nt]); if (TYPE == 2) sb[qi].o[nt] = mfma16(vf[nt], pB[qi][ss], sb[qi].o[nt]); }
        }
        return;
    }
#pragma unroll 1
    for (int ss = 0; ss < 2; ++ss) {
        bool on[2];
#pragma unroll
        for (int qi = 0; qi < 2; ++qi) {
            on[qi] = true;
            if (TYPE == 0) on[qi] = !((c.cg4[qi] == 0 && ss == 1) || (c.cg4[qi] == 3 && ss == 0));
            if (TYPE == 1) { const int k0 = (c.lat0 + i) * 64 + ss * 32; on[qi] = (k0 + 31 >= c.q0[qi] - 128) && (k0 <= c.q0[qi] + 15 + 128); }
        }
        if (on[0] || on[1]) {
            const int krA = ss * 32 + c.kr0, krB = krA + 4;
            const int swA = ((krA >> 4) & 1) << 2, swB = ((krB >> 4) & 1) << 2;
            bf16x8 kf[2][2];
#pragma unroll
            for (int cc = 0; cc < 2; ++cc) { kf[0][cc] = *(const LAS bf16x8*)(kt + krA * AT_ROWB + (((cc * 4 + c.quad) ^ swA) << 4)); kf[1][cc] = *(const LAS bf16x8*)(kt + krB * AT_ROWB + (((cc * 4 + c.quad) ^ swB) << 4)); }
            bf16x8 vf[4];
#pragma unroll
            for (int nt = 0; nt < 4; ++nt) vf[nt] = *(const LAS bf16x8*)(vt + (nt * 16 + c.l15) * AT_ROWB + ss * 64 + (c.quad << 4));
#pragma unroll
            for (int qi = 0; qi < 2; ++qi) {
                if (on[qi]) {
                    f32x4 a0 = mfma16(kf[0][0], qf[qi][0], z4), a1 = mfma16(kf[1][0], qf[qi][0], z4); a0 = mfma16(kf[0][1], qf[qi][1], a0); a1 = mfma16(kf[1][1], qf[qi][1], a1);
                    float s2[8]; unsigned vm = 0u;
#pragma unroll
                    for (int e = 0; e < 4; ++e) { s2[e] = a0[e]; s2[4 + e] = a1[e]; }
                    if (TYPE == 0) {
                        const float* rp = c.rpb + (c.lat0 + i - c.r_w + 7) * 31;
#pragma unroll
                        for (int j = 0; j < 8; ++j) { const int kc = ss * 32 + c.quad * 8 + j; const bool ok = (kc >= c.c0[qi]) && (kc < c.c0[qi] + 16);
                            const int dc = min(max(kc - c.qc[qi] + 15, 0), 30); s2[j] = s2[j] + rp[dc] * LOG2E; vm |= ok ? (1u << j) : 0u; }
                    } else {
#pragma unroll
                        for (int j = 0; j < 8; ++j) { const int dd = (c.lat0 + i) * 64 + ss * 32 + c.quad * 8 + j - c.qt[qi]; const bool ok = (dd <= 128) && (dd >= -128); vm |= ok ? (1u << j) : 0u; }
                    }
                    float al; const bf16x8 pA = softmax_p(sa[qi], s2, vm, al);
#pragma unroll
                    for (int nt = 0; nt < 4; ++nt) sa[qi].o[nt] = mfma16(vf[nt], pA, sa[qi].o[nt] * al);
                }
            }
        }
    }
}

template <int TYPE>
__device__ __forceinline__ void attn_block(const Ctx& p, LAS unsigned char* lds, int l, bool dec, int b, int h, int qblk) {
    const int tid = opaque_tid(), lane = tid & 63, wave = __builtin_amdgcn_readfirstlane(tid >> 6);
    ATC c; c.l15 = lane & 15; c.quad = lane >> 4; c.dec = dec;
    const bf16_t* PROJ = (const bf16_t*)(p.ws + WS_PROJ); const bf16_t* TR = (const bf16_t*)(p.ws + WS_TR);
    const bf16_t* CK = (const bf16_t*)(p.ws + WS_CK); const bf16_t* CV = CK + CK_HALF;
    bf16_t* BR = (bf16_t*)(p.ws + WS_BR);
    const int L = dec ? 2048 : 256, rowbase = dec ? M_CTX + b * 2048 : b * 256, q0 = qblk * 256 + wave * 32;
    const bf16_t* Pb = PROJ + (size_t)rowbase * PROJW;
    LAS unsigned char* KL = lds; LAS unsigned char* VL = lds + 2 * AT_TILEB;
    int qcol, kcol, vcol, hk, Hc; size_t ckoff;
    if (TYPE == 0) { qcol = h * 64; kcol = 256 + h * 64; vcol = h * 64; hk = h; Hc = 4; ckoff = CK_NA; }
    else if (TYPE == 1) { qcol = 768 + h * 64; kcol = 1024 + (h >> 1) * 64; vcol = 256 + (h >> 1) * 64; hk = h >> 1; Hc = 2; ckoff = CK_SW; }
    else { qcol = 2048 + h * 64; kcol = 2304 + h * 64; vcol = 384 + h * 64; hk = h; Hc = 4; ckoff = CK_DF; }
    const int ncache = dec ? 8 : 0;
    c.rs_w = 0; c.r_w = 0;
    int cgb = 0;
    if (!dec) { c.lat0 = 0; c.nlat = 4; }
    else if (TYPE == 0) { const int r0 = qblk * 4; const int rsA = min(max(r0 - 4, 0), 24), rsB = min(max(r0 - 1, 0), 24); c.lat0 = rsA; c.nlat = rsB + 8 - rsA;
        c.r_w = r0 + (wave >> 1); c.rs_w = min(max(c.r_w - 4, 0), 24); cgb = (wave & 1) * 2; }
    else if (TYPE == 1) { const int q0b = qblk * 256; c.lat0 = max(q0b - 128, 0) >> 6; c.nlat = (min(q0b + 384, L) >> 6) - c.lat0; }
    else { c.lat0 = 0; c.nlat = 32; }
#pragma unroll
    for (int qi = 0; qi < 2; ++qi) { c.cg4[qi] = cgb + qi; c.q0[qi] = q0 + 16 * qi; c.qt[qi] = q0 + 16 * qi + c.l15; c.qc[qi] = c.cg4[qi] * 16 + c.l15; c.c0[qi] = min(max(c.qc[qi] - 8, 0), 48); }
    const int ntile = c.nlat + ncache;
    const int srow = tid >> 3, sch = tid & 7;
    const int kst_off = srow * AT_ROWB + ((sch ^ (((srow >> 4) & 1) << 2)) << 4), vst_off = srow * AT_ROWB + (sch << 4);
    const bf16_t* klat = Pb + kcol + (size_t)(c.lat0 * 64 + srow) * PROJW + sch * 8;
    const bf16_t* vlat = TR + (size_t)(vcol + srow) * M_TOT + rowbase + c.lat0 * 64 + sch * 8;
    const bf16_t* kcac = CK + ckoff + ((size_t)(b * Hc + hk) * 512 + srow) * 64 + sch * 8;
    const bf16_t* vcac = CV + ckoff + ((size_t)(b * Hc + hk) * 64 + srow) * 512 + sch * 8;
    c.kr0 = (c.l15 >> 2) * 8 + (c.l15 & 3);
    bf16x8 qf[2][2];
    AttnState sa[2], sb[2];
    float sc2, m0, l0;
    if (TYPE == 1) { m0 = inp(p.ws, I_SINK)[l * 4 + h] * LOG2E; l0 = 1.f; sc2 = 0.125f * LOG2E; }
    else if (TYPE == 0) { m0 = -1e30f; l0 = 0.f; sc2 = 0.125f * LOG2E; }
    else { m0 = -1e30f; l0 = 0.f; sc2 = 0.17677669529663687f * LOG2E; }
#pragma unroll
    for (int qi = 0; qi < 2; ++qi) {
        st_init(sa[qi], m0, l0); st_init(sb[qi], -1e30f, 0.f);
        const size_t qrow = (size_t)(q0 + 16 * qi + c.l15) * PROJW;
        const u32x4 q0w = *(const u32x4*)(Pb + qrow + qcol + c.quad * 8), q1w = *(const u32x4*)(Pb + qrow + qcol + 32 + c.quad * 8);
        u32x4 a, bq;
        a.x = cvt_pk_bf16(bflo(q0w.x) * sc2, bfhi(q0w.x) * sc2); a.y = cvt_pk_bf16(bflo(q0w.y) * sc2, bfhi(q0w.y) * sc2); a.z = cvt_pk_bf16(bflo(q0w.z) * sc2, bfhi(q0w.z) * sc2); a.w = cvt_pk_bf16(bflo(q0w.w) * sc2, bfhi(q0w.w) * sc2);
        bq.x = cvt_pk_bf16(bflo(q1w.x) * sc2, bfhi(q1w.x) * sc2); bq.y = cvt_pk_bf16(bflo(q1w.y) * sc2, bfhi(q1w.y) * sc2); bq.z = cvt_pk_bf16(bflo(q1w.z) * sc2, bfhi(q1w.z) * sc2); bq.w = cvt_pk_bf16(bflo(q1w.w) * sc2, bfhi(q1w.w) * sc2);
        qf[qi][0] = __builtin_bit_cast(bf16x8, a); qf[qi][1] = __builtin_bit_cast(bf16x8, bq);
    }
    c.rpb = inp(p.ws, I_RPB) + ((size_t)(l * 4 + h)) * 15 * 31;
#define AT_KSRC(n) (((n) < c.nlat) ? klat + (size_t)(n) * 64 * PROJW : kcac + (size_t)((n) - c.nlat) * 4096)
#define AT_VSRC(n) (((n) < c.nlat) ? vlat + (n) * 64 : vcac + ((n) - c.nlat) * 64)
    u32x4 kA, vA, kB, vB;
    kA = *(const u32x4*)AT_KSRC(0); vA = *(const u32x4*)AT_VSRC(0);
    { const int n1 = min(1, ntile - 1); kB = *(const u32x4*)AT_KSRC(n1); vB = *(const u32x4*)AT_VSRC(n1); }
    *(LAS u32x4*)(KL + kst_off) = kA; *(LAS u32x4*)(VL + vst_off) = vA;
    __syncthreads();
#pragma unroll 1
    for (int i = 0; i < ntile; i += 2) {
        { const int n2 = min(i + 2, ntile - 1); kA = *(const u32x4*)AT_KSRC(n2); vA = *(const u32x4*)AT_VSRC(n2); }
        attn_tile<TYPE>(sa, sb, qf, c, KL, VL, i);
        *(LAS u32x4*)(KL + AT_TILEB + kst_off) = kB; *(LAS u32x4*)(VL + AT_TILEB + vst_off) = vB;
        __syncthreads();
        if (i + 1 >= ntile) break;
        { const int n3 = min(i + 3, ntile - 1); kB = *(const u32x4*)AT_KSRC(n3); vB = *(const u32x4*)AT_VSRC(n3); }
        attn_tile<TYPE>(sa, sb, qf, c, KL + AT_TILEB, VL + AT_TILEB, i + 1);
        *(LAS u32x4*)(KL + kst_off) = kA; *(LAS u32x4*)(VL + vst_off) = vA;
        __syncthreads();
    }
#undef AT_KSRC
#undef AT_VSRC
#pragma unroll
    for (int qi = 0; qi < 2; ++qi) {
        const size_t orow = (size_t)(rowbase + q0 + 16 * qi + c.l15) * 256 + h * 64 + c.quad * 4;
        if (TYPE != 2) {
            const float il = fast_rcp(sa[qi].l);
            bf16_t* o = BR + (TYPE == 1 ? (size_t)M_TOT * 256 : 0) + orow;
#pragma unroll
            for (int nt = 0; nt < 4; ++nt) { u32x2 w; w.x = cvt_pk_bf16(sa[qi].o[nt][0] * il, sa[qi].o[nt][1] * il); w.y = cvt_pk_bf16(sa[qi].o[nt][2] * il, sa[qi].o[nt][3] * il); *(u32x2*)(o + nt * 16) = w; }
        } else {
            const float lam = ((const float*)(p.ws + WS_LAM))[l], lam_init = ((const float*)(p.ws + WS_LAM))[4 + l];
            const float i0 = fast_rcp(sa[qi].l), i1 = lam * fast_rcp(sb[qi].l);
            f32x4 d[4]; float ss = 0.f;
#pragma unroll
            for (int i = 0; i < 4; ++i) { d[i] = sa[qi].o[i] * i0 - sb[qi].o[i] * i1; ss += (d[i][0] * d[i][0] + d[i][1] * d[i][1]) + (d[i][2] * d[i][2] + d[i][3] * d[i][3]); }
            ss = xadd16(ss); ss = xadd32(ss);
            const float rs = rsqrtf(ss * (1.f / 64.f) + EPSF) * (1.f - lam_init);
            const float* sg = inp(p.ws, I_DSUB) + l * 64 + c.quad * 4;
            bf16_t* o = BR + (size_t)3 * M_TOT * 256 + orow;
#pragma unroll
            for (int nt = 0; nt < 4; ++nt) { const f32x4 g4 = *(const f32x4*)(sg + nt * 16); const f32x4 v = d[nt] * rs * g4;
                u32x2 w; w.x = cvt_pk_bf16(v[0], v[1]); w.y = cvt_pk_bf16(v[2], v[3]); *(u32x2*)(o + nt * 16) = w; }
        }
    }
}

__device__ __forceinline__ void hyena_unit(const Ctx& p, LAS unsigned char* lds, int l, int c, bool dec) {
    const int tid = opaque_tid(), lane = tid & 63, wave = __builtin_amdgcn_readfirstlane(tid >> 6), l15 = lane & 15, quad = lane >> 4;
    const int L = dec ? 2048 : 256, B = dec ? 8 : 16, LP = L + 8, rowbase = dec ? M_CTX : 0, L2 = 2 * L, CS = L2 + 16;
    LAS bf16_t* COP = (LAS bf16_t*)lds;
    LAS bf16_t* YA = (LAS bf16_t*)(lds + 66048);
    LAS bf16_t* YB = (LAS bf16_t*)(lds + 66048 + 33024);
    LAS float* RED = (LAS float*)(lds + 66048 + 2 * 33024);
    const bf16_t* TR = (const bf16_t*)(p.ws + WS_TR);
    bf16_t* BR2 = (bf16_t*)(p.ws + WS_BR) + (size_t)2 * M_TOT * 256;
    const float* HF = (const float*)(p.ws + WS_HFIL) + (dec ? 262144 : 0);
    { const bf16_t* src = TR + (size_t)(640 + c) * M_TOT + rowbase;
      for (int i = tid; i < B * L / 8; i += 512) { const int e = i * 8, b = e / L, t = e - b * L; *(LAS u32x4*)(YA + b * LP + t) = *(const u32x4*)(src + e); } }
#pragma unroll 1
    for (int o = 0; o < 2; ++o) {
        LAS float* RF = (LAS float*)(o == 0 ? YB : YA);
        __syncthreads();
        const float* raw0 = HF + ((size_t)((o * 2 + 0) * 256 + c)) * L; const float* raw1 = HF + ((size_t)((o * 2 + 1) * 256 + c)) * L;
        float part = 0.f;
        for (int u = tid; u < L2; u += 512) { const int lag = L - 1 - u; float v = 0.f; if (lag >= 0) v = raw0[lag]; else if (lag > -L) v = raw1[-lag]; RF[u] = v; part += fabsf(v); }
        part = wave_sum(part);
        if (lane == 0) RED[wave] = part;
        __syncthreads();
        float tot = 0.f;
#pragma unroll
        for (int w = 0; w < 8; ++w) tot += RED[w];
        const float inv = 1.f / (tot + EPSF);
        const int ng = L2 / 8;
        for (int idx = tid; idx < 8 * ng; idx += 512) { const int m = idx / ng, x = (idx - m * ng) * 8; float v[8];
#pragma unroll
            for (int j = 0; j < 8; ++j) { const int u = x + m + j; v[j] = (u < L2) ? RF[u] * inv : 0.f; }
            u32x4 w; w.x = cvt_pk_bf16(v[0], v[1]); w.y = cvt_pk_bf16(v[2], v[3]); w.z = cvt_pk_bf16(v[4], v[5]); w.w = cvt_pk_bf16(v[6], v[7]);
            *(LAS u32x4*)(COP + m * CS + x) = w; }
        __syncthreads();
        const LAS bf16_t* Y = (o == 0) ? YA : YB;
        const LAS bf16_t* cpb = COP + (7 - (l15 & 7)) * CS + (L - 8 - 8 * (l15 >> 3) + quad * 8);
        const float skip = inp(p.ws, I_HSKIP)[(l * 2 + o) * 256 + c];
        const bf16_t* gate = TR + (size_t)((o == 0 ? 896 : 1152) + c) * M_TOT + rowbase;
        const int ngroups = L / 64;
        const bf16x8 zero8 = (bf16x8){0, 0, 0, 0, 0, 0, 0, 0};
        for (int g = wave; g < ngroups; g += 8) {
            const int t0 = (g >> 1) * 128 + (g & 1) * 16;
            f32x4 a0 = (f32x4){0.f, 0.f, 0.f, 0.f}, a1 = a0, a2 = a0, a3 = a0;
#define HY_D(s) (*(const LAS bf16x8*)(cpb + (32 * (s) - t0)))
#define HY_Y(s) ((l15 < B) ? *(const LAS bf16x8*)(Y + l15 * LP + 32 * (s) + quad * 8) : zero8)
            bf16x8 d0, d1 = HY_D(-1), d2 = HY_D(-2), d3 = HY_D(-3), y;
            for (int s = 0; s < L / 32; s += 4) {
                d0 = HY_D(s);     y = HY_Y(s);     a0 = mfma16(d0, y, a0); a1 = mfma16(d1, y, a1); a2 = mfma16(d2, y, a2); a3 = mfma16(d3, y, a3);
                d3 = HY_D(s + 1); y = HY_Y(s + 1); a0 = mfma16(d3, y, a0); a1 = mfma16(d0, y, a1); a2 = mfma16(d1, y, a2); a3 = mfma16(d2, y, a3);
                d2 = HY_D(s + 2); y = HY_Y(s + 2); a0 = mfma16(d2, y, a0); a1 = mfma16(d3, y, a1); a2 = mfma16(d0, y, a2); a3 = mfma16(d1, y, a3);
                d1 = HY_D(s + 3); y = HY_Y(s + 3); a0 = mfma16(d1, y, a0); a1 = mfma16(d2, y, a1); a2 = mfma16(d3, y, a2); a3 = mfma16(d0, y, a3);
            }
#undef HY_D
#undef HY_Y
            if (l15 < B) {
#pragma unroll
                for (int a = 0; a < 4; ++a) {
                    const f32x4 cv = a == 0 ? a0 : (a == 1 ? a1 : (a == 2 ? a2 : a3));
                    const int t = t0 + 32 * a + quad * 4;
                    const u32x2 gw = *(const u32x2*)(gate + (size_t)l15 * L + t);
                    const u32x2 yw = *(const LAS u32x2*)(Y + l15 * LP + t);
                    f32x4 r;
                    r[0] = bflo(gw.x) * (cv[0] + skip * bflo(yw.x)); r[1] = bfhi(gw.x) * (cv[1] + skip * bfhi(yw.x));
                    r[2] = bflo(gw.y) * (cv[2] + skip * bflo(yw.y)); r[3] = bfhi(gw.y) * (cv[3] + skip * bfhi(yw.y));
                    if (o == 0) { u32x2 w; w.x = cvt_pk_bf16(r[0], r[1]); w.y = cvt_pk_bf16(r[2], r[3]); *(LAS u32x2*)(YB + l15 * LP + t) = w; }
                    else { bf16_t* op = BR2 + (size_t)(rowbase + l15 * L + t) * 256 + c;
                        op[0] = f2bf1(r[0]); op[256] = f2bf1(r[1]); op[512] = f2bf1(r[2]); op[768] = f2bf1(r[3]); }
                }
            }
        }
    }
    __syncthreads();
}

__device__ __forceinline__ void mix_phase(const Ctx& p, LAS unsigned char* lds, int l) {
    const int G = gridDim.x;
    for (int u = blockIdx.x; u < 512; u += G) hyena_unit(p, lds, l, u & 255, u < 256);
#ifdef PROBE_HY2
    for (int u = blockIdx.x; u < 512; u += G) hyena_unit(p, lds, l, u & 255, u < 256);
#endif
    const int vcu = (G % 8 == 0) ? ((int)blockIdx.x % 8) * (G / 8) + (int)blockIdx.x / 8 : (int)blockIdx.x;
#pragma unroll 1
    for (int it = vcu; it < 960; it += G) {
        if (it < 768) { const int k = it >> 8, r = it & 255, qblk = r & 7, bh = r >> 3;
            if (k == 0) attn_block<2>(p, lds, l, true, bh >> 2, bh & 3, qblk); else if (k == 1) attn_block<1>(p, lds, l, true, bh >> 2, bh & 3, qblk); else attn_block<0>(p, lds, l, true, bh >> 2, bh & 3, qblk); }
        else { const int q = it - 768, k = q >> 6, bh = q & 63;
            if (k == 0) attn_block<2>(p, lds, l, false, bh >> 2, bh & 3, 0); else if (k == 1) attn_block<1>(p, lds, l, false, bh >> 2, bh & 3, 0); else attn_block<0>(p, lds, l, false, bh >> 2, bh & 3, 0); }
    }
}

#define XB_TMO      128
#define XB_XCNT(j)  (256  + 64 * (j))
#define XB_XSUB(j)  (1280 + 64 * (j))
#define XB_XGEN(j)  (2304 + 64 * (j))
#define XB_TOP      3328
#define XB_TOPGEN   3392
#define XB_SPIN_CAP (1u << 22)
__device__ __forceinline__ unsigned xb_ld(unsigned* p)              { return __hip_atomic_load(p, __ATOMIC_RELAXED, __HIP_MEMORY_SCOPE_AGENT); }
__device__ __forceinline__ unsigned xb_add(unsigned* p, unsigned v) { return __hip_atomic_fetch_add(p, v, __ATOMIC_RELAXED, __HIP_MEMORY_SCOPE_AGENT); }
__device__ __forceinline__ unsigned xb_xcc_id() { return (unsigned)__builtin_amdgcn_s_getreg((3 << 11) | 20) & 0xFu; }
#define XB_SPIN(cond, bar) do { unsigned _sp = 0; while (cond) { __builtin_amdgcn_s_sleep(1); \
    if ((++_sp & 255u) == 0u) { if (xb_ld(&(bar)[XB_TMO])) break; if (_sp > XB_SPIN_CAP) { atomicAdd(&(bar)[XB_TMO], 1u); break; } } } } while (0)
struct XcdBarrier { unsigned* bar; unsigned x; volatile LAS unsigned* st; };
__device__ __forceinline__ XcdBarrier xcd_barrier_post(unsigned* bar, volatile LAS unsigned* st) {
    XcdBarrier b; b.bar = bar; b.x = xb_xcc_id(); b.st = st;
    if (threadIdx.x == 0) (void)xb_add(&bar[XB_XCNT(b.x)], 1u);
    return b;
}
__device__ __forceinline__ void xcd_barrier_complete(unsigned* bar, unsigned x, unsigned& nloc, unsigned& nx) {
    const unsigned G = gridDim.x * gridDim.y * gridDim.z;
    unsigned sum, cnt, mine, sp = 0u;
    for (;;) {
        sum = 0u; cnt = 0u; mine = 0u;
#pragma unroll
        for (unsigned j = 0; j < 16; ++j) { const unsigned c = xb_ld(&bar[XB_XCNT(j)]); sum += c; cnt += (c > 0u) ? 1u : 0u; mine = (j == x) ? c : mine; }
        if (sum == G) break;
        __builtin_amdgcn_s_sleep(1);
        if ((++sp & 255u) == 0u) { if (xb_ld(&bar[XB_TMO])) break; if (sp > XB_SPIN_CAP) { atomicAdd(&bar[XB_TMO], 1u); break; } }
    }
    nloc = mine > 0u ? mine : 1u; nx = cnt > 0u ? cnt : 1u;
}
__device__ __forceinline__ void xcd_barrier(const XcdBarrier& b) {
    asm volatile("s_waitcnt vmcnt(0)" ::: "memory");
    __syncthreads();
    if (threadIdx.x == 0) {
        unsigned* bar = b.bar;
        __builtin_amdgcn_s_waitcnt(0);
        unsigned nloc = b.st[0], nx = b.st[1];
        if (nloc == 0u) { xcd_barrier_complete(bar, b.x, nloc, nx); b.st[0] = nloc; b.st[1] = nx; }
        const unsigned old = xb_add(&bar[XB_XSUB(b.x)], 1u);
        const unsigned gen = old / nloc;
        if (old + 1u == (gen + 1u) * nloc) {
            __builtin_amdgcn_fence(__ATOMIC_RELEASE, "agent");
            asm volatile("s_waitcnt vmcnt(0)" ::: "memory");
            const unsigned og = xb_add(&bar[XB_TOP], 1u);
            const unsigned tg = og / nx;
            if (og + 1u == (tg + 1u) * nx) xb_add(&bar[XB_TOPGEN], 1u);
            else XB_SPIN(xb_ld(&bar[XB_TOPGEN]) == tg, bar);
            __builtin_amdgcn_fence(__ATOMIC_ACQUIRE, "agent");
            xb_add(&bar[XB_XGEN(b.x)], 1u);
            asm volatile("s_waitcnt vmcnt(0)" ::: "memory");
        } else {
            XB_SPIN(xb_ld(&bar[XB_XGEN(b.x)]) == gen, bar);
            __builtin_amdgcn_fence(__ATOMIC_ACQUIRE, "agent");
            asm volatile("s_waitcnt vmcnt(0)" ::: "memory");
        }
    }
    __syncthreads();
}

__global__ void __launch_bounds__(512, 2) mega(Params P) {
    extern __shared__ __attribute__((aligned(16))) unsigned char lds_raw[];
    LAS unsigned char* lds = (LAS unsigned char*)lds_raw;
    cg::grid_group grid = cg::this_grid();
    volatile LAS unsigned* MISC = (volatile LAS unsigned*)(lds + LDS_BYTES - 64);
    if (threadIdx.x < 16) MISC[threadIdx.x] = 0u;
    __syncthreads();
    (void)xcd_barrier_post((unsigned*)(P.ws + WS_CTL) + 1024, MISC);
#pragma unroll 1
    for (int ph = P.ph_lo; ph < P.ph_hi; ++ph) {
        GAS unsigned char* ws_g = (GAS unsigned char*)P.ws; GAS float* out_g = (GAS float*)P.out; asm volatile("" : "+s"(ws_g), "+s"(out_g));
        Ctx p; p.ws = (unsigned char*)ws_g; p.out = (float*)out_g;
        unsigned char* ws = p.ws;
        int prep_part = 0, prep_l = 0, prep_b = blockIdx.x, prep_G = gridDim.x;
        if (ph == 0) {
            { const int t0_ = opaque_tid(); if (t0_ < N_IN) { ((unsigned long long*)(ws + WS_TAB))[t0_] = (unsigned long long)P.in[t0_]; } }
            asm volatile("s_waitcnt vmcnt(0)" ::: "memory"); __syncthreads();
#ifndef NO_PREP
            prep_mod(p, lds); __syncthreads(); prep_part = 1;
#endif
        }
        else if (ph == NPH - 1) final_norm_phase(p);
        else {
#ifdef PROBE_S
            const int l = (ph - 1) / 13, sv_ = (ph - 1) % 13, s = sv_ <= PROBE_S ? sv_ : sv_ - 1;
#else
            const int l = (ph - 1) / 12, s = (ph - 1) % 12;
#endif
            const bool is_gemm = (s == 1 || s == 2 || s == 4 || s == 7 || s == 8 || s == 10 || s == 11);
            if (is_gemm) {
                pg8::Gemm g; pg8::Sched S; pg8::Epi E; bool perm;
                S.G = gridDim.x; S.c = blockIdx.x; S.mode = 0; S.nM = M_TOT / 256; S.wgm = (s == 2 || s == 8 || s == 11) ? RESID_WGM : pg8::WGM;
                E.o16 = nullptr; E.o16b = nullptr; E.of = nullptr; E.g = nullptr; E.gates = nullptr; E.scale = 1.f;
                bf16_t* ACT = (bf16_t*)(ws + WS_ACT); bf16_t* BIG = (bf16_t*)(ws + WS_BIG); float* X = (float*)(ws + WS_X);
                if (s == 1 || s == 10) { g.A = ACT; g.Bt = (const bf16_t*)(ws + wbase(l) + (s == 1 ? W_F1UP : W_F2UP)); g.K = DM; S.nN = 22; E.kind = pg8::EK_SWIGLU; E.o16 = BIG; perm = true; }
                else if (s == 2 || s == 11) { g.A = BIG; g.Bt = (const bf16_t*)(ws + wbase(l) + (s == 2 ? W_F1DN : W_F2DN)); g.K = DFF; S.nN = 4; E.kind = pg8::EK_RESID; E.of = X;
                    E.g = mod_ptr(ws, 0, l, s == 2 ? 2 : 8); E.scale = 0.5f; perm = false; }
                else if (s == 4) { g.A = ACT; g.Bt = (const bf16_t*)(ws + wbase(l) + W_IN); g.K = DM; S.nN = 27; E.kind = pg8::EK_PROJ; E.o16 = (bf16_t*)(ws + WS_PROJ); E.o16b = BIG; perm = true; }
                else if (s == 7) { g.A = (const bf16_t*)(ws + WS_BR); g.Bt = (const bf16_t*)(ws + wbase(l) + W_BR); g.K = 256; S.mode = 1; S.nN = 8; E.kind = pg8::EK_BRANCH;
                    E.o16 = ACT; E.gates = BIG; perm = false; }
                else { g.A = ACT; g.Bt = (const bf16_t*)(ws + wbase(l) + W_OUT); g.K = DM; S.nN = 4; E.kind = pg8::EK_RESID; E.of = X; E.g = mod_ptr(ws, 0, l, 5); E.scale = 1.f; perm = false; }
                S.nwg = S.nM * S.nN;
                #ifndef NO_GEMM
                if (s == 7) pg8::gemm_phase<true>(lds, g, S, E, perm); else pg8::gemm_phase<false>(lds, g, S, E, perm);
                if (blockIdx.x >= 64) {
                    if (s == 2) { prep_part = 2; prep_l = l; } else if (s == 8) { prep_part = 4; prep_l = l; } else if (s == 11 && l < 3) { prep_part = 1; prep_l = l + 1; }
                    prep_b = blockIdx.x - 64; prep_G = gridDim.x - 64;
                }
#endif
            } else if (s == 0 || s == 3 || s == 9) {
                norm_phase(p, l, s == 0 ? 0 : (s == 3 ? 1 : 2));

            } else if (s == 5) {
#ifndef NO_MIXPREP
                mixprep_phase(p, lds, l);
#endif
            } else {
#ifndef NO_MIX
                mix_phase(p, lds, l);
#ifdef PROBE_MIX2
                __syncthreads(); mix_phase(p, lds, l);
#endif
#endif
            }
        }
#ifndef NO_PREP
        if (prep_part) prep_layer(p, lds, prep_l, prep_b, prep_G, prep_part);
#endif
        if (ph + 1 < P.ph_hi) { if (P.ph_hi > 100000) grid.sync();   { XcdBarrier bar; bar.bar = (unsigned*)(p.ws + WS_CTL) + 1024; bar.x = xb_xcc_id(); bar.st = (volatile LAS unsigned*)(lds + LDS_BYTES - 64); xcd_barrier(bar); } }
    }
}

extern "C" void kernel_launch(void* const* d_in, const int* in_sizes, int n_in, void* d_out, int out_size, void* d_ws, size_t ws_size, hipStream_t stream) {
    static int grid = 0;
    if (grid == 0) {
        if (n_in != N_IN || ws_size < WS_END) { fprintf(stderr, "kernel_launch: unexpected n_in %d / ws_size %zu (need %zu)\n", n_in, ws_size, (size_t)WS_END); grid = -1; return; }
        int dev = 0, cus = 0, per_cu = 0;
        hipGetDevice(&dev); hipDeviceGetAttribute(&cus, hipDeviceAttributeMultiprocessorCount, dev);
        if (hipFuncSetAttribute((const void*)mega, hipFuncAttributeMaxDynamicSharedMemorySize, LDS_BYTES) != hipSuccess) { fprintf(stderr, "kernel_launch: hipFuncSetAttribute failed\n"); grid = -1; return; }
        if (hipOccupancyMaxActiveBlocksPerMultiprocessor(&per_cu, (const void*)mega, 512, LDS_BYTES) != hipSuccess || per_cu < 1) per_cu = 1;
        (void)hipGetLastError();
        grid = cus * 1;
        fprintf(stderr, "kernel_launch: grid %d (per_cu %d), ws %zu\n", grid, per_cu, ws_size);
    }
    if (grid < 0) return;
    hipMemsetAsync(d_ws, 0, WS_ZERO_BYTES, stream);
    Params p{};
    for (int i = 0; i < N_IN; ++i) p.in[i] = (const float*)d_in[i];
    p.out = (float*)d_out; p.ws = (unsigned char*)d_ws; p.ph_lo = 0; p.ph_hi = NPH;
    void* args[] = {&p};
    hipError_t e = hipLaunchCooperativeKernel((const void*)mega, dim3(grid), dim3(512), args, LDS_BYTES, stream);
    if (e != hipSuccess) fprintf(stderr, "cooperative launch failed: %s (grid %d)\n", hipGetErrorString(e), grid);
}
```

```cpp
#ifndef RESID_WGM
#define RESID_WGM 1
#endif
#include <hip/hip_runtime.h>
#include <hip/hip_cooperative_groups.h>
#include <cstdio>
#include <cstdint>
namespace cg = cooperative_groups;

#define LAS __attribute__((address_space(3)))
#define GAS __attribute__((address_space(1)))
typedef unsigned short bf16_t;
typedef short bf16x8 __attribute__((ext_vector_type(8)));
typedef float f32x4 __attribute__((ext_vector_type(4)));
typedef float f32x2 __attribute__((ext_vector_type(2)));
typedef unsigned u32x4 __attribute__((ext_vector_type(4)));
typedef unsigned u32x2 __attribute__((ext_vector_type(2)));

constexpr int DM = 1024, DFF = 2816, INW = 6912, PROJW = 2816, GATEW = 4096;
constexpr int M_CTX = 4096, M_DEC = 16384, M_TOT = 20480;
constexpr int NLAYER = 4;
constexpr float EPSF = 1e-6f;
constexpr float LOG2E = 1.4426950408889634f;
constexpr size_t O_Y = 0, O_NAK = 20971520, O_NAV = 25165824, O_SWK = 29360128, O_SWV = 31457280, O_DFK = 33554432, O_DFV = 37748736;
enum { I_XP = 0, I_XS, I_CNAK, I_CNAV, I_CSWK, I_CSWV, I_CDFK, I_CDFV, I_C, I_CCTX, I_WADA, I_BADA, I_NF1, I_NMIX, I_NF2, I_FNORM,
       I_F1W1, I_F1W3, I_F1W2, I_F2W1, I_F2W3, I_F2W2, I_WIN, I_WBR, I_WOUT, I_RPB, I_SINK, I_HSW, I_HSB, I_HW1, I_HB1, I_HW2, I_HB2, I_HW3,
       I_HSF, I_HLD, I_HSKIP, I_DLAM, I_DSUB, N_IN };

constexpr size_t MiB = 1u << 20;
constexpr size_t WS_CTL = 0;
constexpr size_t WS_MOD = 1 * MiB;
constexpr size_t WS_ZERO_BYTES = 65536;
constexpr size_t WS_LAM = 3 * MiB;
constexpr size_t WS_W = 4 * MiB;
constexpr size_t W_F1UP = 0, W_F1DN = W_F1UP + (size_t)5632 * 1024 * 2, W_F2UP = W_F1DN + (size_t)1024 * 2816 * 2, W_F2DN = W_F2UP + (size_t)5632 * 1024 * 2,
                 W_IN = W_F2DN + (size_t)1024 * 2816 * 2, W_BR = W_IN + (size_t)6912 * 1024 * 2, W_OUT = W_BR + (size_t)4 * 1024 * 256 * 2, W_END = W_OUT + (size_t)1024 * 1024 * 2;
static_assert(W_END <= 52 * MiB, "weights");
constexpr size_t WS_X = 56 * MiB;
constexpr size_t WS_ACT = 136 * MiB;
constexpr size_t WS_BR = 176 * MiB;
constexpr size_t WS_BIG = 216 * MiB;
constexpr size_t WS_PROJ = 376 * MiB;
constexpr size_t WS_TR = 486 * MiB;
constexpr size_t WS_CK = 541 * MiB;
constexpr size_t WS_HFIL = 551 * MiB;
constexpr size_t WS_W2 = 560 * MiB;
constexpr size_t WS_END = 612 * MiB;
constexpr int TRW = 1408;
constexpr size_t CK_NA = 0, CK_SW = 1048576, CK_DF = 1572864, CK_HALF = 2621440;
constexpr int LDS_BYTES = 147456;

#ifdef PROBE_S
constexpr int NPH = 54;
#else
constexpr int NPH = 50;
#endif
struct Params { const float* in[N_IN]; float* out; unsigned char* ws; int ph_lo, ph_hi; };
struct Ctx { float* out; unsigned char* ws; };
__device__ __forceinline__ size_t wbase(int l) { return (l & 1) ? WS_W2 : WS_W; }
constexpr size_t WS_TAB = 3 * MiB + 65536;
__device__ __forceinline__ const float* inp(const unsigned char* ws, int i) {
    const unsigned long long v = __hip_atomic_load((const unsigned long long*)(ws + WS_TAB) + i, __ATOMIC_RELAXED, __HIP_MEMORY_SCOPE_AGENT);
    const unsigned lo = __builtin_amdgcn_readfirstlane((unsigned)v), hi = __builtin_amdgcn_readfirstlane((unsigned)(v >> 32));
    return (const float*)(const GAS float*)(((unsigned long long)hi << 32) | lo);
}


__device__ __forceinline__ unsigned cvt_pk_bf16(float lo, float hi) { unsigned r; asm volatile("v_cvt_pk_bf16_f32 %0, %1, %2" : "=v"(r) : "v"(lo), "v"(hi)); return r; }
__device__ __forceinline__ float bf2f(unsigned short v) { return __uint_as_float(((unsigned)v) << 16); }
__device__ __forceinline__ float bflo(unsigned v) { return __uint_as_float(v << 16); }
__device__ __forceinline__ float bfhi(unsigned v) { return __uint_as_float(v & 0xffff0000u); }
__device__ __forceinline__ bf16_t f2bf1(float f) { return (bf16_t)(cvt_pk_bf16(f, 0.f) & 0xffffu); }
__device__ __forceinline__ float fast_exp2(float x) { return __builtin_amdgcn_exp2f(x); }
__device__ __forceinline__ float fast_rcp(float x) { return __builtin_amdgcn_rcpf(x); }
__device__ __forceinline__ float sigmoidf_(float x) { return fast_rcp(1.f + fast_exp2(-x * LOG2E)); }
__device__ __forceinline__ float wave_sum(float v) {
#pragma unroll
    for (int o = 1; o < 64; o <<= 1) v += __shfl_xor(v, o);
    return v;
}
__device__ __forceinline__ int cond_of_row(int row) { return row < M_CTX ? 0 : 1 + ((row - M_CTX) >> 11); }
__device__ __forceinline__ const float* mod_ptr(const unsigned char* ws, int cond, int l, int chunk) { return (const float*)(ws + WS_MOD) + ((size_t)(cond * 4 + l) * 9 + chunk) * 1024; }

__device__ __forceinline__ int opaque_tid() { int t; asm volatile("v_mov_b32 %0, %1" : "=v"(t) : "v"((int)threadIdx.x)); return t; }
namespace pg8 {
constexpr int BM = 256, BK = 64, HALF = 128, HTB = HALF * BK * 2, STAGE_BYTES = 8 * HTB, NXCD = 8, WGM = 4;
__device__ __forceinline__ int lds_byte(int r, int c) { const int st = (r >> 4) * 2 + (c >> 5), rr = r & 15, cc = c & 31, ob = rr * 64 + cc * 2; return st * 1024 + (ob ^ (((ob >> 9) & 1) << 5)); }
__device__ __forceinline__ void stage_rc(int b, int& R, int& C) { const int st = b / 1024, sb = b % 1024, swz = sb ^ (((sb >> 9) & 1) << 5); R = (st >> 1) * 16 + swz / 64; C = (st & 1) * 32 + (swz % 64) / 2; }
__device__ __forceinline__ int perm32(int rho) { const int n = rho >> 4, i = rho & 15; return 8 * (i >> 2) + 4 * n + (i & 3); }
struct Unit { int pm, pn; };
struct Sched { int mode, nM, nN, nwg, G, c, wgm; };
__device__ __forceinline__ bool sched_next(const Sched& S, int i, Unit& u) {
    const int j = (S.mode == 1) ? (i >> 2) : i;
    const long L = (long)j * S.G + S.c; if (L >= S.nwg) return false;
    int wgid = (int)L; { const int q = S.nwg / NXCD, r = S.nwg % NXCD, xcd = wgid % NXCD, off = wgid / NXCD; wgid = (xcd < r ? xcd * (q + 1) : r * (q + 1) + (xcd - r) * q) + off; }
    const int nig = S.wgm * S.nN, gid = wgid / nig, fm = gid * S.wgm, gsz = (S.nM - fm) < S.wgm ? (S.nM - fm) : S.wgm;
    const int pm = fm + ((wgid % nig) % gsz), pn = (wgid % nig) / gsz;
    if (S.mode == 1) { const int b = i & 3; u.pm = b * S.nM + pm; u.pn = b * S.nN + pn; } else { u.pm = pm; u.pn = pn; }
    return true;
}
enum { EK_SWIGLU = 0, EK_RESID = 1, EK_PROJ = 2, EK_BRANCH = 3 };
struct Epi { int kind; bf16_t* o16; bf16_t* o16b; float* of; const float* g; const bf16_t* gates; float scale; };
struct Gemm { const bf16_t* A; const bf16_t* Bt; int K; };

template <bool BR>
__device__ __forceinline__ void epilogue(const Epi& E, f32x4 (&acc)[2][2][4][2], const Unit& u, int wr, int wc, int fr, int fq) {
    if (BR) {
        const int bi = u.pm / 80, pm = u.pm - bi * 80, pn = u.pn & 7;
        const int row0 = pm * BM + wr * 64 + fr, col0 = pn * HALF + wc * 32 + 4 * fq;
        u32x2 gw[2][2][4];
#pragma unroll
        for (int n = 0; n < 2; ++n)
#pragma unroll
            for (int ai = 0; ai < 2; ++ai)
#pragma unroll
                for (int m = 0; m < 4; ++m) gw[n][ai][m] = *(const u32x2*)(E.gates + (size_t)(row0 + ai * HALF + m * 16) * GATEW + bi * 1024 + col0 + n * 16);
#pragma unroll
        for (int n = 0; n < 2; ++n)
#pragma unroll
            for (int ai = 0; ai < 2; ++ai)
#pragma unroll
                for (int m = 0; m < 4; ++m) {
                    const u32x2 g2 = gw[n][ai][m];
                    f32x4 gt; gt[0] = bflo(g2.x); gt[1] = bfhi(g2.x); gt[2] = bflo(g2.y); gt[3] = bfhi(g2.y);
                    f32x4 v = gt * acc[ai][0][m][n];
                    if (bi > 0) v = v + acc[ai][1][m][n];
                    acc[ai][1][m][n] = v;
                    if (bi == 3) { u32x2 w; w.x = cvt_pk_bf16(v[0], v[1]); w.y = cvt_pk_bf16(v[2], v[3]); *(u32x2*)(E.o16 + (size_t)(row0 + ai * HALF + m * 16) * DM + col0 + n * 16) = w; }
                }
    } else if (E.kind == EK_SWIGLU) {
        const int row0 = u.pm * BM + wr * 64 + fr, col0 = u.pn * 128 + wc * 32 + 8 * fq;
#pragma unroll
        for (int ai = 0; ai < 2; ++ai)
#pragma unroll
            for (int m = 0; m < 4; ++m) {
                const f32x4 a0 = acc[ai][0][m][0], a1 = acc[ai][0][m][1], b0 = acc[ai][1][m][0], b1 = acc[ai][1][m][1];
                float r[8];
#pragma unroll
                for (int e = 0; e < 4; ++e) { r[e] = a0[e] * sigmoidf_(a0[e]) * b0[e]; r[4 + e] = a1[e] * sigmoidf_(a1[e]) * b1[e]; }
                u32x4 w; w.x = cvt_pk_bf16(r[0], r[1]); w.y = cvt_pk_bf16(r[2], r[3]); w.z = cvt_pk_bf16(r[4], r[5]); w.w = cvt_pk_bf16(r[6], r[7]);
                *(u32x4*)(E.o16 + (size_t)(row0 + ai * HALF + m * 16) * DFF + col0) = w;
            }
    } else if (E.kind == EK_PROJ) {
        const int row0 = u.pm * BM + wr * 64 + fr;
        const bool isgate = u.pn >= 11;
        bf16_t* base = isgate ? E.o16b : E.o16; const int ld = isgate ? GATEW : PROJW;
        const int col0 = (isgate ? (u.pn - 11) * BM : u.pn * BM) + wc * 32 + 8 * fq;
#pragma unroll
        for (int ai = 0; ai < 2; ++ai)
#pragma unroll
            for (int m = 0; m < 4; ++m)
#pragma unroll
                for (int bj = 0; bj < 2; ++bj) {
                    f32x4 v0 = acc[ai][bj][m][0], v1 = acc[ai][bj][m][1];
                    if (isgate) {
#pragma unroll
                        for (int e = 0; e < 4; ++e) { v0[e] = sigmoidf_(v0[e]); v1[e] = sigmoidf_(v1[e]); }
                    }
                    u32x4 w; w.x = cvt_pk_bf16(v0[0], v0[1]); w.y = cvt_pk_bf16(v0[2], v0[3]); w.z = cvt_pk_bf16(v1[0], v1[1]); w.w = cvt_pk_bf16(v1[2], v1[3]);
                    *(u32x4*)(base + (size_t)(row0 + ai * HALF + m * 16) * ld + col0 + bj * HALF) = w;
                }
    } else if (E.kind == EK_RESID) {
        const int cond = (u.pm < 16) ? 0 : 1 + ((u.pm - 16) >> 3);
        const float* gv = E.g + (size_t)cond * (4 * 9 * 1024);
        const int row0 = u.pm * BM + wr * 64 + fr, col0 = u.pn * BM + wc * 32 + 4 * fq;
        f32x4 g4[2][2];
#pragma unroll
        for (int bj = 0; bj < 2; ++bj)
#pragma unroll
            for (int n = 0; n < 2; ++n) g4[bj][n] = *(const f32x4*)(gv + col0 + bj * HALF + n * 16) * E.scale;
#pragma unroll
        for (int bj = 0; bj < 2; ++bj)
#pragma unroll
            for (int n = 0; n < 2; ++n) {
                const int col = col0 + bj * HALF + n * 16;
                f32x4 xv[2][4];
#pragma unroll
                for (int ai = 0; ai < 2; ++ai)
#pragma unroll
                    for (int m = 0; m < 4; ++m) xv[ai][m] = *(const f32x4*)(E.of + (size_t)(row0 + ai * HALF + m * 16) * DM + col);
#pragma unroll
                for (int ai = 0; ai < 2; ++ai)
#pragma unroll
                    for (int m = 0; m < 4; ++m) *(f32x4*)(E.of + (size_t)(row0 + ai * HALF + m * 16) * DM + col) = xv[ai][m] + g4[bj][n] * acc[ai][bj][m][n];
            }
    }
}

template <bool BR>
__device__ __forceinline__ void gemm_phase(LAS unsigned char* lds, const Gemm g, const Sched& S, const Epi& E, const bool perm) {
    const int tid = opaque_tid(), wid = __builtin_amdgcn_readfirstlane(tid >> 6), lane = tid & 63, wr = wid >> 2, wc = wid & 3, fr = lane & 15, fq = lane >> 4;
    const int K = g.K, nt = K / BK;
    const bool align = !(E.kind == EK_RESID);
    unsigned voffA[2], voffB[2];
#pragma unroll
    for (int i = 0; i < 2; ++i) { int R, C; stage_rc(tid * 16 + i * 8192, R, C); const int Rb = perm ? ((R & ~31) + perm32(R & 31)) : R;
        voffA[i] = (unsigned)(R * K + C) * 2u; voffB[i] = (unsigned)(Rb * K + C) * 2u; }
    const size_t kstep = (size_t)(BK * 2);
    const size_t hstep = (size_t)HALF * K * 2;
    const size_t tstep = 2 * hstep;
    const size_t bstep = BR ? hstep : tstep;
    const unsigned ldsw = (unsigned)wid * 1024u;
    const int aoff = lds_byte(wr * 64 + fr, fq * 8), boff = lds_byte(wc * 32 + fr, fq * 8);
#define PG8_SA(b, h) (((b) * 2 + (h)) * HTB)
#define PG8_SB(b, h) ((4 + (b) * 2 + (h)) * HTB)
#define PG8_STAGE(bufoff, gbase, voff) do { _Pragma("unroll") for (int _i = 0; _i < 2; ++_i) \
        __builtin_amdgcn_global_load_lds((const unsigned*)((const char*)(gbase) + (voff)[_i]), (LAS unsigned*)(lds + (bufoff) + ldsw + _i * 8192), 16, 0, 0); } while (0)
#define PG8_LDA(dst, b, h) do { _Pragma("unroll") for (int m = 0; m < 4; ++m) _Pragma("unroll") for (int k = 0; k < 2; ++k) dst[m][k] = *(const LAS bf16x8*)(lds + PG8_SA(b, h) + aoff + m * 2048 + k * 1024); } while (0)
#define PG8_LDB(dst, b, h) do { _Pragma("unroll") for (int n = 0; n < 2; ++n) _Pragma("unroll") for (int k = 0; k < 2; ++k) dst[n][k] = *(const LAS bf16x8*)(lds + PG8_SB(b, h) + boff + n * 2048 + k * 1024); } while (0)
#define PG8_MMA(ai, bj, At, Bt) do { __builtin_amdgcn_s_setprio(1); _Pragma("unroll") for (int m = 0; m < 4; ++m) _Pragma("unroll") for (int n = 0; n < 2; ++n) _Pragma("unroll") for (int k = 0; k < 2; ++k) \
        acc[ai][bj][m][n] = __builtin_amdgcn_mfma_f32_16x16x32_bf16(Bt[n][k], At[m][k], acc[ai][bj][m][n], 0, 0, 0); __builtin_amdgcn_s_setprio(0); } while (0)
#define PG8_WAIT_V(n) asm volatile("s_waitcnt vmcnt(" #n ")" ::: "memory")
#define PG8_WAIT_L(n) asm volatile("s_waitcnt lgkmcnt(" #n ")" ::: "memory")
#define PG8_BAR __builtin_amdgcn_s_barrier()
#define PG8_SCHED __builtin_amdgcn_sched_barrier(0)
    Unit cur, nxt; int ui = 0;
    if (!sched_next(S, 0, cur)) return;
    f32x4 acc[2][2][4][2];
#pragma unroll
    for (int a = 0; a < 2; ++a)
#pragma unroll
        for (int b = 0; b < 2; ++b)
#pragma unroll
            for (int m = 0; m < 4; ++m)
#pragma unroll
                for (int n = 0; n < 2; ++n) acc[a][b][m][n] = (f32x4){0.f, 0.f, 0.f, 0.f};
    bf16x8 At[4][2], B0[2][2], B1[2][2];
    const char* cA = (const char*)g.A + (size_t)cur.pm * tstep; const char* cB = (const char*)g.Bt + (size_t)cur.pn * bstep;
    PG8_STAGE(PG8_SB(0, 0), cB, voffB); PG8_STAGE(PG8_SB(0, 1), cB + hstep, voffB); PG8_STAGE(PG8_SA(0, 0), cA, voffA); PG8_STAGE(PG8_SA(0, 1), cA + hstep, voffA);
    if (wr == 1) PG8_BAR;
    PG8_WAIT_V(2); PG8_BAR;
    PG8_STAGE(PG8_SB(1, 0), cB + kstep, voffB); PG8_STAGE(PG8_SA(1, 0), cA + kstep, voffA); PG8_STAGE(PG8_SB(1, 1), cB + hstep + kstep, voffB);
    PG8_WAIT_V(6); PG8_BAR;
    for (;;) {
        const bool has_next = sched_next(S, ui + 1, nxt);
        const char* nA = has_next ? (const char*)g.A + (size_t)nxt.pm * tstep : cA; const char* nB = has_next ? (const char*)g.Bt + (size_t)nxt.pn * bstep : cB;
        for (int t = 0; t < nt; t += 2) {
            const bool last = (t == nt - 2);
            const char* a1 = cA + (size_t)(t + 1) * kstep;
            const char* a2 = last ? nA : cA + (size_t)(t + 2) * kstep; const char* b2 = last ? nB : cB + (size_t)(t + 2) * kstep;
            const char* a3 = a2 + kstep; const char* b3 = b2 + kstep;
            PG8_LDB(B0, 0, 0); PG8_LDB(B1, 0, 1); PG8_SCHED; PG8_LDA(At, 0, 0); PG8_STAGE(PG8_SA(1, 1), a1 + hstep, voffA);
            PG8_WAIT_V(8); PG8_WAIT_L(0); PG8_BAR; PG8_MMA(0, 0, At, B0); if (!BR) { PG8_MMA(0, 1, At, B1); } PG8_BAR; PG8_SCHED;
            PG8_LDA(At, 0, 1); PG8_STAGE(PG8_SB(0, 0), b2, voffB); PG8_STAGE(PG8_SB(0, 1), b2 + hstep, voffB); PG8_STAGE(PG8_SA(0, 0), a2, voffA);
            PG8_WAIT_V(8); PG8_WAIT_L(0); PG8_BAR; PG8_MMA(1, 0, At, B0); if (!BR) { PG8_MMA(1, 1, At, B1); } PG8_BAR; PG8_SCHED;
            PG8_LDB(B0, 1, 0); PG8_LDB(B1, 1, 1); PG8_SCHED; PG8_LDA(At, 1, 0); PG8_STAGE(PG8_SA(0, 1), a2 + hstep, voffA);
            PG8_WAIT_V(8); PG8_WAIT_L(0); PG8_BAR; PG8_MMA(0, 0, At, B0); if (!BR) { PG8_MMA(0, 1, At, B1); } PG8_BAR; PG8_SCHED;
            PG8_LDA(At, 1, 1); PG8_STAGE(PG8_SB(1, 0), b3, voffB); PG8_STAGE(PG8_SB(1, 1), b3 + hstep, voffB); PG8_STAGE(PG8_SA(1, 0), a3, voffA);
            PG8_WAIT_V(8); PG8_WAIT_L(0); PG8_BAR; PG8_MMA(1, 0, At, B0); if (!BR) { PG8_MMA(1, 1, At, B1); } PG8_BAR; PG8_SCHED;
        }
        if (align && wr == 0) PG8_BAR;
        epilogue<BR>(E, acc, cur, wr, wc, fr, fq);
        if (!has_next) break;
#pragma unroll
        for (int a = 0; a < 2; ++a)
#pragma unroll
            for (int b = 0; b < (BR ? 1 : 2); ++b)
#pragma unroll
                for (int m = 0; m < 4; ++m)
#pragma unroll
                    for (int n = 0; n < 2; ++n) acc[a][b][m][n] = (f32x4){0.f, 0.f, 0.f, 0.f};
        cur = nxt; cA = nA; cB = nB; ++ui;
        if (align && wr == 1) PG8_BAR;
    }
    PG8_WAIT_V(0);
    if (!align && wr == 0) PG8_BAR;
    PG8_BAR;
#undef PG8_SA
#undef PG8_SB
#undef PG8_STAGE
#undef PG8_LDA
#undef PG8_LDB
#undef PG8_MMA
#undef PG8_WAIT_V
#undef PG8_WAIT_L
#undef PG8_BAR
#undef PG8_SCHED
}
}


__device__ __forceinline__ void transpose_item(const float* W, int K, int N, bf16_t* WT, int dst_row0, LAS float* scr, int k0, int n0, int lane) {
    f32x4 v[16];
    const int rr = lane >> 4, cc = (lane & 15) * 4;
#pragma unroll
    for (int i = 0; i < 16; ++i) v[i] = __builtin_nontemporal_load((const f32x4*)(W + (size_t)(k0 + 4 * i + rr) * N + n0 + cc));
#pragma unroll
    for (int i = 0; i < 16; ++i) { LAS float* d = scr + (4 * i + rr) * 65 + cc; d[0] = v[i][0]; d[1] = v[i][1]; d[2] = v[i][2]; d[3] = v[i][3]; }
    asm volatile("s_waitcnt lgkmcnt(0)" ::: "memory");
    const int c = lane & 7, r = lane >> 3;
#pragma unroll
    for (int j = 0; j < 8; ++j) { const int n = 8 * j + r; const LAS float* q = scr + (8 * c) * 65 + n;
        u32x4 o; o.x = cvt_pk_bf16(q[0], q[65]); o.y = cvt_pk_bf16(q[2 * 65], q[3 * 65]); o.z = cvt_pk_bf16(q[4 * 65], q[5 * 65]); o.w = cvt_pk_bf16(q[6 * 65], q[7 * 65]);
        *(u32x4*)(WT + (size_t)(dst_row0 + n) * K + k0 + 8 * c) = o; }
    asm volatile("s_waitcnt lgkmcnt(0)" ::: "memory");
}

__device__ __forceinline__ void prep_layer(const Ctx& p, LAS unsigned char* lds, int l, int bidx, int G, int part) {
    const int tid = opaque_tid(), lane = tid & 63, wave = tid >> 6;
    const int gw = bidx * 8 + wave, NGW = G * 8;
    unsigned char* ws = p.ws; unsigned char* wsw = p.ws + wbase(l);
    LAS float* scr = (LAS float*)(lds + wave * 16896);
    {
        constexpr int I_UP = 16 * 44, I_DN = 44 * 16, I_IN = 16 * 108, I_BR = 4 * 16, I_OUT = 16 * 16;
        constexpr int NIT = 4 * I_UP + 2 * I_DN + I_IN + 4 * I_BR + I_OUT;
        for (int it = gw; it < NIT; it += NGW) {
            int r = it;
            { const int cls = (r < 4 * I_UP) ? ((r < 2 * I_UP) ? 1 : 4) : ((r < 4 * I_UP + 2 * I_DN) ? ((r < 4 * I_UP + I_DN) ? 1 : 4) : 2); if (!(part & cls)) continue; }
            if (r < 4 * I_UP) {
                const int which = r / I_UP; r -= which * I_UP; const int kb = r / 44, nb = r % 44, n0 = nb * 64;
                const float* W = inp(p.ws, (which >> 1) ? ((which & 1) ? I_F2W3 : I_F2W1) : ((which & 1) ? I_F1W3 : I_F1W1)) + (size_t)l * DM * DFF;
                bf16_t* WT = (bf16_t*)(wsw + ((which >> 1) ? W_F2UP : W_F1UP));
                const int drow = 256 * (n0 >> 7) + (which & 1) * 128 + (n0 & 127);
                transpose_item(W, DM, DFF, WT, drow, scr, kb * 64, n0, lane); continue;
            }
            r -= 4 * I_UP;
            if (r < 2 * I_DN) {
                const int which = r / I_DN; r -= which * I_DN; const int kb = r / 16, nb = r % 16;
                const float* W = inp(p.ws, which ? I_F2W2 : I_F1W2) + (size_t)l * DFF * DM;
                bf16_t* WT = (bf16_t*)(wsw + (which ? W_F2DN : W_F1DN));
                transpose_item(W, DFF, DM, WT, nb * 64, scr, kb * 64, nb * 64, lane); continue;
            }
            r -= 2 * I_DN;
            if (r < I_IN) { const int kb = r / 108, nb = r % 108;
                transpose_item(inp(p.ws, I_WIN) + (size_t)l * DM * INW, DM, INW, (bf16_t*)(wsw + W_IN), nb * 64, scr, kb * 64, nb * 64, lane); continue; }
            r -= I_IN;
            if (r < 4 * I_BR) { const int bi = r / I_BR; r -= bi * I_BR; const int kb = r / 16, nb = r % 16;
                transpose_item(inp(p.ws, I_WBR) + ((size_t)l * 4 + bi) * 256 * DM, 256, DM, (bf16_t*)(wsw + W_BR) + (size_t)bi * 1024 * 256, nb * 64, scr, kb * 64, nb * 64, lane); continue; }
            r -= 4 * I_BR;
            { const int kb = r / 16, nb = r % 16;
              transpose_item(inp(p.ws, I_WOUT) + (size_t)l * DM * DM, DM, DM, (bf16_t*)(wsw + W_OUT), nb * 64, scr, kb * 64, nb * 64, lane); }
        }
    }
    if (!(part & 2)) return;
    {
        bf16_t* CK = (bf16_t*)(ws + WS_CK);
        const int gt = bidx * 512 + tid, NT = G * 512;
        for (int it = gt; it < 327680; it += NT) {
            int e = it * 8; const float* src; bf16_t* dst; int per_b;
            if (e < 1048576) { src = inp(p.ws, I_CNAK); dst = CK + CK_NA; per_b = 131072; }
            else if (e < 1572864) { e -= 1048576; src = inp(p.ws, I_CSWK); dst = CK + CK_SW; per_b = 65536; }
            else { e -= 1572864; src = inp(p.ws, I_CDFK); dst = CK + CK_DF; per_b = 131072; }
            const int b = e / per_b, r = e - b * per_b;
            const float* s = src + ((size_t)(b * 4 + l)) * per_b + r;
            const f32x4 v0 = __builtin_nontemporal_load((const f32x4*)s), v1 = __builtin_nontemporal_load((const f32x4*)(s + 4));
            u32x4 o; o.x = cvt_pk_bf16(v0[0], v0[1]); o.y = cvt_pk_bf16(v0[2], v0[3]); o.z = cvt_pk_bf16(v1[0], v1[1]); o.w = cvt_pk_bf16(v1[2], v1[3]);
            *(u32x4*)(dst + e) = o;
        }
    }
    {
        bf16_t* CV = (bf16_t*)(ws + WS_CK) + CK_HALF;
        for (int it = gw; it < 640; it += NGW) {
            int r = it; const float* src; bf16_t* dst; int H;
            if (r < 256) { src = inp(p.ws, I_CNAV); dst = CV + CK_NA; H = 4; }
            else if (r < 384) { r -= 256; src = inp(p.ws, I_CSWV); dst = CV + CK_SW; H = 2; }
            else { r -= 384; src = inp(p.ws, I_CDFV); dst = CV + CK_DF; H = 4; }
            const int kb = r & 7, bh = r >> 3, b = bh / H, h = bh - b * H;
            transpose_item(src + ((size_t)(b * 4 + l) * H + h) * 512 * 64, 512, 64, dst + (size_t)bh * 64 * 512, 0, scr, kb * 64, 0, lane);
        }
    }
    __syncthreads();
    {
        LAS float* Z = (LAS float*)lds;
        LAS float* G1 = Z + 8 * 33;
        LAS float* G2 = G1 + 8 * 64;
        float* HF = (float*)(ws + WS_HFIL);
        const float* w1 = inp(p.ws, I_HW1) + (size_t)l * 33 * 64; const float* b1 = inp(p.ws, I_HB1) + l * 64;
        const float* w2 = inp(p.ws, I_HW2) + (size_t)l * 64 * 64; const float* b2 = inp(p.ws, I_HB2) + l * 64;
        const float* w3 = inp(p.ws, I_HW3) + (size_t)l * 64 * 1024; const float* sf = inp(p.ws, I_HSF) + l * 64; const float* ld = inp(p.ws, I_HLD) + l * 1024;
        for (int it = bidx; it < 288; it += G) {
            const int Lsel = it >= 32, L = Lsel ? 2048 : 256, n0 = (Lsel ? it - 32 : it) * 8;
            const float invL = 1.f / (float)L;
            if (tid < 8 * 33) { const int nn = tid / 33, i = tid - nn * 33; const float tn = (float)(n0 + nn) * invL; float v;
                if (i == 0) v = tn; else if (i <= 16) v = __cosf(6.283185307179586f * tn * (float)i); else v = __sinf(6.283185307179586f * tn * (float)(i - 16));
                Z[nn * 33 + i] = v; }
            __syncthreads();
            { const int nn = tid >> 6, j = tid & 63; float a = b1[j];
#pragma unroll 11
              for (int i = 0; i < 33; ++i) a += Z[nn * 33 + i] * w1[i * 64 + j];
              G1[nn * 64 + j] = __sinf(sf[j] * a); }
            __syncthreads();
            { const int nn = tid >> 6, j = tid & 63; float a = b2[j];
#pragma unroll 16
              for (int i = 0; i < 64; ++i) a += G1[nn * 64 + i] * w2[i * 64 + j];
              G2[nn * 64 + j] = __sinf(sf[j] * a); }
            __syncthreads();
#pragma unroll 1
            for (int cc = 0; cc < 2; ++cc) {
                const int col = cc * 512 + tid;
                float a[8];
#pragma unroll
                for (int nn = 0; nn < 8; ++nn) a[nn] = 0.f;
#pragma unroll 16
                for (int i = 0; i < 64; ++i) { const float w = w3[i * 1024 + col];
#pragma unroll
                    for (int nn = 0; nn < 8; ++nn) a[nn] += G2[nn * 64 + i] * w; }
                const float rate = __expf(ld[col]);
#pragma unroll
                for (int nn = 0; nn < 8; ++nn) a[nn] *= __expf(-rate * (float)(n0 + nn) * invL);
                float* o = HF + (Lsel ? 262144 : 0) + (size_t)col * L + n0;
                *(f32x4*)o = (f32x4){a[0], a[1], a[2], a[3]}; *(f32x4*)(o + 4) = (f32x4){a[4], a[5], a[6], a[7]};
            }
            __syncthreads();
        }
    }
    if (bidx == 0 && tid == 0) {
        const float* lv = inp(p.ws, I_DLAM) + l * 128; float s01 = 0.f, s23 = 0.f;
        for (int i = 0; i < 32; ++i) { s01 += lv[i] * lv[32 + i]; s23 += lv[64 + i] * lv[96 + i]; }
        float c08; asm volatile("v_mov_b32 %0, 0x3f4ccccd" : "=v"(c08));
        const float lam_init = c08 - 0.6f * __expf(-0.3f * (float)l);
        ((float*)(ws + WS_LAM))[l] = __expf(s01) - __expf(s23) + lam_init; ((float*)(ws + WS_LAM))[4 + l] = lam_init;
    }
}

__device__ __forceinline__ void prep_mod(const Ctx& p, LAS unsigned char* lds) {
    const int tid = opaque_tid(), lane = tid & 63, wave = tid >> 6;
    const int G = gridDim.x;
    LAS float* SC = (LAS float*)lds;
    LAS float* PART = (LAS float*)(lds + 40960);
    for (int i = tid; i < 9 * 1024; i += 512) { const float v = (i < 1024) ? inp(p.ws, I_CCTX)[i] : inp(p.ws, I_C)[i - 1024]; SC[i] = v * sigmoidf_(v); }
    __syncthreads();
    float* mod = (float*)(p.ws + WS_MOD);
    for (int it = blockIdx.x; it < 4 * 36; it += G) {
        const int cb = it % 36, l = it / 36;
        const int col = cb * 256 + lane * 4, k0 = wave * 128;
        const float* W = inp(p.ws, I_WADA) + ((size_t)l * DM + k0) * 9216 + col;
        f32x4 a[9];
#pragma unroll
        for (int c = 0; c < 9; ++c) a[c] = (f32x4){0.f, 0.f, 0.f, 0.f};
#pragma unroll 16
        for (int k = 0; k < 128; ++k) { const f32x4 w = __builtin_nontemporal_load((const f32x4*)(W + (size_t)k * 9216));
#pragma unroll
            for (int c = 0; c < 9; ++c) a[c] += w * SC[c * 1024 + k0 + k]; }
#pragma unroll
        for (int c = 0; c < 9; ++c) *(LAS f32x4*)(PART + (wave * 9 + c) * 256 + lane * 4) = a[c];
        __syncthreads();
        for (int o = tid; o < 9 * 256; o += 512) { const int c = o >> 8, cc = o & 255;
            float v = inp(p.ws, I_BADA)[(size_t)l * 9216 + cb * 256 + cc];
#pragma unroll
            for (int w = 0; w < 8; ++w) v += PART[(w * 9 + c) * 256 + cc];
            mod[((size_t)(c * 4 + l)) * 9216 + cb * 256 + cc] = v; }
        __syncthreads();
    }
}

__device__ __forceinline__ void norm_phase(const Ctx& p, int l, int which  ) {
    const int tid_ = opaque_tid(), lane = tid_ & 63, wave = tid_ >> 6, gw = blockIdx.x * 8 + wave, NGW = gridDim.x * 8;
    float* X = (float*)(p.ws + WS_X); bf16_t* ACT = (bf16_t*)(p.ws + WS_ACT);
    const float* gsrc = inp(p.ws, which == 0 ? I_NF1 : (which == 1 ? I_NMIX : I_NF2)) + l * DM;
    const bool from_in = (l == 0 && which == 0);
    f32x4 gv[4];
#pragma unroll
    for (int j = 0; j < 4; ++j) gv[j] = *(const f32x4*)(gsrc + j * 256 + lane * 4);
    constexpr int NR = 4;
    for (int row0 = gw * NR; row0 < M_TOT; row0 += NGW * NR) {
        f32x4 v[NR][4]; float s[NR];
#pragma unroll
        for (int r = 0; r < NR; ++r) {
            const int row = row0 + r;
            const float* xr = from_in ? (row < M_CTX ? inp(p.ws, I_XP) + (size_t)row * DM : inp(p.ws, I_XS) + (size_t)(row - M_CTX) * DM) : X + (size_t)row * DM;
#pragma unroll
            for (int j = 0; j < 4; ++j) v[r][j] = *(const f32x4*)(xr + j * 256 + lane * 4);
        }
        const int cond = cond_of_row(row0);
        const float* sh = mod_ptr(p.ws, cond, l, which * 3 + 0); const float* sc = mod_ptr(p.ws, cond, l, which * 3 + 1);
        f32x4 s4[4], h4[4];
#pragma unroll
        for (int j = 0; j < 4; ++j) { s4[j] = *(const f32x4*)(sc + j * 256 + lane * 4) + 1.f; h4[j] = *(const f32x4*)(sh + j * 256 + lane * 4); }
#pragma unroll
        for (int r = 0; r < NR; ++r) { float a = 0.f;
#pragma unroll
            for (int j = 0; j < 4; ++j) a += (v[r][j][0] * v[r][j][0] + v[r][j][1] * v[r][j][1]) + (v[r][j][2] * v[r][j][2] + v[r][j][3] * v[r][j][3]);
            s[r] = a; }
        if (from_in) {
#pragma unroll
            for (int r = 0; r < NR; ++r)
#pragma unroll
                for (int j = 0; j < 4; ++j) *(f32x4*)(X + (size_t)(row0 + r) * DM + j * 256 + lane * 4) = v[r][j];
        }
#pragma unroll
        for (int o = 1; o < 64; o <<= 1) {
#pragma unroll
            for (int r = 0; r < NR; ++r) s[r] += __shfl_xor(s[r], o);
        }
#pragma unroll
        for (int r = 0; r < NR; ++r) {
            const float rstd = rsqrtf(s[r] * (1.f / DM) + EPSF);
#pragma unroll
            for (int j = 0; j < 4; ++j) {
                const f32x4 o = (v[r][j] * rstd) * gv[j] * s4[j] + h4[j];
                u32x2 w; w.x = cvt_pk_bf16(o[0], o[1]); w.y = cvt_pk_bf16(o[2], o[3]);
                *(u32x2*)(ACT + (size_t)(row0 + r) * DM + j * 256 + lane * 4) = w;
            }
        }
    }
}
__device__ __forceinline__ void final_norm_phase(const Ctx& p) {
    const int tid_ = opaque_tid(), lane = tid_ & 63, wave = tid_ >> 6, gw = blockIdx.x * 8 + wave, NGW = gridDim.x * 8;
    const float* X = (const float*)(p.ws + WS_X); const float* gsrc = inp(p.ws, I_FNORM);
    f32x4 gv[4];
#pragma unroll
    for (int j = 0; j < 4; ++j) gv[j] = *(const f32x4*)(gsrc + j * 256 + lane * 4);
    constexpr int NR = 4;
    for (int row0 = gw * NR; row0 < M_TOT; row0 += NGW * NR) {
        f32x4 v[NR][4]; float s[NR];
#pragma unroll
        for (int r = 0; r < NR; ++r) { const float* xr = X + (size_t)(row0 + r) * DM;
#pragma unroll
            for (int j = 0; j < 4; ++j) v[r][j] = *(const f32x4*)(xr + j * 256 + lane * 4); }
#pragma unroll
        for (int r = 0; r < NR; ++r) { float a = 0.f;
#pragma unroll
            for (int j = 0; j < 4; ++j) a += (v[r][j][0] * v[r][j][0] + v[r][j][1] * v[r][j][1]) + (v[r][j][2] * v[r][j][2] + v[r][j][3] * v[r][j][3]);
            s[r] = a; }
#pragma unroll
        for (int o = 1; o < 64; o <<= 1) {
#pragma unroll
            for (int r = 0; r < NR; ++r) s[r] += __shfl_xor(s[r], o);
        }
#pragma unroll
        for (int r = 0; r < NR; ++r) { const float rstd = rsqrtf(s[r] * (1.f / DM) + EPSF);
#pragma unroll
            for (int j = 0; j < 4; ++j) __builtin_nontemporal_store((v[r][j] * rstd) * gv[j], (f32x4*)(p.out + O_Y + (size_t)(row0 + r) * DM + j * 256 + lane * 4)); }
    }
}

__device__ __forceinline__ void mixprep_phase(const Ctx& p, LAS unsigned char* lds, int l) {
    const int tid = opaque_tid(), G = gridDim.x;
    bf16_t* PROJ = (bf16_t*)(p.ws + WS_PROJ); bf16_t* TR = (bf16_t*)(p.ws + WS_TR);
    {
        const int lane = tid & 63, wave = tid >> 6, gw = blockIdx.x * 8 + wave, NGW = G * 8;
        LAS float* T = (LAS float*)(lds + wave * 17168);
        const float* sw = inp(p.ws, I_HSW) + (size_t)l * 3 * 768; const float* sb = inp(p.ws, I_HSB) + (size_t)l * 768;
        const int lr = lane >> 3, lc = lane & 7;
        for (int it = gw; it < 320 * 22; it += NGW) {
            const int cb = it % 22, rb = it / 22, row0 = rb * 64, tcol0 = cb * 64;
            int src; bool hy = false;
            if (tcol0 < 256) src = 512 + tcol0; else if (tcol0 < 384) src = 1152 + (tcol0 - 256); else if (tcol0 < 640) src = 2560 + (tcol0 - 384); else { src = 1280 + (tcol0 - 640); hy = true; }
            const bool seq_start = row0 < M_CTX ? ((row0 & 255) == 0) : (((row0 - M_CTX) & 2047) == 0);
            const int rend = row0 + 64; const bool seq_end = rend <= M_CTX ? ((rend & 255) == 0) : (((rend - M_CTX) & 2047) == 0);
            const bf16_t* sp = PROJ + (size_t)row0 * PROJW + src + lc * 8;
            u32x4 w[8], wh = (u32x4){0u, 0u, 0u, 0u};
#pragma unroll
            for (int i = 0; i < 8; ++i) w[i] = *(const u32x4*)(sp + (size_t)(i * 8 + lr) * PROJW);
            if (hy && lane < 16) { const bool top = lane < 8; const bool ok = top ? !seq_start : !seq_end;
                if (ok) wh = *(const u32x4*)(sp + (top ? -(ptrdiff_t)PROJW : (ptrdiff_t)64 * PROJW)); }
#pragma unroll
            for (int i = 0; i < 8; ++i) { LAS float* d = T + (1 + i * 8 + lr) * 65 + lc * 8;
                d[0] = bflo(w[i].x); d[1] = bfhi(w[i].x); d[2] = bflo(w[i].y); d[3] = bfhi(w[i].y); d[4] = bflo(w[i].z); d[5] = bfhi(w[i].z); d[6] = bflo(w[i].w); d[7] = bfhi(w[i].w); }
            if (hy && lane < 16) { LAS float* d = T + (lane < 8 ? 0 : 65) * 65 + lc * 8;
                d[0] = bflo(wh.x); d[1] = bfhi(wh.x); d[2] = bflo(wh.y); d[3] = bfhi(wh.y); d[4] = bflo(wh.z); d[5] = bfhi(wh.z); d[6] = bflo(wh.w); d[7] = bfhi(wh.w); }
            asm volatile("s_waitcnt lgkmcnt(0)" ::: "memory");
            const int rg = lane & 7, csub = lane >> 3;
#pragma unroll 2
            for (int j = 0; j < 8; ++j) {
                const int col = j * 8 + csub; float o[8];
                const LAS float* tp = T + (rg * 8) * 65 + col;
                if (hy) { const int ch = tcol0 - 640 + col; const float w0 = sw[ch], w1 = sw[768 + ch], w2 = sw[1536 + ch], bb = sb[ch];
                    float x[10];
#pragma unroll
                    for (int k = 0; k < 10; ++k) x[k] = tp[k * 65];
#pragma unroll
                    for (int k = 0; k < 8; ++k) o[k] = x[k] * w0 + x[k + 1] * w1 + x[k + 2] * w2 + bb;
                } else {
#pragma unroll
                    for (int k = 0; k < 8; ++k) o[k] = tp[(k + 1) * 65];
                }
                u32x4 ww; ww.x = cvt_pk_bf16(o[0], o[1]); ww.y = cvt_pk_bf16(o[2], o[3]); ww.z = cvt_pk_bf16(o[4], o[5]); ww.w = cvt_pk_bf16(o[6], o[7]);
                *(u32x4*)(TR + (size_t)(tcol0 + col) * M_TOT + row0 + rg * 8) = ww;
            }
            asm volatile("s_waitcnt lgkmcnt(0)" ::: "memory");
        }
    }
    const int gt = blockIdx.x * 512 + tid, NT = G * 512;
    for (int it = gt; it < M_CTX * 160; it += NT) {
        const int row = it / 160, ch = it - row * 160; int pc, H; size_t ob; int c8;
        if (ch < 32) { pc = 256; H = 4; ob = O_NAK; c8 = ch * 8; }
        else if (ch < 64) { pc = 512; H = 4; ob = O_NAV; c8 = (ch - 32) * 8; }
        else if (ch < 80) { pc = 1024; H = 2; ob = O_SWK; c8 = (ch - 64) * 8; }
        else if (ch < 96) { pc = 1152; H = 2; ob = O_SWV; c8 = (ch - 80) * 8; }
        else if (ch < 128) { pc = 2304; H = 4; ob = O_DFK; c8 = (ch - 96) * 8; }
        else { pc = 2560; H = 4; ob = O_DFV; c8 = (ch - 128) * 8; }
        const u32x4 w = *(const u32x4*)(PROJ + (size_t)row * PROJW + pc + c8);
        const int b = row >> 8, t = row & 255, h = c8 >> 6, d = c8 & 63;
        float* o = p.out + ob + ((((size_t)(b * 4 + l) * H + h) * 256 + t) * 64 + d);
        __builtin_nontemporal_store((f32x4){bflo(w.x), bfhi(w.x), bflo(w.y), bfhi(w.y)}, (f32x4*)o); __builtin_nontemporal_store((f32x4){bflo(w.z), bfhi(w.z), bflo(w.w), bfhi(w.w)}, (f32x4*)(o + 4));
    }
    for (int it = gt; it < M_DEC * 56; it += NT) {
        const int rowd = it / 56, q = it - rowd * 56, t = rowd & 2047, gr = t >> 6, gc = t & 63;
        int a, bofs, i0; float pos, fstep;
        if (q < 24) {
            const int base = q < 16 ? 768 : 1024, qq = q < 16 ? q : q - 16, h = qq >> 2, half = (qq >> 1) & 1, grp = qq & 1;
            a = base + h * 64 + half * 32 + grp * 8; bofs = 16; i0 = grp * 8; pos = half ? (float)gc : (float)gr; fstep = 13.287712379549449f / 16.f;
        } else {
            const int base = q < 40 ? 2048 : 2304, qq = q < 40 ? q - 24 : q - 40, mp32 = qq >> 1, half = qq & 1;
            a = base + mp32 * 32 + half * 16; bofs = 8; i0 = 0; pos = half ? (float)gc : (float)gr; fstep = 13.287712379549449f / 8.f;
        }
        bf16_t* pa = PROJ + (size_t)(M_CTX + rowd) * PROJW + a;
        const u32x4 wa = *(const u32x4*)pa, wb = *(const u32x4*)(pa + bofs);
        float xa[8], xb[8];
        xa[0] = bflo(wa.x); xa[1] = bfhi(wa.x); xa[2] = bflo(wa.y); xa[3] = bfhi(wa.y); xa[4] = bflo(wa.z); xa[5] = bfhi(wa.z); xa[6] = bflo(wa.w); xa[7] = bfhi(wa.w);
        xb[0] = bflo(wb.x); xb[1] = bfhi(wb.x); xb[2] = bflo(wb.y); xb[3] = bfhi(wb.y); xb[4] = bflo(wb.z); xb[5] = bfhi(wb.z); xb[6] = bflo(wb.w); xb[7] = bfhi(wb.w);
        float oa[8], ob[8];
#pragma unroll
        for (int j = 0; j < 8; ++j) { const float ang = pos * fast_exp2(-(float)(i0 + j) * fstep); const float cs = __cosf(ang), sn = __sinf(ang);
            oa[j] = xa[j] * cs - xb[j] * sn; ob[j] = xb[j] * cs + xa[j] * sn; }
        u32x4 ra, rb;
        ra.x = cvt_pk_bf16(oa[0], oa[1]); ra.y = cvt_pk_bf16(oa[2], oa[3]); ra.z = cvt_pk_bf16(oa[4], oa[5]); ra.w = cvt_pk_bf16(oa[6], oa[7]);
        rb.x = cvt_pk_bf16(ob[0], ob[1]); rb.y = cvt_pk_bf16(ob[2], ob[3]); rb.z = cvt_pk_bf16(ob[4], ob[5]); rb.w = cvt_pk_bf16(ob[6], ob[7]);
        *(u32x4*)pa = ra; *(u32x4*)(pa + bofs) = rb;
    }
}

struct AttnState { float m, l; f32x4 o[4]; };
__device__ __forceinline__ f32x4 mfma16(bf16x8 a, bf16x8 b, f32x4 c) { return __builtin_amdgcn_mfma_f32_16x16x32_bf16(a, b, c, 0, 0, 0); }

__device__ __forceinline__ float xmax16(float x) { const u32x2 r = __builtin_amdgcn_permlane16_swap(__float_as_uint(x), __float_as_uint(x), false, false); return fmaxf(__uint_as_float(r.x), __uint_as_float(r.y)); }
__device__ __forceinline__ float xmax32(float x) { const u32x2 r = __builtin_amdgcn_permlane32_swap(__float_as_uint(x), __float_as_uint(x), false, false); return fmaxf(__uint_as_float(r.x), __uint_as_float(r.y)); }
__device__ __forceinline__ float xadd16(float x) { const u32x2 r = __builtin_amdgcn_permlane16_swap(__float_as_uint(x), __float_as_uint(x), false, false); return __uint_as_float(r.x) + __uint_as_float(r.y); }
__device__ __forceinline__ float xadd32(float x) { const u32x2 r = __builtin_amdgcn_permlane32_swap(__float_as_uint(x), __float_as_uint(x), false, false); return __uint_as_float(r.x) + __uint_as_float(r.y); }
__device__ __forceinline__ void softmax_d16(AttnState& st, float (&s)[16], bool first, float& alpha, bool& resc, bf16x8& p0, bf16x8& p1) {
    float mx = fmaxf(fmaxf(fmaxf(s[0], s[1]), fmaxf(s[2], s[3])), fmaxf(fmaxf(s[4], s[5]), fmaxf(s[6], s[7])));
    mx = fmaxf(mx, fmaxf(fmaxf(fmaxf(s[8], s[9]), fmaxf(s[10], s[11])), fmaxf(fmaxf(s[12], s[13]), fmaxf(s[14], s[15]))));
    resc = first || (__builtin_amdgcn_ballot_w64(mx > 8.f) != 0ull);
    alpha = 1.f;
    if (resc) {
        mx = xmax16(mx); mx = xmax32(mx);
        const float d = first ? mx : fmaxf(mx, 0.f);
        alpha = first ? 0.f : fast_exp2(-d);
        st.m = first ? mx : st.m + d;
#pragma unroll
        for (int j = 0; j < 16; ++j) s[j] -= d;
    }
    float pr[16];
#pragma unroll
    for (int j = 0; j < 16; ++j) pr[j] = fast_exp2(s[j]);
    float sum = (((pr[0] + pr[1]) + (pr[2] + pr[3])) + ((pr[4] + pr[5]) + (pr[6] + pr[7]))) + (((pr[8] + pr[9]) + (pr[10] + pr[11])) + ((pr[12] + pr[13]) + (pr[14] + pr[15])));
    sum = xadd16(sum); sum = xadd32(sum);
    st.l = st.l * alpha + sum;
    u32x4 w0, w1;
    w0.x = cvt_pk_bf16(pr[0], pr[1]); w0.y = cvt_pk_bf16(pr[2], pr[3]); w0.z = cvt_pk_bf16(pr[4], pr[5]); w0.w = cvt_pk_bf16(pr[6], pr[7]);
    w1.x = cvt_pk_bf16(pr[8], pr[9]); w1.y = cvt_pk_bf16(pr[10], pr[11]); w1.z = cvt_pk_bf16(pr[12], pr[13]); w1.w = cvt_pk_bf16(pr[14], pr[15]);
    p0 = __builtin_bit_cast(bf16x8, w0); p1 = __builtin_bit_cast(bf16x8, w1);
}
__device__ __forceinline__ bf16x8 softmax_p(AttnState& st, const float (&s2)[8], unsigned vm, float& alpha) {
    float mx = -1e30f;
#pragma unroll
    for (int j = 0; j < 8; ++j) mx = fmaxf(mx, ((vm >> j) & 1u) ? s2[j] : -1e30f);
    mx = xmax16(mx); mx = xmax32(mx);
    const float mn = fmaxf(st.m, mx); alpha = fast_exp2(st.m - mn);
    float pr[8]; float sum = 0.f;
#pragma unroll
    for (int j = 0; j < 8; ++j) { pr[j] = ((vm >> j) & 1u) ? fast_exp2(s2[j] - mn) : 0.f; sum += pr[j]; }
    sum += __shfl_xor(sum, 16); sum += __shfl_xor(sum, 32);
    st.l = st.l * alpha + sum; st.m = mn;
    u32x4 pw; pw.x = cvt_pk_bf16(pr[0], pr[1]); pw.y = cvt_pk_bf16(pr[2], pr[3]); pw.z = cvt_pk_bf16(pr[4], pr[5]); pw.w = cvt_pk_bf16(pr[6], pr[7]);
    return __builtin_bit_cast(bf16x8, pw);
}
__device__ __forceinline__ bf16x8 softmax_d(AttnState& st, const float (&s2)[8], float& alpha, bool& resc) {
    float mx = fmaxf(fmaxf(fmaxf(s2[0], s2[1]), fmaxf(s2[2], s2[3])), fmaxf(fmaxf(s2[4], s2[5]), fmaxf(s2[6], s2[7])));
    mx = fmaxf(mx, __shfl_xor(mx, 16)); mx = fmaxf(mx, __shfl_xor(mx, 32));
    const float mn = fmaxf(st.m, mx);
    resc = __builtin_amdgcn_ballot_w64(mn > st.m) != 0ull;
    alpha = fast_exp2(st.m - mn);
    float pr[8];
#pragma unroll
    for (int j = 0; j < 8; ++j) pr[j] = fast_exp2(s2[j] - mn);
    float sum = ((pr[0] + pr[1]) + (pr[2] + pr[3])) + ((pr[4] + pr[5]) + (pr[6] + pr[7]));
    sum = xadd16(sum); sum = xadd32(sum);
    st.l = st.l * alpha + sum; st.m = mn;
    u32x4 pw; pw.x = cvt_pk_bf16(pr[0], pr[1]); pw.y = cvt_pk_bf16(pr[2], pr[3]); pw.z = cvt_pk_bf16(pr[4], pr[5]); pw.w = cvt_pk_bf16(pr[6], pr[7]);
    return __builtin_bit_cast(bf16x8, pw);
}
__device__ __forceinline__ void st_init(AttnState& st, float m0, float l0) { st.m = m0; st.l = l0;
#pragma unroll
    for (int i = 0; i < 4; ++i) st.o[i] = (f32x4){0.f, 0.f, 0.f, 0.f}; }

constexpr int AT_ROWB = 144;
constexpr int AT_TILEB = 64 * AT_ROWB;
struct ATC { int l15, quad, kr0, lat0, nlat, rs_w, r_w; int cg4[2], qc[2], c0[2], qt[2], q0[2]; bool dec; const float* rpb; };

template <int TYPE>
__device__ __forceinline__ void attn_tile(AttnState (&sa)[2], AttnState (&sb)[2], const bf16x8 (&qf)[2][2], const ATC& c, const LAS unsigned char* kt, const LAS unsigned char* vt, int i) {
    const bool masked = c.dec && (i < c.nlat) && (TYPE != 2);
    if (TYPE == 0 && masked) { const int krow = c.lat0 + i; if (!((krow >= c.rs_w) && (krow < c.rs_w + 8))) return; }
    const f32x4 z4 = (f32x4){0.f, 0.f, 0.f, 0.f};
    if (!masked) {
        bf16x8 pA[2][2], pB[2][2]; float alA[2], alB[2]; bool rA[2], rB[2];
        const bool first = (TYPE != 1) && (i == 0);
        if (TYPE == 2) {
#pragma unroll
            for (int qi = 0; qi < 2; ++qi)
#pragma unroll
                for (int mp = 0; mp < 2; ++mp) {
                    float s2[16];
#pragma unroll
                    for (int ss = 0; ss < 2; ++ss)
#pragma unroll
                        for (int t = 0; t < 2; ++t) { const int kr = ss * 32 + c.kr0 + 4 * t, sw = ((kr >> 4) & 1) << 2;
                            const bf16x8 kf = *(const LAS bf16x8*)(kt + kr * AT_ROWB + (((mp * 4 + c.quad) ^ sw) << 4));
                            const float nm = first ? 0.f : -(mp == 0 ? sa[qi].m : sb[qi].m);
                            const f32x4 a = mfma16(kf, qf[qi][mp], (f32x4){nm, nm, nm, nm});
#pragma unroll
                            for (int e = 0; e < 4; ++e) s2[ss * 8 + t * 4 + e] = a[e]; }
                    if (mp == 0) softmax_d16(sa[qi], s2, first, alA[qi], rA[qi], pA[qi][0], pA[qi][1]); else softmax_d16(sb[qi], s2, first, alB[qi], rB[qi], pB[qi][0], pB[qi][1]);
                    asm volatile("" ::: "memory");
                }
        } else {
            bf16x8 kf[2][2][2];
#pragma unroll
            for (int ss = 0; ss < 2; ++ss)
#pragma unroll
                for (int t = 0; t < 2; ++t) { const int kr = ss * 32 + c.kr0 + 4 * t, sw = ((kr >> 4) & 1) << 2;
#pragma unroll
                    for (int cc = 0; cc < 2; ++cc) kf[ss][t][cc] = *(const LAS bf16x8*)(kt + kr * AT_ROWB + (((cc * 4 + c.quad) ^ sw) << 4)); }
#pragma unroll
            for (int qi = 0; qi < 2; ++qi) {
                float s2[16];
#pragma unroll
                for (int ss = 0; ss < 2; ++ss)
#pragma unroll
                    for (int t = 0; t < 2; ++t) { const float nm = first ? 0.f : -sa[qi].m; f32x4 a = mfma16(kf[ss][t][0], qf[qi][0], (f32x4){nm, nm, nm, nm}); a = mfma16(kf[ss][t][1], qf[qi][1], a);
#pragma unroll
                        for (int e = 0; e < 4; ++e) s2[ss * 8 + t * 4 + e] = a[e]; }
                softmax_d16(sa[qi], s2, first, alA[qi], rA[qi], pA[qi][0], pA[qi][1]);
            }
        }
#pragma unroll
        for (int qi = 0; qi < 2; ++qi) {
            if (rA[qi]) {
#pragma unroll
                for (int nt = 0; nt < 4; ++nt) sa[qi].o[nt] = sa[qi].o[nt] * alA[qi]; }
            if (TYPE == 2) { if (rB[qi]) {
#pragma unroll
                for (int nt = 0; nt < 4; ++nt) sb[qi].o[nt] = sb[qi].o[nt] * alB[qi]; } }
        }
#pragma unroll
        for (int ss = 0; ss < 2; ++ss) {
            bf16x8 vf[4];
#pragma unroll
            for (int nt = 0; nt < 4; ++nt) vf[nt] = *(const LAS bf16x8*)(vt + (nt * 16 + c.l15) * AT_ROWB + ss * 64 + (c.quad << 4));
#pragma unroll
            for (int qi = 0; qi < 2; ++qi)
#pragma unroll
                for (int nt = 0; nt < 4; ++nt) { sa[qi].o[nt] = mfma16(vf[nt], pA[qi][ss], sa[qi].o[nt]); if (TYPE == 2) sb[qi].o[nt] = mfma16(vf[nt], pB[qi][ss], sb[qi].o[nt]); }
        }
        return;
    }
#pragma unroll 1
    for (int ss = 0; ss < 2; ++ss) {
        bool on[2];
#pragma unroll
        for (int qi = 0; qi < 2; ++qi) {
            on[qi] = true;
            if (TYPE == 0) on[qi] = !((c.cg4[qi] == 0 && ss == 1) || (c.cg4[qi] == 3 && ss == 0));
            if (TYPE == 1) { const int k0 = (c.lat0 + i) * 64 + ss * 32; on[qi] = (k0 + 31 >= c.q0[qi] - 128) && (k0 <= c.q0[qi] + 15 + 128); }
        }
        if (on[0] || on[1]) {
            const int krA = ss * 32 + c.kr0, krB = krA + 4;
            const int swA = ((krA >> 4) & 1) << 2, swB = ((krB >> 4) & 1) << 2;
            bf16x8 kf[2][2];
#pragma unroll
            for (int cc = 0; cc < 2; ++cc) { kf[0][cc] = *(const LAS bf16x8*)(kt + krA * AT_ROWB + (((cc * 4 + c.quad) ^ swA) << 4)); kf[1][cc] = *(const LAS bf16x8*)(kt + krB * AT_ROWB + (((cc * 4 + c.quad) ^ swB) << 4)); }
            bf16x8 vf[4];
#pragma unroll
            for (int nt = 0; nt < 4; ++nt) vf[nt] = *(const LAS bf16x8*)(vt + (nt * 16 + c.l15) * AT_ROWB + ss * 64 + (c.quad << 4));
#pragma unroll
            for (int qi = 0; qi < 2; ++qi) {
                if (on[qi]) {
                    f32x4 a0 = mfma16(kf[0][0], qf[qi][0], z4), a1 = mfma16(kf[1][0], qf[qi][0], z4); a0 = mfma16(kf[0][1], qf[qi][1], a0); a1 = mfma16(kf[1][1], qf[qi][1], a1);
                    float s2[8]; unsigned vm = 0u;
#pragma unroll
                    for (int e = 0; e < 4; ++e) { s2[e] = a0[e]; s2[4 + e] = a1[e]; }
                    if (TYPE == 0) {
                        const float* rp = c.rpb + (c.lat0 + i - c.r_w + 7) * 31;
#pragma unroll
                        for (int j = 0; j < 8; ++j) { const int kc = ss * 32 + c.quad * 8 + j; const bool ok = (kc >= c.c0[qi]) && (kc < c.c0[qi] + 16);
                            const int dc = min(max(kc - c.qc[qi] + 15, 0), 30); s2[j] = s2[j] + rp[dc] * LOG2E; vm |= ok ? (1u << j) : 0u; }
                    } else {
#pragma unroll
                        for (int j = 0; j < 8; ++j) { const int dd = (c.lat0 + i) * 64 + ss * 32 + c.quad * 8 + j - c.qt[qi]; const bool ok = (dd <= 128) && (dd >= -128); vm |= ok ? (1u << j) : 0u; }
                    }
                    float al; const bf16x8 pA = softmax_p(sa[qi], s2, vm, al);
#pragma unroll
                    for (int nt = 0; nt < 4; ++nt) sa[qi].o[nt] = mfma16(vf[nt], pA, sa[qi].o[nt] * al);
                }
            }
        }
    }
}

template <int TYPE>
__device__ __forceinline__ void attn_block(const Ctx& p, LAS unsigned char* lds, int l, bool dec, int b, int h, int qblk) {
    const int tid = opaque_tid(), lane = tid & 63, wave = __builtin_amdgcn_readfirstlane(tid >> 6);
    ATC c; c.l15 = lane & 15; c.quad = lane >> 4; c.dec = dec;
    const bf16_t* PROJ = (const bf16_t*)(p.ws + WS_PROJ); const bf16_t* TR = (const bf16_t*)(p.ws + WS_TR);
    const bf16_t* CK = (const bf16_t*)(p.ws + WS_CK); const bf16_t* CV = CK + CK_HALF;
    bf16_t* BR = (bf16_t*)(p.ws + WS_BR);
    const int L = dec ? 2048 : 256, rowbase = dec ? M_CTX + b * 2048 : b * 256, q0 = qblk * 256 + wave * 32;
    const bf16_t* Pb = PROJ + (size_t)rowbase * PROJW;
    LAS unsigned char* KL = lds; LAS unsigned char* VL = lds + 2 * AT_TILEB;
    int qcol, kcol, vcol, hk, Hc; size_t ckoff;
    if (TYPE == 0) { qcol = h * 64; kcol = 256 + h * 64; vcol = h * 64; hk = h; Hc = 4; ckoff = CK_NA; }
    else if (TYPE == 1) { qcol = 768 + h * 64; kcol = 1024 + (h >> 1) * 64; vcol = 256 + (h >> 1) * 64; hk = h >> 1; Hc = 2; ckoff = CK_SW; }
    else { qcol = 2048 + h * 64; kcol = 2304 + h * 64; vcol = 384 + h * 64; hk = h; Hc = 4; ckoff = CK_DF; }
    const int ncache = dec ? 8 : 0;
    c.rs_w = 0; c.r_w = 0;
    int cgb = 0;
    if (!dec) { c.lat0 = 0; c.nlat = 4; }
    else if (TYPE == 0) { const int r0 = qblk * 4; const int rsA = min(max(r0 - 4, 0), 24), rsB = min(max(r0 - 1, 0), 24); c.lat0 = rsA; c.nlat = rsB + 8 - rsA;
        c.r_w = r0 + (wave >> 1); c.rs_w = min(max(c.r_w - 4, 0), 24); cgb = (wave & 1) * 2; }
    else if (TYPE == 1) { const int q0b = qblk * 256; c.lat0 = max(q0b - 128, 0) >> 6; c.nlat = (min(q0b + 384, L) >> 6) - c.lat0; }
    else { c.lat0 = 0; c.nlat = 32; }
#pragma unroll
    for (int qi = 0; qi < 2; ++qi) { c.cg4[qi] = cgb + qi; c.q0[qi] = q0 + 16 * qi; c.qt[qi] = q0 + 16 * qi + c.l15; c.qc[qi] = c.cg4[qi] * 16 + c.l15; c.c0[qi] = min(max(c.qc[qi] - 8, 0), 48); }
    const int ntile = c.nlat + ncache;
    const int srow = tid >> 3, sch = tid & 7;
    const int kst_off = srow * AT_ROWB + ((sch ^ (((srow >> 4) & 1) << 2)) << 4), vst_off = srow * AT_ROWB + (sch << 4);
    const bf16_t* klat = Pb + kcol + (size_t)(c.lat0 * 64 + srow) * PROJW + sch * 8;
    const bf16_t* vlat = TR + (size_t)(vcol + srow) * M_TOT + rowbase + c.lat0 * 64 + sch * 8;
    const bf16_t* kcac = CK + ckoff + ((size_t)(b * Hc + hk) * 512 + srow) * 64 + sch * 8;
    const bf16_t* vcac = CV + ckoff + ((size_t)(b * Hc + hk) * 64 + srow) * 512 + sch * 8;
    c.kr0 = (c.l15 >> 2) * 8 + (c.l15 & 3);
    bf16x8 qf[2][2];
    AttnState sa[2], sb[2];
    float sc2, m0, l0;
    if (TYPE == 1) { m0 = inp(p.ws, I_SINK)[l * 4 + h] * LOG2E; l0 = 1.f; sc2 = 0.125f * LOG2E; }
    else if (TYPE == 0) { m0 = -1e30f; l0 = 0.f; sc2 = 0.125f * LOG2E; }
    else { m0 = -1e30f; l0 = 0.f; sc2 = 0.17677669529663687f * LOG2E; }
#pragma unroll
    for (int qi = 0; qi < 2; ++qi) {
        st_init(sa[qi], m0, l0); st_init(sb[qi], -1e30f, 0.f);
        const size_t qrow = (size_t)(q0 + 16 * qi + c.l15) * PROJW;
        const u32x4 q0w = *(const u32x4*)(Pb + qrow + qcol + c.quad * 8), q1w = *(const u32x4*)(Pb + qrow + qcol + 32 + c.quad * 8);
        u32x4 a, bq;
        a.x = cvt_pk_bf16(bflo(q0w.x) * sc2, bfhi(q0w.x) * sc2); a.y = cvt_pk_bf16(bflo(q0w.y) * sc2, bfhi(q0w.y) * sc2); a.z = cvt_pk_bf16(bflo(q0w.z) * sc2, bfhi(q0w.z) * sc2); a.w = cvt_pk_bf16(bflo(q0w.w) * sc2, bfhi(q0w.w) * sc2);
        bq.x = cvt_pk_bf16(bflo(q1w.x) * sc2, bfhi(q1w.x) * sc2); bq.y = cvt_pk_bf16(bflo(q1w.y) * sc2, bfhi(q1w.y) * sc2); bq.z = cvt_pk_bf16(bflo(q1w.z) * sc2, bfhi(q1w.z) * sc2); bq.w = cvt_pk_bf16(bflo(q1w.w) * sc2, bfhi(q1w.w) * sc2);
        qf[qi][0] = __builtin_bit_cast(bf16x8, a); qf[qi][1] = __builtin_bit_cast(bf16x8, bq);
    }
    c.rpb = inp(p.ws, I_RPB) + ((size_t)(l * 4 + h)) * 15 * 31;
#define AT_KSRC(n) (((n) < c.nlat) ? klat + (size_t)(n) * 64 * PROJW : kcac + (size_t)((n) - c.nlat) * 4096)
#define AT_VSRC(n) (((n) < c.nlat) ? vlat + (n) * 64 : vcac + ((n) - c.nlat) * 64)
    u32x4 kA, vA, kB, vB;
    kA = *(const u32x4*)AT_KSRC(0); vA = *(const u32x4*)AT_VSRC(0);
    { const int n1 = min(1, ntile - 1); kB = *(const u32x4*)AT_KSRC(n1); vB = *(const u32x4*)AT_VSRC(n1); }
    *(LAS u32x4*)(KL + kst_off) = kA; *(LAS u32x4*)(VL + vst_off) = vA;
    __syncthreads();
#pragma unroll 1
    for (int i = 0; i < ntile; i += 2) {
        { const int n2 = min(i + 2, ntile - 1); kA = *(const u32x4*)AT_KSRC(n2); vA = *(const u32x4*)AT_VSRC(n2); }
        attn_tile<TYPE>(sa, sb, qf, c, KL, VL, i);
        *(LAS u32x4*)(KL + AT_TILEB + kst_off) = kB; *(LAS u32x4*)(VL + AT_TILEB + vst_off) = vB;
        __syncthreads();
        if (i + 1 >= ntile) break;
        { const int n3 = min(i + 3, ntile - 1); kB = *(const u32x4*)AT_KSRC(n3); vB = *(const u32x4*)AT_VSRC(n3); }
        attn_tile<TYPE>(sa, sb, qf, c, KL + AT_TILEB, VL + AT_TILEB, i + 1);
        *(LAS u32x4*)(KL + kst_off) = kA; *(LAS u32x4*)(VL + vst_off) = vA;
        __syncthreads();
    }
#undef AT_KSRC
#undef AT_VSRC
#pragma unroll
    for (int qi = 0; qi < 2; ++qi) {
        const size_t orow = (size_t)(rowbase + q0 + 16 * qi + c.l15) * 256 + h * 64 + c.quad * 4;
        if (TYPE != 2) {
            const float il = fast_rcp(sa[qi].l);
            bf16_t* o = BR + (TYPE == 1 ? (size_t)M_TOT * 256 : 0) + orow;
#pragma unroll
            for (int nt = 0; nt < 4; ++nt) { u32x2 w; w.x = cvt_pk_bf16(sa[qi].o[nt][0] * il, sa[qi].o[nt][1] * il); w.y = cvt_pk_bf16(sa[qi].o[nt][2] * il, sa[qi].o[nt][3] * il); *(u32x2*)(o + nt * 16) = w; }
        } else {
            const float lam = ((const float*)(p.ws + WS_LAM))[l], lam_init = ((const float*)(p.ws + WS_LAM))[4 + l];
            const float i0 = fast_rcp(sa[qi].l), i1 = lam * fast_rcp(sb[qi].l);
            f32x4 d[4]; float ss = 0.f;
#pragma unroll
            for (int i = 0; i < 4; ++i) { d[i] = sa[qi].o[i] * i0 - sb[qi].o[i] * i1; ss += (d[i][0] * d[i][0] + d[i][1] * d[i][1]) + (d[i][2] * d[i][2] + d[i][3] * d[i][3]); }
            ss = xadd16(ss); ss = xadd32(ss);
            const float rs = rsqrtf(ss * (1.f / 64.f) + EPSF) * (1.f - lam_init);
            const float* sg = inp(p.ws, I_DSUB) + l * 64 + c.quad * 4;
            bf16_t* o = BR + (size_t)3 * M_TOT * 256 + orow;
#pragma unroll
            for (int nt = 0; nt < 4; ++nt) { const f32x4 g4 = *(const f32x4*)(sg + nt * 16); const f32x4 v = d[nt] * rs * g4;
                u32x2 w; w.x = cvt_pk_bf16(v[0], v[1]); w.y = cvt_pk_bf16(v[2], v[3]); *(u32x2*)(o + nt * 16) = w; }
        }
    }
}

__device__ __forceinline__ void hyena_unit(const Ctx& p, LAS unsigned char* lds, int l, int c, bool dec) {
    const int tid = opaque_tid(), lane = tid & 63, wave = __builtin_amdgcn_readfirstlane(tid >> 6), l15 = lane & 15, quad = lane >> 4;
    const int L = dec ? 2048 : 256, B = dec ? 8 : 16, LP = L + 8, rowbase = dec ? M_CTX : 0, L2 = 2 * L, CS = L2 + 16;
    LAS bf16_t* COP = (LAS bf16_t*)lds;
    LAS bf16_t* YA = (LAS bf16_t*)(lds + 66048);
    LAS bf16_t* YB = (LAS bf16_t*)(lds + 66048 + 33024);
    LAS float* RED = (LAS float*)(lds + 66048 + 2 * 33024);
    const bf16_t* TR = (const bf16_t*)(p.ws + WS_TR);
    bf16_t* BR2 = (bf16_t*)(p.ws + WS_BR) + (size_t)2 * M_TOT * 256;
    const float* HF = (const float*)(p.ws + WS_HFIL) + (dec ? 262144 : 0);
    { const bf16_t* src = TR + (size_t)(640 + c) * M_TOT + rowbase;
      for (int i = tid; i < B * L / 8; i += 512) { const int e = i * 8, b = e / L, t = e - b * L; *(LAS u32x4*)(YA + b * LP + t) = *(const u32x4*)(src + e); } }
#pragma unroll 1
    for (int o = 0; o < 2; ++o) {
        LAS float* RF = (LAS float*)(o == 0 ? YB : YA);
        __syncthreads();
        const float* raw0 = HF + ((size_t)((o * 2 + 0) * 256 + c)) * L; const float* raw1 = HF + ((size_t)((o * 2 + 1) * 256 + c)) * L;
        float part = 0.f;
        for (int u = tid; u < L2; u += 512) { const int lag = L - 1 - u; float v = 0.f; if (lag >= 0) v = raw0[lag]; else if (lag > -L) v = raw1[-lag]; RF[u] = v; part += fabsf(v); }
        part = wave_sum(part);
        if (lane == 0) RED[wave] = part;
        __syncthreads();
        float tot = 0.f;
#pragma unroll
        for (int w = 0; w < 8; ++w) tot += RED[w];
        const float inv = 1.f / (tot + EPSF);
        const int ng = L2 / 8;
        for (int idx = tid; idx < 8 * ng; idx += 512) { const int m = idx / ng, x = (idx - m * ng) * 8; float v[8];
#pragma unroll
            for (int j = 0; j < 8; ++j) { const int u = x + m + j; v[j] = (u < L2) ? RF[u] * inv : 0.f; }
            u32x4 w; w.x = cvt_pk_bf16(v[0], v[1]); w.y = cvt_pk_bf16(v[2], v[3]); w.z = cvt_pk_bf16(v[4], v[5]); w.w = cvt_pk_bf16(v[6], v[7]);
            *(LAS u32x4*)(COP + m * CS + x) = w; }
        __syncthreads();
        const LAS bf16_t* Y = (o == 0) ? YA : YB;
        const LAS bf16_t* cpb = COP + (7 - (l15 & 7)) * CS + (L - 8 - 8 * (l15 >> 3) + quad * 8);
        const float skip = inp(p.ws, I_HSKIP)[(l * 2 + o) * 256 + c];
        const bf16_t* gate = TR + (size_t)((o == 0 ? 896 : 1152) + c) * M_TOT + rowbase;
        const int ngroups = L / 64;
        const bf16x8 zero8 = (bf16x8){0, 0, 0, 0, 0, 0, 0, 0};
        for (int g = wave; g < ngroups; g += 8) {
            const int t0 = (g >> 1) * 128 + (g & 1) * 16;
            f32x4 a0 = (f32x4){0.f, 0.f, 0.f, 0.f}, a1 = a0, a2 = a0, a3 = a0;
#define HY_D(s) (*(const LAS bf16x8*)(cpb + (32 * (s) - t0)))
#define HY_Y(s) ((l15 < B) ? *(const LAS bf16x8*)(Y + l15 * LP + 32 * (s) + quad * 8) : zero8)
            bf16x8 d0, d1 = HY_D(-1), d2 = HY_D(-2), d3 = HY_D(-3), y;
            for (int s = 0; s < L / 32; s += 4) {
                d0 = HY_D(s);     y = HY_Y(s);     a0 = mfma16(d0, y, a0); a1 = mfma16(d1, y, a1); a2 = mfma16(d2, y, a2); a3 = mfma16(d3, y, a3);
                d3 = HY_D(s + 1); y = HY_Y(s + 1); a0 = mfma16(d3, y, a0); a1 = mfma16(d0, y, a1); a2 = mfma16(d1, y, a2); a3 = mfma16(d2, y, a3);
                d2 = HY_D(s + 2); y = HY_Y(s + 2); a0 = mfma16(d2, y, a0); a1 = mfma16(d3, y, a1); a2 = mfma16(d0, y, a2); a3 = mfma16(d1, y, a3);
                d1 = HY_D(s + 3); y = HY_Y(s + 3); a0 = mfma16(d1, y, a0); a1 = mfma16(d2, y, a1); a2 = mfma16(d3, y, a2); a3 = mfma16(d0, y, a3);
            }
#undef HY_D
#undef HY_Y
            if (l15 < B) {
#pragma unroll
                for (int a = 0; a < 4; ++a) {
                    const f32x4 cv = a == 0 ? a0 : (a == 1 ? a1 : (a == 2 ? a2 : a3));
                    const int t = t0 + 32 * a + quad * 4;
                    const u32x2 gw = *(const u32x2*)(gate + (size_t)l15 * L + t);
                    const u32x2 yw = *(const LAS u32x2*)(Y + l15 * LP + t);
                    f32x4 r;
                    r[0] = bflo(gw.x) * (cv[0] + skip * bflo(yw.x)); r[1] = bfhi(gw.x) * (cv[1] + skip * bfhi(yw.x));
                    r[2] = bflo(gw.y) * (cv[2] + skip * bflo(yw.y)); r[3] = bfhi(gw.y) * (cv[3] + skip * bfhi(yw.y));
                    if (o == 0) { u32x2 w; w.x = cvt_pk_bf16(r[0], r[1]); w.y = cvt_pk_bf16(r[2], r[3]); *(LAS u32x2*)(YB + l15 * LP + t) = w; }
                    else { bf16_t* op = BR2 + (size_t)(rowbase + l15 * L + t) * 256 + c;
                        op[0] = f2bf1(r[0]); op[256] = f2bf1(r[1]); op[512] = f2bf1(r[2]); op[768] = f2bf1(r[3]); }
                }
            }
        }
    }
    __syncthreads();
}

__device__ __forceinline__ void mix_phase(const Ctx& p, LAS unsigned char* lds, int l) {
    const int G = gridDim.x;
    for (int u = blockIdx.x; u < 512; u += G) hyena_unit(p, lds, l, u & 255, u < 256);
#ifdef PROBE_HY2
    for (int u = blockIdx.x; u < 512; u += G) hyena_unit(p, lds, l, u & 255, u < 256);
#endif
    const int vcu = (G % 8 == 0) ? ((int)blockIdx.x % 8) * (G / 8) + (int)blockIdx.x / 8 : (int)blockIdx.x;
#pragma unroll 1
    for (int it = vcu; it < 960; it += G) {
        if (it < 768) { const int k = it >> 8, r = it & 255, qblk = r & 7, bh = r >> 3;
            if (k == 0) attn_block<2>(p, lds, l, true, bh >> 2, bh & 3, qblk); else if (k == 1) attn_block<1>(p, lds, l, true, bh >> 2, bh & 3, qblk); else attn_block<0>(p, lds, l, true, bh >> 2, bh & 3, qblk); }
        else { const int q = it - 768, k = q >> 6, bh = q & 63;
            if (k == 0) attn_block<2>(p, lds, l, false, bh >> 2, bh & 3, 0); else if (k == 1) attn_block<1>(p, lds, l, false, bh >> 2, bh & 3, 0); else attn_block<0>(p, lds, l, false, bh >> 2, bh & 3, 0); }
    }
}

#define XB_TMO      128
#define XB_XCNT(j)  (256  + 64 * (j))
#define XB_XSUB(j)  (1280 + 64 * (j))
#define XB_XGEN(j)  (2304 + 64 * (j))
#define XB_TOP      3328
#define XB_TOPGEN   3392
#define XB_SPIN_CAP (1u << 22)
__device__ __forceinline__ unsigned xb_ld(unsigned* p)              { return __hip_atomic_load(p, __ATOMIC_RELAXED, __HIP_MEMORY_SCOPE_AGENT); }
__device__ __forceinline__ unsigned xb_add(unsigned* p, unsigned v) { return __hip_atomic_fetch_add(p, v, __ATOMIC_RELAXED, __HIP_MEMORY_SCOPE_AGENT); }
__device__ __forceinline__ unsigned xb_xcc_id() { return (unsigned)__builtin_amdgcn_s_getreg((3 << 11) | 20) & 0xFu; }
#define XB_SPIN(cond, bar) do { unsigned _sp = 0; while (cond) { __builtin_amdgcn_s_sleep(1); \
    if ((++_sp & 255u) == 0u) { if (xb_ld(&(bar)[XB_TMO])) break; if (_sp > XB_SPIN_CAP) { atomicAdd(&(bar)[XB_TMO], 1u); break; } } } } while (0)
struct XcdBarrier { unsigned* bar; unsigned x; volatile LAS unsigned* st; };
__device__ __forceinline__ XcdBarrier xcd_barrier_post(unsigned* bar, volatile LAS unsigned* st) {
    XcdBarrier b; b.bar = bar; b.x = xb_xcc_id(); b.st = st;
    if (threadIdx.x == 0) (void)xb_add(&bar[XB_XCNT(b.x)], 1u);
    return b;
}
__device__ __forceinline__ void xcd_barrier_complete(unsigned* bar, unsigned x, unsigned& nloc, unsigned& nx) {
    const unsigned G = gridDim.x * gridDim.y * gridDim.z;
    unsigned sum, cnt, mine, sp = 0u;
    for (;;) {
        sum = 0u; cnt = 0u; mine = 0u;
#pragma unroll
        for (unsigned j = 0; j < 16; ++j) { const unsigned c = xb_ld(&bar[XB_XCNT(j)]); sum += c; cnt += (c > 0u) ? 1u : 0u; mine = (j == x) ? c : mine; }
        if (sum == G) break;
        __builtin_amdgcn_s_sleep(1);
        if ((++sp & 255u) == 0u) { if (xb_ld(&bar[XB_TMO])) break; if (sp > XB_SPIN_CAP) { atomicAdd(&bar[XB_TMO], 1u); break; } }
    }
    nloc = mine > 0u ? mine : 1u; nx = cnt > 0u ? cnt : 1u;
}
__device__ __forceinline__ void xcd_barrier(const XcdBarrier& b) {
    asm volatile("s_waitcnt vmcnt(0)" ::: "memory");
    __syncthreads();
    if (threadIdx.x == 0) {
        unsigned* bar = b.bar;
        __builtin_amdgcn_s_waitcnt(0);
        unsigned nloc = b.st[0], nx = b.st[1];
        if (nloc == 0u) { xcd_barrier_complete(bar, b.x, nloc, nx); b.st[0] = nloc; b.st[1] = nx; }
        const unsigned old = xb_add(&bar[XB_XSUB(b.x)], 1u);
        const unsigned gen = old / nloc;
        if (old + 1u == (gen + 1u) * nloc) {
            __builtin_amdgcn_fence(__ATOMIC_RELEASE, "agent");
            asm volatile("s_waitcnt vmcnt(0)" ::: "memory");
            const unsigned og = xb_add(&bar[XB_TOP], 1u);
            const unsigned tg = og / nx;
            if (og + 1u == (tg + 1u) * nx) xb_add(&bar[XB_TOPGEN], 1u);
            else XB_SPIN(xb_ld(&bar[XB_TOPGEN]) == tg, bar);
            __builtin_amdgcn_fence(__ATOMIC_ACQUIRE, "agent");
            xb_add(&bar[XB_XGEN(b.x)], 1u);
            asm volatile("s_waitcnt vmcnt(0)" ::: "memory");
        } else {
            XB_SPIN(xb_ld(&bar[XB_XGEN(b.x)]) == gen, bar);
            __builtin_amdgcn_fence(__ATOMIC_ACQUIRE, "agent");
            asm volatile("s_waitcnt vmcnt(0)" ::: "memory");
        }
    }
    __syncthreads();
}

__global__ void __launch_bounds__(512, 2) mega(Params P) {
    extern __shared__ __attribute__((aligned(16))) unsigned char lds_raw[];
    LAS unsigned char* lds = (LAS unsigned char*)lds_raw;
    cg::grid_group grid = cg::this_grid();
    volatile LAS unsigned* MISC = (volatile LAS unsigned*)(lds + LDS_BYTES - 64);
    if (threadIdx.x < 16) MISC[threadIdx.x] = 0u;
    __syncthreads();
    (void)xcd_barrier_post((unsigned*)(P.ws + WS_CTL) + 1024, MISC);
#pragma unroll 1
    for (int ph = P.ph_lo; ph < P.ph_hi; ++ph) {
        GAS unsigned char* ws_g = (GAS unsigned char*)P.ws; GAS float* out_g = (GAS float*)P.out; asm volatile("" : "+s"(ws_g), "+s"(out_g));
        Ctx p; p.ws = (unsigned char*)ws_g; p.out = (float*)out_g;
        unsigned char* ws = p.ws;
        int prep_part = 0, prep_l = 0, prep_b = blockIdx.x, prep_G = gridDim.x;
        if (ph == 0) {
            { const int t0_ = opaque_tid(); if (t0_ < N_IN) { ((unsigned long long*)(ws + WS_TAB))[t0_] = (unsigned long long)P.in[t0_]; } }
            asm volatile("s_waitcnt vmcnt(0)" ::: "memory"); __syncthreads();
#ifndef NO_PREP
            prep_mod(p, lds); __syncthreads(); prep_part = 1;
#endif
        }
        else if (ph == NPH - 1) final_norm_phase(p);
        else {
#ifdef PROBE_S
            const int l = (ph - 1) / 13, sv_ = (ph - 1) % 13, s = sv_ <= PROBE_S ? sv_ : sv_ - 1;
#else
            const int l = (ph - 1) / 12, s = (ph - 1) % 12;
#endif
            const bool is_gemm = (s == 1 || s == 2 || s == 4 || s == 7 || s == 8 || s == 10 || s == 11);
            if (is_gemm) {
                pg8::Gemm g; pg8::Sched S; pg8::Epi E; bool perm;
                S.G = gridDim.x; S.c = blockIdx.x; S.mode = 0; S.nM = M_TOT / 256; S.wgm = (s == 2 || s == 8 || s == 11) ? RESID_WGM : pg8::WGM;
                E.o16 = nullptr; E.o16b = nullptr; E.of = nullptr; E.g = nullptr; E.gates = nullptr; E.scale = 1.f;
                bf16_t* ACT = (bf16_t*)(ws + WS_ACT); bf16_t* BIG = (bf16_t*)(ws + WS_BIG); float* X = (float*)(ws + WS_X);
                if (s == 1 || s == 10) { g.A = ACT; g.Bt = (const bf16_t*)(ws + wbase(l) + (s == 1 ? W_F1UP : W_F2UP)); g.K = DM; S.nN = 22; E.kind = pg8::EK_SWIGLU; E.o16 = BIG; perm = true; }
                else if (s == 2 || s == 11) { g.A = BIG; g.Bt = (const bf16_t*)(ws + wbase(l) + (s == 2 ? W_F1DN : W_F2DN)); g.K = DFF; S.nN = 4; E.kind = pg8::EK_RESID; E.of = X;
                    E.g = mod_ptr(ws, 0, l, s == 2 ? 2 : 8); E.scale = 0.5f; perm = false; }
                else if (s == 4) { g.A = ACT; g.Bt = (const bf16_t*)(ws + wbase(l) + W_IN); g.K = DM; S.nN = 27; E.kind = pg8::EK_PROJ; E.o16 = (bf16_t*)(ws + WS_PROJ); E.o16b = BIG; perm = true; }
                else if (s == 7) { g.A = (const bf16_t*)(ws + WS_BR); g.Bt = (const bf16_t*)(ws + wbase(l) + W_BR); g.K = 256; S.mode = 1; S.nN = 8; E.kind = pg8::EK_BRANCH;
                    E.o16 = ACT; E.gates = BIG; perm = false; }
                else { g.A = ACT; g.Bt = (const bf16_t*)(ws + wbase(l) + W_OUT); g.K = DM; S.nN = 4; E.kind = pg8::EK_RESID; E.of = X; E.g = mod_ptr(ws, 0, l, 5); E.scale = 1.f; perm = false; }
                S.nwg = S.nM * S.nN;
                #ifndef NO_GEMM
                if (s == 7) pg8::gemm_phase<true>(lds, g, S, E, perm); else pg8::gemm_phase<false>(lds, g, S, E, perm);
                if (blockIdx.x >= 64) {
                    if (s == 2) { prep_part = 2; prep_l = l; } else if (s == 8) { prep_part = 4; prep_l = l; } else if (s == 11 && l < 3) { prep_part = 1; prep_l = l + 1; }
                    prep_b = blockIdx.x - 64; prep_G = gridDim.x - 64;
                }
#endif
            } else if (s == 0 || s == 3 || s == 9) {
                norm_phase(p, l, s == 0 ? 0 : (s == 3 ? 1 : 2));

            } else if (s == 5) {
#ifndef NO_MIXPREP
                mixprep_phase(p, lds, l);
#endif
            } else {
#ifndef NO_MIX
                mix_phase(p, lds, l);
#ifdef PROBE_MIX2
                __syncthreads(); mix_phase(p, lds, l);
#endif
#endif
            }
        }
#ifndef NO_PREP
        if (prep_part) prep_layer(p, lds, prep_l, prep_b, prep_G, prep_part);
#endif
        if (ph + 1 < P.ph_hi) { if (P.ph_hi > 100000) grid.sync();   { XcdBarrier bar; bar.bar = (unsigned*)(p.ws + WS_CTL) + 1024; bar.x = xb_xcc_id(); bar.st = (volatile LAS unsigned*)(lds + LDS_BYTES - 64); xcd_barrier(bar); } }
    }
}

extern "C" void kernel_launch(void* const* d_in, const int* in_sizes, int n_in, void* d_out, int out_size, void* d_ws, size_t ws_size, hipStream_t stream) {
    static int grid = 0;
    if (grid == 0) {
        if (n_in != N_IN || ws_size < WS_END) { fprintf(stderr, "kernel_launch: unexpected n_in %d / ws_size %zu (need %zu)\n", n_in, ws_size, (size_t)WS_END); grid = -1; return; }
        int dev = 0, cus = 0, per_cu = 0;
        hipGetDevice(&dev); hipDeviceGetAttribute(&cus, hipDeviceAttributeMultiprocessorCount, dev);
        if (hipFuncSetAttribute((const void*)mega, hipFuncAttributeMaxDynamicSharedMemorySize, LDS_BYTES) != hipSuccess) { fprintf(stderr, "kernel_launch: hipFuncSetAttribute failed\n"); grid = -1; return; }
        if (hipOccupancyMaxActiveBlocksPerMultiprocessor(&per_cu, (const void*)mega, 512, LDS_BYTES) != hipSuccess || per_cu < 1) per_cu = 1;
        (void)hipGetLastError();
        grid = cus * 1;
        fprintf(stderr, "kernel_launch: grid %d (per_cu %d), ws %zu\n", grid, per_cu, ws_size);
    }
    if (grid < 0) return;
    hipMemsetAsync(d_ws, 0, WS_ZERO_BYTES, stream);
    Params p{};
    for (int i = 0; i < N_IN; ++i) p.in[i] = (const float*)d_in[i];
    p.out = (float*)d_out; p.ws = (unsigned char*)d_ws; p.ph_lo = 0; p.ph_hi = NPH;
    void* args[] = {&p};
    hipError_t e = hipLaunchCooperativeKernel((const void*)mega, dim3(grid), dim3(512), args, LDS_BYTES, stream);
    if (e != hipSuccess) fprintf(stderr, "cooperative launch failed: %s (grid %d)\n", hipGetErrorString(e), grid);
}
```

```cpp
#ifndef RESID_WGM
#define RESID_WGM 1
#endif
#include <hip/hip_runtime.h>
#include <hip/hip_cooperative_groups.h>
#include <cstdio>
#include <cstdint>
namespace cg = cooperative_groups;

#define LAS __attribute__((address_space(3)))
#define GAS __attribute__((address_space(1)))
typedef unsigned short bf16_t;
typedef short bf16x8 __attribute__((ext_vector_type(8)));
typedef float f32x4 __attribute__((ext_vector_type(4)));
typedef float f32x2 __attribute__((ext_vector_type(2)));
typedef unsigned u32x4 __attribute__((ext_vector_type(4)));
typedef unsigned u32x2 __attribute__((ext_vector_type(2)));

constexpr int DM = 1024, DFF = 2816, INW = 6912, PROJW = 2816, GATEW = 4096;
constexpr int M_CTX = 4096, M_DEC = 16384, M_TOT = 20480;
constexpr int NLAYER = 4;
constexpr float EPSF = 1e-6f;
constexpr float LOG2E = 1.4426950408889634f;
constexpr size_t O_Y = 0, O_NAK = 20971520, O_NAV = 25165824, O_SWK = 29360128, O_SWV = 31457280, O_DFK = 33554432, O_DFV = 37748736;
enum { I_XP = 0, I_XS, I_CNAK, I_CNAV, I_CSWK, I_CSWV, I_CDFK, I_CDFV, I_C, I_CCTX, I_WADA, I_BADA, I_NF1, I_NMIX, I_NF2, I_FNORM,
       I_F1W1, I_F1W3, I_F1W2, I_F2W1, I_F2W3, I_F2W2, I_WIN, I_WBR, I_WOUT, I_RPB, I_SINK, I_HSW, I_HSB, I_HW1, I_HB1, I_HW2, I_HB2, I_HW3,
       I_HSF, I_HLD, I_HSKIP, I_DLAM, I_DSUB, N_IN };

constexpr size_t MiB = 1u << 20;
constexpr size_t WS_CTL = 0;
constexpr size_t WS_MOD = 1 * MiB;
constexpr size_t WS_ZERO_BYTES = 65536;
constexpr size_t WS_LAM = 3 * MiB;
constexpr size_t WS_W = 4 * MiB;
constexpr size_t W_F1UP = 0, W_F1DN = W_F1UP + (size_t)5632 * 1024 * 2, W_F2UP = W_F1DN + (size_t)1024 * 2816 * 2, W_F2DN = W_F2UP + (size_t)5632 * 1024 * 2,
                 W_IN = W_F2DN + (size_t)1024 * 2816 * 2, W_BR = W_IN + (size_t)6912 * 1024 * 2, W_OUT = W_BR + (size_t)4 * 1024 * 256 * 2, W_END = W_OUT + (size_t)1024 * 1024 * 2;
static_assert(W_END <= 52 * MiB, "weights");
constexpr size_t WS_X = 56 * MiB;
constexpr size_t WS_ACT = 136 * MiB;
constexpr size_t WS_BR = 176 * MiB;
constexpr size_t WS_BIG = 216 * MiB;
constexpr size_t WS_PROJ = 376 * MiB;
constexpr size_t WS_TR = 486 * MiB;
constexpr size_t WS_CK = 541 * MiB;
constexpr size_t WS_HFIL = 551 * MiB;
constexpr size_t WS_W2 = 560 * MiB;
constexpr size_t WS_END = 612 * MiB;
constexpr int TRW = 1408;
constexpr size_t CK_NA = 0, CK_SW = 1048576, CK_DF = 1572864, CK_HALF = 2621440;
constexpr int LDS_BYTES = 147456;

#ifdef PROBE_S
constexpr int NPH = 54;
#else
constexpr int NPH = 50;
#endif
struct Params { const float* in[N_IN]; float* out; unsigned char* ws; int ph_lo, ph_hi; };
struct Ctx { float* out; unsigned char* ws; };
__device__ __forceinline__ size_t wbase(int l) { return (l & 1) ? WS_W2 : WS_W; }
constexpr size_t WS_TAB = 3 * MiB + 65536;
__device__ __forceinline__ const float* inp(const unsigned char* ws, int i) {
    const unsigned long long v = __hip_atomic_load((const unsigned long long*)(ws + WS_TAB) + i, __ATOMIC_RELAXED, __HIP_MEMORY_SCOPE_AGENT);
    const unsigned lo = __builtin_amdgcn_readfirstlane((unsigned)v), hi = __builtin_amdgcn_readfirstlane((unsigned)(v >> 32));
    return (const float*)(const GAS float*)(((unsigned long long)hi << 32) | lo);
}


__device__ __forceinline__ unsigned cvt_pk_bf16(float lo, float hi) { unsigned r; asm volatile("v_cvt_pk_bf16_f32 %0, %1, %2" : "=v"(r) : "v"(lo), "v"(hi)); return r; }
__device__ __forceinline__ float bf2f(unsigned short v) { return __uint_as_float(((unsigned)v) << 16); }
__device__ __forceinline__ float bflo(unsigned v) { return __uint_as_float(v << 16); }
__device__ __forceinline__ float bfhi(unsigned v) { return __uint_as_float(v & 0xffff0000u); }
__device__ __forceinline__ bf16_t f2bf1(float f) { return (bf16_t)(cvt_pk_bf16(f, 0.f) & 0xffffu); }
__device__ __forceinline__ float fast_exp2(float x) { return __builtin_amdgcn_exp2f(x); }
__device__ __forceinline__ float fast_rcp(float x) { return __builtin_amdgcn_rcpf(x); }
__device__ __forceinline__ float sigmoidf_(float x) { return fast_rcp(1.f + fast_exp2(-x * LOG2E)); }
__device__ __forceinline__ float wave_sum(float v) {
#pragma unroll
    for (int o = 1; o < 64; o <<= 1) v += __shfl_xor(v, o);
    return v;
}
__device__ __forceinline__ int cond_of_row(int row) { return row < M_CTX ? 0 : 1 + ((row - M_CTX) >> 11); }
__device__ __forceinline__ const float* mod_ptr(const unsigned char* ws, int cond, int l, int chunk) { return (const float*)(ws + WS_MOD) + ((size_t)(cond * 4 + l) * 9 + chunk) * 1024; }

__device__ __forceinline__ int opaque_tid() { int t; asm volatile("v_mov_b32 %0, %1" : "=v"(t) : "v"((int)threadIdx.x)); return t; }
namespace pg8 {
constexpr int BM = 256, BK = 64, HALF = 128, HTB = HALF * BK * 2, STAGE_BYTES = 8 * HTB, NXCD = 8, WGM = 4;
__device__ __forceinline__ int lds_byte(int r, int c) { const int st = (r >> 4) * 2 + (c >> 5), rr = r & 15, cc = c & 31, ob = rr * 64 + cc * 2; return st * 1024 + (ob ^ (((ob >> 9) & 1) << 5)); }
__device__ __forceinline__ void stage_rc(int b, int& R, int& C) { const int st = b / 1024, sb = b % 1024, swz = sb ^ (((sb >> 9) & 1) << 5); R = (st >> 1) * 16 + swz / 64; C = (st & 1) * 32 + (swz % 64) / 2; }
__device__ __forceinline__ int perm32(int rho) { const int n = rho >> 4, i = rho & 15; return 8 * (i >> 2) + 4 * n + (i & 3); }
struct Unit { int pm, pn; };
struct Sched { int mode, nM, nN, nwg, G, c, wgm; };
__device__ __forceinline__ bool sched_next(const Sched& S, int i, Unit& u) {
    const int j = (S.mode == 1) ? (i >> 2) : i;
    const long L = (long)j * S.G + S.c; if (L >= S.nwg) return false;
    int wgid = (int)L; { const int q = S.nwg / NXCD, r = S.nwg % NXCD, xcd = wgid % NXCD, off = wgid / NXCD; wgid = (xcd < r ? xcd * (q + 1) : r * (q + 1) + (xcd - r) * q) + off; }
    const int nig = S.wgm * S.nN, gid = wgid / nig, fm = gid * S.wgm, gsz = (S.nM - fm) < S.wgm ? (S.nM - fm) : S.wgm;
    const int pm = fm + ((wgid % nig) % gsz), pn = (wgid % nig) / gsz;
    if (S.mode == 1) { const int b = i & 3; u.pm = b * S.nM + pm; u.pn = b * S.nN + pn; } else { u.pm = pm; u.pn = pn; }
    return true;
}
enum { EK_SWIGLU = 0, EK_RESID = 1, EK_PROJ = 2, EK_BRANCH = 3 };
struct Epi { int kind; bf16_t* o16; bf16_t* o16b; float* of; const float* g; const bf16_t* gates; float scale; };
struct Gemm { const bf16_t* A; const bf16_t* Bt; int K; };

template <bool BR>
__device__ __forceinline__ void epilogue(const Epi& E, f32x4 (&acc)[2][2][4][2], const Unit& u, int wr, int wc, int fr, int fq) {
    if (BR) {
        const int bi = u.pm / 80, pm = u.pm - bi * 80, pn = u.pn & 7;
        const int row0 = pm * BM + wr * 64 + fr, col0 = pn * HALF + wc * 32 + 4 * fq;
        u32x2 gw[2][2][4];
#pragma unroll
        for (int n = 0; n < 2; ++n)
#pragma unroll
            for (int ai = 0; ai < 2; ++ai)
#pragma unroll
                for (int m = 0; m < 4; ++m) gw[n][ai][m] = *(const u32x2*)(E.gates + (size_t)(row0 + ai * HALF + m * 16) * GATEW + bi * 1024 + col0 + n * 16);
#pragma unroll
        for (int n = 0; n < 2; ++n)
#pragma unroll
            for (int ai = 0; ai < 2; ++ai)
#pragma unroll
                for (int m = 0; m < 4; ++m) {
                    const u32x2 g2 = gw[n][ai][m];
                    f32x4 gt; gt[0] = bflo(g2.x); gt[1] = bfhi(g2.x); gt[2] = bflo(g2.y); gt[3] = bfhi(g2.y);
                    f32x4 v = gt * acc[ai][0][m][n];
                    if (bi > 0) v = v + acc[ai][1][m][n];
                    acc[ai][1][m][n] = v;
                    if (bi == 3) { u32x2 w; w.x = cvt_pk_bf16(v[0], v[1]); w.y = cvt_pk_bf16(v[2], v[3]); *(u32x2*)(E.o16 + (size_t)(row0 + ai * HALF + m * 16) * DM + col0 + n * 16) = w; }
                }
    } else if (E.kind == EK_SWIGLU) {
        const int row0 = u.pm * BM + wr * 64 + fr, col0 = u.pn * 128 + wc * 32 + 8 * fq;
#pragma unroll
        for (int ai = 0; ai < 2; ++ai)
#pragma unroll
            for (int m = 0; m < 4; ++m) {
                const f32x4 a0 = acc[ai][0][m][0], a1 = acc[ai][0][m][1], b0 = acc[ai][1][m][0], b1 = acc[ai][1][m][1];
                float r[8];
#pragma unroll
                for (int e = 0; e < 4; ++e) { r[e] = a0[e] * sigmoidf_(a0[e]) * b0[e]; r[4 + e] = a1[e] * sigmoidf_(a1[e]) * b1[e]; }
                u32x4 w; w.x = cvt_pk_bf16(r[0], r[1]); w.y = cvt_pk_bf16(r[2], r[3]); w.z = cvt_pk_bf16(r[4], r[5]); w.w = cvt_pk_bf16(r[6], r[7]);
                *(u32x4*)(E.o16 + (size_t)(row0 + ai * HALF + m * 16) * DFF + col0) = w;
            }
    } else if (E.kind == EK_PROJ) {
        const int row0 = u.pm * BM + wr * 64 + fr;
        const bool isgate = u.pn >= 11;
        bf16_t* base = isgate ? E.o16b : E.o16; const int ld = isgate ? GATEW : PROJW;
        const int col0 = (isgate ? (u.pn - 11) * BM : u.pn * BM) + wc * 32 + 8 * fq;
#pragma unroll
        for (int ai = 0; ai < 2; ++ai)
#pragma unroll
            for (int m = 0; m < 4; ++m)
#pragma unroll
                for (int bj = 0; bj < 2; ++bj) {
                    f32x4 v0 = acc[ai][bj][m][0], v1 = acc[ai][bj][m][1];
                    if (isgate) {
#pragma unroll
                        for (int e = 0; e < 4; ++e) { v0[e] = sigmoidf_(v0[e]); v1[e] = sigmoidf_(v1[e]); }
                    }
                    u32x4 w; w.x = cvt_pk_bf16(v0[0], v0[1]); w.y = cvt_pk_bf16(v0[2], v0[3]); w.z = cvt_pk_bf16(v1[0], v1[1]); w.w = cvt_pk_bf16(v1[2], v1[3]);
                    *(u32x4*)(base + (size_t)(row0 + ai * HALF + m * 16) * ld + col0 + bj * HALF) = w;
                }
    } else if (E.kind == EK_RESID) {
        const int cond = (u.pm < 16) ? 0 : 1 + ((u.pm - 16) >> 3);
        const float* gv = E.g + (size_t)cond * (4 * 9 * 1024);
        const int row0 = u.pm * BM + wr * 64 + fr, col0 = u.pn * BM + wc * 32 + 4 * fq;
        f32x4 g4[2][2];
#pragma unroll
        for (int bj = 0; bj < 2; ++bj)
#pragma unroll
            for (int n = 0; n < 2; ++n) g4[bj][n] = *(const f32x4*)(gv + col0 + bj * HALF + n * 16) * E.scale;
#pragma unroll
        for (int bj = 0; bj < 2; ++bj)
#pragma unroll
            for (int n = 0; n < 2; ++n) {
                const int col = col0 + bj * HALF + n * 16;
                f32x4 xv[2][4];
#pragma unroll
                for (int ai = 0; ai < 2; ++ai)
#pragma unroll
                    for (int m = 0; m < 4; ++m) xv[ai][m] = *(const f32x4*)(E.of + (size_t)(row0 + ai * HALF + m * 16) * DM + col);
#pragma unroll
                for (int ai = 0; ai < 2; ++ai)
#pragma unroll
                    for (int m = 0; m < 4; ++m) *(f32x4*)(E.of + (size_t)(row0 + ai * HALF + m * 16) * DM + col) = xv[ai][m] + g4[bj][n] * acc[ai][bj][m][n];
            }
    }
}

template <bool BR>
__device__ __forceinline__ void gemm_phase(LAS unsigned char* lds, const Gemm g, const Sched& S, const Epi& E, const bool perm) {
    const int tid = opaque_tid(), wid = __builtin_amdgcn_readfirstlane(tid >> 6), lane = tid & 63, wr = wid >> 2, wc = wid & 3, fr = lane & 15, fq = lane >> 4;
    const int K = g.K, nt = K / BK;
    const bool align = !(E.kind == EK_RESID);
    unsigned voffA[2], voffB[2];
#pragma unroll
    for (int i = 0; i < 2; ++i) { int R, C; stage_rc(tid * 16 + i * 8192, R, C); const int Rb = perm ? ((R & ~31) + perm32(R & 31)) : R;
        voffA[i] = (unsigned)(R * K + C) * 2u; voffB[i] = (unsigned)(Rb * K + C) * 2u; }
    const size_t kstep = (size_t)(BK * 2);
    const size_t hstep = (size_t)HALF * K * 2;
    const size_t tstep = 2 * hstep;
    const size_t bstep = BR ? hstep : tstep;
    const unsigned ldsw = (unsigned)wid * 1024u;
    const int aoff = lds_byte(wr * 64 + fr, fq * 8), boff = lds_byte(wc * 32 + fr, fq * 8);
#define PG8_SA(b, h) (((b) * 2 + (h)) * HTB)
#define PG8_SB(b, h) ((4 + (b) * 2 + (h)) * HTB)
#define PG8_STAGE(bufoff, gbase, voff) do { _Pragma("unroll") for (int _i = 0; _i < 2; ++_i) \
        __builtin_amdgcn_global_load_lds((const unsigned*)((const char*)(gbase) + (voff)[_i]), (LAS unsigned*)(lds + (bufoff) + ldsw + _i * 8192), 16, 0, 0); } while (0)
#define PG8_LDA(dst, b, h) do { _Pragma("unroll") for (int m = 0; m < 4; ++m) _Pragma("unroll") for (int k = 0; k < 2; ++k) dst[m][k] = *(const LAS bf16x8*)(lds + PG8_SA(b, h) + aoff + m * 2048 + k * 1024); } while (0)
#define PG8_LDB(dst, b, h) do { _Pragma("unroll") for (int n = 0; n < 2; ++n) _Pragma("unroll") for (int k = 0; k < 2; ++k) dst[n][k] = *(const LAS bf16x8*)(lds + PG8_SB(b, h) + boff + n * 2048 + k * 1024); } while (0)
#define PG8_MMA(ai, bj, At, Bt) do { __builtin_amdgcn_s_setprio(1); _Pragma("unroll") for (int m = 0; m < 4; ++m) _Pragma("unroll") for (int n = 0; n < 2; ++n) _Pragma("unroll") for (int k = 0; k < 2; ++k) \
        acc[ai][bj][m][n] = __builtin_amdgcn_mfma_f32_16x16x32_bf16(Bt[n][k], At[m][k], acc[ai][bj][m][n], 0, 0, 0); __builtin_amdgcn_s_setprio(0); } while (0)
#define PG8_WAIT_V(n) asm volatile("s_waitcnt vmcnt(" #n ")" ::: "memory")
#define PG8_WAIT_L(n) asm volatile("s_waitcnt lgkmcnt(" #n ")" ::: "memory")
#define PG8_BAR __builtin_amdgcn_s_barrier()
#define PG8_SCHED __builtin_amdgcn_sched_barrier(0)
    Unit cur, nxt; int ui = 0;
    if (!sched_next(S, 0, cur)) return;
    f32x4 acc[2][2][4][2];
#pragma unroll
    for (int a = 0; a < 2; ++a)
#pragma unroll
        for (int b = 0; b < 2; ++b)
#pragma unroll
            for (int m = 0; m < 4; ++m)
#pragma unroll
                for (int n = 0; n < 2; ++n) acc[a][b][m][n] = (f32x4){0.f, 0.f, 0.f, 0.f};
    bf16x8 At[4][2], B0[2][2], B1[2][2];
    const char* cA = (const char*)g.A + (size_t)cur.pm * tstep; const char* cB = (const char*)g.Bt + (size_t)cur.pn * bstep;
    PG8_STAGE(PG8_SB(0, 0), cB, voffB); PG8_STAGE(PG8_SB(0, 1), cB + hstep, voffB); PG8_STAGE(PG8_SA(0, 0), cA, voffA); PG8_STAGE(PG8_SA(0, 1), cA + hstep, voffA);
    if (wr == 1) PG8_BAR;
    PG8_WAIT_V(2); PG8_BAR;
    PG8_STAGE(PG8_SB(1, 0), cB + kstep, voffB); PG8_STAGE(PG8_SA(1, 0), cA + kstep, voffA); PG8_STAGE(PG8_SB(1, 1), cB + hstep + kstep, voffB);
    PG8_WAIT_V(6); PG8_BAR;
    for (;;) {
        const bool has_next = sched_next(S, ui + 1, nxt);
        const char* nA = has_next ? (const char*)g.A + (size_t)nxt.pm * tstep : cA; const char* nB = has_next ? (const char*)g.Bt + (size_t)nxt.pn * bstep : cB;
        for (int t = 0; t < nt; t += 2) {
            const bool last = (t == nt - 2);
            const char* a1 = cA + (size_t)(t + 1) * kstep;
            const char* a2 = last ? nA : cA + (size_t)(t + 2) * kstep; const char* b2 = last ? nB : cB + (size_t)(t + 2) * kstep;
            const char* a3 = a2 + kstep; const char* b3 = b2 + kstep;
            PG8_LDB(B0, 0, 0); PG8_LDB(B1, 0, 1); PG8_SCHED; PG8_LDA(At, 0, 0); PG8_STAGE(PG8_SA(1, 1), a1 + hstep, voffA);
            PG8_WAIT_V(8); PG8_WAIT_L(0); PG8_BAR; PG8_MMA(0, 0, At, B0); if (!BR) { PG8_MMA(0, 1, At, B1); } PG8_BAR; PG8_SCHED;
            PG8_LDA(At, 0, 1); PG8_STAGE(PG8_SB(0, 0), b2, voffB); PG8_STAGE(PG8_SB(0, 1), b2 + hstep, voffB); PG8_STAGE(PG8_SA(0, 0), a2, voffA);
            PG8_WAIT_V(8); PG8_WAIT_L(0); PG8_BAR; PG8_MMA(1, 0, At, B0); if (!BR) { PG8_MMA(1, 1, At, B1); } PG8_BAR; PG8_SCHED;
            PG8_LDB(B0, 1, 0); PG8_LDB(B1, 1, 1); PG8_SCHED; PG8_LDA(At, 1, 0); PG8_STAGE(PG8_SA(0, 1), a2 + hstep, voffA);
            PG8_WAIT_V(8); PG8_WAIT_L(0); PG8_BAR; PG8_MMA(0, 0, At, B0); if (!BR) { PG8_MMA(0, 1, At, B1); } PG8_BAR; PG8_SCHED;
            PG8_LDA(At, 1, 1); PG8_STAGE(PG8_SB(1, 0), b3, voffB); PG8_STAGE(PG8_SB(1, 1), b3 + hstep, voffB); PG8_STAGE(PG8_SA(1, 0), a3, voffA);
            PG8_WAIT_V(8); PG8_WAIT_L(0); PG8_BAR; PG8_MMA(1, 0, At, B0); if (!BR) { PG8_MMA(1, 1, At, B1); } PG8_BAR; PG8_SCHED;
        }
        if (align && wr == 0) PG8_BAR;
        epilogue<BR>(E, acc, cur, wr, wc, fr, fq);
        if (!has_next) break;
#pragma unroll
        for (int a = 0; a < 2; ++a)
#pragma unroll
            for (int b = 0; b < (BR ? 1 : 2); ++b)
#pragma unroll
                for (int m = 0; m < 4; ++m)
#pragma unroll
                    for (int n = 0; n < 2; ++n) acc[a][b][m][n] = (f32x4){0.f, 0.f, 0.f, 0.f};
        cur = nxt; cA = nA; cB = nB; ++ui;
        if (align && wr == 1) PG8_BAR;
    }
    PG8_WAIT_V(0);
    if (!align && wr == 0) PG8_BAR;
    PG8_BAR;
#undef PG8_SA
#undef PG8_SB
#undef PG8_STAGE
#undef PG8_LDA
#undef PG8_LDB
#undef PG8_MMA
#undef PG8_WAIT_V
#undef PG8_WAIT_L
#undef PG8_BAR
#undef PG8_SCHED
}
}


__device__ __forceinline__ void transpose_item(const float* W, int K, int N, bf16_t* WT, int dst_row0, LAS float* scr, int k0, int n0, int lane) {
    f32x4 v[16];
    const int rr = lane >> 4, cc = (lane & 15) * 4;
#pragma unroll
    for (int i = 0; i < 16; ++i) v[i] = __builtin_nontemporal_load((const f32x4*)(W + (size_t)(k0 + 4 * i + rr) * N + n0 + cc));
#pragma unroll
    for (int i = 0; i < 16; ++i) { LAS float* d = scr + (4 * i + rr) * 65 + cc; d[0] = v[i][0]; d[1] = v[i][1]; d[2] = v[i][2]; d[3] = v[i][3]; }
    asm volatile("s_waitcnt lgkmcnt(0)" ::: "memory");
    const int c = lane & 7, r = lane >> 3;
#pragma unroll
    for (int j = 0; j < 8; ++j) { const int n = 8 * j + r; const LAS float* q = scr + (8 * c) * 65 + n;
        u32x4 o; o.x = cvt_pk_bf16(q[0], q[65]); o.y = cvt_pk_bf16(q[2 * 65], q[3 * 65]); o.z = cvt_pk_bf16(q[4 * 65], q[5 * 65]); o.w = cvt_pk_bf16(q[6 * 65], q[7 * 65]);
        *(u32x4*)(WT + (size_t)(dst_row0 + n) * K + k0 + 8 * c) = o; }
    asm volatile("s_waitcnt lgkmcnt(0)" ::: "memory");
}

__device__ __forceinline__ void prep_layer(const Ctx& p, LAS unsigned char* lds, int l, int bidx, int G, int part) {
    const int tid = opaque_tid(), lane = tid & 63, wave = tid >> 6;
    const int gw = bidx * 8 + wave, NGW = G * 8;
    unsigned char* ws = p.ws; unsigned char* wsw = p.ws + wbase(l);
    LAS float* scr = (LAS float*)(lds + wave * 16896);
    {
        constexpr int I_UP = 16 * 44, I_DN = 44 * 16, I_IN = 16 * 108, I_BR = 4 * 16, I_OUT = 16 * 16;
        constexpr int NIT = 4 * I_UP + 2 * I_DN + I_IN + 4 * I_BR + I_OUT;
        for (int it = gw; it < NIT; it += NGW) {
            int r = it;
            { const int cls = (r < 4 * I_UP) ? ((r < 2 * I_UP) ? 1 : 4) : ((r < 4 * I_UP + 2 * I_DN) ? ((r < 4 * I_UP + I_DN) ? 1 : 4) : 2); if (!(part & cls)) continue; }
            if (r < 4 * I_UP) {
                const int which = r / I_UP; r -= which * I_UP; const int kb = r / 44, nb = r % 44, n0 = nb * 64;
                const float* W = inp(p.ws, (which >> 1) ? ((which & 1) ? I_F2W3 : I_F2W1) : ((which & 1) ? I_F1W3 : I_F1W1)) + (size_t)l * DM * DFF;
                bf16_t* WT = (bf16_t*)(wsw + ((which >> 1) ? W_F2UP : W_F1UP));
                const int drow = 256 * (n0 >> 7) + (which & 1) * 128 + (n0 & 127);
                transpose_item(W, DM, DFF, WT, drow, scr, kb * 64, n0, lane); continue;
            }
            r -= 4 * I_UP;
            if (r < 2 * I_DN) {
                const int which = r / I_DN; r -= which * I_DN; const int kb = r / 16, nb = r % 16;
                const float* W = inp(p.ws, which ? I_F2W2 : I_F1W2) + (size_t)l * DFF * DM;
                bf16_t* WT = (bf16_t*)(wsw + (which ? W_F2DN : W_F1DN));
                transpose_item(W, DFF, DM, WT, nb * 64, scr, kb * 64, nb * 64, lane); continue;
            }
            r -= 2 * I_DN;
            if (r < I_IN) { const int kb = r / 108, nb = r % 108;
                transpose_item(inp(p.ws, I_WIN) + (size_t)l * DM * INW, DM, INW, (bf16_t*)(wsw + W_IN), nb * 64, scr, kb * 64, nb * 64, lane); continue; }
            r -= I_IN;
            if (r < 4 * I_BR) { const int bi = r / I_BR; r -= bi * I_BR; const int kb = r / 16, nb = r % 16;
                transpose_item(inp(p.ws, I_WBR) + ((size_t)l * 4 + bi) * 256 * DM, 256, DM, (bf16_t*)(wsw + W_BR) + (size_t)bi * 1024 * 256, nb * 64, scr, kb * 64, nb * 64, lane); continue; }
            r -= 4 * I_BR;
            { const int kb = r / 16, nb = r % 16;
              transpose_item(inp(p.ws, I_WOUT) + (size_t)l * DM * DM, DM, DM, (bf16_t*)(wsw + W_OUT), nb * 64, scr, kb * 64, nb * 64, lane); }
        }
    }
    if (!(part & 2)) return;
    {
        bf16_t* CK = (bf16_t*)(ws + WS_CK);
        const int gt = bidx * 512 + tid, NT = G * 512;
        for (int it = gt; it < 327680; it += NT) {
            int e = it * 8; const float* src; bf16_t* dst; int per_b;
            if (e < 1048576) { src = inp(p.ws, I_CNAK); dst = CK + CK_NA; per_b = 131072; }
            else if (e < 1572864) { e -= 1048576; src = inp(p.ws, I_CSWK); dst = CK + CK_SW; per_b = 65536; }
            else { e -= 1572864; src = inp(p.ws, I_CDFK); dst = CK + CK_DF; per_b = 131072; }
            const int b = e / per_b, r = e - b * per_b;
            const float* s = src + ((size_t)(b * 4 + l)) * per_b + r;
            const f32x4 v0 = __builtin_nontemporal_load((const f32x4*)s), v1 = __builtin_nontemporal_load((const f32x4*)(s + 4));
            u32x4 o; o.x = cvt_pk_bf16(v0[0], v0[1]); o.y = cvt_pk_bf16(v0[2], v0[3]); o.z = cvt_pk_bf16(v1[0], v1[1]); o.w = cvt_pk_bf16(v1[2], v1[3]);
            *(u32x4*)(dst + e) = o;
        }
    }
    {
        bf16_t* CV = (bf16_t*)(ws + WS_CK) + CK_HALF;
        for (int it = gw; it < 640; it += NGW) {
            int r = it; const float* src; bf16_t* dst; int H;
            if (r < 256) { src = inp(p.ws, I_CNAV); dst = CV + CK_NA; H = 4; }
            else if (r < 384) { r -= 256; src = inp(p.ws, I_CSWV); dst = CV + CK_SW; H = 2; }
            else { r -= 384; src = inp(p.ws, I_CDFV); dst = CV + CK_DF; H = 4; }
            const int kb = r & 7, bh = r >> 3, b = bh / H, h = bh - b * H;
            transpose_item(src + ((size_t)(b * 4 + l) * H + h) * 512 * 64, 512, 64, dst + (size_t)bh * 64 * 512, 0, scr, kb * 64, 0, lane);
        }
    }
    __syncthreads();
    {
        LAS float* Z = (LAS float*)lds;
        LAS float* G1 = Z + 8 * 33;
        LAS float* G2 = G1 + 8 * 64;
        float* HF = (float*)(ws + WS_HFIL);
        const float* w1 = inp(p.ws, I_HW1) + (size_t)l * 33 * 64; const float* b1 = inp(p.ws, I_HB1) + l * 64;
        const float* w2 = inp(p.ws, I_HW2) + (size_t)l * 64 * 64; const float* b2 = inp(p.ws, I_HB2) + l * 64;
        const float* w3 = inp(p.ws, I_HW3) + (size_t)l * 64 * 1024; const float* sf = inp(p.ws, I_HSF) + l * 64; const float* ld = inp(p.ws, I_HLD) + l * 1024;
        for (int it = bidx; it < 288; it += G) {
            const int Lsel = it >= 32, L = Lsel ? 2048 : 256, n0 = (Lsel ? it - 32 : it) * 8;
            const float invL = 1.f / (float)L;
            if (tid < 8 * 33) { const int nn = tid / 33, i = tid - nn * 33; const float tn = (float)(n0 + nn) * invL; float v;
                if (i == 0) v = tn; else if (i <= 16) v = __cosf(6.283185307179586f * tn * (float)i); else v = __sinf(6.283185307179586f * tn * (float)(i - 16));
                Z[nn * 33 + i] = v; }
            __syncthreads();
            { const int nn = tid >> 6, j = tid & 63; float a = b1[j];
#pragma unroll 11
              for (int i = 0; i < 33; ++i) a += Z[nn * 33 + i] * w1[i * 64 + j];
              G1[nn * 64 + j] = __sinf(sf[j] * a); }
            __syncthreads();
            { const int nn = tid >> 6, j = tid & 63; float a = b2[j];
#pragma unroll 16
              for (int i = 0; i < 64; ++i) a += G1[nn * 64 + i] * w2[i * 64 + j];
              G2[nn * 64 + j] = __sinf(sf[j] * a); }
            __syncthreads();
#pragma unroll 1
            for (int cc = 0; cc < 2; ++cc) {
                const int col = cc * 512 + tid;
                float a[8];
#pragma unroll
                for (int nn = 0; nn < 8; ++nn) a[nn] = 0.f;
#pragma unroll 16
                for (int i = 0; i < 64; ++i) { const float w = w3[i * 1024 + col];
#pragma unroll
                    for (int nn = 0; nn < 8; ++nn) a[nn] += G2[nn * 64 + i] * w; }
                const float rate = __expf(ld[col]);
#pragma unroll
                for (int nn = 0; nn < 8; ++nn) a[nn] *= __expf(-rate * (float)(n0 + nn) * invL);
                float* o = HF + (Lsel ? 262144 : 0) + (size_t)col * L + n0;
                *(f32x4*)o = (f32x4){a[0], a[1], a[2], a[3]}; *(f32x4*)(o + 4) = (f32x4){a[4], a[5], a[6], a[7]};
            }
            __syncthreads();
        }
    }
    if (bidx == 0 && tid == 0) {
        const float* lv = inp(p.ws, I_DLAM) + l * 128; float s01 = 0.f, s23 = 0.f;
        for (int i = 0; i < 32; ++i) { s01 += lv[i] * lv[32 + i]; s23 += lv[64 + i] * lv[96 + i]; }
        float c08; asm volatile("v_mov_b32 %0, 0x3f4ccccd" : "=v"(c08));
        const float lam_init = c08 - 0.6f * __expf(-0.3f * (float)l);
        ((float*)(ws + WS_LAM))[l] = __expf(s01) - __expf(s23) + lam_init; ((float*)(ws + WS_LAM))[4 + l] = lam_init;
    }
}

__device__ __forceinline__ void prep_mod(const Ctx& p, LAS unsigned char* lds) {
    const int tid = opaque_tid(), lane = tid & 63, wave = tid >> 6;
    const int G = gridDim.x;
    LAS float* SC = (LAS float*)lds;
    LAS float* PART = (LAS float*)(lds + 40960);
    for (int i = tid; i < 9 * 1024; i += 512) { const float v = (i < 1024) ? inp(p.ws, I_CCTX)[i] : inp(p.ws, I_C)[i - 1024]; SC[i] = v * sigmoidf_(v); }
    __syncthreads();
    float* mod = (float*)(p.ws + WS_MOD);
    for (int it = blockIdx.x; it < 4 * 36; it += G) {
        const int cb = it % 36, l = it / 36;
        const int col = cb * 256 + lane * 4, k0 = wave * 128;
        const float* W = inp(p.ws, I_WADA) + ((size_t)l * DM + k0) * 9216 + col;
        f32x4 a[9];
#pragma unroll
        for (int c = 0; c < 9; ++c) a[c] = (f32x4){0.f, 0.f, 0.f, 0.f};
#pragma unroll 16
        for (int k = 0; k < 128; ++k) { const f32x4 w = __builtin_nontemporal_load((const f32x4*)(W + (size_t)k * 9216));
#pragma unroll
            for (int c = 0; c < 9; ++c) a[c] += w * SC[c * 1024 + k0 + k]; }
#pragma unroll
        for (int c = 0; c < 9; ++c) *(LAS f32x4*)(PART + (wave * 9 + c) * 256 + lane * 4) = a[c];
        __syncthreads();
        for (int o = tid; o < 9 * 256; o += 512) { const int c = o >> 8, cc = o & 255;
            float v = inp(p.ws, I_BADA)[(size_t)l * 9216 + cb * 256 + cc];
#pragma unroll
            for (int w = 0; w < 8; ++w) v += PART[(w * 9 + c) * 256 + cc];
            mod[((size_t)(c * 4 + l)) * 9216 + cb * 256 + cc] = v; }
        __syncthreads();
    }
}

__device__ __forceinline__ void norm_phase(const Ctx& p, int l, int which  ) {
    const int tid_ = opaque_tid(), lane = tid_ & 63, wave = tid_ >> 6, gw = blockIdx.x * 8 + wave, NGW = gridDim.x * 8;
    float* X = (float*)(p.ws + WS_X); bf16_t* ACT = (bf16_t*)(p.ws + WS_ACT);
    const float* gsrc = inp(p.ws, which == 0 ? I_NF1 : (which == 1 ? I_NMIX : I_NF2)) + l * DM;
    const bool from_in = (l == 0 && which == 0);
    f32x4 gv[4];
#pragma unroll
    for (int j = 0; j < 4; ++j) gv[j] = *(const f32x4*)(gsrc + j * 256 + lane * 4);
    constexpr int NR = 4;
    for (int row0 = gw * NR; row0 < M_TOT; row0 += NGW * NR) {
        f32x4 v[NR][4]; float s[NR];
#pragma unroll
        for (int r = 0; r < NR; ++r) {
            const int row = row0 + r;
            const float* xr = from_in ? (row < M_CTX ? inp(p.ws, I_XP) + (size_t)row * DM : inp(p.ws, I_XS) + (size_t)(row - M_CTX) * DM) : X + (size_t)row * DM;
#pragma unroll
            for (int j = 0; j < 4; ++j) v[r][j] = from_in ? __builtin_nontemporal_load((const f32x4*)(xr + j * 256 + lane * 4)) : *(const f32x4*)(xr + j * 256 + lane * 4);
        }
        const int cond = cond_of_row(row0);
        const float* sh = mod_ptr(p.ws, cond, l, which * 3 + 0); const float* sc = mod_ptr(p.ws, cond, l, which * 3 + 1);
        f32x4 s4[4], h4[4];
#pragma unroll
        for (int j = 0; j < 4; ++j) { s4[j] = *(const f32x4*)(sc + j * 256 + lane * 4) + 1.f; h4[j] = *(const f32x4*)(sh + j * 256 + lane * 4); }
#pragma unroll
        for (int r = 0; r < NR; ++r) { float a = 0.f;
#pragma unroll
            for (int j = 0; j < 4; ++j) a += (v[r][j][0] * v[r][j][0] + v[r][j][1] * v[r][j][1]) + (v[r][j][2] * v[r][j][2] + v[r][j][3] * v[r][j][3]);
            s[r] = a; }
        if (from_in) {
#pragma unroll
            for (int r = 0; r < NR; ++r)
#pragma unroll
                for (int j = 0; j < 4; ++j) *(f32x4*)(X + (size_t)(row0 + r) * DM + j * 256 + lane * 4) = v[r][j];
        }
#pragma unroll
        for (int o = 1; o < 64; o <<= 1) {
#pragma unroll
            for (int r = 0; r < NR; ++r) s[r] += __shfl_xor(s[r], o);
        }
#pragma unroll
        for (int r = 0; r < NR; ++r) {
            const float rstd = rsqrtf(s[r] * (1.f / DM) + EPSF);
#pragma unroll
            for (int j = 0; j < 4; ++j) {
                const f32x4 o = (v[r][j] * rstd) * gv[j] * s4[j] + h4[j];
                u32x2 w; w.x = cvt_pk_bf16(o[0], o[1]); w.y = cvt_pk_bf16(o[2], o[3]);
                *(u32x2*)(ACT + (size_t)(row0 + r) * DM + j * 256 + lane * 4) = w;
            }
        }
    }
}
__device__ __forceinline__ void final_norm_phase(const Ctx& p) {
    const int tid_ = opaque_tid(), lane = tid_ & 63, wave = tid_ >> 6, gw = blockIdx.x * 8 + wave, NGW = gridDim.x * 8;
    const float* X = (const float*)(p.ws + WS_X); const float* gsrc = inp(p.ws, I_FNORM);
    f32x4 gv[4];
#pragma unroll
    for (int j = 0; j < 4; ++j) gv[j] = *(const f32x4*)(gsrc + j * 256 + lane * 4);
    constexpr int NR = 4;
    for (int row0 = gw * NR; row0 < M_TOT; row0 += NGW * NR) {
        f32x4 v[NR][4]; float s[NR];
#pragma unroll
        for (int r = 0; r < NR; ++r) { const float* xr = X + (size_t)(row0 + r) * DM;
#pragma unroll
            for (int j = 0; j < 4; ++j) v[r][j] = *(const f32x4*)(xr + j * 256 + lane * 4); }
#pragma unroll
        for (int r = 0; r < NR; ++r) { float a = 0.f;
#pragma unroll
            for (int j = 0; j < 4; ++j) a += (v[r][j][0] * v[r][j][0] + v[r][j][1] * v[r][j][1]) + (v[r][j][2] * v[r][j][2] + v[r][j][3] * v[r][j][3]);
            s[r] = a; }
#pragma unroll
        for (int o = 1; o < 64; o <<= 1) {
#pragma unroll
            for (int r = 0; r < NR; ++r) s[r] += __shfl_xor(s[r], o);
        }
#pragma unroll
        for (int r = 0; r < NR; ++r) { const float rstd = rsqrtf(s[r] * (1.f / DM) + EPSF);
#pragma unroll
            for (int j = 0; j < 4; ++j) __builtin_nontemporal_store((v[r][j] * rstd) * gv[j], (f32x4*)(p.out + O_Y + (size_t)(row0 + r) * DM + j * 256 + lane * 4)); }
    }
}

__device__ __forceinline__ void mixprep_phase(const Ctx& p, LAS unsigned char* lds, int l) {
    const int tid = opaque_tid(), G = gridDim.x;
    bf16_t* PROJ = (bf16_t*)(p.ws + WS_PROJ); bf16_t* TR = (bf16_t*)(p.ws + WS_TR);
    {
        const int lane = tid & 63, wave = tid >> 6, gw = blockIdx.x * 8 + wave, NGW = G * 8;
        LAS float* T = (LAS float*)(lds + wave * 17168);
        const float* sw = inp(p.ws, I_HSW) + (size_t)l * 3 * 768; const float* sb = inp(p.ws, I_HSB) + (size_t)l * 768;
        const int lr = lane >> 3, lc = lane & 7;
        for (int it = gw; it < 320 * 22; it += NGW) {
            const int cb = it % 22, rb = it / 22, row0 = rb * 64, tcol0 = cb * 64;
            int src; bool hy = false;
            if (tcol0 < 256) src = 512 + tcol0; else if (tcol0 < 384) src = 1152 + (tcol0 - 256); else if (tcol0 < 640) src = 2560 + (tcol0 - 384); else { src = 1280 + (tcol0 - 640); hy = true; }
            const bool seq_start = row0 < M_CTX ? ((row0 & 255) == 0) : (((row0 - M_CTX) & 2047) == 0);
            const int rend = row0 + 64; const bool seq_end = rend <= M_CTX ? ((rend & 255) == 0) : (((rend - M_CTX) & 2047) == 0);
            const bf16_t* sp = PROJ + (size_t)row0 * PROJW + src + lc * 8;
            u32x4 w[8], wh = (u32x4){0u, 0u, 0u, 0u};
#pragma unroll
            for (int i = 0; i < 8; ++i) w[i] = *(const u32x4*)(sp + (size_t)(i * 8 + lr) * PROJW);
            if (hy && lane < 16) { const bool top = lane < 8; const bool ok = top ? !seq_start : !seq_end;
                if (ok) wh = *(const u32x4*)(sp + (top ? -(ptrdiff_t)PROJW : (ptrdiff_t)64 * PROJW)); }
#pragma unroll
            for (int i = 0; i < 8; ++i) { LAS float* d = T + (1 + i * 8 + lr) * 65 + lc * 8;
                d[0] = bflo(w[i].x); d[1] = bfhi(w[i].x); d[2] = bflo(w[i].y); d[3] = bfhi(w[i].y); d[4] = bflo(w[i].z); d[5] = bfhi(w[i].z); d[6] = bflo(w[i].w); d[7] = bfhi(w[i].w); }
            if (hy && lane < 16) { LAS float* d = T + (lane < 8 ? 0 : 65) * 65 + lc * 8;
                d[0] = bflo(wh.x); d[1] = bfhi(wh.x); d[2] = bflo(wh.y); d[3] = bfhi(wh.y); d[4] = bflo(wh.z); d[5] = bfhi(wh.z); d[6] = bflo(wh.w); d[7] = bfhi(wh.w); }
            asm volatile("s_waitcnt lgkmcnt(0)" ::: "memory");
            const int rg = lane & 7, csub = lane >> 3;
#pragma unroll 2
            for (int j = 0; j < 8; ++j) {
                const int col = j * 8 + csub; float o[8];
                const LAS float* tp = T + (rg * 8) * 65 + col;
                if (hy) { const int ch = tcol0 - 640 + col; const float w0 = sw[ch], w1 = sw[768 + ch], w2 = sw[1536 + ch], bb = sb[ch];
                    float x[10];
#pragma unroll
                    for (int k = 0; k < 10; ++k) x[k] = tp[k * 65];
#pragma unroll
                    for (int k = 0; k < 8; ++k) o[k] = x[k] * w0 + x[k + 1] * w1 + x[k + 2] * w2 + bb;
                } else {
#pragma unroll
                    for (int k = 0; k < 8; ++k) o[k] = tp[(k + 1) * 65];
                }
                u32x4 ww; ww.x = cvt_pk_bf16(o[0], o[1]); ww.y = cvt_pk_bf16(o[2], o[3]); ww.z = cvt_pk_bf16(o[4], o[5]); ww.w = cvt_pk_bf16(o[6], o[7]);
                *(u32x4*)(TR + (size_t)(tcol0 + col) * M_TOT + row0 + rg * 8) = ww;
            }
            asm volatile("s_waitcnt lgkmcnt(0)" ::: "memory");
        }
    }
    const int gt = blockIdx.x * 512 + tid, NT = G * 512;
    for (int it = gt; it < M_CTX * 160; it += NT) {
        const int row = it / 160, ch = it - row * 160; int pc, H; size_t ob; int c8;
        if (ch < 32) { pc = 256; H = 4; ob = O_NAK; c8 = ch * 8; }
        else if (ch < 64) { pc = 512; H = 4; ob = O_NAV; c8 = (ch - 32) * 8; }
        else if (ch < 80) { pc = 1024; H = 2; ob = O_SWK; c8 = (ch - 64) * 8; }
        else if (ch < 96) { pc = 1152; H = 2; ob = O_SWV; c8 = (ch - 80) * 8; }
        else if (ch < 128) { pc = 2304; H = 4; ob = O_DFK; c8 = (ch - 96) * 8; }
        else { pc = 2560; H = 4; ob = O_DFV; c8 = (ch - 128) * 8; }
        const u32x4 w = *(const u32x4*)(PROJ + (size_t)row * PROJW + pc + c8);
        const int b = row >> 8, t = row & 255, h = c8 >> 6, d = c8 & 63;
        float* o = p.out + ob + ((((size_t)(b * 4 + l) * H + h) * 256 + t) * 64 + d);
        __builtin_nontemporal_store((f32x4){bflo(w.x), bfhi(w.x), bflo(w.y), bfhi(w.y)}, (f32x4*)o); __builtin_nontemporal_store((f32x4){bflo(w.z), bfhi(w.z), bflo(w.w), bfhi(w.w)}, (f32x4*)(o + 4));
    }
    for (int it = gt; it < M_DEC * 56; it += NT) {
        const int rowd = it / 56, q = it - rowd * 56, t = rowd & 2047, gr = t >> 6, gc = t & 63;
        int a, bofs, i0; float pos, fstep;
        if (q < 24) {
            const int base = q < 16 ? 768 : 1024, qq = q < 16 ? q : q - 16, h = qq >> 2, half = (qq >> 1) & 1, grp = qq & 1;
            a = base + h * 64 + half * 32 + grp * 8; bofs = 16; i0 = grp * 8; pos = half ? (float)gc : (float)gr; fstep = 13.287712379549449f / 16.f;
        } else {
            const int base = q < 40 ? 2048 : 2304, qq = q < 40 ? q - 24 : q - 40, mp32 = qq >> 1, half = qq & 1;
            a = base + mp32 * 32 + half * 16; bofs = 8; i0 = 0; pos = half ? (float)gc : (float)gr; fstep = 13.287712379549449f / 8.f;
        }
        bf16_t* pa = PROJ + (size_t)(M_CTX + rowd) * PROJW + a;
        const u32x4 wa = *(const u32x4*)pa, wb = *(const u32x4*)(pa + bofs);
        float xa[8], xb[8];
        xa[0] = bflo(wa.x); xa[1] = bfhi(wa.x); xa[2] = bflo(wa.y); xa[3] = bfhi(wa.y); xa[4] = bflo(wa.z); xa[5] = bfhi(wa.z); xa[6] = bflo(wa.w); xa[7] = bfhi(wa.w);
        xb[0] = bflo(wb.x); xb[1] = bfhi(wb.x); xb[2] = bflo(wb.y); xb[3] = bfhi(wb.y); xb[4] = bflo(wb.z); xb[5] = bfhi(wb.z); xb[6] = bflo(wb.w); xb[7] = bfhi(wb.w);
        float oa[8], ob[8];
#pragma unroll
        for (int j = 0; j < 8; ++j) { const float ang = pos * fast_exp2(-(float)(i0 + j) * fstep); const float cs = __cosf(ang), sn = __sinf(ang);
            oa[j] = xa[j] * cs - xb[j] * sn; ob[j] = xb[j] * cs + xa[j] * sn; }
        u32x4 ra, rb;
        ra.x = cvt_pk_bf16(oa[0], oa[1]); ra.y = cvt_pk_bf16(oa[2], oa[3]); ra.z = cvt_pk_bf16(oa[4], oa[5]); ra.w = cvt_pk_bf16(oa[6], oa[7]);
        rb.x = cvt_pk_bf16(ob[0], ob[1]); rb.y = cvt_pk_bf16(ob[2], ob[3]); rb.z = cvt_pk_bf16(ob[4], ob[5]); rb.w = cvt_pk_bf16(ob[6], ob[7]);
        *(u32x4*)pa = ra; *(u32x4*)(pa + bofs) = rb;
    }
}

struct AttnState { float m, l; f32x4 o[4]; };
__device__ __forceinline__ f32x4 mfma16(bf16x8 a, bf16x8 b, f32x4 c) { return __builtin_amdgcn_mfma_f32_16x16x32_bf16(a, b, c, 0, 0, 0); }

__device__ __forceinline__ float xmax16(float x) { const u32x2 r = __builtin_amdgcn_permlane16_swap(__float_as_uint(x), __float_as_uint(x), false, false); return fmaxf(__uint_as_float(r.x), __uint_as_float(r.y)); }
__device__ __forceinline__ float xmax32(float x) { const u32x2 r = __builtin_amdgcn_permlane32_swap(__float_as_uint(x), __float_as_uint(x), false, false); return fmaxf(__uint_as_float(r.x), __uint_as_float(r.y)); }
__device__ __forceinline__ float xadd16(float x) { const u32x2 r = __builtin_amdgcn_permlane16_swap(__float_as_uint(x), __float_as_uint(x), false, false); return __uint_as_float(r.x) + __uint_as_float(r.y); }
__device__ __forceinline__ float xadd32(float x) { const u32x2 r = __builtin_amdgcn_permlane32_swap(__float_as_uint(x), __float_as_uint(x), false, false); return __uint_as_float(r.x) + __uint_as_float(r.y); }
__device__ __forceinline__ void softmax_d16(AttnState& st, float (&s)[16], bool first, float& alpha, bool& resc, bf16x8& p0, bf16x8& p1) {
    float mx = fmaxf(fmaxf(fmaxf(s[0], s[1]), fmaxf(s[2], s[3])), fmaxf(fmaxf(s[4], s[5]), fmaxf(s[6], s[7])));
    mx = fmaxf(mx, fmaxf(fmaxf(fmaxf(s[8], s[9]), fmaxf(s[10], s[11])), fmaxf(fmaxf(s[12], s[13]), fmaxf(s[14], s[15]))));
    resc = first || (__builtin_amdgcn_ballot_w64(mx > 8.f) != 0ull);
    alpha = 1.f;
    if (resc) {
        mx = xmax16(mx); mx = xmax32(mx);
        const float d = first ? mx : fmaxf(mx, 0.f);
        alpha = first ? 0.f : fast_exp2(-d);
        st.m = first ? mx : st.m + d;
#pragma unroll
        for (int j = 0; j < 16; ++j) s[j] -= d;
    }
    float pr[16];
#pragma unroll
    for (int j = 0; j < 16; ++j) pr[j] = fast_exp2(s[j]);
    float sum = (((pr[0] + pr[1]) + (pr[2] + pr[3])) + ((pr[4] + pr[5]) + (pr[6] + pr[7]))) + (((pr[8] + pr[9]) + (pr[10] + pr[11])) + ((pr[12] + pr[13]) + (pr[14] + pr[15])));
    sum = xadd16(sum); sum = xadd32(sum);
    st.l = st.l * alpha + sum;
    u32x4 w0, w1;
    w0.x = cvt_pk_bf16(pr[0], pr[1]); w0.y = cvt_pk_bf16(pr[2], pr[3]); w0.z = cvt_pk_bf16(pr[4], pr[5]); w0.w = cvt_pk_bf16(pr[6], pr[7]);
    w1.x = cvt_pk_bf16(pr[8], pr[9]); w1.y = cvt_pk_bf16(pr[10], pr[11]); w1.z = cvt_pk_bf16(pr[12], pr[13]); w1.w = cvt_pk_bf16(pr[14], pr[15]);
    p0 = __builtin_bit_cast(bf16x8, w0); p1 = __builtin_bit_cast(bf16x8, w1);
}
__device__ __forceinline__ bf16x8 softmax_p(AttnState& st, const float (&s2)[8], unsigned vm, float& alpha) {
    float mx = -1e30f;
#pragma unroll
    for (int j = 0; j < 8; ++j) mx = fmaxf(mx, ((vm >> j) & 1u) ? s2[j] : -1e30f);
    mx = xmax16(mx); mx = xmax32(mx);
    const float mn = fmaxf(st.m, mx); alpha = fast_exp2(st.m - mn);
    float pr[8]; float sum = 0.f;
#pragma unroll
    for (int j = 0; j < 8; ++j) { pr[j] = ((vm >> j) & 1u) ? fast_exp2(s2[j] - mn) : 0.f; sum += pr[j]; }
    sum += __shfl_xor(sum, 16); sum += __shfl_xor(sum, 32);
    st.l = st.l * alpha + sum; st.m = mn;
    u32x4 pw; pw.x = cvt_pk_bf16(pr[0], pr[1]); pw.y = cvt_pk_bf16(pr[2], pr[3]); pw.z = cvt_pk_bf16(pr[4], pr[5]); pw.w = cvt_pk_bf16(pr[6], pr[7]);
    return __builtin_bit_cast(bf16x8, pw);
}
__device__ __forceinline__ bf16x8 softmax_d(AttnState& st, const float (&s2)[8], float& alpha, bool& resc) {
    float mx = fmaxf(fmaxf(fmaxf(s2[0], s2[1]), fmaxf(s2[2], s2[3])), fmaxf(fmaxf(s2[4], s2[5]), fmaxf(s2[6], s2[7])));
    mx = fmaxf(mx, __shfl_xor(mx, 16)); mx = fmaxf(mx, __shfl_xor(mx, 32));
    const float mn = fmaxf(st.m, mx);
    resc = __builtin_amdgcn_ballot_w64(mn > st.m) != 0ull;
    alpha = fast_exp2(st.m - mn);
    float pr[8];
#pragma unroll
    for (int j = 0; j < 8; ++j) pr[j] = fast_exp2(s2[j] - mn);
    float sum = ((pr[0] + pr[1]) + (pr[2] + pr[3])) + ((pr[4] + pr[5]) + (pr[6] + pr[7]));
    sum = xadd16(sum); sum = xadd32(sum);
    st.l = st.l * alpha + sum; st.m = mn;
    u32x4 pw; pw.x = cvt_pk_bf16(pr[0], pr[1]); pw.y = cvt_pk_bf16(pr[2], pr[3]); pw.z = cvt_pk_bf16(pr[4], pr[5]); pw.w = cvt_pk_bf16(pr[6], pr[7]);
    return __builtin_bit_cast(bf16x8, pw);
}
__device__ __forceinline__ void st_init(AttnState& st, float m0, float l0) { st.m = m0; st.l = l0;
#pragma unroll
    for (int i = 0; i < 4; ++i) st.o[i] = (f32x4){0.f, 0.f, 0.f, 0.f}; }

constexpr int AT_ROWB = 144;
constexpr int AT_TILEB = 64 * AT_ROWB;
struct ATC { int l15, quad, kr0, lat0, nlat, rs_w, r_w; int cg4[2], qc[2], c0[2], qt[2], q0[2]; bool dec; const float* rpb; };

template <int TYPE>
__device__ __forceinline__ void attn_tile(AttnState (&sa)[2], AttnState (&sb)[2], const bf16x8 (&qf)[2][2], const ATC& c, const LAS unsigned char* kt, const LAS unsigned char* vt, int i) {
    const bool masked = c.dec && (i < c.nlat) && (TYPE != 2);
    if (TYPE == 0 && masked) { const int krow = c.lat0 + i; if (!((krow >= c.rs_w) && (krow < c.rs_w + 8))) return; }
    const f32x4 z4 = (f32x4){0.f, 0.f, 0.f, 0.f};
    if (!masked) {
        bf16x8 pA[2][2], pB[2][2]; float alA[2], alB[2]; bool rA[2], rB[2];
        const bool first = (TYPE != 1) && (i == 0);
        if (TYPE == 2) {
#pragma unroll
            for (int qi = 0; qi < 2; ++qi)
#pragma unroll
                for (int mp = 0; mp < 2; ++mp) {
                    float s2[16];
#pragma unroll
                    for (int ss = 0; ss < 2; ++ss)
#pragma unroll
                        for (int t = 0; t < 2; ++t) { const int kr = ss * 32 + c.kr0 + 4 * t, sw = ((kr >> 4) & 1) << 2;
                            const bf16x8 kf = *(const LAS bf16x8*)(kt + kr * AT_ROWB + (((mp * 4 + c.quad) ^ sw) << 4));
                            const float nm = first ? 0.f : -(mp == 0 ? sa[qi].m : sb[qi].m);
                            const f32x4 a = mfma16(kf, qf[qi][mp], (f32x4){nm, nm, nm, nm});
#pragma unroll
                            for (int e = 0; e < 4; ++e) s2[ss * 8 + t * 4 + e] = a[e]; }
                    if (mp == 0) softmax_d16(sa[qi], s2, first, alA[qi], rA[qi], pA[qi][0], pA[qi][1]); else softmax_d16(sb[qi], s2, first, alB[qi], rB[qi], pB[qi][0], pB[qi][1]);
                    asm volatile("" ::: "memory");
                }
        } else {
            bf16x8 kf[2][2][2];
#pragma unroll
            for (int ss = 0; ss < 2; ++ss)
#pragma unroll
                for (int t = 0; t < 2; ++t) { const int kr = ss * 32 + c.kr0 + 4 * t, sw = ((kr >> 4) & 1) << 2;
#pragma unroll
                    for (int cc = 0; cc < 2; ++cc) kf[ss][t][cc] = *(const LAS bf16x8*)(kt + kr * AT_ROWB + (((cc * 4 + c.quad) ^ sw) << 4)); }
#pragma unroll
            for (int qi = 0; qi < 2; ++qi) {
                float s2[16];
#pragma unroll
                for (int ss = 0; ss < 2; ++ss)
#pragma unroll
                    for (int t = 0; t < 2; ++t) { const float nm = first ? 0.f : -sa[qi].m; f32x4 a = mfma16(kf[ss][t][0], qf[qi][0], (f32x4){nm, nm, nm, nm}); a = mfma16(kf[ss][t][1], qf[qi][1], a);
#pragma unroll
                        for (int e = 0; e < 4; ++e) s2[ss * 8 + t * 4 + e] = a[e]; }
                softmax_d16(sa[qi], s2, first, alA[qi], rA[qi], pA[qi][0], pA[qi][1]);
            }
        }
#pragma unroll
        for (int qi = 0; qi < 2; ++qi) {
            if (rA[qi]) {
#pragma unroll
                for (int nt = 0; nt < 4; ++nt) sa[qi].o[nt] = sa[qi].o[nt] * alA[qi]; }
            if (TYPE == 2) { if (rB[qi]) {
#pragma unroll
                for (int nt = 0; nt < 4; ++nt) sb[qi].o[nt] = sb[qi].o[nt] * alB[qi]; } }
        }
#pragma unroll
        for (int ss = 0; ss < 2; ++ss) {
            bf16x8 vf[4];
#pragma unroll
            for (int nt = 0; nt < 4; ++nt) vf[nt] = *(const LAS bf16x8*)(vt + (nt * 16 + c.l15) * AT_ROWB + ss * 64 + (c.quad << 4));
#pragma unroll
            for (int qi = 0; qi < 2; ++qi)
#pragma unroll
                for (int nt = 0; nt < 4; ++nt) { sa[qi].o[nt] = mfma16(vf[nt], pA[qi][ss], sa[qi].o[nt]); if (TYPE == 2) sb[qi].o[nt] = mfma16(vf[nt], pB[qi][ss], sb[qi].o[nt]); }
        }
        return;
    }
#pragma unroll 1
    for (int ss = 0; ss < 2; ++ss) {
        bool on[2];
#pragma unroll
        for (int qi = 0; qi < 2; ++qi) {
            on[qi] = true;
            if (TYPE == 0) on[qi] = !((c.cg4[qi] == 0 && ss == 1) || (c.cg4[qi] == 3 && ss == 0));
            if (TYPE == 1) { const int k0 = (c.lat0 + i) * 64 + ss * 32; on[qi] = (k0 + 31 >= c.q0[qi] - 128) && (k0 <= c.q0[qi] + 15 + 128); }
        }
        if (on[0] || on[1]) {
            const int krA = ss * 32 + c.kr0, krB = krA + 4;
            const int swA = ((krA >> 4) & 1) << 2, swB = ((krB >> 4) & 1) << 2;
            bf16x8 kf[2][2];
#pragma unroll
            for (int cc = 0; cc < 2; ++cc) { kf[0][cc] = *(const LAS bf16x8*)(kt + krA * AT_ROWB + (((cc * 4 + c.quad) ^ swA) << 4)); kf[1][cc] = *(const LAS bf16x8*)(kt + krB * AT_ROWB + (((cc * 4 + c.quad) ^ swB) << 4)); }
            bf16x8 vf[4];
#pragma unroll
            for (int nt = 0; nt < 4; ++nt) vf[nt] = *(const LAS bf16x8*)(vt + (nt * 16 + c.l15) * AT_ROWB + ss * 64 + (c.quad << 4));
#pragma unroll
            for (int qi = 0; qi < 2; ++qi) {
                if (on[qi]) {
                    f32x4 a0 = mfma16(kf[0][0], qf[qi][0], z4), a1 = mfma16(kf[1][0], qf[qi][0], z4); a0 = mfma16(kf[0][1], qf[qi][1], a0); a1 = mfma16(kf[1][1], qf[qi][1], a1);
                    float s2[8]; unsigned vm = 0u;
#pragma unroll
                    for (int e = 0; e < 4; ++e) { s2[e] = a0[e]; s2[4 + e] = a1[e]; }
                    if (TYPE == 0) {
                        const float* rp = c.rpb + (c.lat0 + i - c.r_w + 7) * 31;
#pragma unroll
                        for (int j = 0; j < 8; ++j) { const int kc = ss * 32 + c.quad * 8 + j; const bool ok = (kc >= c.c0[qi]) && (kc < c.c0[qi] + 16);
                            const int dc = min(max(kc - c.qc[qi] + 15, 0), 30); s2[j] = s2[j] + rp[dc] * LOG2E; vm |= ok ? (1u << j) : 0u; }
                    } else {
#pragma unroll
                        for (int j = 0; j < 8; ++j) { const int dd = (c.lat0 + i) * 64 + ss * 32 + c.quad * 8 + j - c.qt[qi]; const bool ok = (dd <= 128) && (dd >= -128); vm |= ok ? (1u << j) : 0u; }
                    }
                    float al; const bf16x8 pA = softmax_p(sa[qi], s2, vm, al);
#pragma unroll
                    for (int nt = 0; nt < 4; ++nt) sa[qi].o[nt] = mfma16(vf[nt], pA, sa[qi].o[nt] * al);
                }
            }
        }
    }
}

template <int TYPE>
__device__ __forceinline__ void attn_block(const Ctx& p, LAS unsigned char* lds, int l, bool dec, int b, int h, int qblk) {
    const int tid = opaque_tid(), lane = tid & 63, wave = __builtin_amdgcn_readfirstlane(tid >> 6);
    ATC c; c.l15 = lane & 15; c.quad = lane >> 4; c.dec = dec;
    const bf16_t* PROJ = (const bf16_t*)(p.ws + WS_PROJ); const bf16_t* TR = (const bf16_t*)(p.ws + WS_TR);
    const bf16_t* CK = (const bf16_t*)(p.ws + WS_CK); const bf16_t* CV = CK + CK_HALF;
    bf16_t* BR = (bf16_t*)(p.ws + WS_BR);
    const int L = dec ? 2048 : 256, rowbase = dec ? M_CTX + b * 2048 : b * 256, q0 = qblk * 256 + wave * 32;
    const bf16_t* Pb = PROJ + (size_t)rowbase * PROJW;
    LAS unsigned char* KL = lds; LAS unsigned char* VL = lds + 2 * AT_TILEB;
    int qcol, kcol, vcol, hk, Hc; size_t ckoff;
    if (TYPE == 0) { qcol = h * 64; kcol = 256 + h * 64; vcol = h * 64; hk = h; Hc = 4; ckoff = CK_NA; }
    else if (TYPE == 1) { qcol = 768 + h * 64; kcol = 1024 + (h >> 1) * 64; vcol = 256 + (h >> 1) * 64; hk = h >> 1; Hc = 2; ckoff = CK_SW; }
    else { qcol = 2048 + h * 64; kcol = 2304 + h * 64; vcol = 384 + h * 64; hk = h; Hc = 4; ckoff = CK_DF; }
    const int ncache = dec ? 8 : 0;
    c.rs_w = 0; c.r_w = 0;
    int cgb = 0;
    if (!dec) { c.lat0 = 0; c.nlat = 4; }
    else if (TYPE == 0) { const int r0 = qblk * 4; const int rsA = min(max(r0 - 4, 0), 24), rsB = min(max(r0 - 1, 0), 24); c.lat0 = rsA; c.nlat = rsB + 8 - rsA;
        c.r_w = r0 + (wave >> 1); c.rs_w = min(max(c.r_w - 4, 0), 24); cgb = (wave & 1) * 2; }
    else if (TYPE == 1) { const int q0b = qblk * 256; c.lat0 = max(q0b - 128, 0) >> 6; c.nlat = (min(q0b + 384, L) >> 6) - c.lat0; }
    else { c.lat0 = 0; c.nlat = 32; }
#pragma unroll
    for (int qi = 0; qi < 2; ++qi) { c.cg4[qi] = cgb + qi; c.q0[qi] = q0 + 16 * qi; c.qt[qi] = q0 + 16 * qi + c.l15; c.qc[qi] = c.cg4[qi] * 16 + c.l15; c.c0[qi] = min(max(c.qc[qi] - 8, 0), 48); }
    const int ntile = c.nlat + ncache;
    const int srow = tid >> 3, sch = tid & 7;
    const int kst_off = srow * AT_ROWB + ((sch ^ (((srow >> 4) & 1) << 2)) << 4), vst_off = srow * AT_ROWB + (sch << 4);
    const bf16_t* klat = Pb + kcol + (size_t)(c.lat0 * 64 + srow) * PROJW + sch * 8;
    const bf16_t* vlat = TR + (size_t)(vcol + srow) * M_TOT + rowbase + c.lat0 * 64 + sch * 8;
    const bf16_t* kcac = CK + ckoff + ((size_t)(b * Hc + hk) * 512 + srow) * 64 + sch * 8;
    const bf16_t* vcac = CV + ckoff + ((size_t)(b * Hc + hk) * 64 + srow) * 512 + sch * 8;
    c.kr0 = (c.l15 >> 2) * 8 + (c.l15 & 3);
    bf16x8 qf[2][2];
    AttnState sa[2], sb[2];
    float sc2, m0, l0;
    if (TYPE == 1) { m0 = inp(p.ws, I_SINK)[l * 4 + h] * LOG2E; l0 = 1.f; sc2 = 0.125f * LOG2E; }
    else if (TYPE == 0) { m0 = -1e30f; l0 = 0.f; sc2 = 0.125f * LOG2E; }
    else { m0 = -1e30f; l0 = 0.f; sc2 = 0.17677669529663687f * LOG2E; }
#pragma unroll
    for (int qi = 0; qi < 2; ++qi) {
        st_init(sa[qi], m0, l0); st_init(sb[qi], -1e30f, 0.f);
        const size_t qrow = (size_t)(q0 + 16 * qi + c.l15) * PROJW;
        const u32x4 q0w = *(const u32x4*)(Pb + qrow + qcol + c.quad * 8), q1w = *(const u32x4*)(Pb + qrow + qcol + 32 + c.quad * 8);
        u32x4 a, bq;
        a.x = cvt_pk_bf16(bflo(q0w.x) * sc2, bfhi(q0w.x) * sc2); a.y = cvt_pk_bf16(bflo(q0w.y) * sc2, bfhi(q0w.y) * sc2); a.z = cvt_pk_bf16(bflo(q0w.z) * sc2, bfhi(q0w.z) * sc2); a.w = cvt_pk_bf16(bflo(q0w.w) * sc2, bfhi(q0w.w) * sc2);
        bq.x = cvt_pk_bf16(bflo(q1w.x) * sc2, bfhi(q1w.x) * sc2); bq.y = cvt_pk_bf16(bflo(q1w.y) * sc2, bfhi(q1w.y) * sc2); bq.z = cvt_pk_bf16(bflo(q1w.z) * sc2, bfhi(q1w.z) * sc2); bq.w = cvt_pk_bf16(bflo(q1w.w) * sc2, bfhi(q1w.w) * sc2);
        qf[qi][0] = __builtin_bit_cast(bf16x8, a); qf[qi][1] = __builtin_bit_cast(bf16x8, bq);
    }
    c.rpb = inp(p.ws, I_RPB) + ((size_t)(l * 4 + h)) * 15 * 31;
#define AT_KSRC(n) (((n) < c.nlat) ? klat + (size_t)(n) * 64 * PROJW : kcac + (size_t)((n) - c.nlat) * 4096)
#define AT_VSRC(n) (((n) < c.nlat) ? vlat + (n) * 64 : vcac + ((n) - c.nlat) * 64)
    u32x4 kA, vA, kB, vB;
    kA = *(const u32x4*)AT_KSRC(0); vA = *(const u32x4*)AT_VSRC(0);
    { const int n1 = min(1, ntile - 1); kB = *(const u32x4*)AT_KSRC(n1); vB = *(const u32x4*)AT_VSRC(n1); }
    *(LAS u32x4*)(KL + kst_off) = kA; *(LAS u32x4*)(VL + vst_off) = vA;
    __syncthreads();
#pragma unroll 1
    for (int i = 0; i < ntile; i += 2) {
        { const int n2 = min(i + 2, ntile - 1); kA = *(const u32x4*)AT_KSRC(n2); vA = *(const u32x4*)AT_VSRC(n2); }
        attn_tile<TYPE>(sa, sb, qf, c, KL, VL, i);
        *(LAS u32x4*)(KL + AT_TILEB + kst_off) = kB; *(LAS u32x4*)(VL + AT_TILEB + vst_off) = vB;
        __syncthreads();
        if (i + 1 >= ntile) break;
        { const int n3 = min(i + 3, ntile - 1); kB = *(const u32x4*)AT_KSRC(n3); vB = *(const u32x4*)AT_VSRC(n3); }
        attn_tile<TYPE>(sa, sb, qf, c, KL + AT_TILEB, VL + AT_TILEB, i + 1);
        *(LAS u32x4*)(KL + kst_off) = kA; *(LAS u32x4*)(VL + vst_off) = vA;
        __syncthreads();
    }
#undef AT_KSRC
#undef AT_VSRC
#pragma unroll
    for (int qi = 0; qi < 2; ++qi) {
        const size_t orow = (size_t)(rowbase + q0 + 16 * qi + c.l15) * 256 + h * 64 + c.quad * 4;
        if (TYPE != 2) {
            const float il = fast_rcp(sa[qi].l);
            bf16_t* o = BR + (TYPE == 1 ? (size_t)M_TOT * 256 : 0) + orow;
#pragma unroll
            for (int nt = 0; nt < 4; ++nt) { u32x2 w; w.x = cvt_pk_bf16(sa[qi].o[nt][0] * il, sa[qi].o[nt][1] * il); w.y = cvt_pk_bf16(sa[qi].o[nt][2] * il, sa[qi].o[nt][3] * il); *(u32x2*)(o + nt * 16) = w; }
        } else {
            const float lam = ((const float*)(p.ws + WS_LAM))[l], lam_init = ((const float*)(p.ws + WS_LAM))[4 + l];
            const float i0 = fast_rcp(sa[qi].l), i1 = lam * fast_rcp(sb[qi].l);
            f32x4 d[4]; float ss = 0.f;
#pragma unroll
            for (int i = 0; i < 4; ++i) { d[i] = sa[qi].o[i] * i0 - sb[qi].o[i] * i1; ss += (d[i][0] * d[i][0] + d[i][1] * d[i][1]) + (d[i][2] * d[i][2] + d[i][3] * d[i][3]); }
            ss = xadd16(ss); ss = xadd32(ss);
            const float rs = rsqrtf(ss * (1.f / 64.f) + EPSF) * (1.f - lam_init);
            const float* sg = inp(p.ws, I_DSUB) + l * 64 + c.quad * 4;
            bf16_t* o = BR + (size_t)3 * M_TOT * 256 + orow;
#pragma unroll
            for (int nt = 0; nt < 4; ++nt) { const f32x4 g4 = *(const f32x4*)(sg + nt * 16); const f32x4 v = d[nt] * rs * g4;
                u32x2 w; w.x = cvt_pk_bf16(v[0], v[1]); w.y = cvt_pk_bf16(v[2], v[3]); *(u32x2*)(o + nt * 16) = w; }
        }
    }
}

__device__ __forceinline__ void hyena_unit(const Ctx& p, LAS unsigned char* lds, int l, int c, bool dec) {
    const int tid = opaque_tid(), lane = tid & 63, wave = __builtin_amdgcn_readfirstlane(tid >> 6), l15 = lane & 15, quad = lane >> 4;
    const int L = dec ? 2048 : 256, B = dec ? 8 : 16, LP = L + 8, rowbase = dec ? M_CTX : 0, L2 = 2 * L, CS = L2 + 16;
    LAS bf16_t* COP = (LAS bf16_t*)lds;
    LAS bf16_t* YA = (LAS bf16_t*)(lds + 66048);
    LAS bf16_t* YB = (LAS bf16_t*)(lds + 66048 + 33024);
    LAS float* RED = (LAS float*)(lds + 66048 + 2 * 33024);
    const bf16_t* TR = (const bf16_t*)(p.ws + WS_TR);
    bf16_t* BR2 = (bf16_t*)(p.ws + WS_BR) + (size_t)2 * M_TOT * 256;
    const float* HF = (const float*)(p.ws + WS_HFIL) + (dec ? 262144 : 0);
    { const bf16_t* src = TR + (size_t)(640 + c) * M_TOT + rowbase;
      for (int i = tid; i < B * L / 8; i += 512) { const int e = i * 8, b = e / L, t = e - b * L; *(LAS u32x4*)(YA + b * LP + t) = *(const u32x4*)(src + e); } }
#pragma unroll 1
    for (int o = 0; o < 2; ++o) {
        LAS float* RF = (LAS float*)(o == 0 ? YB : YA);
        __syncthreads();
        const float* raw0 = HF + ((size_t)((o * 2 + 0) * 256 + c)) * L; const float* raw1 = HF + ((size_t)((o * 2 + 1) * 256 + c)) * L;
        float part = 0.f;
        for (int u = tid; u < L2; u += 512) { const int lag = L - 1 - u; float v = 0.f; if (lag >= 0) v = raw0[lag]; else if (lag > -L) v = raw1[-lag]; RF[u] = v; part += fabsf(v); }
        part = wave_sum(part);
        if (lane == 0) RED[wave] = part;
        __syncthreads();
        float tot = 0.f;
#pragma unroll
        for (int w = 0; w < 8; ++w) tot += RED[w];
        const float inv = 1.f / (tot + EPSF);
        const int ng = L2 / 8;
        for (int idx = tid; idx < 8 * ng; idx += 512) { const int m = idx / ng, x = (idx - m * ng) * 8; float v[8];
#pragma unroll
            for (int j = 0; j < 8; ++j) { const int u = x + m + j; v[j] = (u < L2) ? RF[u] * inv : 0.f; }
            u32x4 w; w.x = cvt_pk_bf16(v[0], v[1]); w.y = cvt_pk_bf16(v[2], v[3]); w.z = cvt_pk_bf16(v[4], v[5]); w.w = cvt_pk_bf16(v[6], v[7]);
            *(LAS u32x4*)(COP + m * CS + x) = w; }
        __syncthreads();
        const LAS bf16_t* Y = (o == 0) ? YA : YB;
        const LAS bf16_t* cpb = COP + (7 - (l15 & 7)) * CS + (L - 8 - 8 * (l15 >> 3) + quad * 8);
        const float skip = inp(p.ws, I_HSKIP)[(l * 2 + o) * 256 + c];
        const bf16_t* gate = TR + (size_t)((o == 0 ? 896 : 1152) + c) * M_TOT + rowbase;
        const int ngroups = L / 64;
        const bf16x8 zero8 = (bf16x8){0, 0, 0, 0, 0, 0, 0, 0};
        for (int g = wave; g < ngroups; g += 8) {
            const int t0 = (g >> 1) * 128 + (g & 1) * 16;
            f32x4 a0 = (f32x4){0.f, 0.f, 0.f, 0.f}, a1 = a0, a2 = a0, a3 = a0;
#define HY_D(s) (*(const LAS bf16x8*)(cpb + (32 * (s) - t0)))
#define HY_Y(s) ((l15 < B) ? *(const LAS bf16x8*)(Y + l15 * LP + 32 * (s) + quad * 8) : zero8)
            bf16x8 d0, d1 = HY_D(-1), d2 = HY_D(-2), d3 = HY_D(-3), y;
            for (int s = 0; s < L / 32; s += 4) {
                d0 = HY_D(s);     y = HY_Y(s);     a0 = mfma16(d0, y, a0); a1 = mfma16(d1, y, a1); a2 = mfma16(d2, y, a2); a3 = mfma16(d3, y, a3);
                d3 = HY_D(s + 1); y = HY_Y(s + 1); a0 = mfma16(d3, y, a0); a1 = mfma16(d0, y, a1); a2 = mfma16(d1, y, a2); a3 = mfma16(d2, y, a3);
                d2 = HY_D(s + 2); y = HY_Y(s + 2); a0 = mfma16(d2, y, a0); a1 = mfma16(d3, y, a1); a2 = mfma16(d0, y, a2); a3 = mfma16(d1, y, a3);
                d1 = HY_D(s + 3); y = HY_Y(s + 3); a0 = mfma16(d1, y, a0); a1 = mfma16(d2, y, a1); a2 = mfma16(d3, y, a2); a3 = mfma16(d0, y, a3);
            }
#undef HY_D
#undef HY_Y
            if (l15 < B) {
#pragma unroll
                for (int a = 0; a < 4; ++a) {
                    const f32x4 cv = a == 0 ? a0 : (a == 1 ? a1 : (a == 2 ? a2 : a3));
                    const int t = t0 + 32 * a + quad * 4;
                    const u32x2 gw = *(const u32x2*)(gate + (size_t)l15 * L + t);
                    const u32x2 yw = *(const LAS u32x2*)(Y + l15 * LP + t);
                    f32x4 r;
                    r[0] = bflo(gw.x) * (cv[0] + skip * bflo(yw.x)); r[1] = bfhi(gw.x) * (cv[1] + skip * bfhi(yw.x));
                    r[2] = bflo(gw.y) * (cv[2] + skip * bflo(yw.y)); r[3] = bfhi(gw.y) * (cv[3] + skip * bfhi(yw.y));
                    if (o == 0) { u32x2 w; w.x = cvt_pk_bf16(r[0], r[1]); w.y = cvt_pk_bf16(r[2], r[3]); *(LAS u32x2*)(YB + l15 * LP + t) = w; }
                    else { bf16_t* op = BR2 + (size_t)(rowbase + l15 * L + t) * 256 + c;
                        op[0] = f2bf1(r[0]); op[256] = f2bf1(r[1]); op[512] = f2bf1(r[2]); op[768] = f2bf1(r[3]); }
                }
            }
        }
    }
    __syncthreads();
}

__device__ __forceinline__ void mix_phase(const Ctx& p, LAS unsigned char* lds, int l) {
    const int G = gridDim.x;
    for (int u = blockIdx.x; u < 512; u += G) hyena_unit(p, lds, l, u & 255, u < 256);
#ifdef PROBE_HY2
    for (int u = blockIdx.x; u < 512; u += G) hyena_unit(p, lds, l, u & 255, u < 256);
#endif
    const int vcu = (G % 8 == 0) ? ((int)blockIdx.x % 8) * (G / 8) + (int)blockIdx.x / 8 : (int)blockIdx.x;
#pragma unroll 1
    for (int it = vcu; it < 960; it += G) {
        if (it < 768) { const int k = it >> 8, r = it & 255, qblk = r & 7, bh = r >> 3;
            if (k == 0) attn_block<2>(p, lds, l, true, bh >> 2, bh & 3, qblk); else if (k == 1) attn_block<1>(p, lds, l, true, bh >> 2, bh & 3, qblk); else attn_block<0>(p, lds, l, true, bh >> 2, bh & 3, qblk); }
        else { const int q = it - 768, k = q >> 6, bh = q & 63;
            if (k == 0) attn_block<2>(p, lds, l, false, bh >> 2, bh & 3, 0); else if (k == 1) attn_block<1>(p, lds, l, false, bh >> 2, bh & 3, 0); else attn_block<0>(p, lds, l, false, bh >> 2, bh & 3, 0); }
    }
}

#define XB_TMO      128
#define XB_XCNT(j)  (256  + 64 * (j))
#define XB_XSUB(j)  (1280 + 64 * (j))
#define XB_XGEN(j)  (2304 + 64 * (j))
#define XB_TOP      3328
#define XB_TOPGEN   3392
#define XB_SPIN_CAP (1u << 22)
__device__ __forceinline__ unsigned xb_ld(unsigned* p)              { return __hip_atomic_load(p, __ATOMIC_RELAXED, __HIP_MEMORY_SCOPE_AGENT); }
__device__ __forceinline__ unsigned xb_add(unsigned* p, unsigned v) { return __hip_atomic_fetch_add(p, v, __ATOMIC_RELAXED, __HIP_MEMORY_SCOPE_AGENT); }
__device__ __forceinline__ unsigned xb_xcc_id() { return (unsigned)__builtin_amdgcn_s_getreg((3 << 11) | 20) & 0xFu; }
#define XB_SPIN(cond, bar) do { unsigned _sp = 0; while (cond) { __builtin_amdgcn_s_sleep(1); \
    if ((++_sp & 255u) == 0u) { if (xb_ld(&(bar)[XB_TMO])) break; if (_sp > XB_SPIN_CAP) { atomicAdd(&(bar)[XB_TMO], 1u); break; } } } } while (0)
struct XcdBarrier { unsigned* bar; unsigned x; volatile LAS unsigned* st; };
__device__ __forceinline__ XcdBarrier xcd_barrier_post(unsigned* bar, volatile LAS unsigned* st) {
    XcdBarrier b; b.bar = bar; b.x = xb_xcc_id(); b.st = st;
    if (threadIdx.x == 0) (void)xb_add(&bar[XB_XCNT(b.x)], 1u);
    return b;
}
__device__ __forceinline__ void xcd_barrier_complete(unsigned* bar, unsigned x, unsigned& nloc, unsigned& nx) {
    const unsigned G = gridDim.x * gridDim.y * gridDim.z;
    unsigned sum, cnt, mine, sp = 0u;
    for (;;) {
        sum = 0u; cnt = 0u; mine = 0u;
#pragma unroll
        for (unsigned j = 0; j < 16; ++j) { const unsigned c = xb_ld(&bar[XB_XCNT(j)]); sum += c; cnt += (c > 0u) ? 1u : 0u; mine = (j == x) ? c : mine; }
        if (sum == G) break;
        __builtin_amdgcn_s_sleep(1);
        if ((++sp & 255u) == 0u) { if (xb_ld(&bar[XB_TMO])) break; if (sp > XB_SPIN_CAP) { atomicAdd(&bar[XB_TMO], 1u); break; } }
    }
    nloc = mine > 0u ? mine : 1u; nx = cnt > 0u ? cnt : 1u;
}
__device__ __forceinline__ void xcd_barrier(const XcdBarrier& b) {
    asm volatile("s_waitcnt vmcnt(0)" ::: "memory");
    __syncthreads();
    if (threadIdx.x == 0) {
        unsigned* bar = b.bar;
        __builtin_amdgcn_s_waitcnt(0);
        unsigned nloc = b.st[0], nx = b.st[1];
        if (nloc == 0u) { xcd_barrier_complete(bar, b.x, nloc, nx); b.st[0] = nloc; b.st[1] = nx; }
        const unsigned old = xb_add(&bar[XB_XSUB(b.x)], 1u);
        const unsigned gen = old / nloc;
        if (old + 1u == (gen + 1u) * nloc) {
            __builtin_amdgcn_fence(__ATOMIC_RELEASE, "agent");
            asm volatile("s_waitcnt vmcnt(0)" ::: "memory");
            const unsigned og = xb_add(&bar[XB_TOP], 1u);
            const unsigned tg = og / nx;
            if (og + 1u == (tg + 1u) * nx) xb_add(&bar[XB_TOPGEN], 1u);
            else XB_SPIN(xb_ld(&bar[XB_TOPGEN]) == tg, bar);
            __builtin_amdgcn_fence(__ATOMIC_ACQUIRE, "agent");
            xb_add(&bar[XB_XGEN(b.x)], 1u);
            asm volatile("s_waitcnt vmcnt(0)" ::: "memory");
        } else {
            XB_SPIN(xb_ld(&bar[XB_XGEN(b.x)]) == gen, bar);
            __builtin_amdgcn_fence(__ATOMIC_ACQUIRE, "agent");
            asm volatile("s_waitcnt vmcnt(0)" ::: "memory");
        }
    }
    __syncthreads();
}

__global__ void __launch_bounds__(512, 2) mega(Params P) {
    extern __shared__ __attribute__((aligned(16))) unsigned char lds_raw[];
    LAS unsigned char* lds = (LAS unsigned char*)lds_raw;
    cg::grid_group grid = cg::this_grid();
    volatile LAS unsigned* MISC = (volatile LAS unsigned*)(lds + LDS_BYTES - 64);
    if (threadIdx.x < 16) MISC[threadIdx.x] = 0u;
    __syncthreads();
    (void)xcd_barrier_post((unsigned*)(P.ws + WS_CTL) + 1024, MISC);
#pragma unroll 1
    for (int ph = P.ph_lo; ph < P.ph_hi; ++ph) {
        GAS unsigned char* ws_g = (GAS unsigned char*)P.ws; GAS float* out_g = (GAS float*)P.out; asm volatile("" : "+s"(ws_g), "+s"(out_g));
        Ctx p; p.ws = (unsigned char*)ws_g; p.out = (float*)out_g;
        unsigned char* ws = p.ws;
        int prep_part = 0, prep_l = 0, prep_b = blockIdx.x, prep_G = gridDim.x;
        if (ph == 0) {
            { const int t0_ = opaque_tid(); if (t0_ < N_IN) { ((unsigned long long*)(ws + WS_TAB))[t0_] = (unsigned long long)P.in[t0_]; } }
            asm volatile("s_waitcnt vmcnt(0)" ::: "memory"); __syncthreads();
#ifndef NO_PREP
            prep_mod(p, lds); __syncthreads(); prep_part = 1;
#endif
        }
        else if (ph == NPH - 1) final_norm_phase(p);
        else {
#ifdef PROBE_S
            const int l = (ph - 1) / 13, sv_ = (ph - 1) % 13, s = sv_ <= PROBE_S ? sv_ : sv_ - 1;
#else
            const int l = (ph - 1) / 12, s = (ph - 1) % 12;
#endif
            const bool is_gemm = (s == 1 || s == 2 || s == 4 || s == 7 || s == 8 || s == 10 || s == 11);
            if (is_gemm) {
                pg8::Gemm g; pg8::Sched S; pg8::Epi E; bool perm;
                S.G = gridDim.x; S.c = blockIdx.x; S.mode = 0; S.nM = M_TOT / 256; S.wgm = (s == 2 || s == 8 || s == 11) ? RESID_WGM : pg8::WGM;
                E.o16 = nullptr; E.o16b = nullptr; E.of = nullptr; E.g = nullptr; E.gates = nullptr; E.scale = 1.f;
                bf16_t* ACT = (bf16_t*)(ws + WS_ACT); bf16_t* BIG = (bf16_t*)(ws + WS_BIG); float* X = (float*)(ws + WS_X);
                if (s == 1 || s == 10) { g.A = ACT; g.Bt = (const bf16_t*)(ws + wbase(l) + (s == 1 ? W_F1UP : W_F2UP)); g.K = DM; S.nN = 22; E.kind = pg8::EK_SWIGLU; E.o16 = BIG; perm = true; }
                else if (s == 2 || s == 11) { g.A = BIG; g.Bt = (const bf16_t*)(ws + wbase(l) + (s == 2 ? W_F1DN : W_F2DN)); g.K = DFF; S.nN = 4; E.kind = pg8::EK_RESID; E.of = X;
                    E.g = mod_ptr(ws, 0, l, s == 2 ? 2 : 8); E.scale = 0.5f; perm = false; }
                else if (s == 4) { g.A = ACT; g.Bt = (const bf16_t*)(ws + wbase(l) + W_IN); g.K = DM; S.nN = 27; E.kind = pg8::EK_PROJ; E.o16 = (bf16_t*)(ws + WS_PROJ); E.o16b = BIG; perm = true; }
                else if (s == 7) { g.A = (const bf16_t*)(ws + WS_BR); g.Bt = (const bf16_t*)(ws + wbase(l) + W_BR); g.K = 256; S.mode = 1; S.nN = 8; E.kind = pg8::EK_BRANCH;
                    E.o16 = ACT; E.gates = BIG; perm = false; }
                else { g.A = ACT; g.Bt = (const bf16_t*)(ws + wbase(l) + W_OUT); g.K = DM; S.nN = 4; E.kind = pg8::EK_RESID; E.of = X; E.g = mod_ptr(ws, 0, l, 5); E.scale = 1.f; perm = false; }
                S.nwg = S.nM * S.nN;
                #ifndef NO_GEMM
                if (s == 7) pg8::gemm_phase<true>(lds, g, S, E, perm); else pg8::gemm_phase<false>(lds, g, S, E, perm);
                if (blockIdx.x >= 64) {
                    if (s == 2) { prep_part = 2; prep_l = l; } else if (s == 8) { prep_part = 4; prep_l = l; } else if (s == 11 && l < 3) { prep_part = 1; prep_l = l + 1; }
                    prep_b = blockIdx.x - 64; prep_G = gridDim.x - 64;
                }
#endif
            } else if (s == 0 || s == 3 || s == 9) {
                norm_phase(p, l, s == 0 ? 0 : (s == 3 ? 1 : 2));

            } else if (s == 5) {
#ifndef NO_MIXPREP
                mixprep_phase(p, lds, l);
#endif
            } else {
#ifndef NO_MIX
                mix_phase(p, lds, l);
#ifdef PROBE_MIX2
                __syncthreads(); mix_phase(p, lds, l);
#endif
#endif
            }
        }
#ifndef NO_PREP
        if (prep_part) prep_layer(p, lds, prep_l, prep_b, prep_G, prep_part);
#endif
        if (ph + 1 < P.ph_hi) { if (P.ph_hi > 100000) grid.sync();   { XcdBarrier bar; bar.bar = (unsigned*)(p.ws + WS_CTL) + 1024; bar.x = xb_xcc_id(); bar.st = (volatile LAS unsigned*)(lds + LDS_BYTES - 64); xcd_barrier(bar); } }
    }
}

extern "C" void kernel_launch(void* const* d_in, const int* in_sizes, int n_in, void* d_out, int out_size, void* d_ws, size_t ws_size, hipStream_t stream) {
    static int grid = 0;
    if (grid == 0) {
        if (n_in != N_IN || ws_size < WS_END) { fprintf(stderr, "kernel_launch: unexpected n_in %d / ws_size %zu (need %zu)\n", n_in, ws_size, (size_t)WS_END); grid = -1; return; }
        int dev = 0, cus = 0, per_cu = 0;
        hipGetDevice(&dev); hipDeviceGetAttribute(&cus, hipDeviceAttributeMultiprocessorCount, dev);
        if (hipFuncSetAttribute((const void*)mega, hipFuncAttributeMaxDynamicSharedMemorySize, LDS_BYTES) != hipSuccess) { fprintf(stderr, "kernel_launch: hipFuncSetAttribute failed\n"); grid = -1; return; }
        if (hipOccupancyMaxActiveBlocksPerMultiprocessor(&per_cu, (const void*)mega, 512, LDS_BYTES) != hipSuccess || per_cu < 1) per_cu = 1;
        (void)hipGetLastError();
        grid = cus * 1;
        fprintf(stderr, "kernel_launch: grid %d (per_cu %d), ws %zu\n", grid, per_cu, ws_size);
    }
    if (grid < 0) return;
    hipMemsetAsync(d_ws, 0, WS_ZERO_BYTES, stream);
    Params p{};
    for (int i = 0; i < N_IN; ++i) p.in[i] = (const float*)d_in[i];
    p.out = (float*)d_out; p.ws = (unsigned char*)d_ws; p.ph_lo = 0; p.ph_hi = NPH;
    void* args[] = {&p};
    hipError_t e = hipLaunchCooperativeKernel((const void*)mega, dim3(grid), dim3(512), args, LDS_BYTES, stream);
    if (e != hipSuccess) fprintf(stderr, "cooperative launch failed: %s (grid %d)\n", hipGetErrorString(e), grid);
}
```
